# Optimizing an MI355X kernel written in HIP

```python
import math
import jax, jax.numpy as jnp
from jax import lax
import numpy as np

D_MODEL = 1024
BATCH = 4
SEQ = 4096
DEPTH = 2
DEC_BATCH = 128
DEC_SEQ = 8
PAST_LEN = 2048
PAGE_SIZE = 128

RET_HEADS = 4
RET_DK = 128
RET_DV = 128
RET_CHUNK = 128
RET_THETA = 10000.0
ATT_HEADS = 8
ATT_KV_HEADS = 2
ATT_HEAD_DIM = 64
ATT_GROUP = ATT_HEADS // ATT_KV_HEADS
ROPE_THETA = 500000.0
ROPE_DIM = ATT_HEAD_DIM // 4
IDX_HEADS = 4
IDX_DIM = 64
IDX_ROPE_DIM = IDX_DIM // 4
TOPK_MAX = 256
Q_BLOCK = 128
PLE_DIM = 256
NORM_EPS = 1e-6
GN_EPS = 1e-5

SPLIT_SIZES = (RET_HEADS * RET_DK, RET_HEADS * RET_DK, RET_HEADS * RET_DV, RET_HEADS * RET_DV,
               ATT_HEADS * ATT_HEAD_DIM, ATT_KV_HEADS * ATT_HEAD_DIM, ATT_KV_HEADS * ATT_HEAD_DIM,
               ATT_HEADS * ATT_HEAD_DIM, IDX_HEADS * IDX_DIM, IDX_DIM, IDX_HEADS, D_MODEL, D_MODEL)
IN_WIDTH = sum(SPLIT_SIZES)

kernel_name = "hybrid_retention_dsa_decode_step"


def rmsnorm(x, g):
    xf = x.astype(jnp.float32)
    r = xf * lax.rsqrt(jnp.mean(xf * xf, axis=-1, keepdims=True) + NORM_EPS)
    return (r * g.astype(jnp.float32)).astype(x.dtype)


def rope(x, pos, rot_dim, theta):
    half = rot_dim // 2
    freqs = jnp.exp(-math.log(theta) * jnp.arange(half, dtype=jnp.float32) / half)
    ang = pos.astype(jnp.float32)[:, None] * freqs[None, :]
    cos = jnp.cos(ang)[None, :, None, :]
    sin = jnp.sin(ang)[None, :, None, :]
    xf = x.astype(jnp.float32)
    x1 = xf[..., :half]
    x2 = xf[..., half:rot_dim]
    out = jnp.concatenate([x1 * cos - x2 * sin, x2 * cos + x1 * sin, xf[..., rot_dim:]], axis=-1)
    return out.astype(x.dtype)


def in_projection(h, w_in, pos, q_gain, k_gain):
    B, T, _ = h.shape
    z = jnp.einsum('btd,de->bte', h, w_in)
    offsets = np.cumsum(np.array(SPLIT_SIZES))[:-1].tolist()
    rq, rk, rv, rz, aq, ak, av, az, iq, ik, iw, gr, ga = jnp.split(z, offsets, axis=-1)
    rq = rope(rq.reshape(B, T, RET_HEADS, RET_DK), pos, RET_DK, RET_THETA)
    rk = rope(rk.reshape(B, T, RET_HEADS, RET_DK), pos, RET_DK, RET_THETA) * (RET_DK ** -0.5)
    rv = rv.reshape(B, T, RET_HEADS, RET_DV)
    aq = rope(rmsnorm(aq.reshape(B, T, ATT_HEADS, ATT_HEAD_DIM), q_gain), pos, ROPE_DIM, ROPE_THETA)
    ak = rope(rmsnorm(ak.reshape(B, T, ATT_KV_HEADS, ATT_HEAD_DIM), k_gain), pos, ROPE_DIM, ROPE_THETA)
    av = av.reshape(B, T, ATT_KV_HEADS, ATT_HEAD_DIM)
    iq = rope(iq.reshape(B, T, IDX_HEADS, IDX_DIM), pos, IDX_ROPE_DIM, ROPE_THETA)
    ik = rope(ik.reshape(B, T, 1, IDX_DIM), pos, IDX_ROPE_DIM, ROPE_THETA)[:, :, 0]
    return rq, rk, rv, rz, aq, ak, av, az, iq, ik, iw, gr, ga


def retention(q, k, v, s0):
    B, T, H, Dk = q.shape
    Dv = v.shape[-1]
    C = RET_CHUNK if T % RET_CHUNK == 0 else T
    n = T // C
    log_g = jnp.log1p(-jnp.exp2(-5.0 - jnp.arange(H, dtype=jnp.float32)))
    c = jnp.arange(C, dtype=jnp.float32)
    diff = c[:, None] - c[None, :]
    decay_intra = jnp.where(diff[None] >= 0, jnp.exp(jnp.maximum(diff, 0.0)[None] * log_g[:, None, None]), 0.0)
    decay_q = jnp.exp((c[:, None] + 1.0) * log_g[None, :])
    decay_k = jnp.exp((C - 1.0 - c)[:, None] * log_g[None, :])
    decay_s = jnp.exp(C * log_g)

    def to_chunks(a):
        return a.astype(jnp.float32).reshape(B, n, C, H, a.shape[-1]).transpose(1, 0, 2, 3, 4)

    def step(S, inp):
        qc, kc, vc = inp
        inner = jnp.einsum('bchd,bshd->bhcs', qc, kc) * decay_intra[None]
        o = (jnp.einsum('bhcs,bshe->bche', inner, vc)
             + jnp.einsum('bchd,bhde->bche', qc * decay_q[None, :, :, None], S))
        S = S * decay_s[None, :, None, None] + jnp.einsum('bchd,bche->bhde', kc * decay_k[None, :, :, None], vc)
        return S, o

    S, o = lax.scan(step, s0.astype(jnp.float32), (to_chunks(q), to_chunks(k), to_chunks(v)))
    o = o.transpose(1, 0, 2, 3, 4).reshape(B, T, H, Dv)
    return o, S


def sparse_attention(q, qpos, k_all, v_all, iq, iw, ik_all, topk):
    B, Tq = q.shape[:2]
    L = k_all.shape[1]
    causal = jnp.arange(L)[None, :] <= qpos[:, None]
    logits = jnp.einsum('bthd,bsd->bths', iq.astype(jnp.float32), ik_all.astype(jnp.float32)) * (IDX_DIM ** -0.5)
    score = jnp.einsum('bths,bth->bts', jax.nn.relu(logits), iw.astype(jnp.float32) * (IDX_HEADS ** -0.5))
    score = jnp.where(causal[None], score, -jnp.inf)
    _, sel = lax.top_k(score, topk)
    valid = sel <= qpos[None, :, None]
    kg = jax.vmap(lambda kb, ib: kb[ib])(k_all, sel)
    vg = jax.vmap(lambda vb, ib: vb[ib])(v_all, sel)
    qg = q.reshape(B, Tq, ATT_KV_HEADS, ATT_GROUP, ATT_HEAD_DIM).astype(jnp.float32)
    att = jnp.einsum('btkgd,btjkd->btkgj', qg, kg.astype(jnp.float32)) * (ATT_HEAD_DIM ** -0.5)
    att = jnp.where(valid[:, :, None, None, :], att, -jnp.inf)
    p = jax.nn.softmax(att, axis=-1)
    o = jnp.einsum('btkgj,btjkd->btkgd', p, vg.astype(jnp.float32))
    return o.reshape(B, Tq, ATT_HEADS * ATT_HEAD_DIM).astype(q.dtype)


def prompt_sparse_attention(aq, iq, iw, ak, av, ik, topk):
    B, T = aq.shape[:2]
    nb = T // Q_BLOCK

    def blk(a):
        return a.reshape(B, nb, Q_BLOCK, *a.shape[2:]).swapaxes(0, 1)

    pos_b = jnp.arange(T, dtype=jnp.int32).reshape(nb, Q_BLOCK)
    out = lax.map(lambda xs: sparse_attention(xs[0], xs[1], ak, av, xs[2], xs[3], ik, topk),
                  (blk(aq), pos_b, blk(iq), blk(iw)))
    return out.swapaxes(0, 1).reshape(B, T, -1)


def gather_pages(pool, page_table):
    g = pool[page_table]
    return g.reshape(page_table.shape[0], -1, *pool.shape[2:])


def group_norm_heads(o):
    mu = jnp.mean(o, axis=-1, keepdims=True)
    var = jnp.mean(jnp.square(o - mu), axis=-1, keepdims=True)
    return (o - mu) * lax.rsqrt(var + GN_EPS)


def decoder_layer(x, p_i, pos, ret_s0, past, topk, g_norm, w_in, q_gain, k_gain,
                  w_o_ret, w_o_att, w_out, w_ple_gate, w_ple_proj):
    B, T, _ = x.shape
    h = rmsnorm(x, g_norm)
    rq, rk, rv, rz, aq, ak, av, az, iq, ik, iw, gr, ga = in_projection(h, w_in, pos, q_gain, k_gain)
    o_r, s_new = retention(rq, rk, rv, ret_s0)
    o_r = group_norm_heads(o_r).reshape(B, T, RET_HEADS * RET_DV).astype(x.dtype)
    u_r = jnp.einsum('bte,ed->btd', o_r * jax.nn.silu(rz), w_o_ret)
    if past is None:
        o_a = prompt_sparse_attention(aq, iq, iw, ak, av, ik, topk)
    else:
        pk, pv, pik = past
        k_all = jnp.concatenate([pk.astype(ak.dtype), ak], axis=1)
        v_all = jnp.concatenate([pv.astype(av.dtype), av], axis=1)
        ik_all = jnp.concatenate([pik.astype(ik.dtype), ik], axis=1)
        o_a = sparse_attention(aq, pos, k_all, v_all, iq, iw, ik_all, topk)
    u_a = jnp.einsum('bte,ed->btd', o_a * jax.nn.silu(az), w_o_att)
    m = jax.nn.sigmoid(gr) * u_r + jax.nn.sigmoid(ga) * u_a
    x = x + jnp.einsum('btd,de->bte', m, w_out)
    gate = jax.nn.sigmoid(jnp.einsum('btd,de->bte', x, w_ple_gate))
    x = x + gate * jnp.einsum('btp,pd->btd', p_i, w_ple_proj)
    return x, ak, av, ik, s_new


def setup_inputs(seed: int = 0) -> dict:
    key = jax.random.key(seed)
    ks = jax.random.split(key, 20)
    n_pages = PAST_LEN // PAGE_SIZE
    n_used = DEC_BATCH * n_pages
    n_pool = n_used + n_used // 4
    f32 = jnp.float32
    nrm = lambda k, s, sc: jax.random.normal(k, s, f32) * sc
    x_prompt = nrm(ks[0], (BATCH, SEQ, D_MODEL), 1.0)
    x_sample = nrm(ks[1], (DEC_BATCH, DEC_SEQ, D_MODEL), 1.0)
    cache_k = nrm(ks[2], (DEPTH, n_pool, PAGE_SIZE, ATT_KV_HEADS, ATT_HEAD_DIM), 1.0)
    cache_v = nrm(ks[3], (DEPTH, n_pool, PAGE_SIZE, ATT_KV_HEADS, ATT_HEAD_DIM), 1.0)
    cache_idx_k = nrm(ks[4], (DEPTH, n_pool, PAGE_SIZE, IDX_DIM), 1.0)
    state_ret = nrm(ks[5], (DEPTH, DEC_BATCH, RET_HEADS, RET_DK, RET_DV), 0.5)
    perm = jax.random.permutation(ks[6], n_pool)[:n_used]
    page_table = perm.reshape(DEC_BATCH, n_pages).astype(jnp.int32)
    p_prompt = nrm(ks[7], (DEPTH, BATCH, SEQ, PLE_DIM), 1.0)
    p_sample = nrm(ks[8], (DEPTH, DEC_BATCH, DEC_SEQ, PLE_DIM), 1.0)
    norm_gain = 1.0 + nrm(ks[9], (DEPTH, D_MODEL), 0.1)
    w_in = nrm(ks[10], (DEPTH, D_MODEL, IN_WIDTH), D_MODEL ** -0.5)
    q_norm_gain = 1.0 + nrm(ks[11], (DEPTH, ATT_HEAD_DIM), 0.1)
    k_norm_gain = 1.0 + nrm(ks[12], (DEPTH, ATT_HEAD_DIM), 0.1)
    w_o_ret = nrm(ks[13], (DEPTH, RET_HEADS * RET_DV, D_MODEL), (RET_HEADS * RET_DV) ** -0.5)
    w_o_att = nrm(ks[14], (DEPTH, ATT_HEADS * ATT_HEAD_DIM, D_MODEL), (ATT_HEADS * ATT_HEAD_DIM) ** -0.5)
    w_out = nrm(ks[15], (DEPTH, D_MODEL, D_MODEL), D_MODEL ** -0.5)
    w_ple_gate = nrm(ks[16], (DEPTH, D_MODEL, D_MODEL), D_MODEL ** -0.5)
    w_ple_proj = nrm(ks[17], (DEPTH, PLE_DIM, D_MODEL), PLE_DIM ** -0.5)
    return {"x_prompt": x_prompt, "x_sample": x_sample, "cache_k": cache_k, "cache_v": cache_v,
            "cache_idx_k": cache_idx_k, "state_ret": state_ret, "page_table": page_table,
            "p_prompt": p_prompt, "p_sample": p_sample, "norm_gain": norm_gain, "w_in": w_in,
            "q_norm_gain": q_norm_gain, "k_norm_gain": k_norm_gain, "w_o_ret": w_o_ret,
            "w_o_att": w_o_att, "w_out": w_out, "w_ple_gate": w_ple_gate, "w_ple_proj": w_ple_proj}


def reference(x_prompt, x_sample, cache_k, cache_v, cache_idx_k, state_ret, page_table,
              p_prompt, p_sample, norm_gain, w_in, q_norm_gain, k_norm_gain, w_o_ret,
              w_o_att, w_out, w_ple_gate, w_ple_proj):
    Bp, Tp, _ = x_prompt.shape
    Bs, Ts, _ = x_sample.shape
    past_len = page_table.shape[1] * cache_k.shape[2]
    topk_prompt = min(TOPK_MAX, Tp // 4)
    topk_sample = min(TOPK_MAX, (past_len + Ts) // 4)
    pos_prompt = jnp.arange(Tp, dtype=jnp.int32)
    pos_sample = past_len + jnp.arange(Ts, dtype=jnp.int32)
    s0_prompt = jnp.zeros((Bp, RET_HEADS, RET_DK, RET_DV), jnp.float32)

    xp = x_prompt
    kp_l, vp_l, ikp_l, sp_l = [], [], [], []
    for i in range(DEPTH):
        xp, ak, av, ik, s_new = decoder_layer(
            xp, p_prompt[i], pos_prompt, s0_prompt, None, topk_prompt, norm_gain[i], w_in[i],
            q_norm_gain[i], k_norm_gain[i], w_o_ret[i], w_o_att[i], w_out[i], w_ple_gate[i], w_ple_proj[i])
        kp_l.append(ak); vp_l.append(av); ikp_l.append(ik); sp_l.append(s_new)

    xs = x_sample
    ks_l, vs_l, iks_l, ss_l = [], [], [], []
    for i in range(DEPTH):
        past = (gather_pages(cache_k[i], page_table), gather_pages(cache_v[i], page_table),
                gather_pages(cache_idx_k[i], page_table))
        xs, ak, av, ik, s_new = decoder_layer(
            xs, p_sample[i], pos_sample, state_ret[i], past, topk_sample, norm_gain[i], w_in[i],
            q_norm_gain[i], k_norm_gain[i], w_o_ret[i], w_o_att[i], w_out[i], w_ple_gate[i], w_ple_proj[i])
        ks_l.append(ak); vs_l.append(av); iks_l.append(ik); ss_l.append(s_new)

    k_prompt = jnp.stack(kp_l)
    v_prompt = jnp.stack(vp_l)
    idx_k_prompt = jnp.stack(ikp_l)
    ret_state_prompt = jnp.stack(sp_l)
    k_sample = jnp.stack(ks_l)
    v_sample = jnp.stack(vs_l)
    idx_k_sample = jnp.stack(iks_l)
    ret_state_sample = jnp.stack(ss_l)
    return (xp, xs, k_prompt, v_prompt, idx_k_prompt, ret_state_prompt,
            k_sample, v_sample, idx_k_sample, ret_state_sample)
```

```cpp
#include <hip/hip_runtime.h>
#include <cstdio>
#include <cstdint>
namespace pg8 {
#define PG8_LAS __attribute__((address_space(3)))
typedef unsigned short bf16_t;
typedef short bf16x8 __attribute__((ext_vector_type(8)));
typedef float f32x4 __attribute__((ext_vector_type(4)));
typedef unsigned u32x4 __attribute__((ext_vector_type(4)));
constexpr int BM = 256, BK = 64, HALF = 128, HTB = HALF * BK * 2  , STAGE_BYTES = 8 * HTB, NXCD = 8, WGM = 8;

__host__ __device__ __forceinline__ int lds_byte(int r, int c) { const int st = (r >> 4) * 2 + (c >> 5), rr = r & 15, cc = c & 31, ob = rr * 64 + cc * 2; return st * 1024 + (ob ^ (((ob >> 9) & 1) << 5)); }
__host__ __device__ __forceinline__ void stage_rc(int b, int& R, int& C) { const int st = b / 1024, sb = b % 1024, swz = sb ^ (((sb >> 9) & 1) << 5); R = (st >> 1) * 16 + swz / 64; C = (st & 1) * 32 + (swz % 64) / 2; }
__host__ __device__ __forceinline__ int perm32(int rho) { const int n = rho >> 4, i = rho & 15; return 8 * (i >> 2) + 4 * n + (i & 3); }

struct Unit { int pm, pn; };
struct Gemm { const bf16_t* A; const bf16_t* Bt; int M, N, K; };

struct StaticOrder {
    int nM, nN, nwg, G, c;
    __host__ __device__ void init(int M, int N, int G_, int c_) { nM = M / BM; nN = N / BM; nwg = nM * nN; G = G_; c = c_; }
    __host__ __device__ bool next(int i, Unit& u) const {
        const int L = i * G + c; if (L >= nwg) return false;
        int wgid = L; { const int q = nwg / NXCD, r = nwg % NXCD, xcd = wgid % NXCD, off = wgid / NXCD; wgid = (xcd < r ? xcd * (q + 1) : r * (q + 1) + (xcd - r) * q) + off; }
        const int nig = WGM * nN, gid = wgid / nig, fm = gid * WGM, gsz = (nM - fm) < WGM ? (nM - fm) : WGM;
        u.pm = fm + ((wgid % nig) % gsz); u.pn = (wgid % nig) / gsz; return true;
    }
    __device__ __forceinline__ void a_ready(const Unit&) const {}
    __device__ __forceinline__ void done(const Unit&) const {}
};
__device__ __forceinline__ unsigned cvt_pk_bf16(float lo, float hi) { unsigned r; asm volatile("v_cvt_pk_bf16_f32 %0, %1, %2" : "=v"(r) : "v"(lo), "v"(hi)); return r; }

template <class Epi, class Sched, bool ALIGN_EPI = false, bool SP2 = false>
__device__ __forceinline__ void gemm_phase(PG8_LAS unsigned char* lds, const Gemm g, const Sched& S, const Epi& E, int tid_) {
    asm volatile("" : "+v"(tid_)); const int tid = tid_, wid = __builtin_amdgcn_readfirstlane(tid >> 6), lane = tid & 63, wr = wid >> 2, wc = wid & 3, fr = lane & 15, fq = lane >> 4;
    const int K = g.K, nt = K / BK;
    unsigned voffA[2], voffB[2];
#pragma unroll
    for (int i = 0; i < 2; ++i) { int R, C; stage_rc(tid * 16 + i * 8192, R, C); const int Rb = Epi::PERM ? ((R & ~31) + perm32(R & 31)) : R;
        voffA[i] = (unsigned)(R * K + C) * 2u; voffB[i] = (unsigned)(Rb * K + C) * 2u; }
    const size_t kstep = (size_t)(BK * 2);
    const size_t hstep = (size_t)HALF * K * 2;
    const size_t tstep = 2 * hstep;
    const unsigned ldsw = (unsigned)wid * 1024u;
    const int aoff = lds_byte(wr * 64 + fr, fq * 8), boff = lds_byte(wc * 32 + fr, fq * 8);
#define PG8_SA(b, h) (((b) * 2 + (h)) * HTB)
#define PG8_SB(b, h) ((4 + (b) * 2 + (h)) * HTB)
#define PG8_STAGE(bufoff, gbase, voff) do { _Pragma("unroll") for (int _i = 0; _i < 2; ++_i) \
        __builtin_amdgcn_global_load_lds((const unsigned*)((const char*)(gbase) + (voff)[_i]), (PG8_LAS unsigned*)(lds + (bufoff) + ldsw + _i * 8192), 16, 0, 0); } while (0)
#define PG8_LDA(dst, b, h) do { _Pragma("unroll") for (int m = 0; m < 4; ++m) _Pragma("unroll") for (int k = 0; k < 2; ++k) dst[m][k] = *(const PG8_LAS bf16x8*)(lds + PG8_SA(b, h) + aoff + m * 2048 + k * 1024); } while (0)
#define PG8_LDB(dst, b, h) do { _Pragma("unroll") for (int n = 0; n < 2; ++n) _Pragma("unroll") for (int k = 0; k < 2; ++k) dst[n][k] = *(const PG8_LAS bf16x8*)(lds + PG8_SB(b, h) + boff + n * 2048 + k * 1024); } while (0)
#define PG8_MMA(ai, bj, At, Bt) do { __builtin_amdgcn_s_setprio(1); _Pragma("unroll") for (int m = 0; m < 4; ++m) _Pragma("unroll") for (int n = 0; n < 2; ++n) _Pragma("unroll") for (int k = 0; k < 2; ++k) \
        acc[ai][bj][m][n] = __builtin_amdgcn_mfma_f32_16x16x32_bf16(Bt[n][k], At[m][k], acc[ai][bj][m][n], 0, 0, 0); __builtin_amdgcn_s_setprio(0); } while (0)
#define PG8_WAIT_V(n) asm volatile("s_waitcnt vmcnt(" #n ")" ::: "memory")
#define PG8_WAIT_L(n) asm volatile("s_waitcnt lgkmcnt(" #n ")" ::: "memory")
#define PG8_BAR __builtin_amdgcn_s_barrier()
#define PG8_SCHED __builtin_amdgcn_sched_barrier(0)
    Unit cur, nxt; int ui = 0;
    if (!S.next(0, cur)) return;
    f32x4 acc[2][2][4][2];
#pragma unroll
    for (int a = 0; a < 2; ++a)
#pragma unroll
        for (int b = 0; b < 2; ++b)
#pragma unroll
            for (int m = 0; m < 4; ++m)
#pragma unroll
                for (int n = 0; n < 2; ++n) acc[a][b][m][n] = (f32x4){0.f, 0.f, 0.f, 0.f};
    bf16x8 At[4][2], B0[2][2], B1[2][2];
    const char* cA = (const char*)g.A + (size_t)cur.pm * tstep; const char* cB = (const char*)g.Bt + (size_t)cur.pn * tstep;
    S.a_ready(cur);
    if constexpr (SP2) {
        PG8_STAGE(PG8_SB(0, 0), cB, voffB); PG8_STAGE(PG8_SB(0, 1), cB + hstep, voffB); PG8_STAGE(PG8_SA(0, 0), cA, voffA); PG8_STAGE(PG8_SA(0, 1), cA + hstep, voffA);
        if (wr == 1) PG8_BAR;
        PG8_WAIT_V(2); PG8_BAR;
        PG8_STAGE(PG8_SB(1, 0), cB + kstep, voffB); PG8_STAGE(PG8_SA(1, 0), cA + kstep, voffA); PG8_STAGE(PG8_SB(1, 1), cB + hstep + kstep, voffB);
        PG8_WAIT_V(6); PG8_BAR;
    } else {
        PG8_STAGE(PG8_SB(0, 0), cB, voffB); PG8_STAGE(PG8_SA(0, 0), cA, voffA); PG8_STAGE(PG8_SB(0, 1), cB + hstep, voffB); PG8_STAGE(PG8_SA(0, 1), cA + hstep, voffA);
        if (wr == 1) PG8_BAR;
        PG8_WAIT_V(4); PG8_BAR;
        PG8_STAGE(PG8_SB(1, 0), cB + kstep, voffB); PG8_STAGE(PG8_SA(1, 0), cA + kstep, voffA); PG8_STAGE(PG8_SB(1, 1), cB + hstep + kstep, voffB);
        PG8_WAIT_V(6); PG8_BAR;
    }
    for (;;) {
        const bool has_next = S.next(ui + 1, nxt);
        const char* nA = has_next ? (const char*)g.A + (size_t)nxt.pm * tstep : cA; const char* nB = has_next ? (const char*)g.Bt + (size_t)nxt.pn * tstep : cB;
        for (int t = 0; t < nt; t += 2) {
            const bool last = (t == nt - 2);
            const char* a1 = cA + (size_t)(t + 1) * kstep;
            const char* a2 = last ? nA : cA + (size_t)(t + 2) * kstep; const char* b2 = last ? nB : cB + (size_t)(t + 2) * kstep;
            const char* a3 = a2 + kstep; const char* b3 = b2 + kstep;
            if (last && has_next) S.a_ready(nxt);
            if constexpr (SP2) {
            PG8_LDB(B0, 0, 0); PG8_LDB(B1, 0, 1); PG8_SCHED; PG8_LDA(At, 0, 0); PG8_STAGE(PG8_SA(1, 1), a1 + hstep, voffA);
            PG8_WAIT_V(8); PG8_WAIT_L(0); PG8_BAR; PG8_MMA(0, 0, At, B0); PG8_MMA(0, 1, At, B1); PG8_BAR; PG8_SCHED;
            PG8_LDA(At, 0, 1); PG8_STAGE(PG8_SB(0, 0), b2, voffB); PG8_STAGE(PG8_SB(0, 1), b2 + hstep, voffB); PG8_STAGE(PG8_SA(0, 0), a2, voffA);
            PG8_WAIT_V(8); PG8_WAIT_L(0); PG8_BAR; PG8_MMA(1, 0, At, B0); PG8_MMA(1, 1, At, B1); PG8_BAR; PG8_SCHED;
            PG8_LDB(B0, 1, 0); PG8_LDB(B1, 1, 1); PG8_SCHED; PG8_LDA(At, 1, 0); PG8_STAGE(PG8_SA(0, 1), a2 + hstep, voffA);
            PG8_WAIT_V(8); PG8_WAIT_L(0); PG8_BAR; PG8_MMA(0, 0, At, B0); PG8_MMA(0, 1, At, B1); PG8_BAR; PG8_SCHED;
            PG8_LDA(At, 1, 1); PG8_STAGE(PG8_SB(1, 0), b3, voffB); PG8_STAGE(PG8_SB(1, 1), b3 + hstep, voffB); PG8_STAGE(PG8_SA(1, 0), a3, voffA);
            PG8_WAIT_V(8); PG8_WAIT_L(0); PG8_BAR; PG8_MMA(1, 0, At, B0); PG8_MMA(1, 1, At, B1); PG8_BAR; PG8_SCHED;
            } else {
            PG8_LDB(B0, 0, 0); PG8_SCHED; PG8_LDA(At, 0, 0); PG8_STAGE(PG8_SA(1, 1), a1 + hstep, voffA);
            PG8_WAIT_L(8); PG8_BAR; PG8_WAIT_L(0); PG8_MMA(0, 0, At, B0); PG8_BAR; PG8_SCHED;
            PG8_LDB(B1, 0, 1); PG8_STAGE(PG8_SB(0, 0), b2, voffB);
            PG8_BAR; PG8_WAIT_L(0); PG8_MMA(0, 1, At, B1); PG8_BAR;
            PG8_LDA(At, 0, 1); PG8_STAGE(PG8_SA(0, 0), a2, voffA);
            PG8_BAR; PG8_WAIT_L(0); PG8_MMA(1, 0, At, B0); PG8_BAR; PG8_SCHED;
            PG8_STAGE(PG8_SB(0, 1), b2 + hstep, voffB);
            PG8_WAIT_V(6); PG8_BAR; PG8_MMA(1, 1, At, B1); PG8_BAR;
            PG8_LDB(B0, 1, 0); PG8_SCHED; PG8_LDA(At, 1, 0); PG8_STAGE(PG8_SA(0, 1), a2 + hstep, voffA);
            PG8_WAIT_L(8); PG8_BAR; PG8_WAIT_L(0); PG8_MMA(0, 0, At, B0); PG8_BAR; PG8_SCHED;
            PG8_LDB(B1, 1, 1); PG8_STAGE(PG8_SB(1, 0), b3, voffB);
            PG8_BAR; PG8_WAIT_L(0); PG8_MMA(0, 1, At, B1); PG8_BAR;
            PG8_LDA(At, 1, 1); PG8_STAGE(PG8_SA(1, 0), a3, voffA);
            PG8_BAR; PG8_WAIT_L(0); PG8_MMA(1, 0, At, B0); PG8_BAR; PG8_SCHED;
            PG8_STAGE(PG8_SB(1, 1), b3 + hstep, voffB);
            PG8_WAIT_V(6); PG8_BAR; PG8_MMA(1, 1, At, B1); PG8_BAR;
            }
        }
        if constexpr (ALIGN_EPI) { if (wr == 0) PG8_BAR; }
        if constexpr (!Epi::AFTER_DRAIN) { E(acc, cur, wr, wc, fr, fq); S.done(cur); }
        if (!has_next) break;
#pragma unroll
        for (int a = 0; a < 2; ++a)
#pragma unroll
            for (int b = 0; b < 2; ++b)
#pragma unroll
                for (int m = 0; m < 4; ++m)
#pragma unroll
                    for (int n = 0; n < 2; ++n) acc[a][b][m][n] = (f32x4){0.f, 0.f, 0.f, 0.f};
        cur = nxt; cA = nA; cB = nB; ++ui;
        if constexpr (ALIGN_EPI) { if (wr == 1) PG8_BAR; }
    }
    PG8_WAIT_V(0);
    if constexpr (!ALIGN_EPI) { if (wr == 0) PG8_BAR; }
    PG8_BAR;
    if constexpr (Epi::AFTER_DRAIN) { E.fused(acc, cur, wr, wc, fr, fq, lds, wid, lane); S.done(cur); }
#undef PG8_SA
#undef PG8_SB
#undef PG8_STAGE
#undef PG8_LDA
#undef PG8_LDB
#undef PG8_MMA
#undef PG8_WAIT_V
#undef PG8_WAIT_L
#undef PG8_BAR
#undef PG8_SCHED
}
}

#define GAS __attribute__((address_space(1)))
#define LAS __attribute__((address_space(3)))
typedef unsigned short bf16;
typedef float f32x4 __attribute__((ext_vector_type(4)));
typedef float f32x2 __attribute__((ext_vector_type(2)));
typedef float f32x16 __attribute__((ext_vector_type(16)));
typedef short bf16x8 __attribute__((ext_vector_type(8)));
typedef unsigned u32x4 __attribute__((ext_vector_type(4)));
typedef unsigned u32x2 __attribute__((ext_vector_type(2)));

constexpr int NWAVES = 8, NTHREADS = 512;
constexpr int DM = 1024, NB = 4, SEQ = 4096, DEPTH = 2, DB = 128, DS = 8, PAST = 2048, NPAGES = 16, NPOOL = 2560;
constexpr int MP = NB * SEQ, MS = DB * DS, MT = MP + MS;
constexpr int NZ = 5888;
constexpr int WIN_N = 5700;
constexpr int ZC_RQ = 0, ZC_RK = 512, ZC_RV = 1024, ZC_RZ = 1536, ZC_AQ = 2048, ZC_AK = 2560, ZC_AV = 2688, ZC_AZ = 2816, ZC_IQ = 3328, ZC_IK = 3584, ZC_IW = 3648, ZC_GR = 3712, ZC_GA = 4736;
constexpr int SS_LD = 2064;
constexpr int TOPK = 256;
constexpr size_t O_Y = 0, O_KP = 17825792, O_VP = 22020096, O_IKP = 26214400, O_RSP = 28311552, O_KS = 28835840, O_VS = 29097984, O_IKS = 29360128, O_RSS = 29491200, O_END = 46268416;
constexpr size_t MiB = 1u << 20;
constexpr size_t WS_CTL = 0, CTL_ZERO_BYTES = 1 * MiB;
constexpr size_t WS_WIN = 1 * MiB, WS_WOR = 24 * MiB, WS_WOA = 26 * MiB, WS_WOUT = 28 * MiB, WS_WPG = 32 * MiB, WS_WPP = 36 * MiB;
constexpr size_t WS_ROPER = 37 * MiB, WS_ROPEA = 39 * MiB, WS_ROWSS0 = 39 * MiB + 256 * 1024, WS_IW = 39 * MiB + 512 * 1024;
constexpr size_t WS_XB0 = 40 * MiB, WS_XB1 = 74 * MiB, WS_X1 = 108 * MiB, WS_TMP = 176 * MiB, WS_MB = 244 * MiB, WS_Z = 278 * MiB;
constexpr size_t WS_RQ = 474 * MiB, WS_RK = 490 * MiB, WS_RKT = 506 * MiB, WS_RVT = 522 * MiB, WS_AQ = 538 * MiB, WS_KB = 555 * MiB, WS_VB = 559 * MiB;
constexpr size_t WS_IQ = 563 * MiB, WS_IKB = 572 * MiB, WS_PB = 930 * MiB, WS_KVT = 583 * MiB, WS_ST = 615 * MiB, WS_OGR = 631 * MiB, WS_OGA = 648 * MiB;
constexpr size_t WS_SS = 665 * MiB, WS_SP = 674 * MiB, WS_END = 948 * MiB;
static_assert(WS_Z + (size_t)MT * NZ * 2 <= WS_RQ && WS_SS + (size_t)MS * SS_LD * 4 <= WS_SP && WS_IW + (size_t)MT * 16 <= WS_XB0, "ws map");
constexpr int CW_TMO = 0, CW_BAR = 4096, CW_ROWSS1 = 131072;
constexpr int N_PHASES = 1 + 8 * DEPTH;
constexpr int RING_BYTES = 131072, MISC_OFF = RING_BYTES + 320, XPOSE_OFF = RING_BYTES + 1024, LDS_BYTES = XPOSE_OFF + 8 * 2048;

#define LDS_WAIT() asm volatile("s_waitcnt lgkmcnt(0)" ::: "memory")
#define VM_WAIT() asm volatile("s_waitcnt vmcnt(0)" ::: "memory")
__device__ __forceinline__ unsigned pk2(float lo, float hi) { unsigned r; asm("v_cvt_pk_bf16_f32 %0, %1, %2" : "=v"(r) : "v"(lo), "v"(hi)); return r; }
__device__ __forceinline__ float bflo(unsigned w) { return __uint_as_float(w << 16); }
__device__ __forceinline__ float bfhi(unsigned w) { return __uint_as_float(w & 0xffff0000u); }
__device__ __forceinline__ float bf2f(bf16 b) { return __uint_as_float(((unsigned)b) << 16); }
__device__ __forceinline__ float sigmoidf_(float x) { return __builtin_amdgcn_rcpf(1.0f + __builtin_amdgcn_exp2f(x * -1.4426950408889634f)); }
__device__ __forceinline__ float siluf_(float x) { return x * sigmoidf_(x); }
__device__ __forceinline__ void unpack8(const u32x4 w, float (&f)[8]) { f[0] = bflo(w.x); f[1] = bfhi(w.x); f[2] = bflo(w.y); f[3] = bfhi(w.y); f[4] = bflo(w.z); f[5] = bfhi(w.z); f[6] = bflo(w.w); f[7] = bfhi(w.w); }
__device__ __forceinline__ u32x4 pack8(const float (&f)[8]) { u32x4 w; w.x = pk2(f[0], f[1]); w.y = pk2(f[2], f[3]); w.z = pk2(f[4], f[5]); w.w = pk2(f[6], f[7]); return w; }
__device__ __forceinline__ bf16x8 as_bf16x8(const u32x4 w) { return __builtin_bit_cast(bf16x8, w); }
__device__ __forceinline__ f32x4 mfma16(bf16x8 a, bf16x8 b, f32x4 c) { return __builtin_amdgcn_mfma_f32_16x16x32_bf16(a, b, c, 0, 0, 0); }
__device__ __forceinline__ f32x16 mfma32(bf16x8 a, bf16x8 b, f32x16 c) { return __builtin_amdgcn_mfma_f32_32x32x16_bf16(a, b, c, 0, 0, 0); }
__device__ __forceinline__ float ret_log2g(int h) { return h == 0 ? -0.04580369f : h == 1 ? -0.022720076f : h == 2 ? -0.011315313f : -0.0056465627f; }
__device__ __forceinline__ int mbcnt64(unsigned long long m) { return (int)__builtin_amdgcn_mbcnt_hi((unsigned)(m >> 32), __builtin_amdgcn_mbcnt_lo((unsigned)m, 0u)); }

template <int M> __device__ __forceinline__ float shx(float v, int lane) {
    if constexpr (M < 32) return __int_as_float(__builtin_amdgcn_ds_swizzle(__float_as_int(v), 0x1F | (M << 10)));
    else return __int_as_float(__builtin_amdgcn_ds_bpermute((lane ^ 32) << 2, __float_as_int(v)));
}
__device__ __forceinline__ float wave_sum(float v, int lane) { v += shx<1>(v, lane); v += shx<2>(v, lane); v += shx<4>(v, lane); v += shx<8>(v, lane); v += shx<16>(v, lane); v += shx<32>(v, lane); return v; }

#define XB_TMO      128
#define XB_XCNT(j)  (256  + 64 * (j))
#define XB_XSUB(j)  (1280 + 64 * (j))
#define XB_XGEN(j)  (2304 + 64 * (j))
#define XB_TOP      3328
#define XB_TOPGEN   3392
#define XCD_BAR_WORDS 3456
#define XB_SPIN_CAP (1u << 18)
__device__ __forceinline__ unsigned xb_ld(unsigned* p)              { return __hip_atomic_load(p, __ATOMIC_RELAXED, __HIP_MEMORY_SCOPE_AGENT); }
__device__ __forceinline__ unsigned xb_add(unsigned* p, unsigned v) { return __hip_atomic_fetch_add(p, v, __ATOMIC_RELAXED, __HIP_MEMORY_SCOPE_AGENT); }
__device__ __forceinline__ unsigned xb_xcc_id() { return (unsigned)__builtin_amdgcn_s_getreg((3 << 11) | 20) & 0xFu; }
#define XB_SPIN(cond, bar) do { unsigned _sp = 0; while (cond) { __builtin_amdgcn_s_sleep(1); \
    if ((++_sp & 255u) == 0u) { if (xb_ld(&(bar)[XB_TMO])) break; if (_sp > XB_SPIN_CAP) { atomicAdd(&(bar)[XB_TMO], 1u); break; } } } } while (0)
struct XcdBarrier { unsigned* bar; unsigned x; volatile LAS unsigned* st; };
__device__ __forceinline__ XcdBarrier xcd_barrier_post(unsigned* bar, volatile LAS unsigned* st, bool leader) {
    XcdBarrier b; b.bar = bar; b.x = xb_xcc_id(); b.st = st;
    if (leader) (void)xb_add(&bar[XB_XCNT(b.x)], 1u);
    return b;
}
__device__ __forceinline__ void xcd_barrier_complete(unsigned* bar, unsigned x, unsigned& nloc, unsigned& nx) {
    const unsigned G = gridDim.x * gridDim.y * gridDim.z;
    unsigned sum, cnt, mine, sp = 0u;
    for (;;) {
        sum = 0u; cnt = 0u; mine = 0u;
#pragma unroll
        for (unsigned j = 0; j < 16; ++j) { const unsigned c = xb_ld(&bar[XB_XCNT(j)]); sum += c; cnt += (c > 0u) ? 1u : 0u; mine = (j == x) ? c : mine; }
        if (sum == G) break;
        __builtin_amdgcn_s_sleep(1);
        if ((++sp & 255u) == 0u) { if (xb_ld(&bar[XB_TMO])) break; if (sp > XB_SPIN_CAP) { atomicAdd(&bar[XB_TMO], 1u); break; } }
    }
    nloc = mine > 0u ? mine : 1u; nx = cnt > 0u ? cnt : 1u;
}
__device__ __forceinline__ void xcd_barrier(const XcdBarrier& b, bool leader) {
    asm volatile("s_waitcnt vmcnt(0)" ::: "memory");
    __syncthreads();
    if (leader) {
        unsigned* bar = b.bar;
        __builtin_amdgcn_s_waitcnt(0);
        unsigned nloc = b.st[0], nx = b.st[1];
        if (nloc == 0u) { xcd_barrier_complete(bar, b.x, nloc, nx); b.st[0] = nloc; b.st[1] = nx; }
        const unsigned old = xb_add(&bar[XB_XSUB(b.x)], 1u);
        const unsigned gen = old / nloc;
        if (old + 1u == (gen + 1u) * nloc) {
            __builtin_amdgcn_fence(__ATOMIC_RELEASE, "agent");
            asm volatile("s_waitcnt vmcnt(0)" ::: "memory");
            const unsigned og = xb_add(&bar[XB_TOP], 1u);
            const unsigned tg = og / nx;
            if (og + 1u == (tg + 1u) * nx) xb_add(&bar[XB_TOPGEN], 1u);
            else XB_SPIN(xb_ld(&bar[XB_TOPGEN]) == tg, bar);
            __builtin_amdgcn_fence(__ATOMIC_ACQUIRE, "agent");
            xb_add(&bar[XB_XGEN(b.x)], 1u);
            asm volatile("s_waitcnt vmcnt(0)" ::: "memory");
        } else {
            XB_SPIN(xb_ld(&bar[XB_XGEN(b.x)]) == gen, bar);
            __builtin_amdgcn_fence(__ATOMIC_ACQUIRE, "agent");
            asm volatile("s_waitcnt vmcnt(0)" ::: "memory");
        }
    }
    __syncthreads();
}

struct Params { const float* in[18]; float* out; unsigned char* ws; int ph_lo, ph_hi, li, pad; };
enum { I_XP = 0, I_XS, I_CK, I_CV, I_CIK, I_STATE, I_PT, I_PP, I_PS, I_GAIN, I_WIN, I_QG, I_KG, I_WOR, I_WOA, I_WOUT, I_WPG, I_WPP };
struct Ctx { int tid, lane, wave, gw, ngw, nblk, blk; LAS unsigned char* lds; };
typedef const __attribute__((address_space(4))) Params* PK;
__device__ __forceinline__ PK phase_args() { PK p = (PK)__builtin_amdgcn_kernarg_segment_ptr(); asm volatile("" : "+s"(p)); return p; }
__device__ __forceinline__ int hw_lane(int salt = 0) { int l; asm volatile("v_mbcnt_lo_u32_b32 %0, -1, 0 ; %1\n\tv_mbcnt_hi_u32_b32 %0, -1, %0" : "=v"(l) : "s"(salt)); return l; }
__device__ __forceinline__ Ctx phase_ctx(LAS unsigned char* lds, int wave_s, int salt) { Ctx C; int tid = wave_s * 64 + hw_lane(salt); asm volatile("" : "+v"(tid)); C.lds = lds; C.tid = tid; C.lane = tid & 63; C.wave = __builtin_amdgcn_readfirstlane(tid >> 6);
    int bx = blockIdx.x; asm volatile("" : "+s"(bx)); C.nblk = gridDim.x; C.blk = bx; C.gw = C.blk * NWAVES + C.wave; C.ngw = C.nblk * NWAVES; return C; }

__device__ __forceinline__ int win_orig_col(int np) {
    const int pn = np >> 8, c = np & 255, bj = c >> 7, cc = c & 127, wc = cc >> 5, l8 = cc & 31;
    if (pn < 4) { const int head = 2 * (pn & 1) + bj, dim = (cc >> 1) + 64 * (cc & 1); return (pn < 2 ? 0 : 512) + head * 128 + dim; }
    if (pn < 8) return np;
    if (pn == 11 || pn == 12) return np;
    if (pn <= 10 || pn == 13) { const int dimp = 32 * bj + l8; const bool rope = !(pn == 10 && wc >= 2);
        const int dim = (rope && dimp < 16) ? (dimp >> 1) + 8 * (dimp & 1) : dimp;
        if (pn < 10) return 2048 + (4 * (pn - 8) + wc) * 64 + dim;
        if (pn == 10) return 2560 + wc * 64 + dim;
        return 3328 + wc * 64 + dim; }
    if (np < 3584 + 64) { const int dimp = np - 3584; return 3584 + (dimp < 16 ? (dimp >> 1) + 8 * (dimp & 1) : dimp); }
    if (np < 3652) return np;
    if (np < ZC_GR) return -1;
    if (np < ZC_GR + 2048) return np - (ZC_GR - 3652);
    return -1;
}
struct EpiZ {
    static constexpr bool PERM = true, AFTER_DRAIN = false;
    unsigned char* ws; float* out; const float* rowss; const float* qgain; const float* kgain; int L; LAS unsigned char* xl;
    __device__ __forceinline__ void rope16(float (&x)[8], const f32x2* ropeA, int fq, int hl) const {
        float lo[4], hi[4];
#pragma unroll
        for (int k = 0; k < 4; ++k) { const f32x2 cs = ropeA[(fq & 1) * 4 + k]; lo[k] = x[2 * k] * cs[0] - x[2 * k + 1] * cs[1]; hi[k] = x[2 * k + 1] * cs[0] + x[2 * k] * cs[1]; }
        float rc[4];
#pragma unroll
        for (int k = 0; k < 4; ++k) rc[k] = shx<16>(fq == 0 ? hi[k] : lo[k], hl);
        if (fq == 0) {
#pragma unroll
            for (int k = 0; k < 4; ++k) { x[k] = lo[k]; x[4 + k] = rc[k]; } }
        else if (fq == 1) {
#pragma unroll
            for (int k = 0; k < 4; ++k) { x[k] = rc[k]; x[4 + k] = hi[k]; } }
    }
    __device__ __forceinline__ void operator()(const f32x4 (&acc)[2][2][4][2], const pg8::Unit& u, int wr, int wc, int, int) const {
        const int hl = hw_lane(), fr = hl & 15, fq = hl >> 4;
        const int pn = u.pn; const bool prompt = u.pm < MP / 256;
        const int row0 = u.pm * 256 + wr * 64 + fr;
        bf16* Z = (bf16*)(ws + WS_Z);
        if (prompt && pn >= 2 && pn < 6) {
            const bool isk = pn < 4; LAS unsigned char* xt = xl + (wr * 4 + wc) * 2048;
            const int b = (u.pm * 256) >> 12, tpan = (u.pm * 256) & (SEQ - 1);
#pragma unroll
            for (int ai = 0; ai < 2; ++ai)
#pragma unroll
                for (int bj = 0; bj < 2; ++bj) { const int head = 2 * (pn & 1) + bj;
#pragma unroll
                    for (int mp = 0; mp < 2; ++mp) {
#pragma unroll
                        for (int mm = 0; mm < 2; ++mm) { const int m = 2 * mp + mm; const int row = row0 + ai * 128 + m * 16, t = row & (SEQ - 1);
                            const float rs = __builtin_amdgcn_rsqf(rowss[row] * (1.0f / 1024.0f) + 1e-6f);
                            float x[8];
#pragma unroll
                            for (int j = 0; j < 4; ++j) { x[j] = acc[ai][bj][m][0][j] * rs; x[4 + j] = acc[ai][bj][m][1][j] * rs; }
                            const int t32 = 16 * mm + fr;
                            if (isk) { const int p0 = 16 * wc + 4 * fq; const f32x2* rr = (const f32x2*)(ws + WS_ROPER) + (size_t)t * 64 + p0; float lo[4], hi[4];
#pragma unroll
                                for (int k = 0; k < 4; ++k) { const f32x2 cs = rr[k]; lo[k] = (x[2 * k] * cs[0] - x[2 * k + 1] * cs[1]) * 0.08838834764831845f; hi[k] = (x[2 * k + 1] * cs[0] + x[2 * k] * cs[1]) * 0.08838834764831845f; }
                                bf16* q = (bf16*)(ws + WS_RK) + (size_t)row * 512 + head * 128 + p0;
                                u32x2 a, c; a.x = pk2(lo[0], lo[1]); a.y = pk2(lo[2], lo[3]); c.x = pk2(hi[0], hi[1]); c.y = pk2(hi[2], hi[3]); *(u32x2*)q = a; *(u32x2*)(q + 64) = c;
                                const float dk = __builtin_amdgcn_exp2f((float)(127 - (t & 127)) * ret_log2g(head));
#pragma unroll
                                for (int k = 0; k < 4; ++k) { *(LAS bf16*)(xt + (4 * fq + k) * 64 + 2 * t32) = (bf16)(pk2(lo[k] * dk, 0.f) & 0xffffu); *(LAS bf16*)(xt + (16 + 4 * fq + k) * 64 + 2 * t32) = (bf16)(pk2(hi[k] * dk, 0.f) & 0xffffu); }
                            } else {
#pragma unroll
                                for (int j = 0; j < 8; ++j) *(LAS bf16*)(xt + (8 * fq + j) * 64 + 2 * t32) = (bf16)(pk2(x[j], 0.f) & 0xffffu); } }
                        asm volatile("s_waitcnt lgkmcnt(0)" ::: "memory");
#pragma unroll
                        for (int i = 0; i < 2; ++i) { const int c = hl + 64 * i, dl = c >> 2, q4 = c & 3; const u32x4 v = *(const LAS u32x4*)(xt + dl * 64 + 16 * q4);
                            const int d = isk ? 16 * wc + (dl & 15) + 64 * (dl >> 4) : 32 * wc + dl;
                            bf16* dst = (bf16*)(ws + (isk ? WS_RKT : WS_RVT)) + ((size_t)(b * 4 + head) * 128 + d) * SEQ + tpan + 128 * ai + 64 * wr + 32 * mp + 8 * q4;
                            *(u32x4*)dst = v; }
                        asm volatile("s_waitcnt lgkmcnt(0)" ::: "memory"); } }
            return;
        }
#define EZ_X(bj_, xv_) float xv_[8]; _Pragma("unroll") for (int j_ = 0; j_ < 4; ++j_) { xv_[j_] = acc[ai][bj_][m][0][j_] * rs; xv_[4 + j_] = acc[ai][bj_][m][1][j_] * rs; }
#pragma unroll
        for (int ai = 0; ai < 2; ++ai)
#pragma unroll
            for (int m = 0; m < 4; ++m) {
                const int row = row0 + ai * 128 + m * 16; const float rs = __builtin_amdgcn_rsqf(rowss[row] * (1.0f / 1024.0f) + 1e-6f);
                const int pos = prompt ? (row & (SEQ - 1)) : PAST + ((row - MP) & 7);
                const unsigned zrow = (unsigned)row * NZ;
                if (pn < 4) {
                    const int p0 = 16 * wc + 4 * fq; const bool isk = pn >= 2;
                    if (!prompt) {
#pragma unroll
                        for (int bj = 0; bj < 2; ++bj) { EZ_X(bj, x) const int hc = (isk ? ZC_RK : ZC_RQ) + (2 * (pn & 1) + bj) * 128;
                            u32x2 a, b; a.x = pk2(x[0], x[2]); a.y = pk2(x[4], x[6]); b.x = pk2(x[1], x[3]); b.y = pk2(x[5], x[7]);
                            *(u32x2*)(Z + zrow + hc + p0) = a; *(u32x2*)(Z + zrow + hc + 64 + p0) = b; }
                    } else {
                        const f32x2* rr = (const f32x2*)(ws + WS_ROPER) + (size_t)pos * 64 + p0; const int b = row >> 12, t = row & (SEQ - 1);
                        f32x2 cs[4];
#pragma unroll
                        for (int k = 0; k < 4; ++k) cs[k] = rr[k];
#pragma unroll
                        for (int bj = 0; bj < 2; ++bj) { EZ_X(bj, x) const int head = 2 * (pn & 1) + bj; float lo[4], hi[4];
#pragma unroll
                            for (int k = 0; k < 4; ++k) { lo[k] = x[2 * k] * cs[k][0] - x[2 * k + 1] * cs[k][1]; hi[k] = x[2 * k + 1] * cs[k][0] + x[2 * k] * cs[k][1]; }
                            if (!isk) { bf16* q = (bf16*)(ws + WS_RQ) + (size_t)row * 512 + head * 128 + p0;
                                u32x2 a, c; a.x = pk2(lo[0], lo[1]); a.y = pk2(lo[2], lo[3]); c.x = pk2(hi[0], hi[1]); c.y = pk2(hi[2], hi[3]); *(u32x2*)q = a; *(u32x2*)(q + 64) = c; }
                            else { const float sc = 0.08838834764831845f;
#pragma unroll
                                for (int k = 0; k < 4; ++k) { lo[k] *= sc; hi[k] *= sc; }
                                bf16* q = (bf16*)(ws + WS_RK) + (size_t)row * 512 + head * 128 + p0;
                                u32x2 a, c; a.x = pk2(lo[0], lo[1]); a.y = pk2(lo[2], lo[3]); c.x = pk2(hi[0], hi[1]); c.y = pk2(hi[2], hi[3]); *(u32x2*)q = a; *(u32x2*)(q + 64) = c;
                                const float dk = __builtin_amdgcn_exp2f((float)(127 - (t & 127)) * ret_log2g(head));
                                bf16* kt = (bf16*)(ws + WS_RKT) + ((size_t)(b * 4 + head) * 128 + p0) * SEQ + t;
#pragma unroll
                                for (int k = 0; k < 4; ++k) { kt[(size_t)k * SEQ] = (bf16)(pk2(lo[k] * dk, 0.f) & 0xffffu); kt[(size_t)(64 + k) * SEQ] = (bf16)(pk2(hi[k] * dk, 0.f) & 0xffffu); } } }
                    }
                } else if (pn < 6 && prompt) {
                    const int b = row >> 12, t = row & (SEQ - 1);
#pragma unroll
                    for (int bj = 0; bj < 2; ++bj) { EZ_X(bj, x) bf16* vt = (bf16*)(ws + WS_RVT) + ((size_t)(b * 4 + 2 * (pn & 1) + bj) * 128 + 32 * wc + 8 * fq) * SEQ + t;
#pragma unroll
                        for (int j = 0; j < 8; ++j) vt[(size_t)j * SEQ] = (bf16)(pk2(x[j], 0.f) & 0xffffu); }
                } else if (pn == 8 || pn == 9 || pn == 10 || pn == 13) {
                    const bool norm = (pn < 10) || (pn == 10 && wc < 2), rope = norm || pn == 13;
                    EZ_X(0, x0) EZ_X(1, x1)
                    if (norm) { float ss = 0.f;
#pragma unroll
                        for (int j = 0; j < 8; ++j) ss += x0[j] * x0[j] + x1[j] * x1[j];
                        ss += shx<16>(ss, hl); ss += shx<32>(ss, hl);
                        const float rr = __builtin_amdgcn_rsqf(ss * (1.0f / 64.0f) + 1e-6f); const float* gn = (pn < 10) ? qgain : kgain;
#pragma unroll
                        for (int j = 0; j < 8; ++j) { const int d0 = (fq < 2) ? 4 * fq + (j >> 1) + 8 * (j & 1) : 8 * fq + j; x0[j] *= rr * gn[d0]; x1[j] *= rr * gn[32 + 8 * fq + j]; } }
                    if (rope) rope16(x0, (const f32x2*)(ws + WS_ROPEA) + (size_t)pos * 8, fq, hl);
                    if (pn < 10) { bf16* q = (bf16*)(ws + WS_AQ) + (size_t)row * 512 + (4 * (pn - 8) + wc) * 64 + 8 * fq; *(u32x4*)q = pack8(x0); *(u32x4*)(q + 32) = pack8(x1); }
                    else if (pn == 13) { bf16* q = (bf16*)(ws + WS_IQ) + (size_t)row * 256 + wc * 64 + 8 * fq; *(u32x4*)q = pack8(x0); *(u32x4*)(q + 32) = pack8(x1); }
                    else { const bool isk = wc < 2; const int hk = wc & 1;
                        float* dst = (isk ? (prompt ? out + O_KP + ((size_t)L * MP + row) * 128 : out + O_KS + ((size_t)L * MS + (row - MP)) * 128)
                                          : (prompt ? out + O_VP + ((size_t)L * MP + row) * 128 : out + O_VS + ((size_t)L * MS + (row - MP)) * 128)) + hk * 64 + 8 * fq;
                        *(f32x4*)dst = (f32x4){x0[0], x0[1], x0[2], x0[3]}; *(f32x4*)(dst + 4) = (f32x4){x0[4], x0[5], x0[6], x0[7]};
                        *(f32x4*)(dst + 32) = (f32x4){x1[0], x1[1], x1[2], x1[3]}; *(f32x4*)(dst + 36) = (f32x4){x1[4], x1[5], x1[6], x1[7]};
                        if (prompt) { bf16* d2 = (bf16*)(ws + (isk ? WS_KB : WS_VB)) + (size_t)row * 128 + hk * 64 + 8 * fq; *(u32x4*)d2 = pack8(x0); *(u32x4*)(d2 + 32) = pack8(x1); } }
                } else if (pn == 14) {
                    { EZ_X(0, x0)
                      if (wc == 0) rope16(x0, (const f32x2*)(ws + WS_ROPEA) + (size_t)pos * 8, fq, hl);
                      if (wc < 2) { float* dst = (prompt ? out + O_IKP + ((size_t)L * MP + row) * 64 : out + O_IKS + ((size_t)L * MS + (row - MP)) * 64) + 32 * wc + 8 * fq;
                          *(f32x4*)dst = (f32x4){x0[0], x0[1], x0[2], x0[3]}; *(f32x4*)(dst + 4) = (f32x4){x0[4], x0[5], x0[6], x0[7]};
                          if (prompt) *(u32x4*)((bf16*)(ws + WS_IKB) + (size_t)row * 64 + 32 * wc + 8 * fq) = pack8(x0); }
                      else if (wc == 2 && fq == 0) *(f32x4*)((float*)(ws + WS_IW) + (size_t)row * 4) = (f32x4){x0[0] * 0.0625f, x0[1] * 0.0625f, x0[2] * 0.0625f, x0[3] * 0.0625f}; }
                    { EZ_X(1, x1) *(u32x4*)(Z + zrow + pn * 256 + 128 + 32 * wc + 8 * fq) = pack8(x1); }
                } else {
#pragma unroll
                    for (int bj = 0; bj < 2; ++bj) { EZ_X(bj, x) *(u32x4*)(Z + zrow + pn * 256 + 128 * bj + 32 * wc + 8 * fq) = pack8(x); }
                }
                asm volatile("" ::: "memory"); }
#undef EZ_X
    }
};

struct InProjOrder {
    pg8::StaticOrder base; int G, c;
    __device__ void init(int G_, int c_) { base.init(MP, NZ, G_, c_); G = G_; c = c_; }
    __device__ bool next(int i, pg8::Unit& u) const {
        const int L = i * G + c; const int np = (MP / 256) * (NZ / 256);
        if (L < np) return base.next(i, u);
        const int l2 = L - np; if (l2 >= 4 * 15) return false;
        u.pm = MP / 256 + l2 / 15; u.pn = l2 % 15; return true;
    }
    __device__ __forceinline__ void a_ready(const pg8::Unit&) const {}
    __device__ __forceinline__ void done(const pg8::Unit&) const {}
};
template <int MODE> struct EpiGate {
    static constexpr bool PERM = true, AFTER_DRAIN = false;
    const bf16* Z; int gcol; bf16* TMP; bf16* MB;
    __device__ __forceinline__ void operator()(const f32x4 (&acc)[2][2][4][2], const pg8::Unit& u, int wr, int wc, int, int) const {
        const int hl_ = hw_lane(), fr = hl_ & 15, fq = hl_ >> 4;
        const int row0 = u.pm * 256 + wr * 64 + fr, col0 = u.pn * 256 + wc * 32 + 8 * fq;
#pragma unroll
        for (int ai = 0; ai < 2; ++ai)
#pragma unroll
            for (int m = 0; m < 4; ++m) { const int row = row0 + ai * 128 + m * 16;
#pragma unroll
                for (int bj = 0; bj < 2; ++bj) { const int col = col0 + bj * 128; const unsigned off = (unsigned)row * DM + (unsigned)col;
                    const u32x4 gw = *(const u32x4*)(Z + ((unsigned)row * NZ + (unsigned)(gcol + col))); float g[8]; unpack8(gw, g);
                    const f32x4 a0 = acc[ai][bj][m][0], a1 = acc[ai][bj][m][1];
                    float r[8];
#pragma unroll
                    for (int j = 0; j < 4; ++j) { r[j] = sigmoidf_(g[j]) * a0[j]; r[4 + j] = sigmoidf_(g[4 + j]) * a1[j]; }
                    if (MODE == 0) *(u32x4*)(TMP + off) = pack8(r);
                    else { float t[8]; unpack8(*(const u32x4*)(TMP + off), t);
#pragma unroll
                        for (int j = 0; j < 8; ++j) r[j] += t[j];
                        *(u32x4*)(MB + off) = pack8(r); } }
                asm volatile("" ::: "memory"); }
    }
};
struct EpiRes {
    static constexpr bool PERM = true, AFTER_DRAIN = false;
    const float* xa; const float* xb; const bf16* xh; bf16* XB1;
    __device__ __forceinline__ void operator()(const f32x4 (&acc)[2][2][4][2], const pg8::Unit& u, int wr, int wc, int, int) const {
        const int hl_ = hw_lane(), fr = hl_ & 15, fq = hl_ >> 4;
        const int row0 = u.pm * 256 + wr * 64 + fr, col0 = u.pn * 256 + wc * 32 + 8 * fq;
#pragma unroll
        for (int ai = 0; ai < 2; ++ai)
#pragma unroll
            for (int m = 0; m < 4; ++m) { const int row = row0 + ai * 128 + m * 16;
                const float* xr = (u.pm < MP / 256) ? xa : xb - (size_t)MP * DM;
#pragma unroll
                for (int bj = 0; bj < 2; ++bj) { const unsigned off = (unsigned)row * DM + (unsigned)(col0 + bj * 128);
                    float x[8];
                    if (xh != nullptr) unpack8(*(const u32x4*)(xh + off), x);
                    else { const f32x4 x0 = *(const f32x4*)(xr + off), x1 = *(const f32x4*)(xr + off + 4); x[0] = x0[0]; x[1] = x0[1]; x[2] = x0[2]; x[3] = x0[3]; x[4] = x1[0]; x[5] = x1[1]; x[6] = x1[2]; x[7] = x1[3]; }
                    const f32x4 a0 = acc[ai][bj][m][0], a1 = acc[ai][bj][m][1];
#pragma unroll
                    for (int j = 0; j < 4; ++j) { x[j] += a0[j]; x[4 + j] += a1[j]; }
                    *(u32x4*)(XB1 + off) = pack8(x); }
                asm volatile("" ::: "memory"); }
    }
};
template <int MODE> struct EpiPle {
    static constexpr bool PERM = true, AFTER_DRAIN = false;
    bf16* TMP; const bf16* XB1; float* Y; bf16* XB0; float* rowss;
    __device__ __forceinline__ void operator()(const f32x4 (&acc)[2][2][4][2], const pg8::Unit& u, int wr, int wc, int, int) const {
        const int hl_ = hw_lane(), fr = hl_ & 15, fq = hl_ >> 4;
        const int row0 = u.pm * 256 + wr * 64 + fr, col0 = u.pn * 256 + wc * 32 + 8 * fq;
#pragma unroll
        for (int ai = 0; ai < 2; ++ai)
#pragma unroll
            for (int m = 0; m < 4; ++m) { const int row = row0 + ai * 128 + m * 16; float ssq = 0.f;
#pragma unroll
                for (int bj = 0; bj < 2; ++bj) { const unsigned off = (unsigned)row * DM + (unsigned)(col0 + bj * 128);
                    const f32x4 a0 = acc[ai][bj][m][0], a1 = acc[ai][bj][m][1];
                    if (MODE == 0) { float r[8];
#pragma unroll
                        for (int j = 0; j < 4; ++j) { r[j] = sigmoidf_(a0[j]); r[4 + j] = sigmoidf_(a1[j]); }
                        *(u32x4*)(TMP + off) = pack8(r); }
                    else { float t[8], x[8]; unpack8(*(const u32x4*)(TMP + off), t); unpack8(*(const u32x4*)(XB1 + off), x);
#pragma unroll
                        for (int j = 0; j < 4; ++j) { x[j] += t[j] * a0[j]; x[4 + j] += t[4 + j] * a1[j]; }
                        if (MODE == 2) { *(f32x4*)(Y + off) = (f32x4){x[0], x[1], x[2], x[3]}; *(f32x4*)(Y + off + 4) = (f32x4){x[4], x[5], x[6], x[7]}; }
                        *(u32x4*)(XB0 + off) = pack8(x);
                        if (MODE == 1) {
#pragma unroll
                            for (int j = 0; j < 8; ++j) ssq += x[j] * x[j]; } }
                    asm volatile("" ::: "memory"); }
                if (MODE == 1) { const int ln_ = fr + 16 * fq; ssq += shx<16>(ssq, ln_); ssq += shx<32>(ssq, ln_); if (fq == 0) atomicAdd(rowss + row, ssq); }
                asm volatile("" ::: "memory"); }
    }
};
__device__ __forceinline__ void p0_transpose_item(const float* W, int ldw, int K, const float* gain, bf16* WT, int nblk, int item, bool win_map, LAS float* scr, int lane) {
    const int kb = item / nblk, nb = item % nblk, k0 = 64 * kb, n0 = 32 * nb;
    const int np = n0 + (lane & 31); int n = np; bool valid = true;
    if (win_map) { n = win_orig_col(np); valid = n >= 0; if (!valid) n = 0; }
#pragma unroll 8
    for (int i = 0; i < 32; ++i) { const int kk = 2 * i + (lane >> 5); float v = valid ? W[(size_t)(k0 + kk) * ldw + n] : 0.f; if (gain) v *= gain[k0 + kk]; scr[kk * 33 + (lane & 31)] = v; }
    LDS_WAIT(); asm volatile("" ::: "memory");
    const int c = lane & 7;
#pragma unroll
    for (int j = 0; j < 4; ++j) { const int nn = (lane >> 3) + 8 * j; const LAS float* s = scr + (8 * c) * 33 + nn;
        u32x4 o; o.x = pk2(s[0 * 33], s[1 * 33]); o.y = pk2(s[2 * 33], s[3 * 33]); o.z = pk2(s[4 * 33], s[5 * 33]); o.w = pk2(s[6 * 33], s[7 * 33]);
        *(u32x4*)(WT + (size_t)(n0 + nn) * K + k0 + 8 * c) = o; }
    LDS_WAIT(); asm volatile("" ::: "memory");
}
__device__ __forceinline__ void p0_prologue(PK P, const Ctx& C) {
    unsigned char* ws = P->ws;
    LAS float* scr = (LAS float*)(C.lds + C.wave * 16384);
    constexpr int I_IN = 16 * (NZ / 32), I_OR = 8 * 32, I_OUT = 16 * 32, I_PPJ = 4 * 32, I_LAYER = I_IN + 2 * I_OR + 2 * I_OUT + I_PPJ;
    for (int it = C.gw; it < DEPTH * I_LAYER; it += C.ngw) {
        const int L = it / I_LAYER; int r = it % I_LAYER;
        if (r < I_IN) { p0_transpose_item(P->in[I_WIN] + (size_t)L * DM * WIN_N, WIN_N, DM, P->in[I_GAIN] + L * DM, (bf16*)(ws + WS_WIN) + (size_t)L * NZ * DM, NZ / 32, r, true, scr, C.lane); continue; } r -= I_IN;
        if (r < I_OR) { p0_transpose_item(P->in[I_WOR] + (size_t)L * 512 * DM, DM, 512, nullptr, (bf16*)(ws + WS_WOR) + (size_t)L * DM * 512, 32, r, false, scr, C.lane); continue; } r -= I_OR;
        if (r < I_OR) { p0_transpose_item(P->in[I_WOA] + (size_t)L * 512 * DM, DM, 512, nullptr, (bf16*)(ws + WS_WOA) + (size_t)L * DM * 512, 32, r, false, scr, C.lane); continue; } r -= I_OR;
        if (r < I_OUT) { p0_transpose_item(P->in[I_WOUT] + (size_t)L * DM * DM, DM, DM, nullptr, (bf16*)(ws + WS_WOUT) + (size_t)L * DM * DM, 32, r, false, scr, C.lane); continue; } r -= I_OUT;
        if (r < I_OUT) { p0_transpose_item(P->in[I_WPG] + (size_t)L * DM * DM, DM, DM, nullptr, (bf16*)(ws + WS_WPG) + (size_t)L * DM * DM, 32, r, false, scr, C.lane); continue; } r -= I_OUT;
        p0_transpose_item(P->in[I_WPP] + (size_t)L * 256 * DM, DM, 256, nullptr, (bf16*)(ws + WS_WPP) + (size_t)L * DM * 256, 32, r, false, scr, C.lane);
    }
    bf16* XB0 = (bf16*)(ws + WS_XB0); float* rowss0 = (float*)(ws + WS_ROWSS0);
    for (int row = C.gw; row < MT; row += C.ngw) {
        const float* xr = (row < MP) ? P->in[I_XP] + (size_t)row * DM : P->in[I_XS] + (size_t)(row - MP) * DM;
        float ss = 0.f;
#pragma unroll
        for (int j = 0; j < 4; ++j) { const f32x4 v = *(const f32x4*)(xr + 256 * j + 4 * C.lane); ss += (v[0] * v[0] + v[1] * v[1]) + (v[2] * v[2] + v[3] * v[3]);
            u32x2 w; w.x = pk2(v[0], v[1]); w.y = pk2(v[2], v[3]); *(u32x2*)(XB0 + (size_t)row * DM + 256 * j + 4 * C.lane) = w; }
        ss = wave_sum(ss, C.lane);
        if (C.lane == 0) rowss0[row] = ss;
    }
    for (int r = C.gw; r < DEPTH * MT; r += C.ngw) { const int L = r / MT, row = r - L * MT;
        const float* pr = (row < MP) ? P->in[I_PP] + ((size_t)L * MP + row) * 256 : P->in[I_PS] + ((size_t)L * MS + (row - MP)) * 256;
        const f32x4 v = *(const f32x4*)(pr + 4 * C.lane); u32x2 w; w.x = pk2(v[0], v[1]); w.y = pk2(v[2], v[3]); *(u32x2*)((bf16*)(ws + WS_PB) + ((size_t)L * MT + row) * 256 + 4 * C.lane) = w; }
    f32x2* rr = (f32x2*)(ws + WS_ROPER); f32x2* ra = (f32x2*)(ws + WS_ROPEA);
    for (int i = C.blk * NTHREADS + C.tid; i < 4096 * 64; i += C.nblk * NTHREADS) { const int pos = i >> 6, k = i & 63;
        const float fr = expf((-9.210340371976184f * (float)k) / 64.0f), ang = (float)pos * fr; rr[i] = (f32x2){cosf(ang), sinf(ang)}; }
    for (int i = C.blk * NTHREADS + C.tid; i < 4096 * 8; i += C.nblk * NTHREADS) { const int pos = i >> 3, k = i & 7;
        const float fr = expf((-13.122363377404328f * (float)k) / 8.0f), ang = (float)pos * fr; ra[i] = (f32x2){cosf(ang), sinf(ang)}; }
}

constexpr int LDT = 272;
__device__ __forceinline__ void post_ret_tile(PK P, const Ctx& C, int unit) {
    unsigned char* ws = P->ws; const bf16* Z = (const bf16*)(ws + WS_Z);
    const int b = unit >> 7, h = (unit >> 5) & 3, n = unit & 31, t0 = n * 128; const int bh = b * 4 + h;
    LAS unsigned char* TK = C.lds; LAS unsigned char* TV = C.lds + 128 * LDT;
    const f32x2* ropeR = (const f32x2*)(ws + WS_ROPER);
    bf16* RQ = (bf16*)(ws + WS_RQ); bf16* RK = (bf16*)(ws + WS_RK);
    const float lg2 = ret_log2g(h);
#pragma unroll
    for (int u = 0; u < 2; ++u) {
        const int idx = C.tid + 512 * u, r = idx >> 3, j = idx & 7, t = t0 + r; const size_t grow = (size_t)b * SEQ + t;
        float cs[8], sn[8];
#pragma unroll
        for (int e = 0; e < 8; e += 2) { const f32x4 v = *(const f32x4*)(ropeR + (size_t)t * 64 + 8 * j + e); cs[e] = v[0]; sn[e] = v[1]; cs[e + 1] = v[2]; sn[e + 1] = v[3]; }
        { float x1[8], x2[8], o1[8], o2[8]; unpack8(*(const u32x4*)(Z + grow * NZ + ZC_RQ + h * 128 + 8 * j), x1); unpack8(*(const u32x4*)(Z + grow * NZ + ZC_RQ + h * 128 + 64 + 8 * j), x2);
#pragma unroll
          for (int e = 0; e < 8; ++e) { o1[e] = x1[e] * cs[e] - x2[e] * sn[e]; o2[e] = x2[e] * cs[e] + x1[e] * sn[e]; }
          *(u32x4*)(RQ + grow * 512 + h * 128 + 8 * j) = pack8(o1); *(u32x4*)(RQ + grow * 512 + h * 128 + 64 + 8 * j) = pack8(o2); }
        { float x1[8], x2[8], o1[8], o2[8]; unpack8(*(const u32x4*)(Z + grow * NZ + ZC_RK + h * 128 + 8 * j), x1); unpack8(*(const u32x4*)(Z + grow * NZ + ZC_RK + h * 128 + 64 + 8 * j), x2);
          const float sc = 0.08838834764831845f, dk = __builtin_amdgcn_exp2f((float)(127 - r) * lg2);
#pragma unroll
          for (int e = 0; e < 8; ++e) { o1[e] = (x1[e] * cs[e] - x2[e] * sn[e]) * sc; o2[e] = (x2[e] * cs[e] + x1[e] * sn[e]) * sc; }
          *(u32x4*)(RK + grow * 512 + h * 128 + 8 * j) = pack8(o1); *(u32x4*)(RK + grow * 512 + h * 128 + 64 + 8 * j) = pack8(o2);
#pragma unroll
          for (int e = 0; e < 8; ++e) { *(LAS bf16*)(TK + (8 * j + e) * LDT + 2 * r) = (bf16)(pk2(o1[e] * dk, 0.f) & 0xffffu); *(LAS bf16*)(TK + (64 + 8 * j + e) * LDT + 2 * r) = (bf16)(pk2(o2[e] * dk, 0.f) & 0xffffu); } }
    }
#pragma unroll
    for (int u = 0; u < 4; ++u) {
        const int idx = C.tid + 512 * u, r = idx >> 4, c = idx & 15; const size_t grow = (size_t)b * SEQ + t0 + r;
        const u32x4 w = *(const u32x4*)(Z + grow * NZ + ZC_RV + h * 128 + 8 * c);
        const unsigned ww[4] = {w.x, w.y, w.z, w.w};
#pragma unroll
        for (int e = 0; e < 4; ++e) { *(LAS bf16*)(TV + (8 * c + 2 * e) * LDT + 2 * r) = (bf16)(ww[e] & 0xffffu); *(LAS bf16*)(TV + (8 * c + 2 * e + 1) * LDT + 2 * r) = (bf16)(ww[e] >> 16); }
    }
    __syncthreads();
    bf16* RKT = (bf16*)(ws + WS_RKT); bf16* RVT = (bf16*)(ws + WS_RVT);
#pragma unroll
    for (int u = 0; u < 4; ++u) {
        const int idx = C.tid + 512 * u, d = idx >> 4, c = idx & 15;
        const u32x4 a = *(const LAS u32x4*)(TK + d * LDT + 16 * c), v = *(const LAS u32x4*)(TV + d * LDT + 16 * c);
        *(u32x4*)(RKT + ((size_t)bh * 128 + d) * SEQ + t0 + 8 * c) = a; *(u32x4*)(RVT + ((size_t)bh * 128 + d) * SEQ + t0 + 8 * c) = v;
    }
    __syncthreads();
}
__device__ __forceinline__ void post_token(PK P, const Ctx& C, int L, int row) {
    unsigned char* ws = P->ws; const bf16* Zr = (const bf16*)(ws + WS_Z) + (size_t)row * NZ; const int lane = C.lane;
    const bool prompt = row < MP; const int sb = (row - MP) >> 3, sc = (row - MP) & 7;
    const int pos = prompt ? (row & (SEQ - 1)) : PAST + sc;
    const f32x2* ropeA = (const f32x2*)(ws + WS_ROPEA) + (size_t)pos * 8;
    const int c8 = lane & 7;
    float cs[8], sn[8];
#pragma unroll
    for (int e = 0; e < 8; e += 2) { const f32x4 v = *(const f32x4*)(ropeA + e); cs[e] = v[0]; sn[e] = v[1]; cs[e + 1] = v[2]; sn[e + 1] = v[3]; }
    { float x[8]; unpack8(*(const u32x4*)(Zr + ZC_AQ + 8 * lane), x);
      float ss = 0.f;
#pragma unroll
      for (int e = 0; e < 8; ++e) ss += x[e] * x[e];
      ss += shx<1>(ss, lane); ss += shx<2>(ss, lane); ss += shx<4>(ss, lane);
      const float rs = __builtin_amdgcn_rsqf(ss * (1.0f / 64.0f) + 1e-6f);
      const float* qg = P->in[I_QG] + L * 64 + 8 * c8; float o[8];
#pragma unroll
      for (int e = 0; e < 8; ++e) { const float y = x[e] * rs * qg[e]; const float pr = shx<1>(y, lane); o[e] = (c8 == 0) ? y * cs[e] - pr * sn[e] : (c8 == 1) ? y * cs[e] + pr * sn[e] : y; }
      *(u32x4*)((bf16*)(ws + WS_AQ) + (size_t)row * 512 + 8 * lane) = pack8(o); }
    { float x[8]; unpack8(*(const u32x4*)(Zr + ZC_AK + 8 * (lane & 31)), x);
      float ss = 0.f;
#pragma unroll
      for (int e = 0; e < 8; ++e) ss += x[e] * x[e];
      ss += shx<1>(ss, lane); ss += shx<2>(ss, lane); ss += shx<4>(ss, lane);
      const float rs = __builtin_amdgcn_rsqf(ss * (1.0f / 64.0f) + 1e-6f);
      const float* kg = P->in[I_KG] + L * 64 + 8 * c8; float o[8]; const bool isk = (lane & 31) < 16;
#pragma unroll
      for (int e = 0; e < 8; ++e) { const float y = isk ? x[e] * rs * kg[e] : x[e]; const float pr = shx<1>(y, lane); o[e] = (isk && c8 == 0) ? y * cs[e] - pr * sn[e] : (isk && c8 == 1) ? y * cs[e] + pr * sn[e] : y; }
      if (lane < 32) {
          const int l16 = lane & 15;
          float* dst = isk ? (prompt ? P->out + O_KP + ((size_t)L * MP + row) * 128 : P->out + O_KS + ((size_t)L * MS + (row - MP)) * 128)
                           : (prompt ? P->out + O_VP + ((size_t)L * MP + row) * 128 : P->out + O_VS + ((size_t)L * MS + (row - MP)) * 128);
          *(f32x4*)(dst + 8 * l16) = (f32x4){o[0], o[1], o[2], o[3]}; *(f32x4*)(dst + 8 * l16 + 4) = (f32x4){o[4], o[5], o[6], o[7]};
          if (prompt) { bf16* d2 = (bf16*)(ws + (isk ? WS_KB : WS_VB)) + (size_t)row * 128 + 8 * l16; *(u32x4*)d2 = pack8(o); } } }
    { const int l40 = lane < 40 ? lane : 39; float x[8]; unpack8(*(const u32x4*)(Zr + ZC_IQ + 8 * l40), x); float o[8];
#pragma unroll
      for (int e = 0; e < 8; ++e) { const float y = x[e]; const float pr = shx<1>(y, lane); o[e] = (c8 == 0) ? y * cs[e] - pr * sn[e] : (c8 == 1) ? y * cs[e] + pr * sn[e] : y; }
      if (lane < 32) *(u32x4*)((bf16*)(ws + WS_IQ) + (size_t)row * 256 + 8 * lane) = pack8(o);
      else if (lane < 40) { const int l8 = lane - 32;
          float* dst = prompt ? P->out + O_IKP + ((size_t)L * MP + row) * 64 : P->out + O_IKS + ((size_t)L * MS + (row - MP)) * 64;
          *(f32x4*)(dst + 8 * l8) = (f32x4){o[0], o[1], o[2], o[3]}; *(f32x4*)(dst + 8 * l8 + 4) = (f32x4){o[4], o[5], o[6], o[7]};
          if (prompt) *(u32x4*)((bf16*)(ws + WS_IKB) + (size_t)row * 64 + 8 * l8) = pack8(o); } }
    if (lane < 4) ((float*)(ws + WS_IW))[(size_t)row * 4 + lane] = bf2f(Zr[ZC_IW + lane]) * 0.0625f;
    { const float* pr = prompt ? P->in[I_PP] + ((size_t)L * MP + row) * 256 : P->in[I_PS] + ((size_t)L * MS + (row - MP)) * 256;
      const f32x4 v = *(const f32x4*)(pr + 4 * lane); u32x2 w; w.x = pk2(v[0], v[1]); w.y = pk2(v[2], v[3]); *(u32x2*)((bf16*)(ws + WS_PB) + (size_t)row * 256 + 4 * lane) = w; }
    (void)sb;
}
__device__ __forceinline__ void phase_post(PK P, const Ctx& C, int L) {
    for (int u = C.blk; u < 512; u += C.nblk) post_ret_tile(P, C, u);
    for (int row = C.gw; row < MT; row += 2 * C.ngw) { post_token(P, C, L, row); if (row + C.ngw < MT) post_token(P, C, L, row + C.ngw); }
}

__device__ __forceinline__ void ret_state_item(PK P, const Ctx& C, int L, int item) {
    unsigned char* ws = P->ws; const bf16* RKT = (const bf16*)(ws + WS_RKT); const bf16* RVT = (const bf16*)(ws + WS_RVT); bf16* ST = (bf16*)(ws + WS_ST);
    const int bh = item >> 6, et = (item >> 3) & 7, dt = item & 7, lane = C.lane, r16 = lane & 15, g = lane >> 4;
    const float dec = __builtin_amdgcn_exp2f(128.0f * ret_log2g(bh & 3));
    LAS unsigned char* img = C.lds + 36864 + (C.wave >> 1) * 8704;
    const int tq = lane >> 4, c16 = lane & 15;
    const bf16* vp = RVT + ((size_t)bh * 128 + 16 * et + tq) * SEQ + 8 * c16;
    const bf16* kp = RKT + ((size_t)bh * 128 + 16 * dt + tq) * SEQ + 8 * c16;
    f32x4 S = {0.f, 0.f, 0.f, 0.f};
#pragma unroll 1
    for (int n0 = 0; n0 < 32; n0 += 4) {
        u32x4 rv[4][4], rk[4][4];
#pragma unroll
        for (int i = 0; i < 4; ++i)
#pragma unroll
            for (int q = 0; q < 4; ++q) { rv[i][q] = *(const u32x4*)(vp + (size_t)(4 * q) * SEQ + (n0 + i) * 128); rk[i][q] = *(const u32x4*)(kp + (size_t)(4 * q) * SEQ + (n0 + i) * 128); }
        asm volatile("" ::: "memory");
#pragma unroll
        for (int i = 0; i < 4; ++i) {
#pragma unroll
            for (int q = 0; q < 4; ++q) { *(LAS u32x4*)(img + (tq + 4 * q) * 272 + 16 * c16) = rv[i][q]; *(LAS u32x4*)(img + (16 + tq + 4 * q) * 272 + 16 * c16) = rk[i][q]; }
            LDS_WAIT(); asm volatile("" ::: "memory");
            f32x4 acc = {0.f, 0.f, 0.f, 0.f};
#pragma unroll
            for (int kk = 0; kk < 4; ++kk) { const bf16x8 a = *(const LAS bf16x8*)(img + r16 * 272 + 64 * kk + 16 * g), b = *(const LAS bf16x8*)(img + (16 + r16) * 272 + 64 * kk + 16 * g); acc = mfma16(a, b, acc); }
            LDS_WAIT(); asm volatile("" ::: "memory");
            bf16* st = ST + (((size_t)bh * 32 + n0 + i) * 128 + 16 * et + 4 * g) * 128 + 16 * dt + r16;
#pragma unroll
            for (int r = 0; r < 4; ++r) st[r * 128] = (bf16)(pk2(S[r], 0.f) & 0xffffu);
            S = S * dec + acc; }
        asm volatile("" : "+v"(S));
    }
    float* o = P->out + O_RSP + ((size_t)L * 16 + bh) * 16384 + (size_t)(16 * dt + r16) * 128 + 16 * et + 4 * g;
    *(f32x4*)o = S;
}
__device__ __forceinline__ void ret_sample_unit(PK P, const Ctx& C, int L, int unit) {
    unsigned char* ws = P->ws; const bf16* Z = (const bf16*)(ws + WS_Z);
    const int b = unit >> 2, h = unit & 3, tid = C.tid; const int r0 = MP + b * 8;
    LAS float* q = (LAS float*)C.lds;
    LAS float* kp = q + 1024;
    LAS float* v = kp + 1024;
    LAS float* rz = v + 1024;
    LAS float* A = rz + 1024;
    LAS float* op = A + 64;
    const float lg2 = ret_log2g(h);
    { const int c = tid >> 6, i = tid & 63; const size_t row = (size_t)(r0 + c);
      const f32x2 cs = ((const f32x2*)(ws + WS_ROPER))[(size_t)(PAST + c) * 64 + i];
      const float q1 = bf2f(Z[row * NZ + ZC_RQ + h * 128 + i]), q2 = bf2f(Z[row * NZ + ZC_RQ + h * 128 + 64 + i]);
      q[i * 8 + c] = q1 * cs[0] - q2 * cs[1]; q[(64 + i) * 8 + c] = q2 * cs[0] + q1 * cs[1];
      const float k1 = bf2f(Z[row * NZ + ZC_RK + h * 128 + i]), k2 = bf2f(Z[row * NZ + ZC_RK + h * 128 + 64 + i]);
      const float ks = 0.08838834764831845f * __builtin_amdgcn_exp2f((float)(7 - c) * lg2);
      kp[i * 8 + c] = (k1 * cs[0] - k2 * cs[1]) * ks; kp[(64 + i) * 8 + c] = (k2 * cs[0] + k1 * cs[1]) * ks;
      v[c * 128 + i] = bf2f(Z[row * NZ + ZC_RV + h * 128 + i]); v[c * 128 + 64 + i] = bf2f(Z[row * NZ + ZC_RV + h * 128 + 64 + i]);
      rz[c * 128 + i] = bf2f(Z[row * NZ + ZC_RZ + h * 128 + i]); rz[c * 128 + 64 + i] = bf2f(Z[row * NZ + ZC_RZ + h * 128 + 64 + i]); }
    __syncthreads();
    { const int pr = tid >> 3, part = tid & 7, c = pr >> 3, s2 = pr & 7; float d = 0.f;
#pragma unroll
      for (int dd = 0; dd < 16; ++dd) d += q[(part * 16 + dd) * 8 + c] * kp[(part * 16 + dd) * 8 + s2];
      d += shx<1>(d, tid & 63); d += shx<2>(d, tid & 63); d += shx<4>(d, tid & 63);
      if (part == 0) A[pr] = (s2 <= c) ? d * __builtin_amdgcn_exp2f((float)(c - 7) * lg2) : 0.f; }
    { const int dq = tid >> 7, e = tid & 127; float vr[8], acc[8];
#pragma unroll
      for (int c = 0; c < 8; ++c) { vr[c] = v[c * 128 + e]; acc[c] = 0.f; }
      const float g8 = __builtin_amdgcn_exp2f(8.0f * lg2);
      const float* S0 = P->in[I_STATE] + (((size_t)L * DB + b) * 4 + h) * 16384; float* S1 = P->out + O_RSS + (((size_t)L * DB + b) * 4 + h) * 16384;
      float s0v[32];
#pragma unroll
      for (int dd = 0; dd < 32; ++dd) s0v[dd] = S0[(dq * 32 + dd) * 128 + e];
#pragma unroll
      for (int dd = 0; dd < 32; ++dd) { const int d = dq * 32 + dd; const float s0 = s0v[dd];
          const f32x4 qa = *(const LAS f32x4*)(q + d * 8), qb = *(const LAS f32x4*)(q + d * 8 + 4), ka = *(const LAS f32x4*)(kp + d * 8), kb = *(const LAS f32x4*)(kp + d * 8 + 4);
          float sn = s0 * g8;
#pragma unroll
          for (int c = 0; c < 4; ++c) { acc[c] += qa[c] * s0; acc[4 + c] += qb[c] * s0; sn += ka[c] * vr[c]; sn += kb[c] * vr[4 + c]; }
          S1[d * 128 + e] = sn; }
#pragma unroll
      for (int c = 0; c < 8; ++c) op[(dq * 8 + c) * 128 + e] = acc[c]; }
    __syncthreads();
    { const int c = tid >> 6, i = tid & 63; float o[2]; const float gq = __builtin_amdgcn_exp2f((float)(c + 1) * lg2);
#pragma unroll
      for (int u = 0; u < 2; ++u) { const int e = i + 64 * u; float s = (op[(0 * 8 + c) * 128 + e] + op[(1 * 8 + c) * 128 + e]) + (op[(2 * 8 + c) * 128 + e] + op[(3 * 8 + c) * 128 + e]); s *= gq;
          for (int sidx = 0; sidx <= c; ++sidx) s += A[c * 8 + sidx] * v[sidx * 128 + e];
          o[u] = s; }
      float sm = o[0] + o[1];
      sm = wave_sum(sm, i);
      const float mu = sm * (1.0f / 128.0f); float qv = (o[0] - mu) * (o[0] - mu) + (o[1] - mu) * (o[1] - mu);
      qv = wave_sum(qv, i);
      const float rstd = __builtin_amdgcn_rsqf(qv * (1.0f / 128.0f) + 1e-5f);
      bf16* og = (bf16*)(ws + WS_OGR) + (size_t)(r0 + c) * 512 + h * 128;
#pragma unroll
      for (int u = 0; u < 2; ++u) { const int e = i + 64 * u; og[e] = (bf16)(pk2((o[u] - mu) * rstd * siluf_(rz[c * 128 + e]), 0.f) & 0xffffu); } }
    __syncthreads();
}
template <bool SAMPLE>
__device__ __forceinline__ void score_item(PK P, const Ctx& C, int L, int b, int qblk, int kc) {
    constexpr int QG = SAMPLE ? 1 : 2;
    constexpr int TG = SAMPLE ? 4 : 5;
    unsigned char* ws = P->ws; const int lane = C.lane, r32 = lane & 31, hf = lane >> 5;
    const bf16* IQ = (const bf16*)(ws + WS_IQ); const float* IW = (const float*)(ws + WS_IW);
    const int q0 = SAMPLE ? 0 : qblk * 16;
    const size_t rowbase = SAMPLE ? (size_t)MP + b * 8 : (size_t)b * SEQ + q0;
    bf16x8 af[QG][4]; f32x4 wv[QG][4];
#pragma unroll
    for (int gq = 0; gq < QG; ++gq) {
#pragma unroll
        for (int s = 0; s < 4; ++s) af[gq][s] = *(const bf16x8*)(IQ + (rowbase + 8 * gq + (r32 >> 2)) * 256 + (r32 & 3) * 64 + 16 * s + 8 * hf);
#pragma unroll
        for (int i = 0; i < 4; ++i) wv[gq][i] = *(const f32x4*)(IW + (rowbase + 8 * gq + 2 * i + hf) * 4); }
    const int nkeys = SAMPLE ? PAST + DS : q0 + 16;
    const int kt_end = min(kc * 16 + 16, (nkeys + 31) >> 5);
    const int* pt = (const int*)P->in[I_PT] + b * NPAGES;
    const float* cik = P->in[I_CIK] + (size_t)L * NPOOL * 128 * 64; const float* nik = P->out + O_IKS + ((size_t)L * DB + b) * DS * 64;
    const bf16* ikb = (const bf16*)(ws + WS_IKB) + (size_t)b * SEQ * 64;
    u32x4 cur[TG][SAMPLE ? 8 : 4];
    auto load_group = [&](int kt0, u32x4 (&dst)[TG][SAMPLE ? 8 : 4]) {
#pragma unroll
        for (int j = 0; j < TG; ++j) { const int kt = min(kt0 + j, kt_end - 1); const int key = kt * 32 + r32;
            if (SAMPLE) { const int kcl = key < PAST + DS ? key : PAST + DS - 1;
                const float* kr = (kcl < PAST) ? cik + ((size_t)pt[(kt >> 2) & 15] * 128 + (kcl & 127)) * 64 : nik + (size_t)(kcl - PAST) * 64;
#pragma unroll
                for (int s = 0; s < 4; ++s) { dst[j][2 * s] = *(const u32x4*)(kr + 16 * s + 8 * hf); dst[j][2 * s + 1] = *(const u32x4*)(kr + 16 * s + 8 * hf + 4); }
            } else { const bf16* kr = ikb + (size_t)key * 64;
#pragma unroll
                for (int s = 0; s < 4; ++s) dst[j][s] = *(const u32x4*)(kr + 16 * s + 8 * hf); } }
    };
    for (int kt0 = kc * 16; kt0 < kt_end; kt0 += TG) {
        load_group(kt0, cur);
#pragma unroll
        for (int j = 0; j < TG; ++j) { const int kt = kt0 + j;
            if (kt < kt_end) {
                const int key = kt * 32 + r32;
                bf16x8 bfr[4];
#pragma unroll
                for (int s = 0; s < 4; ++s) {
                    if (SAMPLE) { const f32x4 a = __builtin_bit_cast(f32x4, cur[j][2 * s]), c = __builtin_bit_cast(f32x4, cur[j][2 * s + 1]);
                        u32x4 w; w.x = pk2(a[0], a[1]); w.y = pk2(a[2], a[3]); w.z = pk2(c[0], c[1]); w.w = pk2(c[2], c[3]); bfr[s] = as_bf16x8(w); }
                    else bfr[s] = as_bf16x8(cur[j][s]); }
#pragma unroll
                for (int gq = 0; gq < QG; ++gq) {
                    f32x16 acc;
#pragma unroll
                    for (int i = 0; i < 16; ++i) acc[i] = 0.f;
#pragma unroll
                    for (int s = 0; s < 4; ++s) acc = mfma32(af[gq][s], bfr[s], acc);
                    float sc[4];
#pragma unroll
                    for (int i = 0; i < 4; ++i) {
                        float v = fmaxf(acc[4 * i + 0], 0.f) * wv[gq][i][0]; v += fmaxf(acc[4 * i + 1], 0.f) * wv[gq][i][1]; v += fmaxf(acc[4 * i + 2], 0.f) * wv[gq][i][2]; v += fmaxf(acc[4 * i + 3], 0.f) * wv[gq][i][3];
                        sc[i] = v + 0.0f; }
                    const bool odd = (lane & 1) != 0;
#pragma unroll
                    for (int i = 0; i < 4; i += 2) {
                        const float snd = odd ? sc[i] : sc[i + 1], rcv = shx<1>(snd, lane);
                        const float lo = odd ? rcv : sc[i], hi = odd ? sc[i + 1] : rcv;
                        const unsigned w = (unsigned)__builtin_bit_cast(unsigned short, (_Float16)lo) | ((unsigned)__builtin_bit_cast(unsigned short, (_Float16)hi) << 16);
                        const int ql = 8 * gq + 2 * (odd ? i + 1 : i) + hf, k0 = key & ~1;
                        if (SAMPLE) { if (k0 < PAST + DS) *(unsigned*)((unsigned short*)(ws + WS_SS) + ((size_t)b * 8 + ql) * SS_LD + k0) = w; }
                        else *(unsigned*)((unsigned short*)(ws + WS_SP) + ((size_t)b * SEQ + q0 + ql) * SEQ + k0) = w;
                    }
                }
            }
        }
        asm volatile("" ::: "memory");
    }
}
__device__ __forceinline__ void score_item_dma(PK P, const Ctx& C, int L, int b, int qblk, int kc, LAS unsigned char* img) {
    constexpr int QG = 2, TG = 4;
    unsigned char* ws = P->ws; const int lane = C.lane, r32 = lane & 31, hf = lane >> 5;
    const bf16* IQ = (const bf16*)(ws + WS_IQ); const float* IW = (const float*)(ws + WS_IW);
    const int q0 = qblk * 16;
    const size_t rowbase = (size_t)b * SEQ + q0;
    bf16x8 af[QG][4]; f32x4 wv[QG][4];
#pragma unroll
    for (int gq = 0; gq < QG; ++gq) {
#pragma unroll
        for (int s = 0; s < 4; ++s) af[gq][s] = *(const bf16x8*)(IQ + (rowbase + 8 * gq + (r32 >> 2)) * 256 + (r32 & 3) * 64 + 16 * s + 8 * hf);
#pragma unroll
        for (int i = 0; i < 4; ++i) wv[gq][i] = *(const f32x4*)(IW + (rowbase + 8 * gq + 2 * i + hf) * 4); }
    const int kt_end = min(kc * 16 + 16, (q0 + 16 + 31) >> 5);
    const unsigned char* ikb = ws + WS_IKB + (size_t)b * SEQ * 128;
    int voff[4], roff[4];
#pragma unroll
    for (int i = 0; i < 4; ++i) { voff[i] = (8 * i + (lane >> 3)) * 128 + 16 * ((lane & 7) ^ ((4 * i + (lane >> 4)) & 7)); roff[i] = r32 * 128 + 16 * ((2 * i + hf) ^ ((r32 >> 1) & 7)); }
#define SC_ISSUE(kt0_) do { _Pragma("unroll") for (int j = 0; j < TG; ++j) { const int kt_ = min((kt0_) + j, kt_end - 1); _Pragma("unroll") for (int i = 0; i < 4; ++i) \
        __builtin_amdgcn_global_load_lds((const unsigned*)(ikb + (size_t)kt_ * 4096 + voff[i]), (LAS unsigned*)(img + j * 4096 + i * 1024), 16, 0, 0); } } while (0)
    SC_ISSUE(kc * 16);
    for (int kt0 = kc * 16; kt0 < kt_end; kt0 += TG) {
        asm volatile("s_waitcnt vmcnt(0)" ::: "memory");
        u32x4 cur[TG][4];
#pragma unroll
        for (int j = 0; j < TG; ++j) {
#pragma unroll
            for (int s = 0; s < 4; ++s) cur[j][s] = *(const LAS u32x4*)(img + j * 4096 + roff[s]); }
        asm volatile("s_waitcnt lgkmcnt(0)" ::: "memory");
        if (kt0 + TG < kt_end) SC_ISSUE(kt0 + TG);
        asm volatile("" ::: "memory");
#pragma unroll
        for (int j = 0; j < TG; ++j) { const int kt = kt0 + j;
            if (kt < kt_end) {
                const int key = kt * 32 + r32;
#pragma unroll
                for (int gq = 0; gq < QG; ++gq) {
                    f32x16 acc;
#pragma unroll
                    for (int i = 0; i < 16; ++i) acc[i] = 0.f;
#pragma unroll
                    for (int s = 0; s < 4; ++s) acc = mfma32(af[gq][s], as_bf16x8(cur[j][s]), acc);
                    float sc[4];
#pragma unroll
                    for (int i = 0; i < 4; ++i) {
                        float v = fmaxf(acc[4 * i + 0], 0.f) * wv[gq][i][0]; v += fmaxf(acc[4 * i + 1], 0.f) * wv[gq][i][1]; v += fmaxf(acc[4 * i + 2], 0.f) * wv[gq][i][2]; v += fmaxf(acc[4 * i + 3], 0.f) * wv[gq][i][3];
                        sc[i] = v + 0.0f; }
                    const bool odd = (lane & 1) != 0;
#pragma unroll
                    for (int i = 0; i < 4; i += 2) {
                        const float snd = odd ? sc[i] : sc[i + 1], rcv = shx<1>(snd, lane);
                        const float lo = odd ? rcv : sc[i], hi = odd ? sc[i + 1] : rcv;
                        const unsigned w = (unsigned)__builtin_bit_cast(unsigned short, (_Float16)lo) | ((unsigned)__builtin_bit_cast(unsigned short, (_Float16)hi) << 16);
                        const int ql = 8 * gq + 2 * (odd ? i + 1 : i) + hf, k0 = key & ~1;
                        *(unsigned*)((unsigned short*)(ws + WS_SP) + ((size_t)b * SEQ + q0 + ql) * SEQ + k0) = w;
                    }
                }
            }
        }
        asm volatile("" ::: "memory");
    }
#undef SC_ISSUE
}
__device__ __forceinline__ void score_item_sdma(PK P, const Ctx& C, int L, int b, int kc, LAS unsigned char* img) {
    constexpr int TG = 2;
    unsigned char* ws = P->ws; const int lane = C.lane, r32 = lane & 31, hf = lane >> 5;
    const bf16* IQ = (const bf16*)(ws + WS_IQ); const float* IW = (const float*)(ws + WS_IW);
    const size_t rowbase = (size_t)MP + b * 8;
    bf16x8 af[4]; f32x4 wv[4];
#pragma unroll
    for (int s = 0; s < 4; ++s) af[s] = *(const bf16x8*)(IQ + (rowbase + (r32 >> 2)) * 256 + (r32 & 3) * 64 + 16 * s + 8 * hf);
#pragma unroll
    for (int i = 0; i < 4; ++i) wv[i] = *(const f32x4*)(IW + (rowbase + 2 * i + hf) * 4);
    const int kt_end = min(kc * 16 + 16, (PAST + DS + 31) >> 5);
    const int* pt = (const int*)P->in[I_PT] + b * NPAGES;
    const float* cik = P->in[I_CIK] + (size_t)L * NPOOL * 128 * 64; const float* nik = P->out + O_IKS + ((size_t)L * DB + b) * DS * 64;
    const int dr = lane >> 4, dq = lane & 15;
#define SS_ISSUE(kt0_) do { _Pragma("unroll") for (int j = 0; j < TG; ++j) { const int kt_ = min((kt0_) + j, kt_end - 1); const float* pg_ = cik + ((size_t)pt[(kt_ >> 2) & 15] * 128 + (kt_ & 3) * 32) * 64; \
        _Pragma("unroll") for (int i = 0; i < 8; ++i) { const int row_ = 4 * i + dr, key_ = kt_ * 32 + row_, kcl_ = key_ < PAST + DS ? key_ : PAST + DS - 1; \
            const float* src_ = (kcl_ < PAST ? pg_ + row_ * 64 : nik + (kcl_ - PAST) * 64) + 4 * (dq ^ (row_ & 15)); \
            __builtin_amdgcn_global_load_lds((const unsigned*)src_, (LAS unsigned*)(img + j * 8192 + i * 1024), 16, 0, 0); } } } while (0)
    SS_ISSUE(kc * 16);
    for (int kt0 = kc * 16; kt0 < kt_end; kt0 += TG) {
        asm volatile("s_waitcnt vmcnt(0)" ::: "memory");
        u32x4 cur[TG][8];
#pragma unroll
        for (int j = 0; j < TG; ++j) {
#pragma unroll
            for (int s = 0; s < 8; ++s) cur[j][s] = *(const LAS u32x4*)(img + j * 8192 + r32 * 256 + 16 * ((4 * (s >> 1) + 2 * hf + (s & 1)) ^ (r32 & 15))); }
        asm volatile("s_waitcnt lgkmcnt(0)" ::: "memory");
        if (kt0 + TG < kt_end) SS_ISSUE(kt0 + TG);
        asm volatile("" ::: "memory");
#pragma unroll
        for (int j = 0; j < TG; ++j) { const int kt = kt0 + j;
            if (kt < kt_end) {
                const int key = kt * 32 + r32;
                f32x16 acc;
#pragma unroll
                for (int i = 0; i < 16; ++i) acc[i] = 0.f;
#pragma unroll
                for (int s = 0; s < 4; ++s) { const f32x4 a = __builtin_bit_cast(f32x4, cur[j][2 * s]), c = __builtin_bit_cast(f32x4, cur[j][2 * s + 1]);
                    u32x4 w; w.x = pk2(a[0], a[1]); w.y = pk2(a[2], a[3]); w.z = pk2(c[0], c[1]); w.w = pk2(c[2], c[3]);
                    acc = mfma32(af[s], as_bf16x8(w), acc); }
                float sc[4];
#pragma unroll
                for (int i = 0; i < 4; ++i) {
                    float v = fmaxf(acc[4 * i + 0], 0.f) * wv[i][0]; v += fmaxf(acc[4 * i + 1], 0.f) * wv[i][1]; v += fmaxf(acc[4 * i + 2], 0.f) * wv[i][2]; v += fmaxf(acc[4 * i + 3], 0.f) * wv[i][3];
                    sc[i] = v + 0.0f; }
                const bool odd = (lane & 1) != 0;
#pragma unroll
                for (int i = 0; i < 4; i += 2) {
                    const float snd = odd ? sc[i] : sc[i + 1], rcv = shx<1>(snd, lane);
                    const float lo = odd ? rcv : sc[i], hi = odd ? sc[i + 1] : rcv;
                    const unsigned w = (unsigned)__builtin_bit_cast(unsigned short, (_Float16)lo) | ((unsigned)__builtin_bit_cast(unsigned short, (_Float16)hi) << 16);
                    const int ql = 2 * (odd ? i + 1 : i) + hf, k0 = key & ~1;
                    if (k0 < PAST + DS) *(unsigned*)((unsigned short*)(ws + WS_SS) + ((size_t)b * 8 + ql) * SS_LD + k0) = w;
                }
            }
        }
        asm volatile("" ::: "memory");
    }
#undef SS_ISSUE
}
__device__ __forceinline__ void phase_c(PK P, const Ctx& C, int L, int sel = 15) {
    LAS unsigned char* imgw = C.lds + C.wave * 16384;
    if (C.nblk == 256) {
        const int q1 = C.blk & 127, n1 = q1 / 32 + 1;
        if ((C.gw & 1) == 0) { if (sel & 1) for (int it = C.gw >> 1; it < 1024; it += C.ngw >> 1) ret_state_item(P, C, L, it); }
        else { const int k = C.wave >> 1, f = (C.blk >> 7) * 4 + k; LAS unsigned char* imgf = C.lds + (k < 3 ? 71680 + k * 16384 : XPOSE_OFF);
            if ((sel & 8) && f < 5) score_item_sdma(P, C, L, q1, f, imgf);
            if ((sel & 4) && f >= 4) { const int j = f == 4 ? 35 : 27 + f; const int b = j / 9, c = j - 9 * b; if (c < n1) score_item_dma(P, C, L, b, q1, c, imgf); else score_item_dma(P, C, L, b, 255 - q1, c - n1, imgf); } }
        if (sel & 2) for (int u = C.blk; u < 512; u += C.nblk) ret_sample_unit(P, C, L, u);
        if (sel & 4) { const int wp = (C.blk >> 7) * NWAVES + C.wave;
            for (int j = wp; j < 32; j += 16) { const int b = j / 9, c = j - 9 * b; if (c < n1) score_item_dma(P, C, L, b, q1, c, imgw); else score_item_dma(P, C, L, b, 255 - q1, c - n1, imgw); } }
    } else {
        if ((sel & 1) && (C.gw & 1) == 0) for (int it = C.gw >> 1; it < 1024; it += C.ngw >> 1) ret_state_item(P, C, L, it);
        if (sel & 2) for (int u = C.blk; u < 512; u += C.nblk) ret_sample_unit(P, C, L, u);
        if (sel & 4) for (int it = C.gw; it < NB * 256 * 8; it += C.ngw) { const int kc = it & 7, qb = (it >> 3) & 255, b = it >> 11; if (kc * 512 <= qb * 16 + 15) score_item_dma(P, C, L, b, qb, kc, imgw); }
        if ((sel & 8) && (C.gw & 1) != 0) for (int it = C.gw >> 1; it < DB * 5; it += C.ngw >> 1) score_item_sdma(P, C, L, it / 5, it % 5, imgw);
    }
}

__device__ __forceinline__ void ret_scan_item(PK P, const Ctx& C, int L, int item) {
    unsigned char* ws = P->ws; const float* KVT = (const float*)(ws + WS_KVT); bf16* ST = (bf16*)(ws + WS_ST);
    const int e0 = item * 1024 + C.tid * 2, bh = e0 >> 14, rem = e0 & 16383, h = bh & 3;
    const float dec = __builtin_amdgcn_exp2f(128.0f * ret_log2g(h));
    float s0 = 0.f, s1 = 0.f;
#pragma unroll 8
    for (int n = 0; n < 32; ++n) { const f32x2 kv = *(const f32x2*)(KVT + ((size_t)bh * 32 + n) * 16384 + rem);
        *(unsigned*)(ST + ((size_t)bh * 32 + n) * 16384 + rem) = pk2(s0, s1); s0 = s0 * dec + kv[0]; s1 = s1 * dec + kv[1]; }
    const int e = rem >> 7, d = rem & 127;
    float* o = P->out + O_RSP + ((size_t)L * 16 + bh) * 16384; o[d * 128 + e] = s0; o[(d + 1) * 128 + e] = s1;
}
template <int G>
__device__ __forceinline__ void cnt_ge4(const unsigned (&kp)[32], unsigned cm1, unsigned& c0, unsigned& c1) {
    unsigned t0, t1, t2, t3;
    asm("v_pk_sub_u16 %2, %6, %10 clamp\n\tv_pk_sub_u16 %3, %7, %10 clamp\n\tv_pk_sub_u16 %4, %8, %10 clamp\n\tv_pk_sub_u16 %5, %9, %10 clamp\n\t"
        "v_pk_min_u16 %2, %2, %11\n\tv_pk_min_u16 %3, %3, %11\n\tv_pk_min_u16 %4, %4, %11\n\tv_pk_min_u16 %5, %5, %11\n\t"
        "v_pk_add_u16 %0, %0, %2\n\tv_pk_add_u16 %1, %1, %3\n\tv_pk_add_u16 %0, %0, %4\n\tv_pk_add_u16 %1, %1, %5"
        : "+v"(c0), "+v"(c1), "=&v"(t0), "=&v"(t1), "=&v"(t2), "=&v"(t3)
        : "v"(kp[4 * G + 0]), "v"(kp[4 * G + 1]), "v"(kp[4 * G + 2]), "v"(kp[4 * G + 3]), "s"(cm1), "s"(0x00010001u));
}
__device__ __forceinline__ int wave_sum_dpp(int v) {
    v += __builtin_amdgcn_update_dpp(0, v, 0x111, 0xf, 0xf, true);
    v += __builtin_amdgcn_update_dpp(0, v, 0x112, 0xf, 0xf, true);
    v += __builtin_amdgcn_update_dpp(0, v, 0x114, 0xf, 0xf, true);
    v += __builtin_amdgcn_update_dpp(0, v, 0x118, 0xf, 0xf, true);
    v += __builtin_amdgcn_update_dpp(0, v, 0x142, 0xa, 0xf, true);
    v += __builtin_amdgcn_update_dpp(0, v, 0x143, 0xc, 0xf, true);
    return __builtin_amdgcn_readlane(v, 63);
}
__device__ __forceinline__ unsigned cnt_ge_lane(const unsigned (&kp)[32], unsigned cand, int ng) {
    const unsigned cm1 = (cand - 1u) * 0x00010001u; unsigned c0 = 0u, c1 = 0u;
    cnt_ge4<0>(kp, cm1, c0, c1);
    if (ng > 1) cnt_ge4<1>(kp, cm1, c0, c1);
    if (ng > 2) cnt_ge4<2>(kp, cm1, c0, c1);
    if (ng > 3) cnt_ge4<3>(kp, cm1, c0, c1);
    if (ng > 4) cnt_ge4<4>(kp, cm1, c0, c1);
    if (ng > 5) cnt_ge4<5>(kp, cm1, c0, c1);
    if (ng > 6) cnt_ge4<6>(kp, cm1, c0, c1);
    if (ng > 7) cnt_ge4<7>(kp, cm1, c0, c1);
    const unsigned c = c0 + c1;
    return (c & 0xffffu) + (c >> 16);
}
__device__ __forceinline__ int cnt_ge(const unsigned (&kp)[32], unsigned cand, int ng) { return wave_sum_dpp((int)cnt_ge_lane(kp, cand, ng)); }
__device__ __forceinline__ void bit_transpose16(unsigned (&x)[16]) {
#define BT_STAGE(J, M) _Pragma("unroll") for (int r = 0; r < 16; ++r) if ((r & (J)) == 0) { const unsigned a = x[r], b = x[r + (J)]; x[r] = (a & (M)) | ((b << (J)) & ~(M)); x[r + (J)] = ((a >> (J)) & (M)) | (b & ~(M)); }
    BT_STAGE(8, 0x00ff00ffu) BT_STAGE(4, 0x0f0f0f0fu) BT_STAGE(2, 0x33333333u) BT_STAGE(1, 0x55555555u)
#undef BT_STAGE
}
__device__ __forceinline__ void select_topk(const unsigned short* srow, int Lk, LAS unsigned* list, int lane, int mode = 3) {
    const int ng = (Lk + 511) >> 9;
    unsigned kp[32];
    const unsigned* sl = (const unsigned*)srow + lane;
    if (ng > 4) {
#pragma unroll
        for (int j = 0; j < 32; ++j) kp[j] = sl[j * 64];
    } else {
#pragma unroll
        for (int j = 0; j < 16; ++j) kp[j] = sl[j * 64];
#pragma unroll
        for (int j = 16; j < 32; ++j) kp[j] = 0u;
    }
    typedef short s16x2 __attribute__((ext_vector_type(2)));
#pragma unroll
    for (int j = 0; j < 32; ++j) { const unsigned w = kp[j];
        const unsigned sg = __builtin_bit_cast(unsigned, __builtin_bit_cast(s16x2, w) >> (s16x2){15, 15});
        unsigned kk = w ^ (sg | 0x80008000u);
        const int rem = Lk - 128 * j;
        if (rem < 128) kk &= ((2 * lane < rem) ? 0xffffu : 0u) | ((2 * lane + 1 < rem) ? 0xffff0000u : 0u);
        kp[j] = kk; }
    unsigned p0[16], p1[16];
#pragma unroll
    for (int j = 0; j < 16; ++j) { p0[j] = kp[j]; p1[j] = 0u; }
    bit_transpose16(p0);
    if (ng > 4) {
#pragma unroll
        for (int j = 0; j < 16; ++j) p1[j] = kp[16 + j];
        bit_transpose16(p1); }
    unsigned prefix = 0u, act0 = ~0u, act1 = ~0u; int G = 0, gl = 0;
#pragma unroll
    for (int bit = 15; bit >= 0; --bit) {
        const unsigned t0 = act0 & p0[bit], t1 = act1 & p1[bit];
        const int c = __builtin_popcount(t0) + __builtin_popcount(t1);
        const int tot = wave_sum_dpp(c);
        const bool take = G + tot >= TOPK;
        if (take) { prefix |= 1u << bit; act0 = t0; act1 = t1; } else { G += tot; gl += c; act0 ^= t0; act1 ^= t1; }
    }
    const int ceq = __builtin_popcount(act0) + __builtin_popcount(act1);
    const int nge = G + wave_sum_dpp(ceq), ngt = G;
    if (nge == TOPK) {
        const int cl = gl + ceq;
        int inc = cl;
#pragma unroll
        for (int d = 1; d < 64; d <<= 1) { const int t = __builtin_amdgcn_ds_bpermute((lane - d) << 2, inc); inc += (lane >= d) ? t : 0; }
        int off = inc - cl;
#pragma unroll
        for (int j = 0; j < 32; ++j) { const unsigned k0 = kp[j] & 0xffffu, k1 = kp[j] >> 16; const bool s0 = k0 >= prefix, s1 = k1 >= prefix;
            list[s0 ? off : 2368 + lane] = (unsigned)(128 * j + 2 * lane); off += s0 ? 1 : 0;
            list[s1 ? off : 2368 + lane] = (unsigned)(128 * j + 2 * lane + 1); off += s1 ? 1 : 0; }
    } else {
        const int need_eq = TOPK - ngt; int run_sel = 0, run_eq = 0;
#pragma unroll
        for (int gi = 0; gi < 8; ++gi) { if (gi < ng) {
#pragma unroll
            for (int j = 4 * gi; j < 4 * gi + 4; ++j) { const unsigned ka = kp[j] & 0xffffu, kb = kp[j] >> 16;
                const bool gt0 = ka > prefix, eq0 = ka == prefix, gt1 = kb > prefix, eq1 = kb == prefix;
                const unsigned long long m0 = __ballot(eq0), m1 = __ballot(eq1);
                const int beq = run_eq + mbcnt64(m0) + mbcnt64(m1);
                const bool sel0 = gt0 || (eq0 && beq < need_eq), sel1 = gt1 || (eq1 && (beq + (eq0 ? 1 : 0)) < need_eq);
                const unsigned long long s0 = __ballot(sel0), s1 = __ballot(sel1);
                const int pos = run_sel + mbcnt64(s0) + mbcnt64(s1);
                if (sel0) list[pos] = (unsigned)(128 * j + 2 * lane);
                if (sel1) list[pos + (sel0 ? 1 : 0)] = (unsigned)(128 * j + 2 * lane + 1);
                run_sel += __popcll(s0) + __popcll(s1); run_eq += __popcll(m0) + __popcll(m1); __builtin_amdgcn_sched_barrier(0); } } }
    }
}
#ifndef SEL2
#define SEL2 0
#endif
#ifndef QK2
#define QK2 0
#endif
#ifndef PV2
#define PV2 0
#endif
#ifndef NOXCD
#define NOXCD 0
#endif
constexpr int ATT_WSTRIDE = 10496;
template <bool SAMPLE>
__device__ __forceinline__ void attend_query(PK P, const Ctx& C, int L, int row, int mode = 3) {
    int lane_ = C.lane; asm volatile("" : "+v"(lane_));
    unsigned char* ws = P->ws; const int lane = lane_;
    LAS unsigned* list = (LAS unsigned*)(C.lds + C.wave * ATT_WSTRIDE);
    int b, Lk; const unsigned short* srow;
    if (SAMPLE) { b = (row - MP) >> 3; const int j = (row - MP) & 7; Lk = PAST + j + 1; srow = (const unsigned short*)(ws + WS_SS) + (size_t)(row - MP) * SS_LD; }
    else { b = row >> 12; const int t = row & (SEQ - 1); Lk = t + 1; srow = (const unsigned short*)(ws + WS_SP) + (size_t)row * SEQ; }
    const int n16 = lane & 15, g = lane >> 4;
    u32x4 qraw[2]; qraw[0] = (u32x4){0u, 0u, 0u, 0u}; qraw[1] = qraw[0];
    if (n16 < 8) { qraw[0] = *(const u32x4*)((const bf16*)(ws + WS_AQ) + (size_t)row * 512 + n16 * 64 + 8 * g); qraw[1] = *(const u32x4*)((const bf16*)(ws + WS_AQ) + (size_t)row * 512 + n16 * 64 + 32 + 8 * g); }
    u32x2 azr[4];
#pragma unroll
    for (int dl = 0; dl < 4; ++dl) azr[dl] = *(const u32x2*)((const bf16*)(ws + WS_Z) + (size_t)row * NZ + ZC_AZ + (n16 & 7) * 64 + 16 * dl + 4 * g);
    int ptv = 0; if (SAMPLE) ptv = ((const int*)P->in[I_PT])[b * NPAGES + (lane & 15)];
    int count;
    if (Lk <= TOPK) { for (int i = lane; i < TOPK; i += 64) list[i] = i < Lk ? (unsigned)i : 0u; count = Lk; }
    else { select_topk(srow, Lk, list, lane, mode); if (SEL2) { LDS_WAIT(); asm volatile("" ::: "memory"); select_topk(srow, Lk, list, lane, mode); } count = TOPK; }
    LDS_WAIT(); asm volatile("" ::: "memory");
    if (mode == 1 || mode == 4 || mode == 5) return;
    {
#pragma unroll
      for (int i = 0; i < 4; ++i) { const unsigned k = list[lane + 64 * i]; unsigned phys;
          if (SAMPLE) { const unsigned pg = (unsigned)__builtin_amdgcn_ds_bpermute((int)(((k >> 7) & 15u) << 2), ptv); phys = (k < (unsigned)PAST) ? pg * 128u + (k & 127u) : (0x80000000u | (k - PAST)); }
          else phys = (unsigned)b * SEQ + k;
          list[lane + 64 * i] = phys; } }
    LDS_WAIT(); asm volatile("" ::: "memory");
    const float* ck = SAMPLE ? P->in[I_CK] + (size_t)L * NPOOL * 128 * 128 : nullptr; const float* cv = SAMPLE ? P->in[I_CV] + (size_t)L * NPOOL * 128 * 128 : nullptr;
    const float* nk = P->out + O_KS + ((size_t)L * DB + b) * DS * 128; const float* nv = P->out + O_VS + ((size_t)L * DB + b) * DS * 128;
    const bf16* KBp = (const bf16*)(ws + WS_KB); const bf16* VBp = (const bf16*)(ws + WS_VB);
    bf16x8 qf[2][2];
#pragma unroll
    for (int kvh = 0; kvh < 2; ++kvh)
#pragma unroll
        for (int s = 0; s < 2; ++s) { const u32x4 zz = {0u, 0u, 0u, 0u}; qf[kvh][s] = as_bf16x8(((n16 >> 2) == kvh) ? qraw[s] : zz); }
    f32x4 S[16];
    for (int rq_ = 0; rq_ < (QK2 ? 2 : 1); ++rq_) {
    { LAS unsigned char* kbuf = C.lds + C.wave * ATT_WSTRIDE + 1024; const int c16k = lane & 15, tqk = lane >> 4;
      constexpr int KS = SAMPLE ? 2 : 4;
#pragma unroll
      for (int sb = 0; sb < 8; sb += KS) {
        u32x4 kraw[KS][SAMPLE ? 16 : 8];
#pragma unroll
        for (int q = 0; q < KS; ++q)
#pragma unroll
            for (int i = 0; i < 8; ++i) { const unsigned phys = list[32 * (sb + q) + tqk + 4 * i];
                if (SAMPLE) { const float* kr = ((phys & 0x80000000u) ? nk + (size_t)(phys & 7u) * 128 : ck + (size_t)phys * 128) + 8 * c16k; kraw[q][2 * i] = *(const u32x4*)kr; kraw[q][2 * i + 1] = *(const u32x4*)(kr + 4); }
                else kraw[q][i] = *(const u32x4*)(KBp + (size_t)phys * 128 + 8 * c16k); }
        asm volatile("" ::: "memory");
#pragma unroll
        for (int q = 0; q < KS; ++q) { const int st = sb + q;
#pragma unroll
            for (int i = 0; i < 8; ++i) { u32x4 w;
                if (SAMPLE) { const f32x4 a = __builtin_bit_cast(f32x4, kraw[q][2 * i]), c = __builtin_bit_cast(f32x4, kraw[q][2 * i + 1]); w.x = pk2(a[0], a[1]); w.y = pk2(a[2], a[3]); w.z = pk2(c[0], c[1]); w.w = pk2(c[2], c[3]); }
                else w = kraw[q][i];
                *(LAS u32x4*)(kbuf + (tqk + 4 * i) * 288 + 16 * c16k) = w; }
            LDS_WAIT(); asm volatile("" ::: "memory");
#pragma unroll
            for (int tt = 0; tt < 2; ++tt) { const LAS unsigned char* rp = kbuf + (16 * tt + n16) * 288 + 16 * g;
                const bf16x8 a00 = *(const LAS bf16x8*)rp, a01 = *(const LAS bf16x8*)(rp + 64), a10 = *(const LAS bf16x8*)(rp + 128), a11 = *(const LAS bf16x8*)(rp + 192);
                f32x4 acc = {0.f, 0.f, 0.f, 0.f};
                acc = mfma16(a00, qf[0][0], acc); acc = mfma16(a01, qf[0][1], acc); acc = mfma16(a10, qf[1][0], acc); acc = mfma16(a11, qf[1][1], acc); asm volatile("" : "+v"(acc)); S[2 * st + tt] = acc; }
            LDS_WAIT(); asm volatile("" ::: "memory"); }
      } }
    asm volatile("" ::: "memory"); }
    float mx = -INFINITY;
#pragma unroll
    for (int i = 0; i < 16; ++i)
#pragma unroll
        for (int r = 0; r < 4; ++r) { const int slot = 16 * i + 4 * g + r; const float sv = slot < count ? S[i][r] * 0.125f : -INFINITY; S[i][r] = sv; mx = fmaxf(mx, sv); }
    mx = fmaxf(mx, shx<16>(mx, lane)); mx = fmaxf(mx, shx<32>(mx, lane));
    float sum = 0.f;
#pragma unroll
    for (int i = 0; i < 16; ++i)
#pragma unroll
        for (int r = 0; r < 4; ++r) { const float p = __builtin_amdgcn_exp2f((S[i][r] - mx) * 1.4426950408889634f); S[i][r] = p; sum += p; }
    sum += shx<16>(sum, lane); sum += shx<32>(sum, lane);
    if (mode == 2) return;
    LAS unsigned char* vbuf = C.lds + C.wave * ATT_WSTRIDE + 1024;
    const int c16 = lane & 15, tq = lane >> 4;
    f32x4 oacc[8];
    for (int rp_ = 0; rp_ < (PV2 ? 2 : 1); ++rp_) {
#pragma unroll
    for (int dt = 0; dt < 8; ++dt) oacc[dt] = (f32x4){0.f, 0.f, 0.f, 0.f};
    u32x4 vraw[SAMPLE ? 16 : 8];
#define ATT_VLOAD(st_) do { _Pragma("unroll") for (int i = 0; i < 8; ++i) { const unsigned phys = list[32 * (st_) + tq + 4 * i]; \
            if (SAMPLE) { const float* vr = ((phys & 0x80000000u) ? nv + (size_t)(phys & 7u) * 128 : cv + (size_t)phys * 128) + 8 * c16; vraw[2 * i] = *(const u32x4*)vr; vraw[2 * i + 1] = *(const u32x4*)(vr + 4); } \
            else vraw[i] = *(const u32x4*)(VBp + (size_t)phys * 128 + 8 * c16); } } while (0)
    ATT_VLOAD(0);
    const unsigned tr_a = (unsigned)(4 * g + (c16 >> 2)) * 288u + (unsigned)(c16 & 3) * 8u;
#pragma unroll
    for (int st = 0; st < 8; ++st) {
#pragma unroll
        for (int i = 0; i < 8; ++i) { u32x4 w;
            if (SAMPLE) { const f32x4 a = __builtin_bit_cast(f32x4, vraw[2 * i]), c = __builtin_bit_cast(f32x4, vraw[2 * i + 1]); w.x = pk2(a[0], a[1]); w.y = pk2(a[2], a[3]); w.z = pk2(c[0], c[1]); w.w = pk2(c[2], c[3]); }
            else w = vraw[i];
            *(LAS u32x4*)(vbuf + (tq + 4 * i) * 288 + 16 * c16) = w; }
        if (st + 1 < 8) ATT_VLOAD(st + 1);
        const f32x4 p0 = S[2 * st], p1 = S[2 * st + 1];
        u32x4 pw; pw.x = pk2(p0[0], p0[1]); pw.y = pk2(p0[2], p0[3]); pw.z = pk2(p1[0], p1[1]); pw.w = pk2(p1[2], p1[3]);
        const bf16x8 pf = as_bf16x8(pw);
        LDS_WAIT(); asm volatile("" ::: "memory");
#pragma unroll
        for (int dt = 0; dt < 8; ++dt) {
            typedef short v4i16_t __attribute__((ext_vector_type(4)));
            const v4i16_t lo = __builtin_amdgcn_ds_read_tr16_b64_v4i16((LAS v4i16_t*)(vbuf + tr_a + 32 * dt));
            const v4i16_t hi = __builtin_amdgcn_ds_read_tr16_b64_v4i16((LAS v4i16_t*)(vbuf + tr_a + 16 * 288 + 32 * dt));
            bf16x8 af; af[0] = lo[0]; af[1] = lo[1]; af[2] = lo[2]; af[3] = lo[3]; af[4] = hi[0]; af[5] = hi[1]; af[6] = hi[2]; af[7] = hi[3];
            oacc[dt] = mfma16(af, pf, oacc[dt]); }
        LDS_WAIT(); asm volatile("" ::: "memory");
    }
    asm volatile("" ::: "memory"); }
    { const float inv = 1.0f / sum;
#define ATT_EPI(base_) do { _Pragma("unroll") for (int dl = 0; dl < 4; ++dl) { const f32x4 v = oacc[(base_) + dl]; \
              const float y0 = v[0] * inv * siluf_(bflo(azr[dl].x)), y1 = v[1] * inv * siluf_(bfhi(azr[dl].x)), y2 = v[2] * inv * siluf_(bflo(azr[dl].y)), y3 = v[3] * inv * siluf_(bfhi(azr[dl].y)); \
              u32x2 ow; ow.x = pk2(y0, y1); ow.y = pk2(y2, y3); \
              *(u32x2*)((bf16*)(ws + WS_OGA) + (size_t)row * 512 + n16 * 64 + 16 * dl + 4 * g) = ow; } } while (0)
      if (n16 < 4) ATT_EPI(0); else if (n16 < 8) ATT_EPI(4);
#undef ATT_EPI
    }
    LDS_WAIT(); asm volatile("" ::: "memory");
#undef ATT_VLOAD
}
__device__ __forceinline__ void ret_out_unit(PK P, const Ctx& C, int unit, bool flip);
__device__ __forceinline__ void phase_d(PK P, const Ctx& C, int L, int mode = 3) {
    if (mode == 3) { bool flip = false; for (int u = C.blk; u < 512; u += C.nblk) { ret_out_unit(P, C, u, flip); flip = !flip; } __syncthreads(); }
#ifndef DSEL
#define DSEL 7
#endif
    if (!(DSEL & 2)) {} else
    if (C.nblk == 256 && !NOXCD) {
        const int x = C.blk & 7, b = x >> 1, wq = (((C.blk >> 3) * 2 + (x & 1)) * NWAVES + C.wave);
        for (int t = wq; t < SEQ; t += 512) attend_query<false>(P, C, L, b * SEQ + t, mode);
    } else for (int row = C.gw; row < MP; row += C.ngw) attend_query<false>(P, C, L, row, mode);
    if (DSEL & 4) for (int i = C.gw; i < 2 * MS; i += C.ngw) if ((i & 1) == 0) attend_query<true>(P, C, L, MP + (i >> 1), mode);
}

__device__ __forceinline__ void ret_out_unit(PK P, const Ctx& C, int unit, bool flip) {
    unsigned char* ws = P->ws; const bf16* RQ = (const bf16*)(ws + WS_RQ); const bf16* RK = (const bf16*)(ws + WS_RK); const bf16* RVT = (const bf16*)(ws + WS_RVT); const bf16* ST = (const bf16*)(ws + WS_ST);
    const int bh = unit >> 5, b = bh >> 2, h = bh & 3, n = unit & 31, r16 = C.lane & 15, g = C.lane >> 4, t0 = n * 128;
    const int w = flip ? 7 - C.wave : C.wave;
    const size_t rowbase = (size_t)b * SEQ + t0;
    const float lg2 = ret_log2g(h);
    constexpr int RS = 272; LAS unsigned char* Ks = C.lds; LAS unsigned char* Vs = C.lds + 128 * RS; LAS unsigned char* Ss = C.lds + 256 * RS;
    bf16x8 qf[4];
#pragma unroll
    for (int kk = 0; kk < 4; ++kk) qf[kk] = *(const bf16x8*)(RQ + (rowbase + 16 * w + r16) * 512 + h * 128 + 32 * kk + 8 * g);
    { const int pr = C.tid >> 4, pc = C.tid & 15;
      u32x4 rk[4], rv[4], rs_[4];
#pragma unroll
      for (int q = 0; q < 4; ++q) { const int r = pr + 32 * q;
          rk[q] = *(const u32x4*)(RK + (rowbase + r) * 512 + h * 128 + 8 * pc);
          rv[q] = *(const u32x4*)(RVT + ((size_t)bh * 128 + r) * SEQ + t0 + 8 * pc);
          rs_[q] = *(const u32x4*)(ST + (((size_t)bh * 32 + n) * 128 + r) * 128 + 8 * pc); }
      __syncthreads();
#pragma unroll
      for (int q = 0; q < 4; ++q) { const int r = pr + 32 * q; *(LAS u32x4*)(Ks + r * RS + 16 * pc) = rk[q]; *(LAS u32x4*)(Vs + r * RS + 16 * pc) = rv[q]; *(LAS u32x4*)(Ss + r * RS + 16 * pc) = rs_[q]; }
      __syncthreads(); }
    unsigned pt[8][2];
#pragma unroll
    for (int st = 0; st < 8; ++st) {
        pt[st][0] = 0u; pt[st][1] = 0u;
        if (st <= w) { f32x4 acc = {0.f, 0.f, 0.f, 0.f};
#pragma unroll
            for (int kk = 0; kk < 4; ++kk) { const bf16x8 kf = *(const LAS bf16x8*)(Ks + (16 * st + r16) * RS + 64 * kk + 16 * g); acc = mfma16(kf, qf[kk], acc); }
            float vals[4];
#pragma unroll
            for (int r = 0; r < 4; ++r) { const int dlt = (16 * w + r16) - (16 * st + 4 * g + r); vals[r] = dlt >= 0 ? acc[r] * __builtin_amdgcn_exp2f((float)dlt * lg2) : 0.f; }
            pt[st][0] = pk2(vals[0], vals[1]); pt[st][1] = pk2(vals[2], vals[3]); }
    }
    const float dq = __builtin_amdgcn_exp2f((float)(16 * w + r16 + 1) * lg2);
    f32x4 o[8];
#pragma unroll
    for (int et = 0; et < 8; ++et) {
        f32x4 a1 = {0.f, 0.f, 0.f, 0.f}, a2 = {0.f, 0.f, 0.f, 0.f};
        const LAS unsigned char* vrow = Vs + (16 * et + r16) * RS;
#pragma unroll
        for (int i = 0; i < 4; ++i) if (2 * i <= w) {
            const u32x2 lo = *(const LAS u32x2*)(vrow + 2 * (32 * i + 4 * g)), hi = *(const LAS u32x2*)(vrow + 2 * (32 * i + 16 + 4 * g));
            const u32x4 aw = {lo.x, lo.y, hi.x, hi.y}, bw = {pt[2 * i][0], pt[2 * i][1], pt[2 * i + 1][0], pt[2 * i + 1][1]};
            a1 = mfma16(as_bf16x8(aw), as_bf16x8(bw), a1); }
#pragma unroll
        for (int kk = 0; kk < 4; ++kk) { const bf16x8 sf = *(const LAS bf16x8*)(Ss + (16 * et + r16) * RS + 64 * kk + 16 * g); a2 = mfma16(sf, qf[kk], a2); }
        o[et] = a1 + a2 * dq;
    }
    float sm = 0.f;
#pragma unroll
    for (int et = 0; et < 8; ++et) sm += (o[et][0] + o[et][1]) + (o[et][2] + o[et][3]);
    sm += shx<16>(sm, C.lane); sm += shx<32>(sm, C.lane);
    const float mu = sm * (1.0f / 128.0f); float qv = 0.f;
#pragma unroll
    for (int et = 0; et < 8; ++et) { const f32x4 d = o[et] - mu; qv += (d[0] * d[0] + d[1] * d[1]) + (d[2] * d[2] + d[3] * d[3]); }
    qv += shx<16>(qv, C.lane); qv += shx<32>(qv, C.lane);
    const float rstd = __builtin_amdgcn_rsqf(qv * (1.0f / 128.0f) + 1e-5f);
    const size_t row = rowbase + 16 * w + r16;
    const bf16* zr = (const bf16*)(ws + WS_Z) + row * NZ + ZC_RZ + h * 128; bf16* og = (bf16*)(ws + WS_OGR) + row * 512 + h * 128;
#pragma unroll
    for (int et = 0; et < 8; ++et) { const u32x2 zw = *(const u32x2*)(zr + 16 * et + 4 * g);
        const float y0 = (o[et][0] - mu) * rstd * siluf_(bflo(zw.x)), y1 = (o[et][1] - mu) * rstd * siluf_(bfhi(zw.x)), y2 = (o[et][2] - mu) * rstd * siluf_(bflo(zw.y)), y3 = (o[et][3] - mu) * rstd * siluf_(bfhi(zw.y));
        u32x2 ow; ow.x = pk2(y0, y1); ow.y = pk2(y2, y3); *(u32x2*)(og + 16 * et + 4 * g) = ow; }
}

template <int K>
__device__ __forceinline__ void mini_mma(const bf16* A, const bf16* Bt, int row0, int col0, const Ctx& C, f32x4 (&acc)[2]) {
    constexpr int RS = 272, BUF = 2 * 64 * RS;
    constexpr int NC = K / 128, PF = NC < 4 ? NC : 4;
    const int tid = C.tid, lane = C.lane, rt = C.wave >> 1, ch = C.wave & 1, r16 = lane & 15, g = lane >> 4;
    LAS unsigned char* sm = C.lds;
    const int pr0 = tid >> 4, pc = tid & 15;
    const bf16* ga = A + (size_t)(row0 + pr0) * K + 8 * pc; const bf16* gb = Bt + (size_t)(col0 + pr0) * K + 8 * pc;
    acc[0] = (f32x4){0.f, 0.f, 0.f, 0.f}; acc[1] = (f32x4){0.f, 0.f, 0.f, 0.f};
    u32x4 rr[PF][4];
#pragma unroll
    for (int p = 0; p < PF; ++p) { rr[p][0] = *(const u32x4*)(ga + 128 * p); rr[p][1] = *(const u32x4*)(ga + (size_t)32 * K + 128 * p); rr[p][2] = *(const u32x4*)(gb + 128 * p); rr[p][3] = *(const u32x4*)(gb + (size_t)32 * K + 128 * p); }
    asm volatile("" ::: "memory");
    __syncthreads();
#pragma unroll
    for (int c = 0; c < NC; ++c) {
        { LAS unsigned char* w = sm + (c & 1) * BUF + pr0 * RS + 16 * pc; *(LAS u32x4*)w = rr[c % PF][0]; *(LAS u32x4*)(w + 32 * RS) = rr[c % PF][1]; *(LAS u32x4*)(w + 64 * RS) = rr[c % PF][2]; *(LAS u32x4*)(w + 96 * RS) = rr[c % PF][3]; }
        if (c + PF < NC) { const int n = c + PF; rr[c % PF][0] = *(const u32x4*)(ga + 128 * n); rr[c % PF][1] = *(const u32x4*)(ga + (size_t)32 * K + 128 * n); rr[c % PF][2] = *(const u32x4*)(gb + 128 * n); rr[c % PF][3] = *(const u32x4*)(gb + (size_t)32 * K + 128 * n); }
        asm volatile("" ::: "memory");
        __syncthreads();
        const LAS unsigned char* rd = sm + (c & 1) * BUF;
#pragma unroll
        for (int kk = 0; kk < 4; ++kk) {
            const bf16x8 a = *(const LAS bf16x8*)(rd + (16 * rt + r16) * RS + 64 * kk + 16 * g);
            const bf16x8 b0 = *(const LAS bf16x8*)(rd + (64 + 32 * ch + r16) * RS + 64 * kk + 16 * g), b1 = *(const LAS bf16x8*)(rd + (64 + 32 * ch + 16 + r16) * RS + 64 * kk + 16 * g);
            acc[0] = mfma16(a, b0, acc[0]); acc[1] = mfma16(a, b1, acc[1]); }
    }
    __syncthreads();
}
__device__ __forceinline__ void mini_oproj(PK P, const Ctx& C, int L) {
    unsigned char* ws = P->ws; const int lane = C.lane, rt = C.wave >> 1, ch = C.wave & 1, r16 = lane & 15, g = lane >> 4;
    for (int u = C.blk; u < 256; u += C.nblk) { const int row0 = MP + 64 * (u >> 4), col0 = 64 * (u & 15);
        f32x4 a1[2], a2[2];
        mini_mma<512>((const bf16*)(ws + WS_OGR), (const bf16*)(ws + WS_WOR) + (size_t)L * DM * 512, row0, col0, C, a1);
        mini_mma<512>((const bf16*)(ws + WS_OGA), (const bf16*)(ws + WS_WOA) + (size_t)L * DM * 512, row0, col0, C, a2);
        const bf16* Z = (const bf16*)(ws + WS_Z); bf16* MB = (bf16*)(ws + WS_MB);
#pragma unroll
        for (int j = 0; j < 2; ++j)
#pragma unroll
            for (int r = 0; r < 4; ++r) { const size_t row = (size_t)(row0 + 16 * rt + 4 * g + r); const int col = col0 + 32 * ch + 16 * j + r16;
                const float m = sigmoidf_(bf2f(Z[row * NZ + ZC_GR + col])) * a1[j][r] + sigmoidf_(bf2f(Z[row * NZ + ZC_GA + col])) * a2[j][r];
                MB[row * DM + col] = (bf16)(pk2(m, 0.f) & 0xffffu); } }
}
__device__ __forceinline__ void mini_wout(PK P, const Ctx& C, int L) {
    unsigned char* ws = P->ws; const int lane = C.lane, rt = C.wave >> 1, ch = C.wave & 1, r16 = lane & 15, g = lane >> 4;
    const float* xs = P->in[I_XS] - (size_t)MP * DM;
    const bf16* xh = (const bf16*)(ws + WS_XB0);
    for (int u = C.blk; u < 256; u += C.nblk) { const int row0 = MP + 64 * (u >> 4), col0 = 64 * (u & 15);
        f32x4 a1[2];
        mini_mma<1024>((const bf16*)(ws + WS_MB), (const bf16*)(ws + WS_WOUT) + (size_t)L * DM * DM, row0, col0, C, a1);
        bf16* XB1 = (bf16*)(ws + WS_XB1);
#pragma unroll
        for (int j = 0; j < 2; ++j)
#pragma unroll
            for (int r = 0; r < 4; ++r) { const size_t row = (size_t)(row0 + 16 * rt + 4 * g + r); const int col = col0 + 32 * ch + 16 * j + r16;
                const float x = (L == 0) ? xs[row * DM + col] : bf2f(xh[row * DM + col]);
                XB1[row * DM + col] = (bf16)(pk2(x + a1[j][r], 0.f) & 0xffffu); } }
}
__device__ __forceinline__ void mini_ple(PK P, const Ctx& C, int L, bool do_ss = true) {
    unsigned char* ws = P->ws; const int lane = C.lane, rt = C.wave >> 1, ch = C.wave & 1, r16 = lane & 15, g = lane >> 4;
    float* rowss = (L + 1 < DEPTH && do_ss) ? (float*)(ws + WS_CTL) + CW_ROWSS1 : nullptr;
    for (int u = C.blk; u < 256; u += C.nblk) { const int row0 = MP + 64 * (u >> 4), col0 = 64 * (u & 15);
        f32x4 a1[2], a2[2];
        mini_mma<1024>((const bf16*)(ws + WS_XB1), (const bf16*)(ws + WS_WPG) + (size_t)L * DM * DM, row0, col0, C, a1);
        mini_mma<256>((const bf16*)(ws + WS_PB) + (size_t)L * MT * 256, (const bf16*)(ws + WS_WPP) + (size_t)L * DM * 256, row0, col0, C, a2);
        const bf16* XB1 = (const bf16*)(ws + WS_XB1); float* Y = P->out; bf16* XB0 = (bf16*)(ws + WS_XB0);
#pragma unroll
        for (int r = 0; r < 4; ++r) { const size_t row = (size_t)(row0 + 16 * rt + 4 * g + r); float ssq = 0.f;
#pragma unroll
            for (int j = 0; j < 2; ++j) { const int col = col0 + 32 * ch + 16 * j + r16;
                const float v = bf2f(XB1[row * DM + col]) + sigmoidf_(a1[j][r]) * a2[j][r]; if (L + 1 == DEPTH) Y[row * DM + col] = v; XB0[row * DM + col] = (bf16)(pk2(v, 0.f) & 0xffffu); ssq += v * v; }
            if (rowss != nullptr) { ssq += shx<1>(ssq, lane); ssq += shx<2>(ssq, lane); ssq += shx<4>(ssq, lane); ssq += shx<8>(ssq, lane); if (r16 == 0) atomicAdd(rowss + row, ssq); } } }
}


__device__ __forceinline__ void mini_inproj_gates(PK P, const Ctx& C, int L) {
    unsigned char* ws = P->ws; const int lane = C.lane, rt = C.wave >> 1, ch = C.wave & 1, r16 = lane & 15, g = lane >> 4;
    const float* rowss = (L == 0) ? (const float*)(ws + WS_ROWSS0) : (const float*)(ws + WS_CTL) + CW_ROWSS1;
    bf16* Z = (bf16*)(ws + WS_Z);
    for (int u = C.blk; u < 16 * 30; u += C.nblk) { const int row0 = MP + 64 * (u / 30), col0 = 15 * 256 + 64 * (u % 30);
        f32x4 a1[2];
        mini_mma<1024>((const bf16*)(ws + WS_XB0), (const bf16*)(ws + WS_WIN) + (size_t)L * NZ * DM, row0, col0, C, a1);
#pragma unroll
        for (int r = 0; r < 4; ++r) { const size_t row = (size_t)(row0 + 16 * rt + 4 * g + r); const float rs = __builtin_amdgcn_rsqf(rowss[row] * (1.0f / 1024.0f) + 1e-6f);
#pragma unroll
            for (int j = 0; j < 2; ++j) Z[row * NZ + col0 + 32 * ch + 16 * j + r16] = (bf16)(pk2(a1[j][r] * rs, 0.f) & 0xffffu); } }
}
__global__ void __launch_bounds__(NTHREADS, 2) mk_fwd(Params Pval) {
    extern __shared__ __attribute__((aligned(16))) unsigned char lds_raw[];
    LAS unsigned char* lds = (LAS unsigned char*)lds_raw;
    volatile LAS unsigned* MISC = (volatile LAS unsigned*)(lds + MISC_OFF);
    const int wave_s = __builtin_amdgcn_readfirstlane((int)threadIdx.x >> 6);
    for (int u = wave_s * 64 + hw_lane(); u < (LDS_BYTES - RING_BYTES) / 4; u += NTHREADS) ((LAS unsigned*)(lds + RING_BYTES))[u] = 0u;
    __syncthreads();
    const int lo = Pval.ph_lo, hi = Pval.ph_hi;
    XcdBarrier bar; bar.bar = (unsigned*)(Pval.ws + WS_CTL) + CW_BAR + Pval.li * XCD_BAR_WORDS; bar.x = 0; bar.st = MISC + 8;
    if (hi - lo > 1) bar = xcd_barrier_post(bar.bar, MISC + 8, wave_s == 0 && hw_lane() == 0);
#ifndef STEPSEL
#define STEPSEL(j) true
#endif
#define IN(k) (lo <= (k) && (k) < hi)
#ifndef DUPMASK
#define DUPMASK 0
#endif
#ifndef XBAR2
#define XBAR2 0
#endif
#ifndef MINI2
#define MINI2 0
#endif
#ifndef DUPMODE
#define DUPMODE 3
#endif
#ifndef CSEL
#define CSEL 15
#endif
#define INL(j) (STEPSEL(j) && IN(pb + (j)))
#define NREP(j) (((DUPMASK) >> (j)) & 1 ? 2 : 1)
#define SEAM(k) do { if (IN((k) + 1)) { XcdBarrier b2_ = bar; asm volatile("" : "+s"(b2_.bar), "+s"(b2_.x)); int t0_ = wave_s * 64 + hw_lane(salt_); asm volatile("" : "+v"(t0_)); xcd_barrier(b2_, t0_ == 0); if (XBAR2) xcd_barrier(b2_, t0_ == 0); } } while (0)
#define PH_ENTER() PK P = phase_args(); const Ctx C = phase_ctx(lds, wave_s, salt_); unsigned char* ws = P->ws; (void)ws; (void)C
    #ifndef PRODUP
#define PRODUP 1
#endif
    const int salt_ = 0;
    if (STEPSEL(-1) && IN(0)) { for (int rep = 0; rep < PRODUP; ++rep) { PH_ENTER(); p0_prologue(P, C); __syncthreads(); } SEAM(0); }
#pragma unroll 1
    for (int L = 0; L < DEPTH; ++L) {
        const int pb = 1 + 8 * L; const int salt_ = pb;
        if (INL(0)) {
            for (int rep = 0; rep < NREP(0); ++rep) { PH_ENTER();
            pg8::Gemm g{(const bf16*)(ws + WS_XB0), (const bf16*)(ws + WS_WIN) + (size_t)L * NZ * DM, MT, NZ, DM}; InProjOrder S; S.init(C.nblk, C.blk);
            EpiZ E{ws, P->out, L == 0 ? (const float*)(ws + WS_ROWSS0) : (const float*)(ws + WS_CTL) + CW_ROWSS1, P->in[I_QG] + L * 64, P->in[I_KG] + L * 64, L, lds + XPOSE_OFF};
            pg8::gemm_phase<EpiZ, InProjOrder, true, true>(lds, g, S, E, C.tid); }
            for (int rm = 0; rm < (MINI2 ? 2 : 1); ++rm) { PH_ENTER(); mini_inproj_gates(P, C, L); }
            SEAM(pb + 0); }
        if (INL(1)) { for (int rep = 0; rep < NREP(1); ++rep) { PH_ENTER(); (void)P; (void)C; }   }
        if (INL(2)) { for (int rep = 0; rep < NREP(2); ++rep) { PH_ENTER(); phase_c(P, C, L, rep == 0 ? 15 : CSEL); __syncthreads(); } SEAM(pb + 2); }
        if (INL(3)) { for (int rep = 0; rep < NREP(3); ++rep) { PH_ENTER(); phase_d(P, C, L, rep == 0 ? 3 : DUPMODE); __syncthreads(); } SEAM(pb + 3); }
        if (INL(4)) {   }
        if (INL(5)) {
            for (int rep = 0; rep < NREP(5); ++rep) {
            { PH_ENTER(); mini_oproj(P, C, L); }
            { PH_ENTER(); pg8::StaticOrder S; S.init(MP, DM, C.nblk, C.blk);
              pg8::Gemm g{(const bf16*)(ws + WS_OGR), (const bf16*)(ws + WS_WOR) + (size_t)L * DM * 512, MP, DM, 512}; EpiGate<0> E{(const bf16*)(ws + WS_Z), ZC_GR, (bf16*)(ws + WS_TMP), (bf16*)(ws + WS_MB)};
              pg8::gemm_phase<EpiGate<0>, pg8::StaticOrder, true, true>(lds, g, S, E, C.tid); }
            { PH_ENTER(); pg8::StaticOrder S; S.init(MP, DM, C.nblk, C.blk);
              pg8::Gemm g{(const bf16*)(ws + WS_OGA), (const bf16*)(ws + WS_WOA) + (size_t)L * DM * 512, MP, DM, 512}; EpiGate<1> E{(const bf16*)(ws + WS_Z), ZC_GA, (bf16*)(ws + WS_TMP), (bf16*)(ws + WS_MB)};
              pg8::gemm_phase<EpiGate<1>, pg8::StaticOrder, true, true>(lds, g, S, E, C.tid); } }
            SEAM(pb + 5); }
        if (INL(6)) {
            for (int rep = 0; rep < NREP(6); ++rep) {
            { PH_ENTER(); mini_wout(P, C, L); }
            { PH_ENTER(); pg8::StaticOrder S; S.init(MP, DM, C.nblk, C.blk);
            pg8::Gemm g{(const bf16*)(ws + WS_MB), (const bf16*)(ws + WS_WOUT) + (size_t)L * DM * DM, MP, DM, DM};
            EpiRes E{P->in[I_XP], P->in[I_XS], L == 0 ? (const bf16*)nullptr : (const bf16*)(ws + WS_XB0), (bf16*)(ws + WS_XB1)};
            pg8::gemm_phase<EpiRes, pg8::StaticOrder, true, true>(lds, g, S, E, C.tid); } }
            SEAM(pb + 6); }
        if (INL(7)) {
            for (int rep = 0; rep < NREP(7); ++rep) {
            { PH_ENTER(); mini_ple(P, C, L, rep == NREP(7) - 1); }
            { PH_ENTER(); pg8::StaticOrder S; S.init(MP, DM, C.nblk, C.blk);
              pg8::Gemm g{(const bf16*)(ws + WS_XB1), (const bf16*)(ws + WS_WPG) + (size_t)L * DM * DM, MP, DM, DM}; EpiPle<0> E{(bf16*)(ws + WS_TMP), (const bf16*)(ws + WS_XB1), nullptr, (bf16*)(ws + WS_XB0), nullptr};
              pg8::gemm_phase<EpiPle<0>, pg8::StaticOrder, true, true>(lds, g, S, E, C.tid); }
            if (L + 1 < DEPTH) { PH_ENTER(); pg8::StaticOrder S; S.init(MP, DM, C.nblk, C.blk);
                pg8::Gemm g{(const bf16*)(ws + WS_PB) + (size_t)L * MT * 256, (const bf16*)(ws + WS_WPP) + (size_t)L * DM * 256, MP, DM, 256};
                EpiPle<1> E{(bf16*)(ws + WS_TMP), (const bf16*)(ws + WS_XB1), P->out, (bf16*)(ws + WS_XB0), (float*)(ws + WS_CTL) + CW_ROWSS1};
                pg8::gemm_phase<EpiPle<1>, pg8::StaticOrder, true, true>(lds, g, S, E, C.tid); }
            else { PH_ENTER(); pg8::StaticOrder S; S.init(MP, DM, C.nblk, C.blk);
                pg8::Gemm g{(const bf16*)(ws + WS_PB) + (size_t)L * MT * 256, (const bf16*)(ws + WS_WPP) + (size_t)L * DM * 256, MP, DM, 256};
                EpiPle<2> E{(bf16*)(ws + WS_TMP), (const bf16*)(ws + WS_XB1), P->out, (bf16*)(ws + WS_XB0), (float*)(ws + WS_CTL) + CW_ROWSS1};
                pg8::gemm_phase<EpiPle<2>, pg8::StaticOrder, true, true>(lds, g, S, E, C.tid); } }
            SEAM(pb + 7); }
    }
#undef IN
#undef INL
#undef SEAM
#undef PH_ENTER
}

#ifndef MK_N_LAUNCHES
#define MK_N_LAUNCHES 1
#endif
extern "C" void kernel_launch(void* const* d_in, const int* in_sizes, int n_in, void* d_out, int out_size, void* d_ws, size_t ws_size, hipStream_t stream) {
    static int grid = 0;
    if (grid == 0) {
        if (n_in != 18 || out_size != (int)O_END || ws_size < WS_END) { fprintf(stderr, "kernel_launch: unexpected problem: n_in %d out %d ws %zu; nothing launched\n", n_in, out_size, ws_size); grid = -1; return; }
        int dev = 0, cus = 0, per_cu = 0;
        if (hipGetDevice(&dev) != hipSuccess || hipDeviceGetAttribute(&cus, hipDeviceAttributeMultiprocessorCount, dev) != hipSuccess) { grid = -1; return; }
        if (hipFuncSetAttribute((const void*)mk_fwd, hipFuncAttributeMaxDynamicSharedMemorySize, LDS_BYTES) != hipSuccess) { fprintf(stderr, "kernel_launch: hipFuncSetAttribute failed\n"); grid = -1; return; }
        if (hipOccupancyMaxActiveBlocksPerMultiprocessor(&per_cu, (const void*)mk_fwd, NTHREADS, LDS_BYTES) != hipSuccess || per_cu < 1) { fprintf(stderr, "kernel_launch: occupancy query says %d blocks per CU\n", per_cu); grid = -1; (void)hipGetLastError(); return; }
        grid = cus;
    }
    if (grid < 0) return;
    (void)hipMemsetAsync((char*)d_ws + WS_CTL, 0, CTL_ZERO_BYTES, stream);
    Params a{};
    for (int i = 0; i < 18; ++i) a.in[i] = (const float*)d_in[i];
    a.out = (float*)d_out; a.ws = (unsigned char*)d_ws;
#if MK_N_LAUNCHES == 1
    a.ph_lo = 0; a.ph_hi = N_PHASES; a.li = 0;
    hipLaunchKernelGGL(mk_fwd, dim3(grid), dim3(NTHREADS), LDS_BYTES, stream, a);
#else
    for (int li = 0; li < N_PHASES; ++li) { a.ph_lo = li; a.ph_hi = li + 1; a.li = 0; hipLaunchKernelGGL(mk_fwd, dim3(grid), dim3(NTHREADS), LDS_BYTES, stream, a); }
#endif
    (void)in_sizes;
}
```

```cpp
#include <hip/hip_runtime.h>
#include <cstdio>
#include <cstdint>
namespace pg8 {
#define PG8_LAS __attribute__((address_space(3)))
typedef unsigned short bf16_t;
typedef short bf16x8 __attribute__((ext_vector_type(8)));
typedef float f32x4 __attribute__((ext_vector_type(4)));
typedef unsigned u32x4 __attribute__((ext_vector_type(4)));
constexpr int BM = 256, BK = 64, HALF = 128, HTB = HALF * BK * 2  , STAGE_BYTES = 8 * HTB, NXCD = 8, WGM = 8;

__host__ __device__ __forceinline__ int lds_byte(int r, int c) { const int st = (r >> 4) * 2 + (c >> 5), rr = r & 15, cc = c & 31, ob = rr * 64 + cc * 2; return st * 1024 + (ob ^ (((ob >> 9) & 1) << 5)); }
__host__ __device__ __forceinline__ void stage_rc(int b, int& R, int& C) { const int st = b / 1024, sb = b % 1024, swz = sb ^ (((sb >> 9) & 1) << 5); R = (st >> 1) * 16 + swz / 64; C = (st & 1) * 32 + (swz % 64) / 2; }
__host__ __device__ __forceinline__ int perm32(int rho) { const int n = rho >> 4, i = rho & 15; return 8 * (i >> 2) + 4 * n + (i & 3); }

struct Unit { int pm, pn; };
struct Gemm { const bf16_t* A; const bf16_t* Bt; int M, N, K; };

struct StaticOrder {
    int nM, nN, nwg, G, c;
    __host__ __device__ void init(int M, int N, int G_, int c_) { nM = M / BM; nN = N / BM; nwg = nM * nN; G = G_; c = c_; }
    __host__ __device__ bool next(int i, Unit& u) const {
        const int L = i * G + c; if (L >= nwg) return false;
        int wgid = L; { const int q = nwg / NXCD, r = nwg % NXCD, xcd = wgid % NXCD, off = wgid / NXCD; wgid = (xcd < r ? xcd * (q + 1) : r * (q + 1) + (xcd - r) * q) + off; }
        const int nig = WGM * nN, gid = wgid / nig, fm = gid * WGM, gsz = (nM - fm) < WGM ? (nM - fm) : WGM;
        u.pm = fm + ((wgid % nig) % gsz); u.pn = (wgid % nig) / gsz; return true;
    }
    __device__ __forceinline__ void a_ready(const Unit&) const {}
    __device__ __forceinline__ void done(const Unit&) const {}
};
__device__ __forceinline__ unsigned cvt_pk_bf16(float lo, float hi) { unsigned r; asm volatile("v_cvt_pk_bf16_f32 %0, %1, %2" : "=v"(r) : "v"(lo), "v"(hi)); return r; }

template <class Epi, class Sched, bool ALIGN_EPI = false, bool SP2 = false>
__device__ __forceinline__ void gemm_phase(PG8_LAS unsigned char* lds, const Gemm g, const Sched& S, const Epi& E, int tid_) {
    asm volatile("" : "+v"(tid_)); const int tid = tid_, wid = __builtin_amdgcn_readfirstlane(tid >> 6), lane = tid & 63, wr = wid >> 2, wc = wid & 3, fr = lane & 15, fq = lane >> 4;
    const int K = g.K, nt = K / BK;
    unsigned voffA[2], voffB[2];
#pragma unroll
    for (int i = 0; i < 2; ++i) { int R, C; stage_rc(tid * 16 + i * 8192, R, C); const int Rb = Epi::PERM ? ((R & ~31) + perm32(R & 31)) : R;
        voffA[i] = (unsigned)(R * K + C) * 2u; voffB[i] = (unsigned)(Rb * K + C) * 2u; }
    const size_t kstep = (size_t)(BK * 2);
    const size_t hstep = (size_t)HALF * K * 2;
    const size_t tstep = 2 * hstep;
    const unsigned ldsw = (unsigned)wid * 1024u;
    const int aoff = lds_byte(wr * 64 + fr, fq * 8), boff = lds_byte(wc * 32 + fr, fq * 8);
#define PG8_SA(b, h) (((b) * 2 + (h)) * HTB)
#define PG8_SB(b, h) ((4 + (b) * 2 + (h)) * HTB)
#define PG8_STAGE(bufoff, gbase, voff) do { _Pragma("unroll") for (int _i = 0; _i < 2; ++_i) \
        __builtin_amdgcn_global_load_lds((const unsigned*)((const char*)(gbase) + (voff)[_i]), (PG8_LAS unsigned*)(lds + (bufoff) + ldsw + _i * 8192), 16, 0, 0); } while (0)
#define PG8_LDA(dst, b, h) do { _Pragma("unroll") for (int m = 0; m < 4; ++m) _Pragma("unroll") for (int k = 0; k < 2; ++k) dst[m][k] = *(const PG8_LAS bf16x8*)(lds + PG8_SA(b, h) + aoff + m * 2048 + k * 1024); } while (0)
#define PG8_LDB(dst, b, h) do { _Pragma("unroll") for (int n = 0; n < 2; ++n) _Pragma("unroll") for (int k = 0; k < 2; ++k) dst[n][k] = *(const PG8_LAS bf16x8*)(lds + PG8_SB(b, h) + boff + n * 2048 + k * 1024); } while (0)
#define PG8_MMA(ai, bj, At, Bt) do { __builtin_amdgcn_s_setprio(1); _Pragma("unroll") for (int m = 0; m < 4; ++m) _Pragma("unroll") for (int n = 0; n < 2; ++n) _Pragma("unroll") for (int k = 0; k < 2; ++k) \
        acc[ai][bj][m][n] = __builtin_amdgcn_mfma_f32_16x16x32_bf16(Bt[n][k], At[m][k], acc[ai][bj][m][n], 0, 0, 0); __builtin_amdgcn_s_setprio(0); } while (0)
#define PG8_WAIT_V(n) asm volatile("s_waitcnt vmcnt(" #n ")" ::: "memory")
#define PG8_WAIT_L(n) asm volatile("s_waitcnt lgkmcnt(" #n ")" ::: "memory")
#define PG8_BAR __builtin_amdgcn_s_barrier()
#define PG8_SCHED __builtin_amdgcn_sched_barrier(0)
    Unit cur, nxt; int ui = 0;
    if (!S.next(0, cur)) return;
    f32x4 acc[2][2][4][2];
#pragma unroll
    for (int a = 0; a < 2; ++a)
#pragma unroll
        for (int b = 0; b < 2; ++b)
#pragma unroll
            for (int m = 0; m < 4; ++m)
#pragma unroll
                for (int n = 0; n < 2; ++n) acc[a][b][m][n] = (f32x4){0.f, 0.f, 0.f, 0.f};
    bf16x8 At[4][2], B0[2][2], B1[2][2];
    const char* cA = (const char*)g.A + (size_t)cur.pm * tstep; const char* cB = (const char*)g.Bt + (size_t)cur.pn * tstep;
    S.a_ready(cur);
    if constexpr (SP2) {
        PG8_STAGE(PG8_SB(0, 0), cB, voffB); PG8_STAGE(PG8_SB(0, 1), cB + hstep, voffB); PG8_STAGE(PG8_SA(0, 0), cA, voffA); PG8_STAGE(PG8_SA(0, 1), cA + hstep, voffA);
        if (wr == 1) PG8_BAR;
        PG8_WAIT_V(2); PG8_BAR;
        PG8_STAGE(PG8_SB(1, 0), cB + kstep, voffB); PG8_STAGE(PG8_SA(1, 0), cA + kstep, voffA); PG8_STAGE(PG8_SB(1, 1), cB + hstep + kstep, voffB);
        PG8_WAIT_V(6); PG8_BAR;
    } else {
        PG8_STAGE(PG8_SB(0, 0), cB, voffB); PG8_STAGE(PG8_SA(0, 0), cA, voffA); PG8_STAGE(PG8_SB(0, 1), cB + hstep, voffB); PG8_STAGE(PG8_SA(0, 1), cA + hstep, voffA);
        if (wr == 1) PG8_BAR;
        PG8_WAIT_V(4); PG8_BAR;
        PG8_STAGE(PG8_SB(1, 0), cB + kstep, voffB); PG8_STAGE(PG8_SA(1, 0), cA + kstep, voffA); PG8_STAGE(PG8_SB(1, 1), cB + hstep + kstep, voffB);
        PG8_WAIT_V(6); PG8_BAR;
    }
    for (;;) {
        const bool has_next = S.next(ui + 1, nxt);
        const char* nA = has_next ? (const char*)g.A + (size_t)nxt.pm * tstep : cA; const char* nB = has_next ? (const char*)g.Bt + (size_t)nxt.pn * tstep : cB;
        for (int t = 0; t < nt; t += 2) {
            const bool last = (t == nt - 2);
            const char* a1 = cA + (size_t)(t + 1) * kstep;
            const char* a2 = last ? nA : cA + (size_t)(t + 2) * kstep; const char* b2 = last ? nB : cB + (size_t)(t + 2) * kstep;
            const char* a3 = a2 + kstep; const char* b3 = b2 + kstep;
            if (last && has_next) S.a_ready(nxt);
            if constexpr (SP2) {
            PG8_LDB(B0, 0, 0); PG8_LDB(B1, 0, 1); PG8_SCHED; PG8_LDA(At, 0, 0); PG8_STAGE(PG8_SA(1, 1), a1 + hstep, voffA);
            PG8_WAIT_V(8); PG8_WAIT_L(0); PG8_BAR; PG8_MMA(0, 0, At, B0); PG8_MMA(0, 1, At, B1); PG8_BAR; PG8_SCHED;
            PG8_LDA(At, 0, 1); PG8_STAGE(PG8_SB(0, 0), b2, voffB); PG8_STAGE(PG8_SB(0, 1), b2 + hstep, voffB); PG8_STAGE(PG8_SA(0, 0), a2, voffA);
            PG8_WAIT_V(8); PG8_WAIT_L(0); PG8_BAR; PG8_MMA(1, 0, At, B0); PG8_MMA(1, 1, At, B1); PG8_BAR; PG8_SCHED;
            PG8_LDB(B0, 1, 0); PG8_LDB(B1, 1, 1); PG8_SCHED; PG8_LDA(At, 1, 0); PG8_STAGE(PG8_SA(0, 1), a2 + hstep, voffA);
            PG8_WAIT_V(8); PG8_WAIT_L(0); PG8_BAR; PG8_MMA(0, 0, At, B0); PG8_MMA(0, 1, At, B1); PG8_BAR; PG8_SCHED;
            PG8_LDA(At, 1, 1); PG8_STAGE(PG8_SB(1, 0), b3, voffB); PG8_STAGE(PG8_SB(1, 1), b3 + hstep, voffB); PG8_STAGE(PG8_SA(1, 0), a3, voffA);
            PG8_WAIT_V(8); PG8_WAIT_L(0); PG8_BAR; PG8_MMA(1, 0, At, B0); PG8_MMA(1, 1, At, B1); PG8_BAR; PG8_SCHED;
            } else {
            PG8_LDB(B0, 0, 0); PG8_SCHED; PG8_LDA(At, 0, 0); PG8_STAGE(PG8_SA(1, 1), a1 + hstep, voffA);
            PG8_WAIT_L(8); PG8_BAR; PG8_WAIT_L(0); PG8_MMA(0, 0, At, B0); PG8_BAR; PG8_SCHED;
            PG8_LDB(B1, 0, 1); PG8_STAGE(PG8_SB(0, 0), b2, voffB);
            PG8_BAR; PG8_WAIT_L(0); PG8_MMA(0, 1, At, B1); PG8_BAR;
            PG8_LDA(At, 0, 1); PG8_STAGE(PG8_SA(0, 0), a2, voffA);
            PG8_BAR; PG8_WAIT_L(0); PG8_MMA(1, 0, At, B0); PG8_BAR; PG8_SCHED;
            PG8_STAGE(PG8_SB(0, 1), b2 + hstep, voffB);
            PG8_WAIT_V(6); PG8_BAR; PG8_MMA(1, 1, At, B1); PG8_BAR;
            PG8_LDB(B0, 1, 0); PG8_SCHED; PG8_LDA(At, 1, 0); PG8_STAGE(PG8_SA(0, 1), a2 + hstep, voffA);
            PG8_WAIT_L(8); PG8_BAR; PG8_WAIT_L(0); PG8_MMA(0, 0, At, B0); PG8_BAR; PG8_SCHED;
            PG8_LDB(B1, 1, 1); PG8_STAGE(PG8_SB(1, 0), b3, voffB);
            PG8_BAR; PG8_WAIT_L(0); PG8_MMA(0, 1, At, B1); PG8_BAR;
            PG8_LDA(At, 1, 1); PG8_STAGE(PG8_SA(1, 0), a3, voffA);
            PG8_BAR; PG8_WAIT_L(0); PG8_MMA(1, 0, At, B0); PG8_BAR; PG8_SCHED;
            PG8_STAGE(PG8_SB(1, 1), b3 + hstep, voffB);
            PG8_WAIT_V(6); PG8_BAR; PG8_MMA(1, 1, At, B1); PG8_BAR;
            }
        }
        if constexpr (ALIGN_EPI) { if (wr == 0) PG8_BAR; }
        if constexpr (!Epi::AFTER_DRAIN) { E(acc, cur, wr, wc, fr, fq); S.done(cur); }
        if (!has_next) break;
#pragma unroll
        for (int a = 0; a < 2; ++a)
#pragma unroll
            for (int b = 0; b < 2; ++b)
#pragma unroll
                for (int m = 0; m < 4; ++m)
#pragma unroll
                    for (int n = 0; n < 2; ++n) acc[a][b][m][n] = (f32x4){0.f, 0.f, 0.f, 0.f};
        cur = nxt; cA = nA; cB = nB; ++ui;
        if constexpr (ALIGN_EPI) { if (wr == 1) PG8_BAR; }
    }
    PG8_WAIT_V(0);
    if constexpr (!ALIGN_EPI) { if (wr == 0) PG8_BAR; }
    PG8_BAR;
    if constexpr (Epi::AFTER_DRAIN) { E.fused(acc, cur, wr, wc, fr, fq, lds, wid, lane); S.done(cur); }
#undef PG8_SA
#undef PG8_SB
#undef PG8_STAGE
#undef PG8_LDA
#undef PG8_LDB
#undef PG8_MMA
#undef PG8_WAIT_V
#undef PG8_WAIT_L
#undef PG8_BAR
#undef PG8_SCHED
}
}

#define GAS __attribute__((address_space(1)))
#define LAS __attribute__((address_space(3)))
typedef unsigned short bf16;
typedef float f32x4 __attribute__((ext_vector_type(4)));
typedef float f32x2 __attribute__((ext_vector_type(2)));
typedef float f32x16 __attribute__((ext_vector_type(16)));
typedef short bf16x8 __attribute__((ext_vector_type(8)));
typedef unsigned u32x4 __attribute__((ext_vector_type(4)));
typedef unsigned u32x2 __attribute__((ext_vector_type(2)));

constexpr int NWAVES = 8, NTHREADS = 512;
constexpr int DM = 1024, NB = 4, SEQ = 4096, DEPTH = 2, DB = 128, DS = 8, PAST = 2048, NPAGES = 16, NPOOL = 2560;
constexpr int MP = NB * SEQ, MS = DB * DS, MT = MP + MS;
constexpr int NZ = 5888;
constexpr int WIN_N = 5700;
constexpr int ZC_RQ = 0, ZC_RK = 512, ZC_RV = 1024, ZC_RZ = 1536, ZC_AQ = 2048, ZC_AK = 2560, ZC_AV = 2688, ZC_AZ = 2816, ZC_IQ = 3328, ZC_IK = 3584, ZC_IW = 3648, ZC_GR = 3712, ZC_GA = 4736;
constexpr int SS_LD = 2064;
constexpr int TOPK = 256;
constexpr size_t O_Y = 0, O_KP = 17825792, O_VP = 22020096, O_IKP = 26214400, O_RSP = 28311552, O_KS = 28835840, O_VS = 29097984, O_IKS = 29360128, O_RSS = 29491200, O_END = 46268416;
constexpr size_t MiB = 1u << 20;
constexpr size_t WS_CTL = 0, CTL_ZERO_BYTES = 1 * MiB;
constexpr size_t WS_WIN = 1 * MiB, WS_WOR = 24 * MiB, WS_WOA = 26 * MiB, WS_WOUT = 28 * MiB, WS_WPG = 32 * MiB, WS_WPP = 36 * MiB;
constexpr size_t WS_ROPER = 37 * MiB, WS_ROPEA = 39 * MiB, WS_ROWSS0 = 39 * MiB + 256 * 1024, WS_IW = 39 * MiB + 512 * 1024;
constexpr size_t WS_XB0 = 40 * MiB, WS_XB1 = 74 * MiB, WS_X1 = 108 * MiB, WS_TMP = 176 * MiB, WS_MB = 244 * MiB, WS_Z = 278 * MiB;
constexpr size_t WS_RQ = 474 * MiB, WS_RK = 490 * MiB, WS_RKT = 506 * MiB, WS_RVT = 522 * MiB, WS_AQ = 538 * MiB, WS_KB = 555 * MiB, WS_VB = 559 * MiB;
constexpr size_t WS_IQ = 563 * MiB, WS_IKB = 572 * MiB, WS_PB = 930 * MiB, WS_KVT = 583 * MiB, WS_ST = 615 * MiB, WS_OGR = 631 * MiB, WS_OGA = 648 * MiB;
constexpr size_t WS_SS = 665 * MiB, WS_SP = 674 * MiB, WS_END = 948 * MiB;
static_assert(WS_Z + (size_t)MT * NZ * 2 <= WS_RQ && WS_SS + (size_t)MS * SS_LD * 4 <= WS_SP && WS_IW + (size_t)MT * 16 <= WS_XB0, "ws map");
constexpr int CW_TMO = 0, CW_BAR = 4096, CW_ROWSS1 = 131072;
constexpr int N_PHASES = 1 + 8 * DEPTH;
constexpr int RING_BYTES = 131072, MISC_OFF = RING_BYTES + 320, XPOSE_OFF = RING_BYTES + 1024, LDS_BYTES = XPOSE_OFF + 8 * 2048;

#define LDS_WAIT() asm volatile("s_waitcnt lgkmcnt(0)" ::: "memory")
#define VM_WAIT() asm volatile("s_waitcnt vmcnt(0)" ::: "memory")
__device__ __forceinline__ unsigned pk2(float lo, float hi) { unsigned r; asm("v_cvt_pk_bf16_f32 %0, %1, %2" : "=v"(r) : "v"(lo), "v"(hi)); return r; }
__device__ __forceinline__ float bflo(unsigned w) { return __uint_as_float(w << 16); }
__device__ __forceinline__ float bfhi(unsigned w) { return __uint_as_float(w & 0xffff0000u); }
__device__ __forceinline__ float bf2f(bf16 b) { return __uint_as_float(((unsigned)b) << 16); }
__device__ __forceinline__ float sigmoidf_(float x) { return __builtin_amdgcn_rcpf(1.0f + __builtin_amdgcn_exp2f(x * -1.4426950408889634f)); }
__device__ __forceinline__ float siluf_(float x) { return x * sigmoidf_(x); }
__device__ __forceinline__ void unpack8(const u32x4 w, float (&f)[8]) { f[0] = bflo(w.x); f[1] = bfhi(w.x); f[2] = bflo(w.y); f[3] = bfhi(w.y); f[4] = bflo(w.z); f[5] = bfhi(w.z); f[6] = bflo(w.w); f[7] = bfhi(w.w); }
__device__ __forceinline__ u32x4 pack8(const float (&f)[8]) { u32x4 w; w.x = pk2(f[0], f[1]); w.y = pk2(f[2], f[3]); w.z = pk2(f[4], f[5]); w.w = pk2(f[6], f[7]); return w; }
__device__ __forceinline__ bf16x8 as_bf16x8(const u32x4 w) { return __builtin_bit_cast(bf16x8, w); }
__device__ __forceinline__ f32x4 mfma16(bf16x8 a, bf16x8 b, f32x4 c) { return __builtin_amdgcn_mfma_f32_16x16x32_bf16(a, b, c, 0, 0, 0); }
__device__ __forceinline__ f32x16 mfma32(bf16x8 a, bf16x8 b, f32x16 c) { return __builtin_amdgcn_mfma_f32_32x32x16_bf16(a, b, c, 0, 0, 0); }
__device__ __forceinline__ float ret_log2g(int h) { return h == 0 ? -0.04580369f : h == 1 ? -0.022720076f : h == 2 ? -0.011315313f : -0.0056465627f; }
__device__ __forceinline__ int mbcnt64(unsigned long long m) { return (int)__builtin_amdgcn_mbcnt_hi((unsigned)(m >> 32), __builtin_amdgcn_mbcnt_lo((unsigned)m, 0u)); }

template <int M> __device__ __forceinline__ float shx(float v, int lane) {
    if constexpr (M < 32) return __int_as_float(__builtin_amdgcn_ds_swizzle(__float_as_int(v), 0x1F | (M << 10)));
    else return __int_as_float(__builtin_amdgcn_ds_bpermute((lane ^ 32) << 2, __float_as_int(v)));
}
__device__ __forceinline__ float wave_sum(float v, int lane) { v += shx<1>(v, lane); v += shx<2>(v, lane); v += shx<4>(v, lane); v += shx<8>(v, lane); v += shx<16>(v, lane); v += shx<32>(v, lane); return v; }

#define XB_TMO      128
#define XB_XCNT(j)  (256  + 64 * (j))
#define XB_XSUB(j)  (1280 + 64 * (j))
#define XB_XGEN(j)  (2304 + 64 * (j))
#define XB_TOP      3328
#define XB_TOPGEN   3392
#define XCD_BAR_WORDS 3456
#define XB_SPIN_CAP (1u << 18)
__device__ __forceinline__ unsigned xb_ld(unsigned* p)              { return __hip_atomic_load(p, __ATOMIC_RELAXED, __HIP_MEMORY_SCOPE_AGENT); }
__device__ __forceinline__ unsigned xb_add(unsigned* p, unsigned v) { return __hip_atomic_fetch_add(p, v, __ATOMIC_RELAXED, __HIP_MEMORY_SCOPE_AGENT); }
__device__ __forceinline__ unsigned xb_xcc_id() { return (unsigned)__builtin_amdgcn_s_getreg((3 << 11) | 20) & 0xFu; }
#define XB_SPIN(cond, bar) do { unsigned _sp = 0; while (cond) { __builtin_amdgcn_s_sleep(1); \
    if ((++_sp & 255u) == 0u) { if (xb_ld(&(bar)[XB_TMO])) break; if (_sp > XB_SPIN_CAP) { atomicAdd(&(bar)[XB_TMO], 1u); break; } } } } while (0)
struct XcdBarrier { unsigned* bar; unsigned x; volatile LAS unsigned* st; };
__device__ __forceinline__ XcdBarrier xcd_barrier_post(unsigned* bar, volatile LAS unsigned* st, bool leader) {
    XcdBarrier b; b.bar = bar; b.x = xb_xcc_id(); b.st = st;
    if (leader) (void)xb_add(&bar[XB_XCNT(b.x)], 1u);
    return b;
}
__device__ __forceinline__ void xcd_barrier_complete(unsigned* bar, unsigned x, unsigned& nloc, unsigned& nx) {
    const unsigned G = gridDim.x * gridDim.y * gridDim.z;
    unsigned sum, cnt, mine, sp = 0u;
    for (;;) {
        sum = 0u; cnt = 0u; mine = 0u;
#pragma unroll
        for (unsigned j = 0; j < 16; ++j) { const unsigned c = xb_ld(&bar[XB_XCNT(j)]); sum += c; cnt += (c > 0u) ? 1u : 0u; mine = (j == x) ? c : mine; }
        if (sum == G) break;
        __builtin_amdgcn_s_sleep(1);
        if ((++sp & 255u) == 0u) { if (xb_ld(&bar[XB_TMO])) break; if (sp > XB_SPIN_CAP) { atomicAdd(&bar[XB_TMO], 1u); break; } }
    }
    nloc = mine > 0u ? mine : 1u; nx = cnt > 0u ? cnt : 1u;
}
__device__ __forceinline__ void xcd_barrier(const XcdBarrier& b, bool leader) {
    asm volatile("s_waitcnt vmcnt(0)" ::: "memory");
    __syncthreads();
    if (leader) {
        unsigned* bar = b.bar;
        __builtin_amdgcn_s_waitcnt(0);
        unsigned nloc = b.st[0], nx = b.st[1];
        if (nloc == 0u) { xcd_barrier_complete(bar, b.x, nloc, nx); b.st[0] = nloc; b.st[1] = nx; }
        const unsigned old = xb_add(&bar[XB_XSUB(b.x)], 1u);
        const unsigned gen = old / nloc;
        if (old + 1u == (gen + 1u) * nloc) {
            __builtin_amdgcn_fence(__ATOMIC_RELEASE, "agent");
            asm volatile("s_waitcnt vmcnt(0)" ::: "memory");
            const unsigned og = xb_add(&bar[XB_TOP], 1u);
            const unsigned tg = og / nx;
            if (og + 1u == (tg + 1u) * nx) xb_add(&bar[XB_TOPGEN], 1u);
            else XB_SPIN(xb_ld(&bar[XB_TOPGEN]) == tg, bar);
            __builtin_amdgcn_fence(__ATOMIC_ACQUIRE, "agent");
            xb_add(&bar[XB_XGEN(b.x)], 1u);
            asm volatile("s_waitcnt vmcnt(0)" ::: "memory");
        } else {
            XB_SPIN(xb_ld(&bar[XB_XGEN(b.x)]) == gen, bar);
            __builtin_amdgcn_fence(__ATOMIC_ACQUIRE, "agent");
            asm volatile("s_waitcnt vmcnt(0)" ::: "memory");
        }
    }
    __syncthreads();
}

struct Params { const float* in[18]; float* out; unsigned char* ws; int ph_lo, ph_hi, li, pad; };
enum { I_XP = 0, I_XS, I_CK, I_CV, I_CIK, I_STATE, I_PT, I_PP, I_PS, I_GAIN, I_WIN, I_QG, I_KG, I_WOR, I_WOA, I_WOUT, I_WPG, I_WPP };
struct Ctx { int tid, lane, wave, gw, ngw, nblk, blk; LAS unsigned char* lds; };
typedef const __attribute__((address_space(4))) Params* PK;
__device__ __forceinline__ PK phase_args() { PK p = (PK)__builtin_amdgcn_kernarg_segment_ptr(); asm volatile("" : "+s"(p)); return p; }
__device__ __forceinline__ int hw_lane(int salt = 0) { int l; asm volatile("v_mbcnt_lo_u32_b32 %0, -1, 0 ; %1\n\tv_mbcnt_hi_u32_b32 %0, -1, %0" : "=v"(l) : "s"(salt)); return l; }
__device__ __forceinline__ Ctx phase_ctx(LAS unsigned char* lds, int wave_s, int salt) { Ctx C; int tid = wave_s * 64 + hw_lane(salt); asm volatile("" : "+v"(tid)); C.lds = lds; C.tid = tid; C.lane = tid & 63; C.wave = __builtin_amdgcn_readfirstlane(tid >> 6);
    int bx = blockIdx.x; asm volatile("" : "+s"(bx)); C.nblk = gridDim.x; C.blk = bx; C.gw = C.blk * NWAVES + C.wave; C.ngw = C.nblk * NWAVES; return C; }

__device__ __forceinline__ int win_orig_col(int np) {
    const int pn = np >> 8, c = np & 255, bj = c >> 7, cc = c & 127, wc = cc >> 5, l8 = cc & 31;
    if (pn < 4) { const int head = 2 * (pn & 1) + bj, dim = (cc >> 1) + 64 * (cc & 1); return (pn < 2 ? 0 : 512) + head * 128 + dim; }
    if (pn < 8) return np;
    if (pn == 11 || pn == 12) return np;
    if (pn <= 10 || pn == 13) { const int dimp = 32 * bj + l8; const bool rope = !(pn == 10 && wc >= 2);
        const int dim = (rope && dimp < 16) ? (dimp >> 1) + 8 * (dimp & 1) : dimp;
        if (pn < 10) return 2048 + (4 * (pn - 8) + wc) * 64 + dim;
        if (pn == 10) return 2560 + wc * 64 + dim;
        return 3328 + wc * 64 + dim; }
    if (np < 3584 + 64) { const int dimp = np - 3584; return 3584 + (dimp < 16 ? (dimp >> 1) + 8 * (dimp & 1) : dimp); }
    if (np < 3652) return np;
    if (np < ZC_GR) return -1;
    if (np < ZC_GR + 2048) return np - (ZC_GR - 3652);
    return -1;
}
struct EpiZ {
    static constexpr bool PERM = true, AFTER_DRAIN = false;
    unsigned char* ws; float* out; const float* rowss; const float* qgain; const float* kgain; int L; LAS unsigned char* xl;
    __device__ __forceinline__ void rope16(float (&x)[8], const f32x2* ropeA, int fq, int hl) const {
        float lo[4], hi[4];
#pragma unroll
        for (int k = 0; k < 4; ++k) { const f32x2 cs = ropeA[(fq & 1) * 4 + k]; lo[k] = x[2 * k] * cs[0] - x[2 * k + 1] * cs[1]; hi[k] = x[2 * k + 1] * cs[0] + x[2 * k] * cs[1]; }
        float rc[4];
#pragma unroll
        for (int k = 0; k < 4; ++k) rc[k] = shx<16>(fq == 0 ? hi[k] : lo[k], hl);
        if (fq == 0) {
#pragma unroll
            for (int k = 0; k < 4; ++k) { x[k] = lo[k]; x[4 + k] = rc[k]; } }
        else if (fq == 1) {
#pragma unroll
            for (int k = 0; k < 4; ++k) { x[k] = rc[k]; x[4 + k] = hi[k]; } }
    }
    __device__ __forceinline__ void operator()(const f32x4 (&acc)[2][2][4][2], const pg8::Unit& u, int wr, int wc, int, int) const {
        const int hl = hw_lane(), fr = hl & 15, fq = hl >> 4;
        const int pn = u.pn; const bool prompt = u.pm < MP / 256;
        const int row0 = u.pm * 256 + wr * 64 + fr;
        bf16* Z = (bf16*)(ws + WS_Z);
        if (prompt && pn >= 2 && pn < 6) {
            const bool isk = pn < 4; LAS unsigned char* xt = xl + (wr * 4 + wc) * 2048;
            const int b = (u.pm * 256) >> 12, tpan = (u.pm * 256) & (SEQ - 1);
#pragma unroll
            for (int ai = 0; ai < 2; ++ai)
#pragma unroll
                for (int bj = 0; bj < 2; ++bj) { const int head = 2 * (pn & 1) + bj;
#pragma unroll
                    for (int mp = 0; mp < 2; ++mp) {
#pragma unroll
                        for (int mm = 0; mm < 2; ++mm) { const int m = 2 * mp + mm; const int row = row0 + ai * 128 + m * 16, t = row & (SEQ - 1);
                            const float rs = __builtin_amdgcn_rsqf(rowss[row] * (1.0f / 1024.0f) + 1e-6f);
                            float x[8];
#pragma unroll
                            for (int j = 0; j < 4; ++j) { x[j] = acc[ai][bj][m][0][j] * rs; x[4 + j] = acc[ai][bj][m][1][j] * rs; }
                            const int t32 = 16 * mm + fr;
                            if (isk) { const int p0 = 16 * wc + 4 * fq; const f32x2* rr = (const f32x2*)(ws + WS_ROPER) + (size_t)t * 64 + p0; float lo[4], hi[4];
#pragma unroll
                                for (int k = 0; k < 4; ++k) { const f32x2 cs = rr[k]; lo[k] = (x[2 * k] * cs[0] - x[2 * k + 1] * cs[1]) * 0.08838834764831845f; hi[k] = (x[2 * k + 1] * cs[0] + x[2 * k] * cs[1]) * 0.08838834764831845f; }
                                bf16* q = (bf16*)(ws + WS_RK) + (size_t)row * 512 + head * 128 + p0;
                                u32x2 a, c; a.x = pk2(lo[0], lo[1]); a.y = pk2(lo[2], lo[3]); c.x = pk2(hi[0], hi[1]); c.y = pk2(hi[2], hi[3]); *(u32x2*)q = a; *(u32x2*)(q + 64) = c;
                                const float dk = __builtin_amdgcn_exp2f((float)(127 - (t & 127)) * ret_log2g(head));
#pragma unroll
                                for (int k = 0; k < 4; ++k) { *(LAS bf16*)(xt + (4 * fq + k) * 64 + 2 * t32) = (bf16)(pk2(lo[k] * dk, 0.f) & 0xffffu); *(LAS bf16*)(xt + (16 + 4 * fq + k) * 64 + 2 * t32) = (bf16)(pk2(hi[k] * dk, 0.f) & 0xffffu); }
                            } else {
#pragma unroll
                                for (int j = 0; j < 8; ++j) *(LAS bf16*)(xt + (8 * fq + j) * 64 + 2 * t32) = (bf16)(pk2(x[j], 0.f) & 0xffffu); } }
                        asm volatile("s_waitcnt lgkmcnt(0)" ::: "memory");
#pragma unroll
                        for (int i = 0; i < 2; ++i) { const int c = hl + 64 * i, dl = c >> 2, q4 = c & 3; const u32x4 v = *(const LAS u32x4*)(xt + dl * 64 + 16 * q4);
                            const int d = isk ? 16 * wc + (dl & 15) + 64 * (dl >> 4) : 32 * wc + dl;
                            bf16* dst = (bf16*)(ws + (isk ? WS_RKT : WS_RVT)) + ((size_t)(b * 4 + head) * 128 + d) * SEQ + tpan + 128 * ai + 64 * wr + 32 * mp + 8 * q4;
                            *(u32x4*)dst = v; }
                        asm volatile("s_waitcnt lgkmcnt(0)" ::: "memory"); } }
            return;
        }
#define EZ_X(bj_, xv_) float xv_[8]; _Pragma("unroll") for (int j_ = 0; j_ < 4; ++j_) { xv_[j_] = acc[ai][bj_][m][0][j_] * rs; xv_[4 + j_] = acc[ai][bj_][m][1][j_] * rs; }
#pragma unroll
        for (int ai = 0; ai < 2; ++ai)
#pragma unroll
            for (int m = 0; m < 4; ++m) {
                const int row = row0 + ai * 128 + m * 16; const float rs = __builtin_amdgcn_rsqf(rowss[row] * (1.0f / 1024.0f) + 1e-6f);
                const int pos = prompt ? (row & (SEQ - 1)) : PAST + ((row - MP) & 7);
                const unsigned zrow = (unsigned)row * NZ;
                if (pn < 4) {
                    const int p0 = 16 * wc + 4 * fq; const bool isk = pn >= 2;
                    if (!prompt) {
#pragma unroll
                        for (int bj = 0; bj < 2; ++bj) { EZ_X(bj, x) const int hc = (isk ? ZC_RK : ZC_RQ) + (2 * (pn & 1) + bj) * 128;
                            u32x2 a, b; a.x = pk2(x[0], x[2]); a.y = pk2(x[4], x[6]); b.x = pk2(x[1], x[3]); b.y = pk2(x[5], x[7]);
                            *(u32x2*)(Z + zrow + hc + p0) = a; *(u32x2*)(Z + zrow + hc + 64 + p0) = b; }
                    } else {
                        const f32x2* rr = (const f32x2*)(ws + WS_ROPER) + (size_t)pos * 64 + p0; const int b = row >> 12, t = row & (SEQ - 1);
                        f32x2 cs[4];
#pragma unroll
                        for (int k = 0; k < 4; ++k) cs[k] = rr[k];
#pragma unroll
                        for (int bj = 0; bj < 2; ++bj) { EZ_X(bj, x) const int head = 2 * (pn & 1) + bj; float lo[4], hi[4];
#pragma unroll
                            for (int k = 0; k < 4; ++k) { lo[k] = x[2 * k] * cs[k][0] - x[2 * k + 1] * cs[k][1]; hi[k] = x[2 * k + 1] * cs[k][0] + x[2 * k] * cs[k][1]; }
                            if (!isk) { bf16* q = (bf16*)(ws + WS_RQ) + (size_t)row * 512 + head * 128 + p0;
                                u32x2 a, c; a.x = pk2(lo[0], lo[1]); a.y = pk2(lo[2], lo[3]); c.x = pk2(hi[0], hi[1]); c.y = pk2(hi[2], hi[3]); *(u32x2*)q = a; *(u32x2*)(q + 64) = c; }
                            else { const float sc = 0.08838834764831845f;
#pragma unroll
                                for (int k = 0; k < 4; ++k) { lo[k] *= sc; hi[k] *= sc; }
                                bf16* q = (bf16*)(ws + WS_RK) + (size_t)row * 512 + head * 128 + p0;
                                u32x2 a, c; a.x = pk2(lo[0], lo[1]); a.y = pk2(lo[2], lo[3]); c.x = pk2(hi[0], hi[1]); c.y = pk2(hi[2], hi[3]); *(u32x2*)q = a; *(u32x2*)(q + 64) = c;
                                const float dk = __builtin_amdgcn_exp2f((float)(127 - (t & 127)) * ret_log2g(head));
                                bf16* kt = (bf16*)(ws + WS_RKT) + ((size_t)(b * 4 + head) * 128 + p0) * SEQ + t;
#pragma unroll
                                for (int k = 0; k < 4; ++k) { kt[(size_t)k * SEQ] = (bf16)(pk2(lo[k] * dk, 0.f) & 0xffffu); kt[(size_t)(64 + k) * SEQ] = (bf16)(pk2(hi[k] * dk, 0.f) & 0xffffu); } } }
                    }
                } else if (pn < 6 && prompt) {
                    const int b = row >> 12, t = row & (SEQ - 1);
#pragma unroll
                    for (int bj = 0; bj < 2; ++bj) { EZ_X(bj, x) bf16* vt = (bf16*)(ws + WS_RVT) + ((size_t)(b * 4 + 2 * (pn & 1) + bj) * 128 + 32 * wc + 8 * fq) * SEQ + t;
#pragma unroll
                        for (int j = 0; j < 8; ++j) vt[(size_t)j * SEQ] = (bf16)(pk2(x[j], 0.f) & 0xffffu); }
                } else if (pn == 8 || pn == 9 || pn == 10 || pn == 13) {
                    const bool norm = (pn < 10) || (pn == 10 && wc < 2), rope = norm || pn == 13;
                    EZ_X(0, x0) EZ_X(1, x1)
                    if (norm) { float ss = 0.f;
#pragma unroll
                        for (int j = 0; j < 8; ++j) ss += x0[j] * x0[j] + x1[j] * x1[j];
                        ss += shx<16>(ss, hl); ss += shx<32>(ss, hl);
                        const float rr = __builtin_amdgcn_rsqf(ss * (1.0f / 64.0f) + 1e-6f); const float* gn = (pn < 10) ? qgain : kgain;
#pragma unroll
                        for (int j = 0; j < 8; ++j) { const int d0 = (fq < 2) ? 4 * fq + (j >> 1) + 8 * (j & 1) : 8 * fq + j; x0[j] *= rr * gn[d0]; x1[j] *= rr * gn[32 + 8 * fq + j]; } }
                    if (rope) rope16(x0, (const f32x2*)(ws + WS_ROPEA) + (size_t)pos * 8, fq, hl);
                    if (pn < 10) { bf16* q = (bf16*)(ws + WS_AQ) + (size_t)row * 512 + (4 * (pn - 8) + wc) * 64 + 8 * fq; *(u32x4*)q = pack8(x0); *(u32x4*)(q + 32) = pack8(x1); }
                    else if (pn == 13) { bf16* q = (bf16*)(ws + WS_IQ) + (size_t)row * 256 + wc * 64 + 8 * fq; *(u32x4*)q = pack8(x0); *(u32x4*)(q + 32) = pack8(x1); }
                    else { const bool isk = wc < 2; const int hk = wc & 1;
                        float* dst = (isk ? (prompt ? out + O_KP + ((size_t)L * MP + row) * 128 : out + O_KS + ((size_t)L * MS + (row - MP)) * 128)
                                          : (prompt ? out + O_VP + ((size_t)L * MP + row) * 128 : out + O_VS + ((size_t)L * MS + (row - MP)) * 128)) + hk * 64 + 8 * fq;
                        *(f32x4*)dst = (f32x4){x0[0], x0[1], x0[2], x0[3]}; *(f32x4*)(dst + 4) = (f32x4){x0[4], x0[5], x0[6], x0[7]};
                        *(f32x4*)(dst + 32) = (f32x4){x1[0], x1[1], x1[2], x1[3]}; *(f32x4*)(dst + 36) = (f32x4){x1[4], x1[5], x1[6], x1[7]};
                        if (prompt) { bf16* d2 = (bf16*)(ws + (isk ? WS_KB : WS_VB)) + (size_t)row * 128 + hk * 64 + 8 * fq; *(u32x4*)d2 = pack8(x0); *(u32x4*)(d2 + 32) = pack8(x1); } }
                } else if (pn == 14) {
                    { EZ_X(0, x0)
                      if (wc == 0) rope16(x0, (const f32x2*)(ws + WS_ROPEA) + (size_t)pos * 8, fq, hl);
                      if (wc < 2) { float* dst = (prompt ? out + O_IKP + ((size_t)L * MP + row) * 64 : out + O_IKS + ((size_t)L * MS + (row - MP)) * 64) + 32 * wc + 8 * fq;
                          *(f32x4*)dst = (f32x4){x0[0], x0[1], x0[2], x0[3]}; *(f32x4*)(dst + 4) = (f32x4){x0[4], x0[5], x0[6], x0[7]};
                          if (prompt) *(u32x4*)((bf16*)(ws + WS_IKB) + (size_t)row * 64 + 32 * wc + 8 * fq) = pack8(x0); }
                      else if (wc == 2 && fq == 0) *(f32x4*)((float*)(ws + WS_IW) + (size_t)row * 4) = (f32x4){x0[0] * 0.0625f, x0[1] * 0.0625f, x0[2] * 0.0625f, x0[3] * 0.0625f}; }
                    { EZ_X(1, x1) *(u32x4*)(Z + zrow + pn * 256 + 128 + 32 * wc + 8 * fq) = pack8(x1); }
                } else {
#pragma unroll
                    for (int bj = 0; bj < 2; ++bj) { EZ_X(bj, x) *(u32x4*)(Z + zrow + pn * 256 + 128 * bj + 32 * wc + 8 * fq) = pack8(x); }
                }
                asm volatile("" ::: "memory"); }
#undef EZ_X
    }
};

struct InProjOrder {
    pg8::StaticOrder base; int G, c;
    __device__ void init(int G_, int c_) { base.init(MP, NZ, G_, c_); G = G_; c = c_; }
    __device__ bool next(int i, pg8::Unit& u) const {
        const int L = i * G + c; const int np = (MP / 256) * (NZ / 256);
        if (L < np) return base.next(i, u);
        const int l2 = L - np; if (l2 >= 4 * 15) return false;
        u.pm = MP / 256 + l2 / 15; u.pn = l2 % 15; return true;
    }
    __device__ __forceinline__ void a_ready(const pg8::Unit&) const {}
    __device__ __forceinline__ void done(const pg8::Unit&) const {}
};
template <int MODE> struct EpiGate {
    static constexpr bool PERM = true, AFTER_DRAIN = false;
    const bf16* Z; int gcol; bf16* TMP; bf16* MB;
    __device__ __forceinline__ void operator()(const f32x4 (&acc)[2][2][4][2], const pg8::Unit& u, int wr, int wc, int, int) const {
        const int hl_ = hw_lane(), fr = hl_ & 15, fq = hl_ >> 4;
        const int row0 = u.pm * 256 + wr * 64 + fr, col0 = u.pn * 256 + wc * 32 + 8 * fq;
#pragma unroll
        for (int ai = 0; ai < 2; ++ai)
#pragma unroll
            for (int m = 0; m < 4; ++m) { const int row = row0 + ai * 128 + m * 16;
#pragma unroll
                for (int bj = 0; bj < 2; ++bj) { const int col = col0 + bj * 128; const unsigned off = (unsigned)row * DM + (unsigned)col;
                    const u32x4 gw = *(const u32x4*)(Z + ((unsigned)row * NZ + (unsigned)(gcol + col))); float g[8]; unpack8(gw, g);
                    const f32x4 a0 = acc[ai][bj][m][0], a1 = acc[ai][bj][m][1];
                    float r[8];
#pragma unroll
                    for (int j = 0; j < 4; ++j) { r[j] = sigmoidf_(g[j]) * a0[j]; r[4 + j] = sigmoidf_(g[4 + j]) * a1[j]; }
                    if (MODE == 0) *(u32x4*)(TMP + off) = pack8(r);
                    else { float t[8]; unpack8(*(const u32x4*)(TMP + off), t);
#pragma unroll
                        for (int j = 0; j < 8; ++j) r[j] += t[j];
                        *(u32x4*)(MB + off) = pack8(r); } }
                asm volatile("" ::: "memory"); }
    }
};
struct EpiRes {
    static constexpr bool PERM = true, AFTER_DRAIN = false;
    const float* xa; const float* xb; const bf16* xh; bf16* XB1;
    __device__ __forceinline__ void operator()(const f32x4 (&acc)[2][2][4][2], const pg8::Unit& u, int wr, int wc, int, int) const {
        const int hl_ = hw_lane(), fr = hl_ & 15, fq = hl_ >> 4;
        const int row0 = u.pm * 256 + wr * 64 + fr, col0 = u.pn * 256 + wc * 32 + 8 * fq;
#pragma unroll
        for (int ai = 0; ai < 2; ++ai)
#pragma unroll
            for (int m = 0; m < 4; ++m) { const int row = row0 + ai * 128 + m * 16;
                const float* xr = (u.pm < MP / 256) ? xa : xb - (size_t)MP * DM;
#pragma unroll
                for (int bj = 0; bj < 2; ++bj) { const unsigned off = (unsigned)row * DM + (unsigned)(col0 + bj * 128);
                    float x[8];
                    if (xh != nullptr) unpack8(*(const u32x4*)(xh + off), x);
                    else { const f32x4 x0 = *(const f32x4*)(xr + off), x1 = *(const f32x4*)(xr + off + 4); x[0] = x0[0]; x[1] = x0[1]; x[2] = x0[2]; x[3] = x0[3]; x[4] = x1[0]; x[5] = x1[1]; x[6] = x1[2]; x[7] = x1[3]; }
                    const f32x4 a0 = acc[ai][bj][m][0], a1 = acc[ai][bj][m][1];
#pragma unroll
                    for (int j = 0; j < 4; ++j) { x[j] += a0[j]; x[4 + j] += a1[j]; }
                    *(u32x4*)(XB1 + off) = pack8(x); }
                asm volatile("" ::: "memory"); }
    }
};
template <int MODE> struct EpiPle {
    static constexpr bool PERM = true, AFTER_DRAIN = false;
    bf16* TMP; const bf16* XB1; float* Y; bf16* XB0; float* rowss;
    __device__ __forceinline__ void operator()(const f32x4 (&acc)[2][2][4][2], const pg8::Unit& u, int wr, int wc, int, int) const {
        const int hl_ = hw_lane(), fr = hl_ & 15, fq = hl_ >> 4;
        const int row0 = u.pm * 256 + wr * 64 + fr, col0 = u.pn * 256 + wc * 32 + 8 * fq;
#pragma unroll
        for (int ai = 0; ai < 2; ++ai)
#pragma unroll
            for (int m = 0; m < 4; ++m) { const int row = row0 + ai * 128 + m * 16; float ssq = 0.f;
#pragma unroll
                for (int bj = 0; bj < 2; ++bj) { const unsigned off = (unsigned)row * DM + (unsigned)(col0 + bj * 128);
                    const f32x4 a0 = acc[ai][bj][m][0], a1 = acc[ai][bj][m][1];
                    if (MODE == 0) { float r[8];
#pragma unroll
                        for (int j = 0; j < 4; ++j) { r[j] = sigmoidf_(a0[j]); r[4 + j] = sigmoidf_(a1[j]); }
                        *(u32x4*)(TMP + off) = pack8(r); }
                    else { float t[8], x[8]; unpack8(*(const u32x4*)(TMP + off), t); unpack8(*(const u32x4*)(XB1 + off), x);
#pragma unroll
                        for (int j = 0; j < 4; ++j) { x[j] += t[j] * a0[j]; x[4 + j] += t[4 + j] * a1[j]; }
                        if (MODE == 2) { *(f32x4*)(Y + off) = (f32x4){x[0], x[1], x[2], x[3]}; *(f32x4*)(Y + off + 4) = (f32x4){x[4], x[5], x[6], x[7]}; }
                        *(u32x4*)(XB0 + off) = pack8(x);
                        if (MODE == 1) {
#pragma unroll
                            for (int j = 0; j < 8; ++j) ssq += x[j] * x[j]; } }
                    asm volatile("" ::: "memory"); }
                if (MODE == 1) { const int ln_ = fr + 16 * fq; ssq += shx<16>(ssq, ln_); ssq += shx<32>(ssq, ln_); if (fq == 0) atomicAdd(rowss + row, ssq); }
                asm volatile("" ::: "memory"); }
    }
};
__device__ __forceinline__ void p0_transpose_item(const float* W, int ldw, int K, const float* gain, bf16* WT, int nblk, int item, bool win_map, LAS float* scr, int lane) {
    const int kb = item / nblk, nb = item % nblk, k0 = 64 * kb, n0 = 32 * nb;
    const int np = n0 + (lane & 31); int n = np; bool valid = true;
    if (win_map) { n = win_orig_col(np); valid = n >= 0; if (!valid) n = 0; }
#pragma unroll 8
    for (int i = 0; i < 32; ++i) { const int kk = 2 * i + (lane >> 5); float v = valid ? W[(size_t)(k0 + kk) * ldw + n] : 0.f; if (gain) v *= gain[k0 + kk]; scr[kk * 33 + (lane & 31)] = v; }
    LDS_WAIT(); asm volatile("" ::: "memory");
    const int c = lane & 7;
#pragma unroll
    for (int j = 0; j < 4; ++j) { const int nn = (lane >> 3) + 8 * j; const LAS float* s = scr + (8 * c) * 33 + nn;
        u32x4 o; o.x = pk2(s[0 * 33], s[1 * 33]); o.y = pk2(s[2 * 33], s[3 * 33]); o.z = pk2(s[4 * 33], s[5 * 33]); o.w = pk2(s[6 * 33], s[7 * 33]);
        *(u32x4*)(WT + (size_t)(n0 + nn) * K + k0 + 8 * c) = o; }
    LDS_WAIT(); asm volatile("" ::: "memory");
}
__device__ __forceinline__ void p0_prologue(PK P, const Ctx& C) {
    unsigned char* ws = P->ws;
    LAS float* scr = (LAS float*)(C.lds + C.wave * 16384);
    constexpr int I_IN = 16 * (NZ / 32), I_OR = 8 * 32, I_OUT = 16 * 32, I_PPJ = 4 * 32, I_LAYER = I_IN + 2 * I_OR + 2 * I_OUT + I_PPJ;
    for (int it = C.gw; it < DEPTH * I_LAYER; it += C.ngw) {
        const int L = it / I_LAYER; int r = it % I_LAYER;
        if (r < I_IN) { p0_transpose_item(P->in[I_WIN] + (size_t)L * DM * WIN_N, WIN_N, DM, P->in[I_GAIN] + L * DM, (bf16*)(ws + WS_WIN) + (size_t)L * NZ * DM, NZ / 32, r, true, scr, C.lane); continue; } r -= I_IN;
        if (r < I_OR) { p0_transpose_item(P->in[I_WOR] + (size_t)L * 512 * DM, DM, 512, nullptr, (bf16*)(ws + WS_WOR) + (size_t)L * DM * 512, 32, r, false, scr, C.lane); continue; } r -= I_OR;
        if (r < I_OR) { p0_transpose_item(P->in[I_WOA] + (size_t)L * 512 * DM, DM, 512, nullptr, (bf16*)(ws + WS_WOA) + (size_t)L * DM * 512, 32, r, false, scr, C.lane); continue; } r -= I_OR;
        if (r < I_OUT) { p0_transpose_item(P->in[I_WOUT] + (size_t)L * DM * DM, DM, DM, nullptr, (bf16*)(ws + WS_WOUT) + (size_t)L * DM * DM, 32, r, false, scr, C.lane); continue; } r -= I_OUT;
        if (r < I_OUT) { p0_transpose_item(P->in[I_WPG] + (size_t)L * DM * DM, DM, DM, nullptr, (bf16*)(ws + WS_WPG) + (size_t)L * DM * DM, 32, r, false, scr, C.lane); continue; } r -= I_OUT;
        p0_transpose_item(P->in[I_WPP] + (size_t)L * 256 * DM, DM, 256, nullptr, (bf16*)(ws + WS_WPP) + (size_t)L * DM * 256, 32, r, false, scr, C.lane);
    }
    bf16* XB0 = (bf16*)(ws + WS_XB0); float* rowss0 = (float*)(ws + WS_ROWSS0);
    for (int row = C.gw; row < MT; row += C.ngw) {
        const float* xr = (row < MP) ? P->in[I_XP] + (size_t)row * DM : P->in[I_XS] + (size_t)(row - MP) * DM;
        float ss = 0.f;
#pragma unroll
        for (int j = 0; j < 4; ++j) { const f32x4 v = *(const f32x4*)(xr + 256 * j + 4 * C.lane); ss += (v[0] * v[0] + v[1] * v[1]) + (v[2] * v[2] + v[3] * v[3]);
            u32x2 w; w.x = pk2(v[0], v[1]); w.y = pk2(v[2], v[3]); *(u32x2*)(XB0 + (size_t)row * DM + 256 * j + 4 * C.lane) = w; }
        ss = wave_sum(ss, C.lane);
        if (C.lane == 0) rowss0[row] = ss;
    }
    for (int r = C.gw; r < DEPTH * MT; r += C.ngw) { const int L = r / MT, row = r - L * MT;
        const float* pr = (row < MP) ? P->in[I_PP] + ((size_t)L * MP + row) * 256 : P->in[I_PS] + ((size_t)L * MS + (row - MP)) * 256;
        const f32x4 v = *(const f32x4*)(pr + 4 * C.lane); u32x2 w; w.x = pk2(v[0], v[1]); w.y = pk2(v[2], v[3]); *(u32x2*)((bf16*)(ws + WS_PB) + ((size_t)L * MT + row) * 256 + 4 * C.lane) = w; }
    f32x2* rr = (f32x2*)(ws + WS_ROPER); f32x2* ra = (f32x2*)(ws + WS_ROPEA);
    for (int i = C.blk * NTHREADS + C.tid; i < 4096 * 64; i += C.nblk * NTHREADS) { const int pos = i >> 6, k = i & 63;
        const float fr = expf((-9.210340371976184f * (float)k) / 64.0f), ang = (float)pos * fr; rr[i] = (f32x2){cosf(ang), sinf(ang)}; }
    for (int i = C.blk * NTHREADS + C.tid; i < 4096 * 8; i += C.nblk * NTHREADS) { const int pos = i >> 3, k = i & 7;
        const float fr = expf((-13.122363377404328f * (float)k) / 8.0f), ang = (float)pos * fr; ra[i] = (f32x2){cosf(ang), sinf(ang)}; }
}

constexpr int LDT = 272;
__device__ __forceinline__ void post_ret_tile(PK P, const Ctx& C, int unit) {
    unsigned char* ws = P->ws; const bf16* Z = (const bf16*)(ws + WS_Z);
    const int b = unit >> 7, h = (unit >> 5) & 3, n = unit & 31, t0 = n * 128; const int bh = b * 4 + h;
    LAS unsigned char* TK = C.lds; LAS unsigned char* TV = C.lds + 128 * LDT;
    const f32x2* ropeR = (const f32x2*)(ws + WS_ROPER);
    bf16* RQ = (bf16*)(ws + WS_RQ); bf16* RK = (bf16*)(ws + WS_RK);
    const float lg2 = ret_log2g(h);
#pragma unroll
    for (int u = 0; u < 2; ++u) {
        const int idx = C.tid + 512 * u, r = idx >> 3, j = idx & 7, t = t0 + r; const size_t grow = (size_t)b * SEQ + t;
        float cs[8], sn[8];
#pragma unroll
        for (int e = 0; e < 8; e += 2) { const f32x4 v = *(const f32x4*)(ropeR + (size_t)t * 64 + 8 * j + e); cs[e] = v[0]; sn[e] = v[1]; cs[e + 1] = v[2]; sn[e + 1] = v[3]; }
        { float x1[8], x2[8], o1[8], o2[8]; unpack8(*(const u32x4*)(Z + grow * NZ + ZC_RQ + h * 128 + 8 * j), x1); unpack8(*(const u32x4*)(Z + grow * NZ + ZC_RQ + h * 128 + 64 + 8 * j), x2);
#pragma unroll
          for (int e = 0; e < 8; ++e) { o1[e] = x1[e] * cs[e] - x2[e] * sn[e]; o2[e] = x2[e] * cs[e] + x1[e] * sn[e]; }
          *(u32x4*)(RQ + grow * 512 + h * 128 + 8 * j) = pack8(o1); *(u32x4*)(RQ + grow * 512 + h * 128 + 64 + 8 * j) = pack8(o2); }
        { float x1[8], x2[8], o1[8], o2[8]; unpack8(*(const u32x4*)(Z + grow * NZ + ZC_RK + h * 128 + 8 * j), x1); unpack8(*(const u32x4*)(Z + grow * NZ + ZC_RK + h * 128 + 64 + 8 * j), x2);
          const float sc = 0.08838834764831845f, dk = __builtin_amdgcn_exp2f((float)(127 - r) * lg2);
#pragma unroll
          for (int e = 0; e < 8; ++e) { o1[e] = (x1[e] * cs[e] - x2[e] * sn[e]) * sc; o2[e] = (x2[e] * cs[e] + x1[e] * sn[e]) * sc; }
          *(u32x4*)(RK + grow * 512 + h * 128 + 8 * j) = pack8(o1); *(u32x4*)(RK + grow * 512 + h * 128 + 64 + 8 * j) = pack8(o2);
#pragma unroll
          for (int e = 0; e < 8; ++e) { *(LAS bf16*)(TK + (8 * j + e) * LDT + 2 * r) = (bf16)(pk2(o1[e] * dk, 0.f) & 0xffffu); *(LAS bf16*)(TK + (64 + 8 * j + e) * LDT + 2 * r) = (bf16)(pk2(o2[e] * dk, 0.f) & 0xffffu); } }
    }
#pragma unroll
    for (int u = 0; u < 4; ++u) {
        const int idx = C.tid + 512 * u, r = idx >> 4, c = idx & 15; const size_t grow = (size_t)b * SEQ + t0 + r;
        const u32x4 w = *(const u32x4*)(Z + grow * NZ + ZC_RV + h * 128 + 8 * c);
        const unsigned ww[4] = {w.x, w.y, w.z, w.w};
#pragma unroll
        for (int e = 0; e < 4; ++e) { *(LAS bf16*)(TV + (8 * c + 2 * e) * LDT + 2 * r) = (bf16)(ww[e] & 0xffffu); *(LAS bf16*)(TV + (8 * c + 2 * e + 1) * LDT + 2 * r) = (bf16)(ww[e] >> 16); }
    }
    __syncthreads();
    bf16* RKT = (bf16*)(ws + WS_RKT); bf16* RVT = (bf16*)(ws + WS_RVT);
#pragma unroll
    for (int u = 0; u < 4; ++u) {
        const int idx = C.tid + 512 * u, d = idx >> 4, c = idx & 15;
        const u32x4 a = *(const LAS u32x4*)(TK + d * LDT + 16 * c), v = *(const LAS u32x4*)(TV + d * LDT + 16 * c);
        *(u32x4*)(RKT + ((size_t)bh * 128 + d) * SEQ + t0 + 8 * c) = a; *(u32x4*)(RVT + ((size_t)bh * 128 + d) * SEQ + t0 + 8 * c) = v;
    }
    __syncthreads();
}
__device__ __forceinline__ void post_token(PK P, const Ctx& C, int L, int row) {
    unsigned char* ws = P->ws; const bf16* Zr = (const bf16*)(ws + WS_Z) + (size_t)row * NZ; const int lane = C.lane;
    const bool prompt = row < MP; const int sb = (row - MP) >> 3, sc = (row - MP) & 7;
    const int pos = prompt ? (row & (SEQ - 1)) : PAST + sc;
    const f32x2* ropeA = (const f32x2*)(ws + WS_ROPEA) + (size_t)pos * 8;
    const int c8 = lane & 7;
    float cs[8], sn[8];
#pragma unroll
    for (int e = 0; e < 8; e += 2) { const f32x4 v = *(const f32x4*)(ropeA + e); cs[e] = v[0]; sn[e] = v[1]; cs[e + 1] = v[2]; sn[e + 1] = v[3]; }
    { float x[8]; unpack8(*(const u32x4*)(Zr + ZC_AQ + 8 * lane), x);
      float ss = 0.f;
#pragma unroll
      for (int e = 0; e < 8; ++e) ss += x[e] * x[e];
      ss += shx<1>(ss, lane); ss += shx<2>(ss, lane); ss += shx<4>(ss, lane);
      const float rs = __builtin_amdgcn_rsqf(ss * (1.0f / 64.0f) + 1e-6f);
      const float* qg = P->in[I_QG] + L * 64 + 8 * c8; float o[8];
#pragma unroll
      for (int e = 0; e < 8; ++e) { const float y = x[e] * rs * qg[e]; const float pr = shx<1>(y, lane); o[e] = (c8 == 0) ? y * cs[e] - pr * sn[e] : (c8 == 1) ? y * cs[e] + pr * sn[e] : y; }
      *(u32x4*)((bf16*)(ws + WS_AQ) + (size_t)row * 512 + 8 * lane) = pack8(o); }
    { float x[8]; unpack8(*(const u32x4*)(Zr + ZC_AK + 8 * (lane & 31)), x);
      float ss = 0.f;
#pragma unroll
      for (int e = 0; e < 8; ++e) ss += x[e] * x[e];
      ss += shx<1>(ss, lane); ss += shx<2>(ss, lane); ss += shx<4>(ss, lane);
      const float rs = __builtin_amdgcn_rsqf(ss * (1.0f / 64.0f) + 1e-6f);
      const float* kg = P->in[I_KG] + L * 64 + 8 * c8; float o[8]; const bool isk = (lane & 31) < 16;
#pragma unroll
      for (int e = 0; e < 8; ++e) { const float y = isk ? x[e] * rs * kg[e] : x[e]; const float pr = shx<1>(y, lane); o[e] = (isk && c8 == 0) ? y * cs[e] - pr * sn[e] : (isk && c8 == 1) ? y * cs[e] + pr * sn[e] : y; }
      if (lane < 32) {
          const int l16 = lane & 15;
          float* dst = isk ? (prompt ? P->out + O_KP + ((size_t)L * MP + row) * 128 : P->out + O_KS + ((size_t)L * MS + (row - MP)) * 128)
                           : (prompt ? P->out + O_VP + ((size_t)L * MP + row) * 128 : P->out + O_VS + ((size_t)L * MS + (row - MP)) * 128);
          *(f32x4*)(dst + 8 * l16) = (f32x4){o[0], o[1], o[2], o[3]}; *(f32x4*)(dst + 8 * l16 + 4) = (f32x4){o[4], o[5], o[6], o[7]};
          if (prompt) { bf16* d2 = (bf16*)(ws + (isk ? WS_KB : WS_VB)) + (size_t)row * 128 + 8 * l16; *(u32x4*)d2 = pack8(o); } } }
    { const int l40 = lane < 40 ? lane : 39; float x[8]; unpack8(*(const u32x4*)(Zr + ZC_IQ + 8 * l40), x); float o[8];
#pragma unroll
      for (int e = 0; e < 8; ++e) { const float y = x[e]; const float pr = shx<1>(y, lane); o[e] = (c8 == 0) ? y * cs[e] - pr * sn[e] : (c8 == 1) ? y * cs[e] + pr * sn[e] : y; }
      if (lane < 32) *(u32x4*)((bf16*)(ws + WS_IQ) + (size_t)row * 256 + 8 * lane) = pack8(o);
      else if (lane < 40) { const int l8 = lane - 32;
          float* dst = prompt ? P->out + O_IKP + ((size_t)L * MP + row) * 64 : P->out + O_IKS + ((size_t)L * MS + (row - MP)) * 64;
          *(f32x4*)(dst + 8 * l8) = (f32x4){o[0], o[1], o[2], o[3]}; *(f32x4*)(dst + 8 * l8 + 4) = (f32x4){o[4], o[5], o[6], o[7]};
          if (prompt) *(u32x4*)((bf16*)(ws + WS_IKB) + (size_t)row * 64 + 8 * l8) = pack8(o); } }
    if (lane < 4) ((float*)(ws + WS_IW))[(size_t)row * 4 + lane] = bf2f(Zr[ZC_IW + lane]) * 0.0625f;
    { const float* pr = prompt ? P->in[I_PP] + ((size_t)L * MP + row) * 256 : P->in[I_PS] + ((size_t)L * MS + (row - MP)) * 256;
      const f32x4 v = *(const f32x4*)(pr + 4 * lane); u32x2 w; w.x = pk2(v[0], v[1]); w.y = pk2(v[2], v[3]); *(u32x2*)((bf16*)(ws + WS_PB) + (size_t)row * 256 + 4 * lane) = w; }
    (void)sb;
}
__device__ __forceinline__ void phase_post(PK P, const Ctx& C, int L) {
    for (int u = C.blk; u < 512; u += C.nblk) post_ret_tile(P, C, u);
    for (int row = C.gw; row < MT; row += 2 * C.ngw) { post_token(P, C, L, row); if (row + C.ngw < MT) post_token(P, C, L, row + C.ngw); }
}

__device__ __forceinline__ void ret_state_item(PK P, const Ctx& C, int L, int item) {
    unsigned char* ws = P->ws; const bf16* RKT = (const bf16*)(ws + WS_RKT); const bf16* RVT = (const bf16*)(ws + WS_RVT); bf16* ST = (bf16*)(ws + WS_ST);
    const int bh = item >> 6, et = (item >> 3) & 7, dt = item & 7, lane = C.lane, r16 = lane & 15, g = lane >> 4;
    const float dec = __builtin_amdgcn_exp2f(128.0f * ret_log2g(bh & 3));
    LAS unsigned char* img = C.lds + 36864 + (C.wave >> 1) * 8704;
    const int tq = lane >> 4, c16 = lane & 15;
    const bf16* vp = RVT + ((size_t)bh * 128 + 16 * et + tq) * SEQ + 8 * c16;
    const bf16* kp = RKT + ((size_t)bh * 128 + 16 * dt + tq) * SEQ + 8 * c16;
    f32x4 S = {0.f, 0.f, 0.f, 0.f};
#pragma unroll 1
    for (int n0 = 0; n0 < 32; n0 += 4) {
        u32x4 rv[4][4], rk[4][4];
#pragma unroll
        for (int i = 0; i < 4; ++i)
#pragma unroll
            for (int q = 0; q < 4; ++q) { rv[i][q] = *(const u32x4*)(vp + (size_t)(4 * q) * SEQ + (n0 + i) * 128); rk[i][q] = *(const u32x4*)(kp + (size_t)(4 * q) * SEQ + (n0 + i) * 128); }
        asm volatile("" ::: "memory");
#pragma unroll
        for (int i = 0; i < 4; ++i) {
#pragma unroll
            for (int q = 0; q < 4; ++q) { *(LAS u32x4*)(img + (tq + 4 * q) * 272 + 16 * c16) = rv[i][q]; *(LAS u32x4*)(img + (16 + tq + 4 * q) * 272 + 16 * c16) = rk[i][q]; }
            LDS_WAIT(); asm volatile("" ::: "memory");
            f32x4 acc = {0.f, 0.f, 0.f, 0.f};
#pragma unroll
            for (int kk = 0; kk < 4; ++kk) { const bf16x8 a = *(const LAS bf16x8*)(img + r16 * 272 + 64 * kk + 16 * g), b = *(const LAS bf16x8*)(img + (16 + r16) * 272 + 64 * kk + 16 * g); acc = mfma16(a, b, acc); }
            LDS_WAIT(); asm volatile("" ::: "memory");
            bf16* st = ST + (((size_t)bh * 32 + n0 + i) * 128 + 16 * et + 4 * g) * 128 + 16 * dt + r16;
#pragma unroll
            for (int r = 0; r < 4; ++r) st[r * 128] = (bf16)(pk2(S[r], 0.f) & 0xffffu);
            S = S * dec + acc; }
        asm volatile("" : "+v"(S));
    }
    float* o = P->out + O_RSP + ((size_t)L * 16 + bh) * 16384 + (size_t)(16 * dt + r16) * 128 + 16 * et + 4 * g;
    *(f32x4*)o = S;
}
__device__ __forceinline__ void ret_sample_unit(PK P, const Ctx& C, int L, int unit) {
    unsigned char* ws = P->ws; const bf16* Z = (const bf16*)(ws + WS_Z);
    const int b = unit >> 2, h = unit & 3, tid = C.tid; const int r0 = MP + b * 8;
    LAS float* q = (LAS float*)C.lds;
    LAS float* kp = q + 1024;
    LAS float* v = kp + 1024;
    LAS float* rz = v + 1024;
    LAS float* A = rz + 1024;
    LAS float* op = A + 64;
    const float lg2 = ret_log2g(h);
    { const int c = tid >> 6, i = tid & 63; const size_t row = (size_t)(r0 + c);
      const f32x2 cs = ((const f32x2*)(ws + WS_ROPER))[(size_t)(PAST + c) * 64 + i];
      const float q1 = bf2f(Z[row * NZ + ZC_RQ + h * 128 + i]), q2 = bf2f(Z[row * NZ + ZC_RQ + h * 128 + 64 + i]);
      q[i * 8 + c] = q1 * cs[0] - q2 * cs[1]; q[(64 + i) * 8 + c] = q2 * cs[0] + q1 * cs[1];
      const float k1 = bf2f(Z[row * NZ + ZC_RK + h * 128 + i]), k2 = bf2f(Z[row * NZ + ZC_RK + h * 128 + 64 + i]);
      const float ks = 0.08838834764831845f * __builtin_amdgcn_exp2f((float)(7 - c) * lg2);
      kp[i * 8 + c] = (k1 * cs[0] - k2 * cs[1]) * ks; kp[(64 + i) * 8 + c] = (k2 * cs[0] + k1 * cs[1]) * ks;
      v[c * 128 + i] = bf2f(Z[row * NZ + ZC_RV + h * 128 + i]); v[c * 128 + 64 + i] = bf2f(Z[row * NZ + ZC_RV + h * 128 + 64 + i]);
      rz[c * 128 + i] = bf2f(Z[row * NZ + ZC_RZ + h * 128 + i]); rz[c * 128 + 64 + i] = bf2f(Z[row * NZ + ZC_RZ + h * 128 + 64 + i]); }
    __syncthreads();
    { const int pr = tid >> 3, part = tid & 7, c = pr >> 3, s2 = pr & 7; float d = 0.f;
#pragma unroll
      for (int dd = 0; dd < 16; ++dd) d += q[(part * 16 + dd) * 8 + c] * kp[(part * 16 + dd) * 8 + s2];
      d += shx<1>(d, tid & 63); d += shx<2>(d, tid & 63); d += shx<4>(d, tid & 63);
      if (part == 0) A[pr] = (s2 <= c) ? d * __builtin_amdgcn_exp2f((float)(c - 7) * lg2) : 0.f; }
    { const int dq = tid >> 7, e = tid & 127; float vr[8], acc[8];
#pragma unroll
      for (int c = 0; c < 8; ++c) { vr[c] = v[c * 128 + e]; acc[c] = 0.f; }
      const float g8 = __builtin_amdgcn_exp2f(8.0f * lg2);
      const float* S0 = P->in[I_STATE] + (((size_t)L * DB + b) * 4 + h) * 16384; float* S1 = P->out + O_RSS + (((size_t)L * DB + b) * 4 + h) * 16384;
      float s0v[32];
#pragma unroll
      for (int dd = 0; dd < 32; ++dd) s0v[dd] = S0[(dq * 32 + dd) * 128 + e];
#pragma unroll
      for (int dd = 0; dd < 32; ++dd) { const int d = dq * 32 + dd; const float s0 = s0v[dd];
          const f32x4 qa = *(const LAS f32x4*)(q + d * 8), qb = *(const LAS f32x4*)(q + d * 8 + 4), ka = *(const LAS f32x4*)(kp + d * 8), kb = *(const LAS f32x4*)(kp + d * 8 + 4);
          float sn = s0 * g8;
#pragma unroll
          for (int c = 0; c < 4; ++c) { acc[c] += qa[c] * s0; acc[4 + c] += qb[c] * s0; sn += ka[c] * vr[c]; sn += kb[c] * vr[4 + c]; }
          S1[d * 128 + e] = sn; }
#pragma unroll
      for (int c = 0; c < 8; ++c) op[(dq * 8 + c) * 128 + e] = acc[c]; }
    __syncthreads();
    { const int c = tid >> 6, i = tid & 63; float o[2]; const float gq = __builtin_amdgcn_exp2f((float)(c + 1) * lg2);
#pragma unroll
      for (int u = 0; u < 2; ++u) { const int e = i + 64 * u; float s = (op[(0 * 8 + c) * 128 + e] + op[(1 * 8 + c) * 128 + e]) + (op[(2 * 8 + c) * 128 + e] + op[(3 * 8 + c) * 128 + e]); s *= gq;
          for (int sidx = 0; sidx <= c; ++sidx) s += A[c * 8 + sidx] * v[sidx * 128 + e];
          o[u] = s; }
      float sm = o[0] + o[1];
      sm = wave_sum(sm, i);
      const float mu = sm * (1.0f / 128.0f); float qv = (o[0] - mu) * (o[0] - mu) + (o[1] - mu) * (o[1] - mu);
      qv = wave_sum(qv, i);
      const float rstd = __builtin_amdgcn_rsqf(qv * (1.0f / 128.0f) + 1e-5f);
      bf16* og = (bf16*)(ws + WS_OGR) + (size_t)(r0 + c) * 512 + h * 128;
#pragma unroll
      for (int u = 0; u < 2; ++u) { const int e = i + 64 * u; og[e] = (bf16)(pk2((o[u] - mu) * rstd * siluf_(rz[c * 128 + e]), 0.f) & 0xffffu); } }
    __syncthreads();
}
template <bool SAMPLE>
__device__ __forceinline__ void score_item(PK P, const Ctx& C, int L, int b, int qblk, int kc) {
    constexpr int QG = SAMPLE ? 1 : 2;
    constexpr int TG = SAMPLE ? 4 : 5;
    unsigned char* ws = P->ws; const int lane = C.lane, r32 = lane & 31, hf = lane >> 5;
    const bf16* IQ = (const bf16*)(ws + WS_IQ); const float* IW = (const float*)(ws + WS_IW);
    const int q0 = SAMPLE ? 0 : qblk * 16;
    const size_t rowbase = SAMPLE ? (size_t)MP + b * 8 : (size_t)b * SEQ + q0;
    bf16x8 af[QG][4]; f32x4 wv[QG][4];
#pragma unroll
    for (int gq = 0; gq < QG; ++gq) {
#pragma unroll
        for (int s = 0; s < 4; ++s) af[gq][s] = *(const bf16x8*)(IQ + (rowbase + 8 * gq + (r32 >> 2)) * 256 + (r32 & 3) * 64 + 16 * s + 8 * hf);
#pragma unroll
        for (int i = 0; i < 4; ++i) wv[gq][i] = *(const f32x4*)(IW + (rowbase + 8 * gq + 2 * i + hf) * 4); }
    const int nkeys = SAMPLE ? PAST + DS : q0 + 16;
    const int kt_end = min(kc * 16 + 16, (nkeys + 31) >> 5);
    const int* pt = (const int*)P->in[I_PT] + b * NPAGES;
    const float* cik = P->in[I_CIK] + (size_t)L * NPOOL * 128 * 64; const float* nik = P->out + O_IKS + ((size_t)L * DB + b) * DS * 64;
    const bf16* ikb = (const bf16*)(ws + WS_IKB) + (size_t)b * SEQ * 64;
    u32x4 cur[TG][SAMPLE ? 8 : 4];
    auto load_group = [&](int kt0, u32x4 (&dst)[TG][SAMPLE ? 8 : 4]) {
#pragma unroll
        for (int j = 0; j < TG; ++j) { const int kt = min(kt0 + j, kt_end - 1); const int key = kt * 32 + r32;
            if (SAMPLE) { const int kcl = key < PAST + DS ? key : PAST + DS - 1;
                const float* kr = (kcl < PAST) ? cik + ((size_t)pt[(kt >> 2) & 15] * 128 + (kcl & 127)) * 64 : nik + (size_t)(kcl - PAST) * 64;
#pragma unroll
                for (int s = 0; s < 4; ++s) { dst[j][2 * s] = *(const u32x4*)(kr + 16 * s + 8 * hf); dst[j][2 * s + 1] = *(const u32x4*)(kr + 16 * s + 8 * hf + 4); }
            } else { const bf16* kr = ikb + (size_t)key * 64;
#pragma unroll
                for (int s = 0; s < 4; ++s) dst[j][s] = *(const u32x4*)(kr + 16 * s + 8 * hf); } }
    };
    for (int kt0 = kc * 16; kt0 < kt_end; kt0 += TG) {
        load_group(kt0, cur);
#pragma unroll
        for (int j = 0; j < TG; ++j) { const int kt = kt0 + j;
            if (kt < kt_end) {
                const int key = kt * 32 + r32;
                bf16x8 bfr[4];
#pragma unroll
                for (int s = 0; s < 4; ++s) {
                    if (SAMPLE) { const f32x4 a = __builtin_bit_cast(f32x4, cur[j][2 * s]), c = __builtin_bit_cast(f32x4, cur[j][2 * s + 1]);
                        u32x4 w; w.x = pk2(a[0], a[1]); w.y = pk2(a[2], a[3]); w.z = pk2(c[0], c[1]); w.w = pk2(c[2], c[3]); bfr[s] = as_bf16x8(w); }
                    else bfr[s] = as_bf16x8(cur[j][s]); }
#pragma unroll
                for (int gq = 0; gq < QG; ++gq) {
                    f32x16 acc;
#pragma unroll
                    for (int i = 0; i < 16; ++i) acc[i] = 0.f;
#pragma unroll
                    for (int s = 0; s < 4; ++s) acc = mfma32(af[gq][s], bfr[s], acc);
                    float sc[4];
#pragma unroll
                    for (int i = 0; i < 4; ++i) {
                        float v = fmaxf(acc[4 * i + 0], 0.f) * wv[gq][i][0]; v += fmaxf(acc[4 * i + 1], 0.f) * wv[gq][i][1]; v += fmaxf(acc[4 * i + 2], 0.f) * wv[gq][i][2]; v += fmaxf(acc[4 * i + 3], 0.f) * wv[gq][i][3];
                        sc[i] = v + 0.0f; }
                    const bool odd = (lane & 1) != 0;
#pragma unroll
                    for (int i = 0; i < 4; i += 2) {
                        const float snd = odd ? sc[i] : sc[i + 1], rcv = shx<1>(snd, lane);
                        const float lo = odd ? rcv : sc[i], hi = odd ? sc[i + 1] : rcv;
                        const unsigned w = (unsigned)__builtin_bit_cast(unsigned short, (_Float16)lo) | ((unsigned)__builtin_bit_cast(unsigned short, (_Float16)hi) << 16);
                        const int ql = 8 * gq + 2 * (odd ? i + 1 : i) + hf, k0 = key & ~1;
                        if (SAMPLE) { if (k0 < PAST + DS) *(unsigned*)((unsigned short*)(ws + WS_SS) + ((size_t)b * 8 + ql) * SS_LD + k0) = w; }
                        else *(unsigned*)((unsigned short*)(ws + WS_SP) + ((size_t)b * SEQ + q0 + ql) * SEQ + k0) = w;
                    }
                }
            }
        }
        asm volatile("" ::: "memory");
    }
}
__device__ __forceinline__ void score_item_dma(PK P, const Ctx& C, int L, int b, int qblk, int kc, LAS unsigned char* img) {
    constexpr int QG = 2, TG = 4;
    unsigned char* ws = P->ws; const int lane = C.lane, r32 = lane & 31, hf = lane >> 5;
    const bf16* IQ = (const bf16*)(ws + WS_IQ); const float* IW = (const float*)(ws + WS_IW);
    const int q0 = qblk * 16;
    const size_t rowbase = (size_t)b * SEQ + q0;
    bf16x8 af[QG][4]; f32x4 wv[QG][4];
#pragma unroll
    for (int gq = 0; gq < QG; ++gq) {
#pragma unroll
        for (int s = 0; s < 4; ++s) af[gq][s] = *(const bf16x8*)(IQ + (rowbase + 8 * gq + (r32 >> 2)) * 256 + (r32 & 3) * 64 + 16 * s + 8 * hf);
#pragma unroll
        for (int i = 0; i < 4; ++i) wv[gq][i] = *(const f32x4*)(IW + (rowbase + 8 * gq + 2 * i + hf) * 4); }
    const int kt_end = min(kc * 16 + 16, (q0 + 16 + 31) >> 5);
    const unsigned char* ikb = ws + WS_IKB + (size_t)b * SEQ * 128;
    int voff[4], roff[4];
#pragma unroll
    for (int i = 0; i < 4; ++i) { voff[i] = (8 * i + (lane >> 3)) * 128 + 16 * ((lane & 7) ^ ((4 * i + (lane >> 4)) & 7)); roff[i] = r32 * 128 + 16 * ((2 * i + hf) ^ ((r32 >> 1) & 7)); }
#define SC_ISSUE(kt0_) do { _Pragma("unroll") for (int j = 0; j < TG; ++j) { const int kt_ = min((kt0_) + j, kt_end - 1); _Pragma("unroll") for (int i = 0; i < 4; ++i) \
        __builtin_amdgcn_global_load_lds((const unsigned*)(ikb + (size_t)kt_ * 4096 + voff[i]), (LAS unsigned*)(img + j * 4096 + i * 1024), 16, 0, 0); } } while (0)
    SC_ISSUE(kc * 16);
    for (int kt0 = kc * 16; kt0 < kt_end; kt0 += TG) {
        asm volatile("s_waitcnt vmcnt(0)" ::: "memory");
        u32x4 cur[TG][4];
#pragma unroll
        for (int j = 0; j < TG; ++j) {
#pragma unroll
            for (int s = 0; s < 4; ++s) cur[j][s] = *(const LAS u32x4*)(img + j * 4096 + roff[s]); }
        asm volatile("s_waitcnt lgkmcnt(0)" ::: "memory");
        if (kt0 + TG < kt_end) SC_ISSUE(kt0 + TG);
        asm volatile("" ::: "memory");
#pragma unroll
        for (int j = 0; j < TG; ++j) { const int kt = kt0 + j;
            if (kt < kt_end) {
                const int key = kt * 32 + r32;
#pragma unroll
                for (int gq = 0; gq < QG; ++gq) {
                    f32x16 acc;
#pragma unroll
                    for (int i = 0; i < 16; ++i) acc[i] = 0.f;
#pragma unroll
                    for (int s = 0; s < 4; ++s) acc = mfma32(af[gq][s], as_bf16x8(cur[j][s]), acc);
                    float sc[4];
#pragma unroll
                    for (int i = 0; i < 4; ++i) {
                        float v = fmaxf(acc[4 * i + 0], 0.f) * wv[gq][i][0]; v += fmaxf(acc[4 * i + 1], 0.f) * wv[gq][i][1]; v += fmaxf(acc[4 * i + 2], 0.f) * wv[gq][i][2]; v += fmaxf(acc[4 * i + 3], 0.f) * wv[gq][i][3];
                        sc[i] = v + 0.0f; }
                    const bool odd = (lane & 1) != 0;
#pragma unroll
                    for (int i = 0; i < 4; i += 2) {
                        const float snd = odd ? sc[i] : sc[i + 1], rcv = shx<1>(snd, lane);
                        const float lo = odd ? rcv : sc[i], hi = odd ? sc[i + 1] : rcv;
                        const unsigned w = (unsigned)__builtin_bit_cast(unsigned short, (_Float16)lo) | ((unsigned)__builtin_bit_cast(unsigned short, (_Float16)hi) << 16);
                        const int ql = 8 * gq + 2 * (odd ? i + 1 : i) + hf, k0 = key & ~1;
                        *(unsigned*)((unsigned short*)(ws + WS_SP) + ((size_t)b * SEQ + q0 + ql) * SEQ + k0) = w;
                    }
                }
            }
        }
        asm volatile("" ::: "memory");
    }
#undef SC_ISSUE
}
__device__ __forceinline__ void score_item_sdma(PK P, const Ctx& C, int L, int b, int kc, LAS unsigned char* img) {
    constexpr int TG = 2;
    unsigned char* ws = P->ws; const int lane = C.lane, r32 = lane & 31, hf = lane >> 5;
    const bf16* IQ = (const bf16*)(ws + WS_IQ); const float* IW = (const float*)(ws + WS_IW);
    const size_t rowbase = (size_t)MP + b * 8;
    bf16x8 af[4]; f32x4 wv[4];
#pragma unroll
    for (int s = 0; s < 4; ++s) af[s] = *(const bf16x8*)(IQ + (rowbase + (r32 >> 2)) * 256 + (r32 & 3) * 64 + 16 * s + 8 * hf);
#pragma unroll
    for (int i = 0; i < 4; ++i) wv[i] = *(const f32x4*)(IW + (rowbase + 2 * i + hf) * 4);
    const int kt_end = min(kc * 16 + 16, (PAST + DS + 31) >> 5);
    const int* pt = (const int*)P->in[I_PT] + b * NPAGES;
    const float* cik = P->in[I_CIK] + (size_t)L * NPOOL * 128 * 64; const float* nik = P->out + O_IKS + ((size_t)L * DB + b) * DS * 64;
    const int dr = lane >> 4, dq = lane & 15;
#define SS_ISSUE(kt0_) do { _Pragma("unroll") for (int j = 0; j < TG; ++j) { const int kt_ = min((kt0_) + j, kt_end - 1); const float* pg_ = cik + ((size_t)pt[(kt_ >> 2) & 15] * 128 + (kt_ & 3) * 32) * 64; \
        _Pragma("unroll") for (int i = 0; i < 8; ++i) { const int row_ = 4 * i + dr, key_ = kt_ * 32 + row_, kcl_ = key_ < PAST + DS ? key_ : PAST + DS - 1; \
            const float* src_ = (kcl_ < PAST ? pg_ + row_ * 64 : nik + (kcl_ - PAST) * 64) + 4 * (dq ^ (row_ & 15)); \
            __builtin_amdgcn_global_load_lds((const unsigned*)src_, (LAS unsigned*)(img + j * 8192 + i * 1024), 16, 0, 0); } } } while (0)
    SS_ISSUE(kc * 16);
    for (int kt0 = kc * 16; kt0 < kt_end; kt0 += TG) {
        asm volatile("s_waitcnt vmcnt(0)" ::: "memory");
        u32x4 cur[TG][8];
#pragma unroll
        for (int j = 0; j < TG; ++j) {
#pragma unroll
            for (int s = 0; s < 8; ++s) cur[j][s] = *(const LAS u32x4*)(img + j * 8192 + r32 * 256 + 16 * ((4 * (s >> 1) + 2 * hf + (s & 1)) ^ (r32 & 15))); }
        asm volatile("s_waitcnt lgkmcnt(0)" ::: "memory");
        if (kt0 + TG < kt_end) SS_ISSUE(kt0 + TG);
        asm volatile("" ::: "memory");
#pragma unroll
        for (int j = 0; j < TG; ++j) { const int kt = kt0 + j;
            if (kt < kt_end) {
                const int key = kt * 32 + r32;
                f32x16 acc;
#pragma unroll
                for (int i = 0; i < 16; ++i) acc[i] = 0.f;
#pragma unroll
                for (int s = 0; s < 4; ++s) { const f32x4 a = __builtin_bit_cast(f32x4, cur[j][2 * s]), c = __builtin_bit_cast(f32x4, cur[j][2 * s + 1]);
                    u32x4 w; w.x = pk2(a[0], a[1]); w.y = pk2(a[2], a[3]); w.z = pk2(c[0], c[1]); w.w = pk2(c[2], c[3]);
                    acc = mfma32(af[s], as_bf16x8(w), acc); }
                float sc[4];
#pragma unroll
                for (int i = 0; i < 4; ++i) {
                    float v = fmaxf(acc[4 * i + 0], 0.f) * wv[i][0]; v += fmaxf(acc[4 * i + 1], 0.f) * wv[i][1]; v += fmaxf(acc[4 * i + 2], 0.f) * wv[i][2]; v += fmaxf(acc[4 * i + 3], 0.f) * wv[i][3];
                    sc[i] = v + 0.0f; }
                const bool odd = (lane & 1) != 0;
#pragma unroll
                for (int i = 0; i < 4; i += 2) {
                    const float snd = odd ? sc[i] : sc[i + 1], rcv = shx<1>(snd, lane);
                    const float lo = odd ? rcv : sc[i], hi = odd ? sc[i + 1] : rcv;
                    const unsigned w = (unsigned)__builtin_bit_cast(unsigned short, (_Float16)lo) | ((unsigned)__builtin_bit_cast(unsigned short, (_Float16)hi) << 16);
                    const int ql = 2 * (odd ? i + 1 : i) + hf, k0 = key & ~1;
                    if (k0 < PAST + DS) *(unsigned*)((unsigned short*)(ws + WS_SS) + ((size_t)b * 8 + ql) * SS_LD + k0) = w;
                }
            }
        }
        asm volatile("" ::: "memory");
    }
#undef SS_ISSUE
}
__device__ __forceinline__ void phase_c(PK P, const Ctx& C, int L, int sel = 15) {
    LAS unsigned char* imgw = C.lds + C.wave * 16384;
    if (C.nblk == 256) {
        const int q1 = C.blk & 127, n1 = q1 / 32 + 1;
        if ((C.gw & 1) == 0) { if (sel & 1) for (int it = C.gw >> 1; it < 1024; it += C.ngw >> 1) ret_state_item(P, C, L, it); }
        else { const int k = C.wave >> 1, f = (C.blk >> 7) * 4 + k; LAS unsigned char* imgf = C.lds + (k < 3 ? 71680 + k * 16384 : XPOSE_OFF);
            if ((sel & 8) && f < 5) score_item_sdma(P, C, L, q1, f, imgf);
            if ((sel & 4) && f >= 4) { const int j = f == 4 ? 35 : 27 + f; const int b = j / 9, c = j - 9 * b; if (c < n1) score_item_dma(P, C, L, b, q1, c, imgf); else score_item_dma(P, C, L, b, 255 - q1, c - n1, imgf); } }
        if (sel & 2) for (int u = C.blk; u < 512; u += C.nblk) ret_sample_unit(P, C, L, u);
        if (sel & 4) { const int wp = (C.blk >> 7) * NWAVES + C.wave;
            for (int j = wp; j < 32; j += 16) { const int b = j / 9, c = j - 9 * b; if (c < n1) score_item_dma(P, C, L, b, q1, c, imgw); else score_item_dma(P, C, L, b, 255 - q1, c - n1, imgw); } }
    } else {
        if ((sel & 1) && (C.gw & 1) == 0) for (int it = C.gw >> 1; it < 1024; it += C.ngw >> 1) ret_state_item(P, C, L, it);
        if (sel & 2) for (int u = C.blk; u < 512; u += C.nblk) ret_sample_unit(P, C, L, u);
        if (sel & 4) for (int it = C.gw; it < NB * 256 * 8; it += C.ngw) { const int kc = it & 7, qb = (it >> 3) & 255, b = it >> 11; if (kc * 512 <= qb * 16 + 15) score_item_dma(P, C, L, b, qb, kc, imgw); }
        if ((sel & 8) && (C.gw & 1) != 0) for (int it = C.gw >> 1; it < DB * 5; it += C.ngw >> 1) score_item_sdma(P, C, L, it / 5, it % 5, imgw);
    }
}

__device__ __forceinline__ void ret_scan_item(PK P, const Ctx& C, int L, int item) {
    unsigned char* ws = P->ws; const float* KVT = (const float*)(ws + WS_KVT); bf16* ST = (bf16*)(ws + WS_ST);
    const int e0 = item * 1024 + C.tid * 2, bh = e0 >> 14, rem = e0 & 16383, h = bh & 3;
    const float dec = __builtin_amdgcn_exp2f(128.0f * ret_log2g(h));
    float s0 = 0.f, s1 = 0.f;
#pragma unroll 8
    for (int n = 0; n < 32; ++n) { const f32x2 kv = *(const f32x2*)(KVT + ((size_t)bh * 32 + n) * 16384 + rem);
        *(unsigned*)(ST + ((size_t)bh * 32 + n) * 16384 + rem) = pk2(s0, s1); s0 = s0 * dec + kv[0]; s1 = s1 * dec + kv[1]; }
    const int e = rem >> 7, d = rem & 127;
    float* o = P->out + O_RSP + ((size_t)L * 16 + bh) * 16384; o[d * 128 + e] = s0; o[(d + 1) * 128 + e] = s1;
}
template <int G>
__device__ __forceinline__ void cnt_ge4(const unsigned (&kp)[32], unsigned cm1, unsigned& c0, unsigned& c1) {
    unsigned t0, t1, t2, t3;
    asm("v_pk_sub_u16 %2, %6, %10 clamp\n\tv_pk_sub_u16 %3, %7, %10 clamp\n\tv_pk_sub_u16 %4, %8, %10 clamp\n\tv_pk_sub_u16 %5, %9, %10 clamp\n\t"
        "v_pk_min_u16 %2, %2, %11\n\tv_pk_min_u16 %3, %3, %11\n\tv_pk_min_u16 %4, %4, %11\n\tv_pk_min_u16 %5, %5, %11\n\t"
        "v_pk_add_u16 %0, %0, %2\n\tv_pk_add_u16 %1, %1, %3\n\tv_pk_add_u16 %0, %0, %4\n\tv_pk_add_u16 %1, %1, %5"
        : "+v"(c0), "+v"(c1), "=&v"(t0), "=&v"(t1), "=&v"(t2), "=&v"(t3)
        : "v"(kp[4 * G + 0]), "v"(kp[4 * G + 1]), "v"(kp[4 * G + 2]), "v"(kp[4 * G + 3]), "s"(cm1), "s"(0x00010001u));
}
__device__ __forceinline__ int wave_sum_dpp(int v) {
    v += __builtin_amdgcn_update_dpp(0, v, 0x111, 0xf, 0xf, true);
    v += __builtin_amdgcn_update_dpp(0, v, 0x112, 0xf, 0xf, true);
    v += __builtin_amdgcn_update_dpp(0, v, 0x114, 0xf, 0xf, true);
    v += __builtin_amdgcn_update_dpp(0, v, 0x118, 0xf, 0xf, true);
    v += __builtin_amdgcn_update_dpp(0, v, 0x142, 0xa, 0xf, true);
    v += __builtin_amdgcn_update_dpp(0, v, 0x143, 0xc, 0xf, true);
    return __builtin_amdgcn_readlane(v, 63);
}
__device__ __forceinline__ unsigned cnt_ge_lane(const unsigned (&kp)[32], unsigned cand, int ng) {
    const unsigned cm1 = (cand - 1u) * 0x00010001u; unsigned c0 = 0u, c1 = 0u;
    cnt_ge4<0>(kp, cm1, c0, c1);
    if (ng > 1) cnt_ge4<1>(kp, cm1, c0, c1);
    if (ng > 2) cnt_ge4<2>(kp, cm1, c0, c1);
    if (ng > 3) cnt_ge4<3>(kp, cm1, c0, c1);
    if (ng > 4) cnt_ge4<4>(kp, cm1, c0, c1);
    if (ng > 5) cnt_ge4<5>(kp, cm1, c0, c1);
    if (ng > 6) cnt_ge4<6>(kp, cm1, c0, c1);
    if (ng > 7) cnt_ge4<7>(kp, cm1, c0, c1);
    const unsigned c = c0 + c1;
    return (c & 0xffffu) + (c >> 16);
}
__device__ __forceinline__ int cnt_ge(const unsigned (&kp)[32], unsigned cand, int ng) { return wave_sum_dpp((int)cnt_ge_lane(kp, cand, ng)); }
__device__ __forceinline__ void bit_transpose16(unsigned (&x)[16]) {
#define BT_STAGE(J, M) _Pragma("unroll") for (int r = 0; r < 16; ++r) if ((r & (J)) == 0) { const unsigned a = x[r], b = x[r + (J)]; x[r] = (a & (M)) | ((b << (J)) & ~(M)); x[r + (J)] = ((a >> (J)) & (M)) | (b & ~(M)); }
    BT_STAGE(8, 0x00ff00ffu) BT_STAGE(4, 0x0f0f0f0fu) BT_STAGE(2, 0x33333333u) BT_STAGE(1, 0x55555555u)
#undef BT_STAGE
}
__device__ __forceinline__ void select_topk(const unsigned short* srow, int Lk, LAS unsigned* list, int lane, int mode = 3) {
    const int ng = (Lk + 511) >> 9;
    unsigned kp[32];
    const unsigned* sl = (const unsigned*)srow + lane;
    if (ng > 4) {
#pragma unroll
        for (int j = 0; j < 32; ++j) kp[j] = sl[j * 64];
    } else {
#pragma unroll
        for (int j = 0; j < 16; ++j) kp[j] = sl[j * 64];
#pragma unroll
        for (int j = 16; j < 32; ++j) kp[j] = 0u;
    }
    typedef short s16x2 __attribute__((ext_vector_type(2)));
#pragma unroll
    for (int j = 0; j < 32; ++j) { const unsigned w = kp[j];
        const unsigned sg = __builtin_bit_cast(unsigned, __builtin_bit_cast(s16x2, w) >> (s16x2){15, 15});
        unsigned kk = w ^ (sg | 0x80008000u);
        const int rem = Lk - 128 * j;
        if (rem < 128) kk &= ((2 * lane < rem) ? 0xffffu : 0u) | ((2 * lane + 1 < rem) ? 0xffff0000u : 0u);
        kp[j] = kk; }
    unsigned p0[16], p1[16];
#pragma unroll
    for (int j = 0; j < 16; ++j) { p0[j] = kp[j]; p1[j] = 0u; }
    bit_transpose16(p0);
    if (ng > 4) {
#pragma unroll
        for (int j = 0; j < 16; ++j) p1[j] = kp[16 + j];
        bit_transpose16(p1); }
    unsigned act0 = ~0u, act1 = ~0u, gt0 = 0u, gt1 = 0u; int G = 0;
#pragma unroll
    for (int bit = 15; bit >= 0; --bit) {
        const unsigned t0 = act0 & p0[bit], t1 = act1 & p1[bit];
        const int c = __builtin_popcount(t0) + __builtin_popcount(t1);
        const int tot = wave_sum_dpp(c);
        const bool take = G + tot >= TOPK;
        if (take) { act0 = t0; act1 = t1; } else { G += tot; gt0 |= t0; gt1 |= t1; act0 ^= t0; act1 ^= t1; }
    }
    const int neq = wave_sum_dpp(__builtin_popcount(act0) + __builtin_popcount(act1));
    unsigned sel0, sel1;
    if (G + neq == TOPK) { sel0 = gt0 | act0; sel1 = gt1 | act1; }
    else {
        const int need_eq = TOPK - G; int jc = 0, base = 0;
#define SEL_MASKR(m_) ((m_) <= 0 ? 0u : (m_) >= 16 ? 0xffffffffu : ((1u << (m_)) - 1u) * 0x00010001u)
#pragma unroll
        for (int s = 16; s >= 1; s >>= 1) { const int jm = jc + s; const unsigned m0 = SEL_MASKR(jm), m1 = SEL_MASKR(jm - 16);
            const int cb = wave_sum_dpp(__builtin_popcount(act0 & m0) + __builtin_popcount(act1 & m1));
            if (cb < need_eq) { jc = jm; base = cb; } }
        const int rc = jc & 15; const unsigned aw = jc >= 16 ? act1 : act0;
        const bool e0 = ((aw >> rc) & 1u) != 0u, e1 = ((aw >> (16 + rc)) & 1u) != 0u;
        const unsigned long long b0 = __ballot(e0), b1 = __ballot(e1);
        const int rk = base + mbcnt64(b0) + mbcnt64(b1);
        const bool s0 = e0 && rk < need_eq, s1 = e1 && (rk + (e0 ? 1 : 0)) < need_eq;
        const unsigned add = ((s0 ? 1u : 0u) << rc) | ((s1 ? 1u : 0u) << (16 + rc));
        const unsigned m0 = SEL_MASKR(jc), m1 = SEL_MASKR(jc - 16);
        sel0 = gt0 | (act0 & m0) | (jc < 16 ? add : 0u);
        sel1 = gt1 | (act1 & m1) | (jc >= 16 ? add : 0u);
#undef SEL_MASKR
    }
    { const int cl = __builtin_popcount(sel0) + __builtin_popcount(sel1);
      int inc = cl;
      inc += __builtin_amdgcn_update_dpp(0, inc, 0x111, 0xf, 0xf, true);
      inc += __builtin_amdgcn_update_dpp(0, inc, 0x112, 0xf, 0xf, true);
      inc += __builtin_amdgcn_update_dpp(0, inc, 0x114, 0xf, 0xf, true);
      inc += __builtin_amdgcn_update_dpp(0, inc, 0x118, 0xf, 0xf, true);
      inc += __builtin_amdgcn_update_dpp(0, inc, 0x142, 0xa, 0xf, true);
      inc += __builtin_amdgcn_update_dpp(0, inc, 0x143, 0xc, 0xf, true);
      int off = inc - cl; unsigned m0 = sel0, m1 = sel1;
      while (__ballot((m0 | m1) != 0u) != 0ull) {
          const bool has0 = m0 != 0u; const unsigned m = has0 ? m0 : m1; const bool valid = m != 0u;
          const int p = __builtin_ctz(m | 0x80000000u);
          const unsigned idx = (unsigned)((((p & 15) + (has0 ? 0 : 16)) << 7) + 2 * lane + (p >> 4));
          list[valid ? off : 2368 + lane] = idx;
          off += valid ? 1 : 0;
          const unsigned nm = m & (m - 1u);
          m0 = has0 ? nm : m0; m1 = has0 ? m1 : nm; }
    }
}
#ifndef SEL2
#define SEL2 0
#endif
#ifndef QK2
#define QK2 0
#endif
#ifndef PV2
#define PV2 0
#endif
#ifndef NOXCD
#define NOXCD 0
#endif
constexpr int ATT_WSTRIDE = 10496;
template <bool SAMPLE>
__device__ __forceinline__ void attend_query(PK P, const Ctx& C, int L, int row, int mode = 3) {
    int lane_ = C.lane; asm volatile("" : "+v"(lane_));
    unsigned char* ws = P->ws; const int lane = lane_;
    LAS unsigned* list = (LAS unsigned*)(C.lds + C.wave * ATT_WSTRIDE);
    int b, Lk; const unsigned short* srow;
    if (SAMPLE) { b = (row - MP) >> 3; const int j = (row - MP) & 7; Lk = PAST + j + 1; srow = (const unsigned short*)(ws + WS_SS) + (size_t)(row - MP) * SS_LD; }
    else { b = row >> 12; const int t = row & (SEQ - 1); Lk = t + 1; srow = (const unsigned short*)(ws + WS_SP) + (size_t)row * SEQ; }
    const int n16 = lane & 15, g = lane >> 4;
    u32x4 qraw[2]; qraw[0] = (u32x4){0u, 0u, 0u, 0u}; qraw[1] = qraw[0];
    if (n16 < 8) { qraw[0] = *(const u32x4*)((const bf16*)(ws + WS_AQ) + (size_t)row * 512 + n16 * 64 + 8 * g); qraw[1] = *(const u32x4*)((const bf16*)(ws + WS_AQ) + (size_t)row * 512 + n16 * 64 + 32 + 8 * g); }
    u32x2 azr[4];
#pragma unroll
    for (int dl = 0; dl < 4; ++dl) azr[dl] = *(const u32x2*)((const bf16*)(ws + WS_Z) + (size_t)row * NZ + ZC_AZ + (n16 & 7) * 64 + 16 * dl + 4 * g);
    int ptv = 0; if (SAMPLE) ptv = ((const int*)P->in[I_PT])[b * NPAGES + (lane & 15)];
    int count;
    if (Lk <= TOPK) { for (int i = lane; i < TOPK; i += 64) list[i] = i < Lk ? (unsigned)i : 0u; count = Lk; }
    else { select_topk(srow, Lk, list, lane, mode); if (SEL2) { LDS_WAIT(); asm volatile("" ::: "memory"); select_topk(srow, Lk, list, lane, mode); } count = TOPK; }
    LDS_WAIT(); asm volatile("" ::: "memory");
    if (mode == 1 || mode == 4 || mode == 5) return;
    {
#pragma unroll
      for (int i = 0; i < 4; ++i) { const unsigned k = list[lane + 64 * i]; unsigned phys;
          if (SAMPLE) { const unsigned pg = (unsigned)__builtin_amdgcn_ds_bpermute((int)(((k >> 7) & 15u) << 2), ptv); phys = (k < (unsigned)PAST) ? pg * 128u + (k & 127u) : (0x80000000u | (k - PAST)); }
          else phys = (unsigned)b * SEQ + k;
          list[lane + 64 * i] = phys; } }
    LDS_WAIT(); asm volatile("" ::: "memory");
    const float* ck = SAMPLE ? P->in[I_CK] + (size_t)L * NPOOL * 128 * 128 : nullptr; const float* cv = SAMPLE ? P->in[I_CV] + (size_t)L * NPOOL * 128 * 128 : nullptr;
    const float* nk = P->out + O_KS + ((size_t)L * DB + b) * DS * 128; const float* nv = P->out + O_VS + ((size_t)L * DB + b) * DS * 128;
    const bf16* KBp = (const bf16*)(ws + WS_KB); const bf16* VBp = (const bf16*)(ws + WS_VB);
    bf16x8 qf[2][2];
#pragma unroll
    for (int kvh = 0; kvh < 2; ++kvh)
#pragma unroll
        for (int s = 0; s < 2; ++s) { const u32x4 zz = {0u, 0u, 0u, 0u}; qf[kvh][s] = as_bf16x8(((n16 >> 2) == kvh) ? qraw[s] : zz); }
    f32x4 S[16];
    for (int rq_ = 0; rq_ < (QK2 ? 2 : 1); ++rq_) {
    { LAS unsigned char* kbuf = C.lds + C.wave * ATT_WSTRIDE + 1024; const int c16k = lane & 15, tqk = lane >> 4;
      constexpr int SB = SAMPLE ? 1 : 2, NBT = 8 / SB;
      u32x4 kraw[2][SB][SAMPLE ? 16 : 8];
#define ATT_KLOAD(buf_, k_) do { _Pragma("unroll") for (int q = 0; q < SB; ++q) _Pragma("unroll") for (int i = 0; i < 8; ++i) { const unsigned phys = list[32 * ((k_) * SB + q) + tqk + 4 * i]; \
                if (SAMPLE) { const float* kr = ((phys & 0x80000000u) ? nk + (size_t)(phys & 7u) * 128 : ck + (size_t)phys * 128) + 8 * c16k; kraw[buf_][q][2 * i] = *(const u32x4*)kr; kraw[buf_][q][2 * i + 1] = *(const u32x4*)(kr + 4); } \
                else kraw[buf_][q][i] = *(const u32x4*)(KBp + (size_t)phys * 128 + 8 * c16k); } } while (0)
      ATT_KLOAD(0, 0); ATT_KLOAD(1, 1);
      asm volatile("" ::: "memory");
#pragma unroll
      for (int k = 0; k < NBT; ++k) {
#pragma unroll
        for (int q = 0; q < SB; ++q) { const int st = k * SB + q;
#pragma unroll
            for (int i = 0; i < 8; ++i) { u32x4 w;
                if (SAMPLE) { const f32x4 a = __builtin_bit_cast(f32x4, kraw[k & 1][q][2 * i]), c = __builtin_bit_cast(f32x4, kraw[k & 1][q][2 * i + 1]); w.x = pk2(a[0], a[1]); w.y = pk2(a[2], a[3]); w.z = pk2(c[0], c[1]); w.w = pk2(c[2], c[3]); }
                else w = kraw[k & 1][q][i];
                *(LAS u32x4*)(kbuf + (tqk + 4 * i) * 288 + 16 * c16k) = w; }
            if (q == SB - 1 && k + 2 < NBT) ATT_KLOAD(k & 1, k + 2);
            LDS_WAIT(); asm volatile("" ::: "memory");
#pragma unroll
            for (int tt = 0; tt < 2; ++tt) { const LAS unsigned char* rp = kbuf + (16 * tt + n16) * 288 + 16 * g;
                const bf16x8 a00 = *(const LAS bf16x8*)rp, a01 = *(const LAS bf16x8*)(rp + 64), a10 = *(const LAS bf16x8*)(rp + 128), a11 = *(const LAS bf16x8*)(rp + 192);
                f32x4 acc = {0.f, 0.f, 0.f, 0.f};
                acc = mfma16(a00, qf[0][0], acc); acc = mfma16(a01, qf[0][1], acc); acc = mfma16(a10, qf[1][0], acc); acc = mfma16(a11, qf[1][1], acc); asm volatile("" : "+v"(acc)); S[2 * st + tt] = acc; }
            LDS_WAIT(); asm volatile("" ::: "memory"); }
      }
#undef ATT_KLOAD
    }
    asm volatile("" ::: "memory"); }
    LAS unsigned char* vbuf = C.lds + C.wave * ATT_WSTRIDE + 1024;
    const int c16 = lane & 15, tq = lane >> 4;
    constexpr int VD = SAMPLE ? 1 : 2;
    u32x4 vraw[VD][SAMPLE ? 16 : 8];
#define ATT_VLOAD(buf_, st_) do { _Pragma("unroll") for (int i = 0; i < 8; ++i) { const unsigned phys = list[32 * (st_) + tq + 4 * i]; \
            if (SAMPLE) { const float* vr = ((phys & 0x80000000u) ? nv + (size_t)(phys & 7u) * 128 : cv + (size_t)phys * 128) + 8 * c16; vraw[buf_][2 * i] = *(const u32x4*)vr; vraw[buf_][2 * i + 1] = *(const u32x4*)(vr + 4); } \
            else vraw[buf_][i] = *(const u32x4*)(VBp + (size_t)phys * 128 + 8 * c16); } } while (0)
    if (mode != 2) {
#pragma unroll
        for (int d = 0; d < VD; ++d) ATT_VLOAD(d, d); }
    asm volatile("" ::: "memory");
    float mx = -INFINITY;
#pragma unroll
    for (int i = 0; i < 16; ++i)
#pragma unroll
        for (int r = 0; r < 4; ++r) { const int slot = 16 * i + 4 * g + r; const float sv = slot < count ? S[i][r] * 0.125f : -INFINITY; S[i][r] = sv; mx = fmaxf(mx, sv); }
    mx = fmaxf(mx, shx<16>(mx, lane)); mx = fmaxf(mx, shx<32>(mx, lane));
    float sum = 0.f;
#pragma unroll
    for (int i = 0; i < 16; ++i)
#pragma unroll
        for (int r = 0; r < 4; ++r) { const float p = __builtin_amdgcn_exp2f((S[i][r] - mx) * 1.4426950408889634f); S[i][r] = p; sum += p; }
    sum += shx<16>(sum, lane); sum += shx<32>(sum, lane);
    if (mode == 2) return;
    f32x4 oacc[8];
    {
#pragma unroll
    for (int dt = 0; dt < 8; ++dt) oacc[dt] = (f32x4){0.f, 0.f, 0.f, 0.f};
    const unsigned tr_a = (unsigned)(4 * g + (c16 >> 2)) * 288u + (unsigned)(c16 & 3) * 8u;
#pragma unroll
    for (int st = 0; st < 8; ++st) {
#pragma unroll
        for (int i = 0; i < 8; ++i) { u32x4 w;
            if (SAMPLE) { const f32x4 a = __builtin_bit_cast(f32x4, vraw[st % VD][2 * i]), c = __builtin_bit_cast(f32x4, vraw[st % VD][2 * i + 1]); w.x = pk2(a[0], a[1]); w.y = pk2(a[2], a[3]); w.z = pk2(c[0], c[1]); w.w = pk2(c[2], c[3]); }
            else w = vraw[st % VD][i];
            *(LAS u32x4*)(vbuf + (tq + 4 * i) * 288 + 16 * c16) = w; }
        if (st + VD < 8) ATT_VLOAD(st % VD, st + VD);
        const f32x4 p0 = S[2 * st], p1 = S[2 * st + 1];
        u32x4 pw; pw.x = pk2(p0[0], p0[1]); pw.y = pk2(p0[2], p0[3]); pw.z = pk2(p1[0], p1[1]); pw.w = pk2(p1[2], p1[3]);
        const bf16x8 pf = as_bf16x8(pw);
        LDS_WAIT(); asm volatile("" ::: "memory");
#pragma unroll
        for (int dt = 0; dt < 8; ++dt) {
            typedef short v4i16_t __attribute__((ext_vector_type(4)));
            const v4i16_t lo = __builtin_amdgcn_ds_read_tr16_b64_v4i16((LAS v4i16_t*)(vbuf + tr_a + 32 * dt));
            const v4i16_t hi = __builtin_amdgcn_ds_read_tr16_b64_v4i16((LAS v4i16_t*)(vbuf + tr_a + 16 * 288 + 32 * dt));
            bf16x8 af; af[0] = lo[0]; af[1] = lo[1]; af[2] = lo[2]; af[3] = lo[3]; af[4] = hi[0]; af[5] = hi[1]; af[6] = hi[2]; af[7] = hi[3];
            oacc[dt] = mfma16(af, pf, oacc[dt]); }
        LDS_WAIT(); asm volatile("" ::: "memory");
    }
    asm volatile("" ::: "memory"); }
    { const float inv = 1.0f / sum;
#define ATT_EPI(base_) do { _Pragma("unroll") for (int dl = 0; dl < 4; ++dl) { const f32x4 v = oacc[(base_) + dl]; \
              const float y0 = v[0] * inv * siluf_(bflo(azr[dl].x)), y1 = v[1] * inv * siluf_(bfhi(azr[dl].x)), y2 = v[2] * inv * siluf_(bflo(azr[dl].y)), y3 = v[3] * inv * siluf_(bfhi(azr[dl].y)); \
              u32x2 ow; ow.x = pk2(y0, y1); ow.y = pk2(y2, y3); \
              *(u32x2*)((bf16*)(ws + WS_OGA) + (size_t)row * 512 + n16 * 64 + 16 * dl + 4 * g) = ow; } } while (0)
      if (n16 < 4) ATT_EPI(0); else if (n16 < 8) ATT_EPI(4);
#undef ATT_EPI
    }
    LDS_WAIT(); asm volatile("" ::: "memory");
#undef ATT_VLOAD
}
__device__ __forceinline__ void ret_out_unit(PK P, const Ctx& C, int unit, bool flip);
__device__ __forceinline__ void phase_d(PK P, const Ctx& C, int L, int mode = 3) {
    if (mode == 3) { bool flip = false; for (int u = C.blk; u < 512; u += C.nblk) { ret_out_unit(P, C, u, flip); flip = !flip; } __syncthreads(); }
#ifndef DSEL
#define DSEL 7
#endif
    if (!(DSEL & 2)) {} else
    if (C.nblk == 256 && !NOXCD) {
        const int x = C.blk & 7, b = x >> 1, wq = (((C.blk >> 3) * 2 + (x & 1)) * NWAVES + C.wave);
        for (int t = wq; t < SEQ; t += 512) attend_query<false>(P, C, L, b * SEQ + t, mode);
    } else for (int row = C.gw; row < MP; row += C.ngw) attend_query<false>(P, C, L, row, mode);
    if (DSEL & 4) for (int i = C.gw; i < 2 * MS; i += C.ngw) if ((i & 1) == 0) attend_query<true>(P, C, L, MP + (i >> 1), mode);
}

__device__ __forceinline__ void ret_out_unit(PK P, const Ctx& C, int unit, bool flip) {
    unsigned char* ws = P->ws; const bf16* RQ = (const bf16*)(ws + WS_RQ); const bf16* RK = (const bf16*)(ws + WS_RK); const bf16* RVT = (const bf16*)(ws + WS_RVT); const bf16* ST = (const bf16*)(ws + WS_ST);
    const int bh = unit >> 5, b = bh >> 2, h = bh & 3, n = unit & 31, r16 = C.lane & 15, g = C.lane >> 4, t0 = n * 128;
    const int w = flip ? 7 - C.wave : C.wave;
    const size_t rowbase = (size_t)b * SEQ + t0;
    const float lg2 = ret_log2g(h);
    constexpr int RS = 272; LAS unsigned char* Ks = C.lds; LAS unsigned char* Vs = C.lds + 128 * RS; LAS unsigned char* Ss = C.lds + 256 * RS;
    bf16x8 qf[4];
#pragma unroll
    for (int kk = 0; kk < 4; ++kk) qf[kk] = *(const bf16x8*)(RQ + (rowbase + 16 * w + r16) * 512 + h * 128 + 32 * kk + 8 * g);
    { const int pr = C.tid >> 4, pc = C.tid & 15;
      u32x4 rk[4], rv[4], rs_[4];
#pragma unroll
      for (int q = 0; q < 4; ++q) { const int r = pr + 32 * q;
          rk[q] = *(const u32x4*)(RK + (rowbase + r) * 512 + h * 128 + 8 * pc);
          rv[q] = *(const u32x4*)(RVT + ((size_t)bh * 128 + r) * SEQ + t0 + 8 * pc);
          rs_[q] = *(const u32x4*)(ST + (((size_t)bh * 32 + n) * 128 + r) * 128 + 8 * pc); }
      __syncthreads();
#pragma unroll
      for (int q = 0; q < 4; ++q) { const int r = pr + 32 * q; *(LAS u32x4*)(Ks + r * RS + 16 * pc) = rk[q]; *(LAS u32x4*)(Vs + r * RS + 16 * pc) = rv[q]; *(LAS u32x4*)(Ss + r * RS + 16 * pc) = rs_[q]; }
      __syncthreads(); }
    unsigned pt[8][2];
#pragma unroll
    for (int st = 0; st < 8; ++st) {
        pt[st][0] = 0u; pt[st][1] = 0u;
        if (st <= w) { f32x4 acc = {0.f, 0.f, 0.f, 0.f};
#pragma unroll
            for (int kk = 0; kk < 4; ++kk) { const bf16x8 kf = *(const LAS bf16x8*)(Ks + (16 * st + r16) * RS + 64 * kk + 16 * g); acc = mfma16(kf, qf[kk], acc); }
            float vals[4];
#pragma unroll
            for (int r = 0; r < 4; ++r) { const int dlt = (16 * w + r16) - (16 * st + 4 * g + r); vals[r] = dlt >= 0 ? acc[r] * __builtin_amdgcn_exp2f((float)dlt * lg2) : 0.f; }
            pt[st][0] = pk2(vals[0], vals[1]); pt[st][1] = pk2(vals[2], vals[3]); }
    }
    const float dq = __builtin_amdgcn_exp2f((float)(16 * w + r16 + 1) * lg2);
    f32x4 o[8];
#pragma unroll
    for (int et = 0; et < 8; ++et) {
        f32x4 a1 = {0.f, 0.f, 0.f, 0.f}, a2 = {0.f, 0.f, 0.f, 0.f};
        const LAS unsigned char* vrow = Vs + (16 * et + r16) * RS;
#pragma unroll
        for (int i = 0; i < 4; ++i) if (2 * i <= w) {
            const u32x2 lo = *(const LAS u32x2*)(vrow + 2 * (32 * i + 4 * g)), hi = *(const LAS u32x2*)(vrow + 2 * (32 * i + 16 + 4 * g));
            const u32x4 aw = {lo.x, lo.y, hi.x, hi.y}, bw = {pt[2 * i][0], pt[2 * i][1], pt[2 * i + 1][0], pt[2 * i + 1][1]};
            a1 = mfma16(as_bf16x8(aw), as_bf16x8(bw), a1); }
#pragma unroll
        for (int kk = 0; kk < 4; ++kk) { const bf16x8 sf = *(const LAS bf16x8*)(Ss + (16 * et + r16) * RS + 64 * kk + 16 * g); a2 = mfma16(sf, qf[kk], a2); }
        o[et] = a1 + a2 * dq;
    }
    float sm = 0.f;
#pragma unroll
    for (int et = 0; et < 8; ++et) sm += (o[et][0] + o[et][1]) + (o[et][2] + o[et][3]);
    sm += shx<16>(sm, C.lane); sm += shx<32>(sm, C.lane);
    const float mu = sm * (1.0f / 128.0f); float qv = 0.f;
#pragma unroll
    for (int et = 0; et < 8; ++et) { const f32x4 d = o[et] - mu; qv += (d[0] * d[0] + d[1] * d[1]) + (d[2] * d[2] + d[3] * d[3]); }
    qv += shx<16>(qv, C.lane); qv += shx<32>(qv, C.lane);
    const float rstd = __builtin_amdgcn_rsqf(qv * (1.0f / 128.0f) + 1e-5f);
    const size_t row = rowbase + 16 * w + r16;
    const bf16* zr = (const bf16*)(ws + WS_Z) + row * NZ + ZC_RZ + h * 128; bf16* og = (bf16*)(ws + WS_OGR) + row * 512 + h * 128;
#pragma unroll
    for (int et = 0; et < 8; ++et) { const u32x2 zw = *(const u32x2*)(zr + 16 * et + 4 * g);
        const float y0 = (o[et][0] - mu) * rstd * siluf_(bflo(zw.x)), y1 = (o[et][1] - mu) * rstd * siluf_(bfhi(zw.x)), y2 = (o[et][2] - mu) * rstd * siluf_(bflo(zw.y)), y3 = (o[et][3] - mu) * rstd * siluf_(bfhi(zw.y));
        u32x2 ow; ow.x = pk2(y0, y1); ow.y = pk2(y2, y3); *(u32x2*)(og + 16 * et + 4 * g) = ow; }
}

template <int K>
__device__ __forceinline__ void mini_mma(const bf16* A, const bf16* Bt, int row0, int col0, const Ctx& C, f32x4 (&acc)[2]) {
    constexpr int RS = 272, BUF = 2 * 64 * RS;
    constexpr int NC = K / 128, PF = NC < 4 ? NC : 4;
    const int tid = C.tid, lane = C.lane, rt = C.wave >> 1, ch = C.wave & 1, r16 = lane & 15, g = lane >> 4;
    LAS unsigned char* sm = C.lds;
    const int pr0 = tid >> 4, pc = tid & 15;
    const bf16* ga = A + (size_t)(row0 + pr0) * K + 8 * pc; const bf16* gb = Bt + (size_t)(col0 + pr0) * K + 8 * pc;
    acc[0] = (f32x4){0.f, 0.f, 0.f, 0.f}; acc[1] = (f32x4){0.f, 0.f, 0.f, 0.f};
    u32x4 rr[PF][4];
#pragma unroll
    for (int p = 0; p < PF; ++p) { rr[p][0] = *(const u32x4*)(ga + 128 * p); rr[p][1] = *(const u32x4*)(ga + (size_t)32 * K + 128 * p); rr[p][2] = *(const u32x4*)(gb + 128 * p); rr[p][3] = *(const u32x4*)(gb + (size_t)32 * K + 128 * p); }
    asm volatile("" ::: "memory");
    __syncthreads();
#pragma unroll
    for (int c = 0; c < NC; ++c) {
        { LAS unsigned char* w = sm + (c & 1) * BUF + pr0 * RS + 16 * pc; *(LAS u32x4*)w = rr[c % PF][0]; *(LAS u32x4*)(w + 32 * RS) = rr[c % PF][1]; *(LAS u32x4*)(w + 64 * RS) = rr[c % PF][2]; *(LAS u32x4*)(w + 96 * RS) = rr[c % PF][3]; }
        if (c + PF < NC) { const int n = c + PF; rr[c % PF][0] = *(const u32x4*)(ga + 128 * n); rr[c % PF][1] = *(const u32x4*)(ga + (size_t)32 * K + 128 * n); rr[c % PF][2] = *(const u32x4*)(gb + 128 * n); rr[c % PF][3] = *(const u32x4*)(gb + (size_t)32 * K + 128 * n); }
        asm volatile("" ::: "memory");
        __syncthreads();
        const LAS unsigned char* rd = sm + (c & 1) * BUF;
#pragma unroll
        for (int kk = 0; kk < 4; ++kk) {
            const bf16x8 a = *(const LAS bf16x8*)(rd + (16 * rt + r16) * RS + 64 * kk + 16 * g);
            const bf16x8 b0 = *(const LAS bf16x8*)(rd + (64 + 32 * ch + r16) * RS + 64 * kk + 16 * g), b1 = *(const LAS bf16x8*)(rd + (64 + 32 * ch + 16 + r16) * RS + 64 * kk + 16 * g);
            acc[0] = mfma16(a, b0, acc[0]); acc[1] = mfma16(a, b1, acc[1]); }
    }
    __syncthreads();
}
__device__ __forceinline__ void mini_oproj(PK P, const Ctx& C, int L) {
    unsigned char* ws = P->ws; const int lane = C.lane, rt = C.wave >> 1, ch = C.wave & 1, r16 = lane & 15, g = lane >> 4;
    for (int u = C.blk; u < 256; u += C.nblk) { const int row0 = MP + 64 * (u >> 4), col0 = 64 * (u & 15);
        f32x4 a1[2], a2[2];
        mini_mma<512>((const bf16*)(ws + WS_OGR), (const bf16*)(ws + WS_WOR) + (size_t)L * DM * 512, row0, col0, C, a1);
        mini_mma<512>((const bf16*)(ws + WS_OGA), (const bf16*)(ws + WS_WOA) + (size_t)L * DM * 512, row0, col0, C, a2);
        const bf16* Z = (const bf16*)(ws + WS_Z); bf16* MB = (bf16*)(ws + WS_MB);
#pragma unroll
        for (int j = 0; j < 2; ++j)
#pragma unroll
            for (int r = 0; r < 4; ++r) { const size_t row = (size_t)(row0 + 16 * rt + 4 * g + r); const int col = col0 + 32 * ch + 16 * j + r16;
                const float m = sigmoidf_(bf2f(Z[row * NZ + ZC_GR + col])) * a1[j][r] + sigmoidf_(bf2f(Z[row * NZ + ZC_GA + col])) * a2[j][r];
                MB[row * DM + col] = (bf16)(pk2(m, 0.f) & 0xffffu); } }
}
__device__ __forceinline__ void mini_wout(PK P, const Ctx& C, int L) {
    unsigned char* ws = P->ws; const int lane = C.lane, rt = C.wave >> 1, ch = C.wave & 1, r16 = lane & 15, g = lane >> 4;
    const float* xs = P->in[I_XS] - (size_t)MP * DM;
    const bf16* xh = (const bf16*)(ws + WS_XB0);
    for (int u = C.blk; u < 256; u += C.nblk) { const int row0 = MP + 64 * (u >> 4), col0 = 64 * (u & 15);
        f32x4 a1[2];
        mini_mma<1024>((const bf16*)(ws + WS_MB), (const bf16*)(ws + WS_WOUT) + (size_t)L * DM * DM, row0, col0, C, a1);
        bf16* XB1 = (bf16*)(ws + WS_XB1);
#pragma unroll
        for (int j = 0; j < 2; ++j)
#pragma unroll
            for (int r = 0; r < 4; ++r) { const size_t row = (size_t)(row0 + 16 * rt + 4 * g + r); const int col = col0 + 32 * ch + 16 * j + r16;
                const float x = (L == 0) ? xs[row * DM + col] : bf2f(xh[row * DM + col]);
                XB1[row * DM + col] = (bf16)(pk2(x + a1[j][r], 0.f) & 0xffffu); } }
}
__device__ __forceinline__ void mini_ple(PK P, const Ctx& C, int L, bool do_ss = true) {
    unsigned char* ws = P->ws; const int lane = C.lane, rt = C.wave >> 1, ch = C.wave & 1, r16 = lane & 15, g = lane >> 4;
    float* rowss = (L + 1 < DEPTH && do_ss) ? (float*)(ws + WS_CTL) + CW_ROWSS1 : nullptr;
    for (int u = C.blk; u < 256; u += C.nblk) { const int row0 = MP + 64 * (u >> 4), col0 = 64 * (u & 15);
        f32x4 a1[2], a2[2];
        mini_mma<1024>((const bf16*)(ws + WS_XB1), (const bf16*)(ws + WS_WPG) + (size_t)L * DM * DM, row0, col0, C, a1);
        mini_mma<256>((const bf16*)(ws + WS_PB) + (size_t)L * MT * 256, (const bf16*)(ws + WS_WPP) + (size_t)L * DM * 256, row0, col0, C, a2);
        const bf16* XB1 = (const bf16*)(ws + WS_XB1); float* Y = P->out; bf16* XB0 = (bf16*)(ws + WS_XB0);
#pragma unroll
        for (int r = 0; r < 4; ++r) { const size_t row = (size_t)(row0 + 16 * rt + 4 * g + r); float ssq = 0.f;
#pragma unroll
            for (int j = 0; j < 2; ++j) { const int col = col0 + 32 * ch + 16 * j + r16;
                const float v = bf2f(XB1[row * DM + col]) + sigmoidf_(a1[j][r]) * a2[j][r]; if (L + 1 == DEPTH) Y[row * DM + col] = v; XB0[row * DM + col] = (bf16)(pk2(v, 0.f) & 0xffffu); ssq += v * v; }
            if (rowss != nullptr) { ssq += shx<1>(ssq, lane); ssq += shx<2>(ssq, lane); ssq += shx<4>(ssq, lane); ssq += shx<8>(ssq, lane); if (r16 == 0) atomicAdd(rowss + row, ssq); } } }
}


__device__ __forceinline__ void mini_inproj_gates(PK P, const Ctx& C, int L) {
    unsigned char* ws = P->ws; const int lane = C.lane, rt = C.wave >> 1, ch = C.wave & 1, r16 = lane & 15, g = lane >> 4;
    const float* rowss = (L == 0) ? (const float*)(ws + WS_ROWSS0) : (const float*)(ws + WS_CTL) + CW_ROWSS1;
    bf16* Z = (bf16*)(ws + WS_Z);
    for (int u = C.blk; u < 16 * 30; u += C.nblk) { const int row0 = MP + 64 * (u / 30), col0 = 15 * 256 + 64 * (u % 30);
        f32x4 a1[2];
        mini_mma<1024>((const bf16*)(ws + WS_XB0), (const bf16*)(ws + WS_WIN) + (size_t)L * NZ * DM, row0, col0, C, a1);
#pragma unroll
        for (int r = 0; r < 4; ++r) { const size_t row = (size_t)(row0 + 16 * rt + 4 * g + r); const float rs = __builtin_amdgcn_rsqf(rowss[row] * (1.0f / 1024.0f) + 1e-6f);
#pragma unroll
            for (int j = 0; j < 2; ++j) Z[row * NZ + col0 + 32 * ch + 16 * j + r16] = (bf16)(pk2(a1[j][r] * rs, 0.f) & 0xffffu); } }
}
__global__ void __launch_bounds__(NTHREADS, 2) mk_fwd(Params Pval) {
    extern __shared__ __attribute__((aligned(16))) unsigned char lds_raw[];
    LAS unsigned char* lds = (LAS unsigned char*)lds_raw;
    volatile LAS unsigned* MISC = (volatile LAS unsigned*)(lds + MISC_OFF);
    const int wave_s = __builtin_amdgcn_readfirstlane((int)threadIdx.x >> 6);
    for (int u = wave_s * 64 + hw_lane(); u < (LDS_BYTES - RING_BYTES) / 4; u += NTHREADS) ((LAS unsigned*)(lds + RING_BYTES))[u] = 0u;
    __syncthreads();
    const int lo = Pval.ph_lo, hi = Pval.ph_hi;
    XcdBarrier bar; bar.bar = (unsigned*)(Pval.ws + WS_CTL) + CW_BAR + Pval.li * XCD_BAR_WORDS; bar.x = 0; bar.st = MISC + 8;
    if (hi - lo > 1) bar = xcd_barrier_post(bar.bar, MISC + 8, wave_s == 0 && hw_lane() == 0);
#ifndef STEPSEL
#define STEPSEL(j) true
#endif
#define IN(k) (lo <= (k) && (k) < hi)
#ifndef DUPMASK
#define DUPMASK 0
#endif
#ifndef XBAR2
#define XBAR2 0
#endif
#ifndef MINI2
#define MINI2 0
#endif
#ifndef DUPMODE
#define DUPMODE 3
#endif
#ifndef CSEL
#define CSEL 15
#endif
#define INL(j) (STEPSEL(j) && IN(pb + (j)))
#define NREP(j) (((DUPMASK) >> (j)) & 1 ? 2 : 1)
#define SEAM(k) do { if (IN((k) + 1)) { XcdBarrier b2_ = bar; asm volatile("" : "+s"(b2_.bar), "+s"(b2_.x)); int t0_ = wave_s * 64 + hw_lane(salt_); asm volatile("" : "+v"(t0_)); xcd_barrier(b2_, t0_ == 0); if (XBAR2) xcd_barrier(b2_, t0_ == 0); } } while (0)
#define PH_ENTER() PK P = phase_args(); const Ctx C = phase_ctx(lds, wave_s, salt_); unsigned char* ws = P->ws; (void)ws; (void)C
    #ifndef PRODUP
#define PRODUP 1
#endif
    const int salt_ = 0;
    if (STEPSEL(-1) && IN(0)) { for (int rep = 0; rep < PRODUP; ++rep) { PH_ENTER(); p0_prologue(P, C); __syncthreads(); } SEAM(0); }
#pragma unroll 1
    for (int L = 0; L < DEPTH; ++L) {
        const int pb = 1 + 8 * L; const int salt_ = pb;
        if (INL(0)) {
            for (int rep = 0; rep < NREP(0); ++rep) { PH_ENTER();
            pg8::Gemm g{(const bf16*)(ws + WS_XB0), (const bf16*)(ws + WS_WIN) + (size_t)L * NZ * DM, MT, NZ, DM}; InProjOrder S; S.init(C.nblk, C.blk);
            EpiZ E{ws, P->out, L == 0 ? (const float*)(ws + WS_ROWSS0) : (const float*)(ws + WS_CTL) + CW_ROWSS1, P->in[I_QG] + L * 64, P->in[I_KG] + L * 64, L, lds + XPOSE_OFF};
            pg8::gemm_phase<EpiZ, InProjOrder, true, true>(lds, g, S, E, C.tid); }
            for (int rm = 0; rm < (MINI2 ? 2 : 1); ++rm) { PH_ENTER(); mini_inproj_gates(P, C, L); }
            SEAM(pb + 0); }
        if (INL(1)) { for (int rep = 0; rep < NREP(1); ++rep) { PH_ENTER(); (void)P; (void)C; }   }
        if (INL(2)) { for (int rep = 0; rep < NREP(2); ++rep) { PH_ENTER(); phase_c(P, C, L, rep == 0 ? 15 : CSEL); __syncthreads(); } SEAM(pb + 2); }
        if (INL(3)) { for (int rep = 0; rep < NREP(3); ++rep) { PH_ENTER(); phase_d(P, C, L, rep == 0 ? 3 : DUPMODE); __syncthreads(); } SEAM(pb + 3); }
        if (INL(4)) {   }
        if (INL(5)) {
            for (int rep = 0; rep < NREP(5); ++rep) {
            { PH_ENTER(); mini_oproj(P, C, L); }
            { PH_ENTER(); pg8::StaticOrder S; S.init(MP, DM, C.nblk, C.blk);
              pg8::Gemm g{(const bf16*)(ws + WS_OGR), (const bf16*)(ws + WS_WOR) + (size_t)L * DM * 512, MP, DM, 512}; EpiGate<0> E{(const bf16*)(ws + WS_Z), ZC_GR, (bf16*)(ws + WS_TMP), (bf16*)(ws + WS_MB)};
              pg8::gemm_phase<EpiGate<0>, pg8::StaticOrder, true, true>(lds, g, S, E, C.tid); }
            { PH_ENTER(); pg8::StaticOrder S; S.init(MP, DM, C.nblk, C.blk);
              pg8::Gemm g{(const bf16*)(ws + WS_OGA), (const bf16*)(ws + WS_WOA) + (size_t)L * DM * 512, MP, DM, 512}; EpiGate<1> E{(const bf16*)(ws + WS_Z), ZC_GA, (bf16*)(ws + WS_TMP), (bf16*)(ws + WS_MB)};
              pg8::gemm_phase<EpiGate<1>, pg8::StaticOrder, true, true>(lds, g, S, E, C.tid); } }
            SEAM(pb + 5); }
        if (INL(6)) {
            for (int rep = 0; rep < NREP(6); ++rep) {
            { PH_ENTER(); mini_wout(P, C, L); }
            { PH_ENTER(); pg8::StaticOrder S; S.init(MP, DM, C.nblk, C.blk);
            pg8::Gemm g{(const bf16*)(ws + WS_MB), (const bf16*)(ws + WS_WOUT) + (size_t)L * DM * DM, MP, DM, DM};
            EpiRes E{P->in[I_XP], P->in[I_XS], L == 0 ? (const bf16*)nullptr : (const bf16*)(ws + WS_XB0), (bf16*)(ws + WS_XB1)};
            pg8::gemm_phase<EpiRes, pg8::StaticOrder, true, true>(lds, g, S, E, C.tid); } }
            SEAM(pb + 6); }
        if (INL(7)) {
            for (int rep = 0; rep < NREP(7); ++rep) {
            { PH_ENTER(); mini_ple(P, C, L, rep == NREP(7) - 1); }
            { PH_ENTER(); pg8::StaticOrder S; S.init(MP, DM, C.nblk, C.blk);
              pg8::Gemm g{(const bf16*)(ws + WS_XB1), (const bf16*)(ws + WS_WPG) + (size_t)L * DM * DM, MP, DM, DM}; EpiPle<0> E{(bf16*)(ws + WS_TMP), (const bf16*)(ws + WS_XB1), nullptr, (bf16*)(ws + WS_XB0), nullptr};
              pg8::gemm_phase<EpiPle<0>, pg8::StaticOrder, true, true>(lds, g, S, E, C.tid); }
            if (L + 1 < DEPTH) { PH_ENTER(); pg8::StaticOrder S; S.init(MP, DM, C.nblk, C.blk);
                pg8::Gemm g{(const bf16*)(ws + WS_PB) + (size_t)L * MT * 256, (const bf16*)(ws + WS_WPP) + (size_t)L * DM * 256, MP, DM, 256};
                EpiPle<1> E{(bf16*)(ws + WS_TMP), (const bf16*)(ws + WS_XB1), P->out, (bf16*)(ws + WS_XB0), (float*)(ws + WS_CTL) + CW_ROWSS1};
                pg8::gemm_phase<EpiPle<1>, pg8::StaticOrder, true, true>(lds, g, S, E, C.tid); }
            else { PH_ENTER(); pg8::StaticOrder S; S.init(MP, DM, C.nblk, C.blk);
                pg8::Gemm g{(const bf16*)(ws + WS_PB) + (size_t)L * MT * 256, (const bf16*)(ws + WS_WPP) + (size_t)L * DM * 256, MP, DM, 256};
                EpiPle<2> E{(bf16*)(ws + WS_TMP), (const bf16*)(ws + WS_XB1), P->out, (bf16*)(ws + WS_XB0), (float*)(ws + WS_CTL) + CW_ROWSS1};
                pg8::gemm_phase<EpiPle<2>, pg8::StaticOrder, true, true>(lds, g, S, E, C.tid); } }
            SEAM(pb + 7); }
    }
#undef IN
#undef INL
#undef SEAM
#undef PH_ENTER
}

#ifndef MK_N_LAUNCHES
#define MK_N_LAUNCHES 1
#endif
extern "C" void kernel_launch(void* const* d_in, const int* in_sizes, int n_in, void* d_out, int out_size, void* d_ws, size_t ws_size, hipStream_t stream) {
    static int grid = 0;
    if (grid == 0) {
        if (n_in != 18 || out_size != (int)O_END || ws_size < WS_END) { fprintf(stderr, "kernel_launch: unexpected problem: n_in %d out %d ws %zu; nothing launched\n", n_in, out_size, ws_size); grid = -1; return; }
        int dev = 0, cus = 0, per_cu = 0;
        if (hipGetDevice(&dev) != hipSuccess || hipDeviceGetAttribute(&cus, hipDeviceAttributeMultiprocessorCount, dev) != hipSuccess) { grid = -1; return; }
        if (hipFuncSetAttribute((const void*)mk_fwd, hipFuncAttributeMaxDynamicSharedMemorySize, LDS_BYTES) != hipSuccess) { fprintf(stderr, "kernel_launch: hipFuncSetAttribute failed\n"); grid = -1; return; }
        if (hipOccupancyMaxActiveBlocksPerMultiprocessor(&per_cu, (const void*)mk_fwd, NTHREADS, LDS_BYTES) != hipSuccess || per_cu < 1) { fprintf(stderr, "kernel_launch: occupancy query says %d blocks per CU\n", per_cu); grid = -1; (void)hipGetLastError(); return; }
        grid = cus;
    }
    if (grid < 0) return;
    (void)hipMemsetAsync((char*)d_ws + WS_CTL, 0, CTL_ZERO_BYTES, stream);
    Params a{};
    for (int i = 0; i < 18; ++i) a.in[i] = (const float*)d_in[i];
    a.out = (float*)d_out; a.ws = (unsigned char*)d_ws;
#if MK_N_LAUNCHES == 1
    a.ph_lo = 0; a.ph_hi = N_PHASES; a.li = 0;
    hipLaunchKernelGGL(mk_fwd, dim3(grid), dim3(NTHREADS), LDS_BYTES, stream, a);
#else
    for (int li = 0; li < N_PHASES; ++li) { a.ph_lo = li; a.ph_hi = li + 1; a.li = 0; hipLaunchKernelGGL(mk_fwd, dim3(grid), dim3(NTHREADS), LDS_BYTES, stream, a); }
#endif
    (void)in_sizes;
}
```

```cpp
#include <hip/hip_runtime.h>
#include <cstdio>
#include <cstdint>
namespace pg8 {
#define PG8_LAS __attribute__((address_space(3)))
typedef unsigned short bf16_t;
typedef short bf16x8 __attribute__((ext_vector_type(8)));
typedef float f32x4 __attribute__((ext_vector_type(4)));
typedef unsigned u32x4 __attribute__((ext_vector_type(4)));
constexpr int BM = 256, BK = 64, HALF = 128, HTB = HALF * BK * 2  , STAGE_BYTES = 8 * HTB, NXCD = 8, WGM = 8;

__host__ __device__ __forceinline__ int lds_byte(int r, int c) { const int st = (r >> 4) * 2 + (c >> 5), rr = r & 15, cc = c & 31, ob = rr * 64 + cc * 2; return st * 1024 + (ob ^ (((ob >> 9) & 1) << 5)); }
__host__ __device__ __forceinline__ void stage_rc(int b, int& R, int& C) { const int st = b / 1024, sb = b % 1024, swz = sb ^ (((sb >> 9) & 1) << 5); R = (st >> 1) * 16 + swz / 64; C = (st & 1) * 32 + (swz % 64) / 2; }
__host__ __device__ __forceinline__ int perm32(int rho) { const int n = rho >> 4, i = rho & 15; return 8 * (i >> 2) + 4 * n + (i & 3); }

struct Unit { int pm, pn; };
struct Gemm { const bf16_t* A; const bf16_t* Bt; int M, N, K; };

struct StaticOrder {
    int nM, nN, nwg, G, c;
    __host__ __device__ void init(int M, int N, int G_, int c_) { nM = M / BM; nN = N / BM; nwg = nM * nN; G = G_; c = c_; }
    __host__ __device__ bool next(int i, Unit& u) const {
        const int L = i * G + c; if (L >= nwg) return false;
        int wgid = L; { const int q = nwg / NXCD, r = nwg % NXCD, xcd = wgid % NXCD, off = wgid / NXCD; wgid = (xcd < r ? xcd * (q + 1) : r * (q + 1) + (xcd - r) * q) + off; }
        const int nig = WGM * nN, gid = wgid / nig, fm = gid * WGM, gsz = (nM - fm) < WGM ? (nM - fm) : WGM;
        u.pm = fm + ((wgid % nig) % gsz); u.pn = (wgid % nig) / gsz; return true;
    }
    __device__ __forceinline__ void a_ready(const Unit&) const {}
    __device__ __forceinline__ void done(const Unit&) const {}
};
__device__ __forceinline__ unsigned cvt_pk_bf16(float lo, float hi) { unsigned r; asm volatile("v_cvt_pk_bf16_f32 %0, %1, %2" : "=v"(r) : "v"(lo), "v"(hi)); return r; }

template <class Epi, class Sched, bool ALIGN_EPI = false, bool SP2 = false>
__device__ __forceinline__ void gemm_phase(PG8_LAS unsigned char* lds, const Gemm g, const Sched& S, const Epi& E, int tid_) {
    asm volatile("" : "+v"(tid_)); const int tid = tid_, wid = __builtin_amdgcn_readfirstlane(tid >> 6), lane = tid & 63, wr = wid >> 2, wc = wid & 3, fr = lane & 15, fq = lane >> 4;
    const int K = g.K, nt = K / BK;
    unsigned voffA[2], voffB[2];
#pragma unroll
    for (int i = 0; i < 2; ++i) { int R, C; stage_rc(tid * 16 + i * 8192, R, C); const int Rb = Epi::PERM ? ((R & ~31) + perm32(R & 31)) : R;
        voffA[i] = (unsigned)(R * K + C) * 2u; voffB[i] = (unsigned)(Rb * K + C) * 2u; }
    const size_t kstep = (size_t)(BK * 2);
    const size_t hstep = (size_t)HALF * K * 2;
    const size_t tstep = 2 * hstep;
    const unsigned ldsw = (unsigned)wid * 1024u;
    const int aoff = lds_byte(wr * 64 + fr, fq * 8), boff = lds_byte(wc * 32 + fr, fq * 8);
#define PG8_SA(b, h) (((b) * 2 + (h)) * HTB)
#define PG8_SB(b, h) ((4 + (b) * 2 + (h)) * HTB)
#define PG8_STAGE(bufoff, gbase, voff) do { _Pragma("unroll") for (int _i = 0; _i < 2; ++_i) \
        __builtin_amdgcn_global_load_lds((const unsigned*)((const char*)(gbase) + (voff)[_i]), (PG8_LAS unsigned*)(lds + (bufoff) + ldsw + _i * 8192), 16, 0, 0); } while (0)
#define PG8_LDA(dst, b, h) do { _Pragma("unroll") for (int m = 0; m < 4; ++m) _Pragma("unroll") for (int k = 0; k < 2; ++k) dst[m][k] = *(const PG8_LAS bf16x8*)(lds + PG8_SA(b, h) + aoff + m * 2048 + k * 1024); } while (0)
#define PG8_LDB(dst, b, h) do { _Pragma("unroll") for (int n = 0; n < 2; ++n) _Pragma("unroll") for (int k = 0; k < 2; ++k) dst[n][k] = *(const PG8_LAS bf16x8*)(lds + PG8_SB(b, h) + boff + n * 2048 + k * 1024); } while (0)
#define PG8_MMA(ai, bj, At, Bt) do { __builtin_amdgcn_s_setprio(1); _Pragma("unroll") for (int m = 0; m < 4; ++m) _Pragma("unroll") for (int n = 0; n < 2; ++n) _Pragma("unroll") for (int k = 0; k < 2; ++k) \
        acc[ai][bj][m][n] = __builtin_amdgcn_mfma_f32_16x16x32_bf16(Bt[n][k], At[m][k], acc[ai][bj][m][n], 0, 0, 0); __builtin_amdgcn_s_setprio(0); } while (0)
#define PG8_WAIT_V(n) asm volatile("s_waitcnt vmcnt(" #n ")" ::: "memory")
#define PG8_WAIT_L(n) asm volatile("s_waitcnt lgkmcnt(" #n ")" ::: "memory")
#define PG8_BAR __builtin_amdgcn_s_barrier()
#define PG8_SCHED __builtin_amdgcn_sched_barrier(0)
    Unit cur, nxt; int ui = 0;
    if (!S.next(0, cur)) return;
    f32x4 acc[2][2][4][2];
#pragma unroll
    for (int a = 0; a < 2; ++a)
#pragma unroll
        for (int b = 0; b < 2; ++b)
#pragma unroll
            for (int m = 0; m < 4; ++m)
#pragma unroll
                for (int n = 0; n < 2; ++n) acc[a][b][m][n] = (f32x4){0.f, 0.f, 0.f, 0.f};
    bf16x8 At[4][2], B0[2][2], B1[2][2];
    const char* cA = (const char*)g.A + (size_t)cur.pm * tstep; const char* cB = (const char*)g.Bt + (size_t)cur.pn * tstep;
    S.a_ready(cur);
    if constexpr (SP2) {
        PG8_STAGE(PG8_SB(0, 0), cB, voffB); PG8_STAGE(PG8_SB(0, 1), cB + hstep, voffB); PG8_STAGE(PG8_SA(0, 0), cA, voffA); PG8_STAGE(PG8_SA(0, 1), cA + hstep, voffA);
        if (wr == 1) PG8_BAR;
        PG8_WAIT_V(2); PG8_BAR;
        PG8_STAGE(PG8_SB(1, 0), cB + kstep, voffB); PG8_STAGE(PG8_SA(1, 0), cA + kstep, voffA); PG8_STAGE(PG8_SB(1, 1), cB + hstep + kstep, voffB);
        PG8_WAIT_V(6); PG8_BAR;
    } else {
        PG8_STAGE(PG8_SB(0, 0), cB, voffB); PG8_STAGE(PG8_SA(0, 0), cA, voffA); PG8_STAGE(PG8_SB(0, 1), cB + hstep, voffB); PG8_STAGE(PG8_SA(0, 1), cA + hstep, voffA);
        if (wr == 1) PG8_BAR;
        PG8_WAIT_V(4); PG8_BAR;
        PG8_STAGE(PG8_SB(1, 0), cB + kstep, voffB); PG8_STAGE(PG8_SA(1, 0), cA + kstep, voffA); PG8_STAGE(PG8_SB(1, 1), cB + hstep + kstep, voffB);
        PG8_WAIT_V(6); PG8_BAR;
    }
    for (;;) {
        const bool has_next = S.next(ui + 1, nxt);
        const char* nA = has_next ? (const char*)g.A + (size_t)nxt.pm * tstep : cA; const char* nB = has_next ? (const char*)g.Bt + (size_t)nxt.pn * tstep : cB;
        for (int t = 0; t < nt; t += 2) {
            const bool last = (t == nt - 2);
            const char* a1 = cA + (size_t)(t + 1) * kstep;
            const char* a2 = last ? nA : cA + (size_t)(t + 2) * kstep; const char* b2 = last ? nB : cB + (size_t)(t + 2) * kstep;
            const char* a3 = a2 + kstep; const char* b3 = b2 + kstep;
            if (last && has_next) S.a_ready(nxt);
            if constexpr (SP2) {
            PG8_LDB(B0, 0, 0); PG8_LDB(B1, 0, 1); PG8_SCHED; PG8_LDA(At, 0, 0); PG8_STAGE(PG8_SA(1, 1), a1 + hstep, voffA);
            PG8_WAIT_V(8); PG8_WAIT_L(0); PG8_BAR; PG8_MMA(0, 0, At, B0); PG8_MMA(0, 1, At, B1); PG8_BAR; PG8_SCHED;
            PG8_LDA(At, 0, 1); PG8_STAGE(PG8_SB(0, 0), b2, voffB); PG8_STAGE(PG8_SB(0, 1), b2 + hstep, voffB); PG8_STAGE(PG8_SA(0, 0), a2, voffA);
            PG8_WAIT_V(8); PG8_WAIT_L(0); PG8_BAR; PG8_MMA(1, 0, At, B0); PG8_MMA(1, 1, At, B1); PG8_BAR; PG8_SCHED;
            PG8_LDB(B0, 1, 0); PG8_LDB(B1, 1, 1); PG8_SCHED; PG8_LDA(At, 1, 0); PG8_STAGE(PG8_SA(0, 1), a2 + hstep, voffA);
            PG8_WAIT_V(8); PG8_WAIT_L(0); PG8_BAR; PG8_MMA(0, 0, At, B0); PG8_MMA(0, 1, At, B1); PG8_BAR; PG8_SCHED;
            PG8_LDA(At, 1, 1); PG8_STAGE(PG8_SB(1, 0), b3, voffB); PG8_STAGE(PG8_SB(1, 1), b3 + hstep, voffB); PG8_STAGE(PG8_SA(1, 0), a3, voffA);
            PG8_WAIT_V(8); PG8_WAIT_L(0); PG8_BAR; PG8_MMA(1, 0, At, B0); PG8_MMA(1, 1, At, B1); PG8_BAR; PG8_SCHED;
            } else {
            PG8_LDB(B0, 0, 0); PG8_SCHED; PG8_LDA(At, 0, 0); PG8_STAGE(PG8_SA(1, 1), a1 + hstep, voffA);
            PG8_WAIT_L(8); PG8_BAR; PG8_WAIT_L(0); PG8_MMA(0, 0, At, B0); PG8_BAR; PG8_SCHED;
            PG8_LDB(B1, 0, 1); PG8_STAGE(PG8_SB(0, 0), b2, voffB);
            PG8_BAR; PG8_WAIT_L(0); PG8_MMA(0, 1, At, B1); PG8_BAR;
            PG8_LDA(At, 0, 1); PG8_STAGE(PG8_SA(0, 0), a2, voffA);
            PG8_BAR; PG8_WAIT_L(0); PG8_MMA(1, 0, At, B0); PG8_BAR; PG8_SCHED;
            PG8_STAGE(PG8_SB(0, 1), b2 + hstep, voffB);
            PG8_WAIT_V(6); PG8_BAR; PG8_MMA(1, 1, At, B1); PG8_BAR;
            PG8_LDB(B0, 1, 0); PG8_SCHED; PG8_LDA(At, 1, 0); PG8_STAGE(PG8_SA(0, 1), a2 + hstep, voffA);
            PG8_WAIT_L(8); PG8_BAR; PG8_WAIT_L(0); PG8_MMA(0, 0, At, B0); PG8_BAR; PG8_SCHED;
            PG8_LDB(B1, 1, 1); PG8_STAGE(PG8_SB(1, 0), b3, voffB);
            PG8_BAR; PG8_WAIT_L(0); PG8_MMA(0, 1, At, B1); PG8_BAR;
            PG8_LDA(At, 1, 1); PG8_STAGE(PG8_SA(1, 0), a3, voffA);
            PG8_BAR; PG8_WAIT_L(0); PG8_MMA(1, 0, At, B0); PG8_BAR; PG8_SCHED;
            PG8_STAGE(PG8_SB(1, 1), b3 + hstep, voffB);
            PG8_WAIT_V(6); PG8_BAR; PG8_MMA(1, 1, At, B1); PG8_BAR;
            }
        }
        if constexpr (ALIGN_EPI) { if (wr == 0) PG8_BAR; }
        if constexpr (!Epi::AFTER_DRAIN) { E(acc, cur, wr, wc, fr, fq); S.done(cur); }
        if (!has_next) break;
#pragma unroll
        for (int a = 0; a < 2; ++a)
#pragma unroll
            for (int b = 0; b < 2; ++b)
#pragma unroll
                for (int m = 0; m < 4; ++m)
#pragma unroll
                    for (int n = 0; n < 2; ++n) acc[a][b][m][n] = (f32x4){0.f, 0.f, 0.f, 0.f};
        cur = nxt; cA = nA; cB = nB; ++ui;
        if constexpr (ALIGN_EPI) { if (wr == 1) PG8_BAR; }
    }
    PG8_WAIT_V(0);
    if constexpr (!ALIGN_EPI) { if (wr == 0) PG8_BAR; }
    PG8_BAR;
    if constexpr (Epi::AFTER_DRAIN) { E.fused(acc, cur, wr, wc, fr, fq, lds, wid, lane); S.done(cur); }
#undef PG8_SA
#undef PG8_SB
#undef PG8_STAGE
#undef PG8_LDA
#undef PG8_LDB
#undef PG8_MMA
#undef PG8_WAIT_V
#undef PG8_WAIT_L
#undef PG8_BAR
#undef PG8_SCHED
}
}

#define GAS __attribute__((address_space(1)))
#define LAS __attribute__((address_space(3)))
typedef unsigned short bf16;
typedef float f32x4 __attribute__((ext_vector_type(4)));
typedef float f32x2 __attribute__((ext_vector_type(2)));
typedef float f32x16 __attribute__((ext_vector_type(16)));
typedef short bf16x8 __attribute__((ext_vector_type(8)));
typedef unsigned u32x4 __attribute__((ext_vector_type(4)));
typedef unsigned u32x2 __attribute__((ext_vector_type(2)));

constexpr int NWAVES = 8, NTHREADS = 512;
constexpr int DM = 1024, NB = 4, SEQ = 4096, DEPTH = 2, DB = 128, DS = 8, PAST = 2048, NPAGES = 16, NPOOL = 2560;
constexpr int MP = NB * SEQ, MS = DB * DS, MT = MP + MS;
constexpr int NZ = 5888;
constexpr int WIN_N = 5700;
constexpr int ZC_RQ = 0, ZC_RK = 512, ZC_RV = 1024, ZC_RZ = 1536, ZC_AQ = 2048, ZC_AK = 2560, ZC_AV = 2688, ZC_AZ = 2816, ZC_IQ = 3328, ZC_IK = 3584, ZC_IW = 3648, ZC_GR = 3712, ZC_GA = 4736;
constexpr int SS_LD = 2064;
constexpr int TOPK = 256;
constexpr size_t O_Y = 0, O_KP = 17825792, O_VP = 22020096, O_IKP = 26214400, O_RSP = 28311552, O_KS = 28835840, O_VS = 29097984, O_IKS = 29360128, O_RSS = 29491200, O_END = 46268416;
constexpr size_t MiB = 1u << 20;
constexpr size_t WS_CTL = 0, CTL_ZERO_BYTES = 1 * MiB;
constexpr size_t WS_WIN = 1 * MiB, WS_WOR = 24 * MiB, WS_WOA = 26 * MiB, WS_WOUT = 28 * MiB, WS_WPG = 32 * MiB, WS_WPP = 36 * MiB;
constexpr size_t WS_ROPER = 37 * MiB, WS_ROPEA = 39 * MiB, WS_ROWSS0 = 39 * MiB + 256 * 1024, WS_IW = 39 * MiB + 512 * 1024;
constexpr size_t WS_XB0 = 40 * MiB, WS_XB1 = 74 * MiB, WS_X1 = 108 * MiB, WS_TMP = 176 * MiB, WS_MB = 244 * MiB, WS_Z = 278 * MiB;
constexpr size_t WS_RQ = 474 * MiB, WS_RK = 490 * MiB, WS_RKT = 506 * MiB, WS_RVT = 522 * MiB, WS_AQ = 538 * MiB, WS_KB = 555 * MiB, WS_VB = 559 * MiB;
constexpr size_t WS_IQ = 563 * MiB, WS_IKB = 572 * MiB, WS_PB = 930 * MiB, WS_KVT = 583 * MiB, WS_ST = 615 * MiB, WS_OGR = 631 * MiB, WS_OGA = 648 * MiB;
constexpr size_t WS_SS = 665 * MiB, WS_SP = 674 * MiB, WS_END = 948 * MiB;
static_assert(WS_Z + (size_t)MT * NZ * 2 <= WS_RQ && WS_SS + (size_t)MS * SS_LD * 4 <= WS_SP && WS_IW + (size_t)MT * 16 <= WS_XB0, "ws map");
constexpr int CW_TMO = 0, CW_BAR = 4096, CW_ROWSS1 = 131072;
constexpr int N_PHASES = 1 + 8 * DEPTH;
constexpr int RING_BYTES = 131072, MISC_OFF = RING_BYTES + 320, XPOSE_OFF = RING_BYTES + 1024, LDS_BYTES = XPOSE_OFF + 8 * 2048;

#define LDS_WAIT() asm volatile("s_waitcnt lgkmcnt(0)" ::: "memory")
#define VM_WAIT() asm volatile("s_waitcnt vmcnt(0)" ::: "memory")
__device__ __forceinline__ unsigned pk2(float lo, float hi) { unsigned r; asm("v_cvt_pk_bf16_f32 %0, %1, %2" : "=v"(r) : "v"(lo), "v"(hi)); return r; }
__device__ __forceinline__ float bflo(unsigned w) { return __uint_as_float(w << 16); }
__device__ __forceinline__ float bfhi(unsigned w) { return __uint_as_float(w & 0xffff0000u); }
__device__ __forceinline__ float bf2f(bf16 b) { return __uint_as_float(((unsigned)b) << 16); }
__device__ __forceinline__ float sigmoidf_(float x) { return __builtin_amdgcn_rcpf(1.0f + __builtin_amdgcn_exp2f(x * -1.4426950408889634f)); }
__device__ __forceinline__ float siluf_(float x) { return x * sigmoidf_(x); }
__device__ __forceinline__ void unpack8(const u32x4 w, float (&f)[8]) { f[0] = bflo(w.x); f[1] = bfhi(w.x); f[2] = bflo(w.y); f[3] = bfhi(w.y); f[4] = bflo(w.z); f[5] = bfhi(w.z); f[6] = bflo(w.w); f[7] = bfhi(w.w); }
__device__ __forceinline__ u32x4 pack8(const float (&f)[8]) { u32x4 w; w.x = pk2(f[0], f[1]); w.y = pk2(f[2], f[3]); w.z = pk2(f[4], f[5]); w.w = pk2(f[6], f[7]); return w; }
__device__ __forceinline__ bf16x8 as_bf16x8(const u32x4 w) { return __builtin_bit_cast(bf16x8, w); }
__device__ __forceinline__ f32x4 mfma16(bf16x8 a, bf16x8 b, f32x4 c) { return __builtin_amdgcn_mfma_f32_16x16x32_bf16(a, b, c, 0, 0, 0); }
__device__ __forceinline__ f32x16 mfma32(bf16x8 a, bf16x8 b, f32x16 c) { return __builtin_amdgcn_mfma_f32_32x32x16_bf16(a, b, c, 0, 0, 0); }
__device__ __forceinline__ float ret_log2g(int h) { return h == 0 ? -0.04580369f : h == 1 ? -0.022720076f : h == 2 ? -0.011315313f : -0.0056465627f; }
__device__ __forceinline__ int mbcnt64(unsigned long long m) { return (int)__builtin_amdgcn_mbcnt_hi((unsigned)(m >> 32), __builtin_amdgcn_mbcnt_lo((unsigned)m, 0u)); }

template <int M> __device__ __forceinline__ float shx(float v, int lane) {
    if constexpr (M < 32) return __int_as_float(__builtin_amdgcn_ds_swizzle(__float_as_int(v), 0x1F | (M << 10)));
    else return __int_as_float(__builtin_amdgcn_ds_bpermute((lane ^ 32) << 2, __float_as_int(v)));
}
__device__ __forceinline__ float wave_sum(float v, int lane) { v += shx<1>(v, lane); v += shx<2>(v, lane); v += shx<4>(v, lane); v += shx<8>(v, lane); v += shx<16>(v, lane); v += shx<32>(v, lane); return v; }

#define XB_TMO      128
#define XB_XCNT(j)  (256  + 64 * (j))
#define XB_XSUB(j)  (1280 + 64 * (j))
#define XB_XGEN(j)  (2304 + 64 * (j))
#define XB_TOP      3328
#define XB_TOPGEN   3392
#define XCD_BAR_WORDS 3456
#define XB_SPIN_CAP (1u << 18)
__device__ __forceinline__ unsigned xb_ld(unsigned* p)              { return __hip_atomic_load(p, __ATOMIC_RELAXED, __HIP_MEMORY_SCOPE_AGENT); }
__device__ __forceinline__ unsigned xb_add(unsigned* p, unsigned v) { return __hip_atomic_fetch_add(p, v, __ATOMIC_RELAXED, __HIP_MEMORY_SCOPE_AGENT); }
__device__ __forceinline__ unsigned xb_xcc_id() { return (unsigned)__builtin_amdgcn_s_getreg((3 << 11) | 20) & 0xFu; }
#define XB_SPIN(cond, bar) do { unsigned _sp = 0; while (cond) { __builtin_amdgcn_s_sleep(1); \
    if ((++_sp & 255u) == 0u) { if (xb_ld(&(bar)[XB_TMO])) break; if (_sp > XB_SPIN_CAP) { atomicAdd(&(bar)[XB_TMO], 1u); break; } } } } while (0)
struct XcdBarrier { unsigned* bar; unsigned x; volatile LAS unsigned* st; };
__device__ __forceinline__ XcdBarrier xcd_barrier_post(unsigned* bar, volatile LAS unsigned* st, bool leader) {
    XcdBarrier b; b.bar = bar; b.x = xb_xcc_id(); b.st = st;
    if (leader) (void)xb_add(&bar[XB_XCNT(b.x)], 1u);
    return b;
}
__device__ __forceinline__ void xcd_barrier_complete(unsigned* bar, unsigned x, unsigned& nloc, unsigned& nx) {
    const unsigned G = gridDim.x * gridDim.y * gridDim.z;
    unsigned sum, cnt, mine, sp = 0u;
    for (;;) {
        sum = 0u; cnt = 0u; mine = 0u;
#pragma unroll
        for (unsigned j = 0; j < 16; ++j) { const unsigned c = xb_ld(&bar[XB_XCNT(j)]); sum += c; cnt += (c > 0u) ? 1u : 0u; mine = (j == x) ? c : mine; }
        if (sum == G) break;
        __builtin_amdgcn_s_sleep(1);
        if ((++sp & 255u) == 0u) { if (xb_ld(&bar[XB_TMO])) break; if (sp > XB_SPIN_CAP) { atomicAdd(&bar[XB_TMO], 1u); break; } }
    }
    nloc = mine > 0u ? mine : 1u; nx = cnt > 0u ? cnt : 1u;
}
__device__ __forceinline__ void xcd_barrier(const XcdBarrier& b, bool leader) {
    asm volatile("s_waitcnt vmcnt(0)" ::: "memory");
    __syncthreads();
    if (leader) {
        unsigned* bar = b.bar;
        __builtin_amdgcn_s_waitcnt(0);
        unsigned nloc = b.st[0], nx = b.st[1];
        if (nloc == 0u) { xcd_barrier_complete(bar, b.x, nloc, nx); b.st[0] = nloc; b.st[1] = nx; }
        const unsigned old = xb_add(&bar[XB_XSUB(b.x)], 1u);
        const unsigned gen = old / nloc;
        if (old + 1u == (gen + 1u) * nloc) {
            __builtin_amdgcn_fence(__ATOMIC_RELEASE, "agent");
            asm volatile("s_waitcnt vmcnt(0)" ::: "memory");
            const unsigned og = xb_add(&bar[XB_TOP], 1u);
            const unsigned tg = og / nx;
            if (og + 1u == (tg + 1u) * nx) xb_add(&bar[XB_TOPGEN], 1u);
            else XB_SPIN(xb_ld(&bar[XB_TOPGEN]) == tg, bar);
            __builtin_amdgcn_fence(__ATOMIC_ACQUIRE, "agent");
            xb_add(&bar[XB_XGEN(b.x)], 1u);
            asm volatile("s_waitcnt vmcnt(0)" ::: "memory");
        } else {
            XB_SPIN(xb_ld(&bar[XB_XGEN(b.x)]) == gen, bar);
            __builtin_amdgcn_fence(__ATOMIC_ACQUIRE, "agent");
            asm volatile("s_waitcnt vmcnt(0)" ::: "memory");
        }
    }
    __syncthreads();
}

struct Params { const float* in[18]; float* out; unsigned char* ws; int ph_lo, ph_hi, li, pad; };
enum { I_XP = 0, I_XS, I_CK, I_CV, I_CIK, I_STATE, I_PT, I_PP, I_PS, I_GAIN, I_WIN, I_QG, I_KG, I_WOR, I_WOA, I_WOUT, I_WPG, I_WPP };
struct Ctx { int tid, lane, wave, gw, ngw, nblk, blk; LAS unsigned char* lds; };
typedef const __attribute__((address_space(4))) Params* PK;
__device__ __forceinline__ PK phase_args() { PK p = (PK)__builtin_amdgcn_kernarg_segment_ptr(); asm volatile("" : "+s"(p)); return p; }
__device__ __forceinline__ int hw_lane(int salt = 0) { int l; asm volatile("v_mbcnt_lo_u32_b32 %0, -1, 0 ; %1\n\tv_mbcnt_hi_u32_b32 %0, -1, %0" : "=v"(l) : "s"(salt)); return l; }
__device__ __forceinline__ Ctx phase_ctx(LAS unsigned char* lds, int wave_s, int salt) { Ctx C; int tid = wave_s * 64 + hw_lane(salt); asm volatile("" : "+v"(tid)); C.lds = lds; C.tid = tid; C.lane = tid & 63; C.wave = __builtin_amdgcn_readfirstlane(tid >> 6);
    int bx = blockIdx.x; asm volatile("" : "+s"(bx)); C.nblk = gridDim.x; C.blk = bx; C.gw = C.blk * NWAVES + C.wave; C.ngw = C.nblk * NWAVES; return C; }

__device__ __forceinline__ int win_orig_col(int np) {
    const int pn = np >> 8, c = np & 255, bj = c >> 7, cc = c & 127, wc = cc >> 5, l8 = cc & 31;
    if (pn < 4) { const int head = 2 * (pn & 1) + bj, dim = (cc >> 1) + 64 * (cc & 1); return (pn < 2 ? 0 : 512) + head * 128 + dim; }
    if (pn < 8) return np;
    if (pn == 11 || pn == 12) return np;
    if (pn <= 10 || pn == 13) { const int dimp = 32 * bj + l8; const bool rope = !(pn == 10 && wc >= 2);
        const int dim = (rope && dimp < 16) ? (dimp >> 1) + 8 * (dimp & 1) : dimp;
        if (pn < 10) return 2048 + (4 * (pn - 8) + wc) * 64 + dim;
        if (pn == 10) return 2560 + wc * 64 + dim;
        return 3328 + wc * 64 + dim; }
    if (np < 3584 + 64) { const int dimp = np - 3584; return 3584 + (dimp < 16 ? (dimp >> 1) + 8 * (dimp & 1) : dimp); }
    if (np < 3652) return np;
    if (np < ZC_GR) return -1;
    if (np < ZC_GR + 2048) return np - (ZC_GR - 3652);
    return -1;
}
struct EpiZ {
    static constexpr bool PERM = true, AFTER_DRAIN = false;
    unsigned char* ws; float* out; const float* rowss; const float* qgain; const float* kgain; int L; LAS unsigned char* xl;
    __device__ __forceinline__ void rope16(float (&x)[8], const f32x2* ropeA, int fq, int hl) const {
        float lo[4], hi[4];
#pragma unroll
        for (int k = 0; k < 4; ++k) { const f32x2 cs = ropeA[(fq & 1) * 4 + k]; lo[k] = x[2 * k] * cs[0] - x[2 * k + 1] * cs[1]; hi[k] = x[2 * k + 1] * cs[0] + x[2 * k] * cs[1]; }
        float rc[4];
#pragma unroll
        for (int k = 0; k < 4; ++k) rc[k] = shx<16>(fq == 0 ? hi[k] : lo[k], hl);
        if (fq == 0) {
#pragma unroll
            for (int k = 0; k < 4; ++k) { x[k] = lo[k]; x[4 + k] = rc[k]; } }
        else if (fq == 1) {
#pragma unroll
            for (int k = 0; k < 4; ++k) { x[k] = rc[k]; x[4 + k] = hi[k]; } }
    }
    __device__ __forceinline__ void operator()(const f32x4 (&acc)[2][2][4][2], const pg8::Unit& u, int wr, int wc, int, int) const {
        const int hl = hw_lane(), fr = hl & 15, fq = hl >> 4;
        const int pn = u.pn; const bool prompt = u.pm < MP / 256;
        const int row0 = u.pm * 256 + wr * 64 + fr;
        bf16* Z = (bf16*)(ws + WS_Z);
        if (prompt && pn >= 2 && pn < 6) {
            const bool isk = pn < 4; LAS unsigned char* xt = xl + (wr * 4 + wc) * 2048;
            const int b = (u.pm * 256) >> 12, tpan = (u.pm * 256) & (SEQ - 1);
#pragma unroll
            for (int ai = 0; ai < 2; ++ai)
#pragma unroll
                for (int bj = 0; bj < 2; ++bj) { const int head = 2 * (pn & 1) + bj;
#pragma unroll
                    for (int mp = 0; mp < 2; ++mp) {
#pragma unroll
                        for (int mm = 0; mm < 2; ++mm) { const int m = 2 * mp + mm; const int row = row0 + ai * 128 + m * 16, t = row & (SEQ - 1);
                            const float rs = __builtin_amdgcn_rsqf(rowss[row] * (1.0f / 1024.0f) + 1e-6f);
                            float x[8];
#pragma unroll
                            for (int j = 0; j < 4; ++j) { x[j] = acc[ai][bj][m][0][j] * rs; x[4 + j] = acc[ai][bj][m][1][j] * rs; }
                            const int t32 = 16 * mm + fr;
                            if (isk) { const int p0 = 16 * wc + 4 * fq; const f32x2* rr = (const f32x2*)(ws + WS_ROPER) + (size_t)t * 64 + p0; float lo[4], hi[4];
#pragma unroll
                                for (int k = 0; k < 4; ++k) { const f32x2 cs = rr[k]; lo[k] = (x[2 * k] * cs[0] - x[2 * k + 1] * cs[1]) * 0.08838834764831845f; hi[k] = (x[2 * k + 1] * cs[0] + x[2 * k] * cs[1]) * 0.08838834764831845f; }
                                bf16* q = (bf16*)(ws + WS_RK) + (size_t)row * 512 + head * 128 + p0;
                                u32x2 a, c; a.x = pk2(lo[0], lo[1]); a.y = pk2(lo[2], lo[3]); c.x = pk2(hi[0], hi[1]); c.y = pk2(hi[2], hi[3]); *(u32x2*)q = a; *(u32x2*)(q + 64) = c;
                                const float dk = __builtin_amdgcn_exp2f((float)(127 - (t & 127)) * ret_log2g(head));
#pragma unroll
                                for (int k = 0; k < 4; ++k) { *(LAS bf16*)(xt + (4 * fq + k) * 64 + 2 * t32) = (bf16)(pk2(lo[k] * dk, 0.f) & 0xffffu); *(LAS bf16*)(xt + (16 + 4 * fq + k) * 64 + 2 * t32) = (bf16)(pk2(hi[k] * dk, 0.f) & 0xffffu); }
                            } else {
#pragma unroll
                                for (int j = 0; j < 8; ++j) *(LAS bf16*)(xt + (8 * fq + j) * 64 + 2 * t32) = (bf16)(pk2(x[j], 0.f) & 0xffffu); } }
                        asm volatile("s_waitcnt lgkmcnt(0)" ::: "memory");
#pragma unroll
                        for (int i = 0; i < 2; ++i) { const int c = hl + 64 * i, dl = c >> 2, q4 = c & 3; const u32x4 v = *(const LAS u32x4*)(xt + dl * 64 + 16 * q4);
                            const int d = isk ? 16 * wc + (dl & 15) + 64 * (dl >> 4) : 32 * wc + dl;
                            bf16* dst = (bf16*)(ws + (isk ? WS_RKT : WS_RVT)) + ((size_t)(b * 4 + head) * 128 + d) * SEQ + tpan + 128 * ai + 64 * wr + 32 * mp + 8 * q4;
                            *(u32x4*)dst = v; }
                        asm volatile("s_waitcnt lgkmcnt(0)" ::: "memory"); } }
            return;
        }
#define EZ_X(bj_, xv_) float xv_[8]; _Pragma("unroll") for (int j_ = 0; j_ < 4; ++j_) { xv_[j_] = acc[ai][bj_][m][0][j_] * rs; xv_[4 + j_] = acc[ai][bj_][m][1][j_] * rs; }
#pragma unroll
        for (int ai = 0; ai < 2; ++ai)
#pragma unroll
            for (int m = 0; m < 4; ++m) {
                const int row = row0 + ai * 128 + m * 16; const float rs = __builtin_amdgcn_rsqf(rowss[row] * (1.0f / 1024.0f) + 1e-6f);
                const int pos = prompt ? (row & (SEQ - 1)) : PAST + ((row - MP) & 7);
                const unsigned zrow = (unsigned)row * NZ;
                if (pn < 4) {
                    const int p0 = 16 * wc + 4 * fq; const bool isk = pn >= 2;
                    if (!prompt) {
#pragma unroll
                        for (int bj = 0; bj < 2; ++bj) { EZ_X(bj, x) const int hc = (isk ? ZC_RK : ZC_RQ) + (2 * (pn & 1) + bj) * 128;
                            u32x2 a, b; a.x = pk2(x[0], x[2]); a.y = pk2(x[4], x[6]); b.x = pk2(x[1], x[3]); b.y = pk2(x[5], x[7]);
                            *(u32x2*)(Z + zrow + hc + p0) = a; *(u32x2*)(Z + zrow + hc + 64 + p0) = b; }
                    } else {
                        const f32x2* rr = (const f32x2*)(ws + WS_ROPER) + (size_t)pos * 64 + p0; const int b = row >> 12, t = row & (SEQ - 1);
                        f32x2 cs[4];
#pragma unroll
                        for (int k = 0; k < 4; ++k) cs[k] = rr[k];
#pragma unroll
                        for (int bj = 0; bj < 2; ++bj) { EZ_X(bj, x) const int head = 2 * (pn & 1) + bj; float lo[4], hi[4];
#pragma unroll
                            for (int k = 0; k < 4; ++k) { lo[k] = x[2 * k] * cs[k][0] - x[2 * k + 1] * cs[k][1]; hi[k] = x[2 * k + 1] * cs[k][0] + x[2 * k] * cs[k][1]; }
                            if (!isk) { bf16* q = (bf16*)(ws + WS_RQ) + (size_t)row * 512 + head * 128 + p0;
                                u32x2 a, c; a.x = pk2(lo[0], lo[1]); a.y = pk2(lo[2], lo[3]); c.x = pk2(hi[0], hi[1]); c.y = pk2(hi[2], hi[3]); *(u32x2*)q = a; *(u32x2*)(q + 64) = c; }
                            else { const float sc = 0.08838834764831845f;
#pragma unroll
                                for (int k = 0; k < 4; ++k) { lo[k] *= sc; hi[k] *= sc; }
                                bf16* q = (bf16*)(ws + WS_RK) + (size_t)row * 512 + head * 128 + p0;
                                u32x2 a, c; a.x = pk2(lo[0], lo[1]); a.y = pk2(lo[2], lo[3]); c.x = pk2(hi[0], hi[1]); c.y = pk2(hi[2], hi[3]); *(u32x2*)q = a; *(u32x2*)(q + 64) = c;
                                const float dk = __builtin_amdgcn_exp2f((float)(127 - (t & 127)) * ret_log2g(head));
                                bf16* kt = (bf16*)(ws + WS_RKT) + ((size_t)(b * 4 + head) * 128 + p0) * SEQ + t;
#pragma unroll
                                for (int k = 0; k < 4; ++k) { kt[(size_t)k * SEQ] = (bf16)(pk2(lo[k] * dk, 0.f) & 0xffffu); kt[(size_t)(64 + k) * SEQ] = (bf16)(pk2(hi[k] * dk, 0.f) & 0xffffu); } } }
                    }
                } else if (pn < 6 && prompt) {
                    const int b = row >> 12, t = row & (SEQ - 1);
#pragma unroll
                    for (int bj = 0; bj < 2; ++bj) { EZ_X(bj, x) bf16* vt = (bf16*)(ws + WS_RVT) + ((size_t)(b * 4 + 2 * (pn & 1) + bj) * 128 + 32 * wc + 8 * fq) * SEQ + t;
#pragma unroll
                        for (int j = 0; j < 8; ++j) vt[(size_t)j * SEQ] = (bf16)(pk2(x[j], 0.f) & 0xffffu); }
                } else if (pn == 8 || pn == 9 || pn == 10 || pn == 13) {
                    const bool norm = (pn < 10) || (pn == 10 && wc < 2), rope = norm || pn == 13;
                    EZ_X(0, x0) EZ_X(1, x1)
                    if (norm) { float ss = 0.f;
#pragma unroll
                        for (int j = 0; j < 8; ++j) ss += x0[j] * x0[j] + x1[j] * x1[j];
                        ss += shx<16>(ss, hl); ss += shx<32>(ss, hl);
                        const float rr = __builtin_amdgcn_rsqf(ss * (1.0f / 64.0f) + 1e-6f); const float* gn = (pn < 10) ? qgain : kgain;
#pragma unroll
                        for (int j = 0; j < 8; ++j) { const int d0 = (fq < 2) ? 4 * fq + (j >> 1) + 8 * (j & 1) : 8 * fq + j; x0[j] *= rr * gn[d0]; x1[j] *= rr * gn[32 + 8 * fq + j]; } }
                    if (rope) rope16(x0, (const f32x2*)(ws + WS_ROPEA) + (size_t)pos * 8, fq, hl);
                    if (pn < 10) { bf16* q = (bf16*)(ws + WS_AQ) + (size_t)row * 512 + (4 * (pn - 8) + wc) * 64 + 8 * fq; *(u32x4*)q = pack8(x0); *(u32x4*)(q + 32) = pack8(x1); }
                    else if (pn == 13) { bf16* q = (bf16*)(ws + WS_IQ) + (size_t)row * 256 + wc * 64 + 8 * fq; *(u32x4*)q = pack8(x0); *(u32x4*)(q + 32) = pack8(x1); }
                    else { const bool isk = wc < 2; const int hk = wc & 1;
                        float* dst = (isk ? (prompt ? out + O_KP + ((size_t)L * MP + row) * 128 : out + O_KS + ((size_t)L * MS + (row - MP)) * 128)
                                          : (prompt ? out + O_VP + ((size_t)L * MP + row) * 128 : out + O_VS + ((size_t)L * MS + (row - MP)) * 128)) + hk * 64 + 8 * fq;
                        *(f32x4*)dst = (f32x4){x0[0], x0[1], x0[2], x0[3]}; *(f32x4*)(dst + 4) = (f32x4){x0[4], x0[5], x0[6], x0[7]};
                        *(f32x4*)(dst + 32) = (f32x4){x1[0], x1[1], x1[2], x1[3]}; *(f32x4*)(dst + 36) = (f32x4){x1[4], x1[5], x1[6], x1[7]};
                        if (prompt) { bf16* d2 = (bf16*)(ws + (isk ? WS_KB : WS_VB)) + (size_t)row * 128 + hk * 64 + 8 * fq; *(u32x4*)d2 = pack8(x0); *(u32x4*)(d2 + 32) = pack8(x1); } }
                } else if (pn == 14) {
                    { EZ_X(0, x0)
                      if (wc == 0) rope16(x0, (const f32x2*)(ws + WS_ROPEA) + (size_t)pos * 8, fq, hl);
                      if (wc < 2) { float* dst = (prompt ? out + O_IKP + ((size_t)L * MP + row) * 64 : out + O_IKS + ((size_t)L * MS + (row - MP)) * 64) + 32 * wc + 8 * fq;
                          *(f32x4*)dst = (f32x4){x0[0], x0[1], x0[2], x0[3]}; *(f32x4*)(dst + 4) = (f32x4){x0[4], x0[5], x0[6], x0[7]};
                          if (prompt) *(u32x4*)((bf16*)(ws + WS_IKB) + (size_t)row * 64 + 32 * wc + 8 * fq) = pack8(x0); }
                      else if (wc == 2 && fq == 0) *(f32x4*)((float*)(ws + WS_IW) + (size_t)row * 4) = (f32x4){x0[0] * 0.0625f, x0[1] * 0.0625f, x0[2] * 0.0625f, x0[3] * 0.0625f}; }
                    { EZ_X(1, x1) *(u32x4*)(Z + zrow + pn * 256 + 128 + 32 * wc + 8 * fq) = pack8(x1); }
                } else {
#pragma unroll
                    for (int bj = 0; bj < 2; ++bj) { EZ_X(bj, x) *(u32x4*)(Z + zrow + pn * 256 + 128 * bj + 32 * wc + 8 * fq) = pack8(x); }
                }
                asm volatile("" ::: "memory"); }
#undef EZ_X
    }
};

struct InProjOrder {
    pg8::StaticOrder base; int G, c;
    __device__ void init(int G_, int c_) { base.init(MP, NZ, G_, c_); G = G_; c = c_; }
    __device__ bool next(int i, pg8::Unit& u) const {
        const int L = i * G + c; const int np = (MP / 256) * (NZ / 256);
        if (L < np) return base.next(i, u);
        const int l2 = L - np; if (l2 >= 4 * 15) return false;
        u.pm = MP / 256 + l2 / 15; u.pn = l2 % 15; return true;
    }
    __device__ __forceinline__ void a_ready(const pg8::Unit&) const {}
    __device__ __forceinline__ void done(const pg8::Unit&) const {}
};
template <int MODE> struct EpiGate {
    static constexpr bool PERM = true, AFTER_DRAIN = false;
    const bf16* Z; int gcol; bf16* TMP; bf16* MB;
    __device__ __forceinline__ void operator()(const f32x4 (&acc)[2][2][4][2], const pg8::Unit& u, int wr, int wc, int, int) const {
        const int hl_ = hw_lane(), fr = hl_ & 15, fq = hl_ >> 4;
        const int row0 = u.pm * 256 + wr * 64 + fr, col0 = u.pn * 256 + wc * 32 + 8 * fq;
#pragma unroll
        for (int ai = 0; ai < 2; ++ai)
#pragma unroll
            for (int m = 0; m < 4; ++m) { const int row = row0 + ai * 128 + m * 16;
#pragma unroll
                for (int bj = 0; bj < 2; ++bj) { const int col = col0 + bj * 128; const unsigned off = (unsigned)row * DM + (unsigned)col;
                    const u32x4 gw = *(const u32x4*)(Z + ((unsigned)row * NZ + (unsigned)(gcol + col))); float g[8]; unpack8(gw, g);
                    const f32x4 a0 = acc[ai][bj][m][0], a1 = acc[ai][bj][m][1];
                    float r[8];
#pragma unroll
                    for (int j = 0; j < 4; ++j) { r[j] = sigmoidf_(g[j]) * a0[j]; r[4 + j] = sigmoidf_(g[4 + j]) * a1[j]; }
                    if (MODE == 0) *(u32x4*)(TMP + off) = pack8(r);
                    else { float t[8]; unpack8(*(const u32x4*)(TMP + off), t);
#pragma unroll
                        for (int j = 0; j < 8; ++j) r[j] += t[j];
                        *(u32x4*)(MB + off) = pack8(r); } }
                asm volatile("" ::: "memory"); }
    }
};
struct EpiRes {
    static constexpr bool PERM = true, AFTER_DRAIN = false;
    const float* xa; const float* xb; const bf16* xh; bf16* XB1;
    __device__ __forceinline__ void operator()(const f32x4 (&acc)[2][2][4][2], const pg8::Unit& u, int wr, int wc, int, int) const {
        const int hl_ = hw_lane(), fr = hl_ & 15, fq = hl_ >> 4;
        const int row0 = u.pm * 256 + wr * 64 + fr, col0 = u.pn * 256 + wc * 32 + 8 * fq;
#pragma unroll
        for (int ai = 0; ai < 2; ++ai)
#pragma unroll
            for (int m = 0; m < 4; ++m) { const int row = row0 + ai * 128 + m * 16;
                const float* xr = (u.pm < MP / 256) ? xa : xb - (size_t)MP * DM;
#pragma unroll
                for (int bj = 0; bj < 2; ++bj) { const unsigned off = (unsigned)row * DM + (unsigned)(col0 + bj * 128);
                    float x[8];
                    if (xh != nullptr) unpack8(*(const u32x4*)(xh + off), x);
                    else { const f32x4 x0 = *(const f32x4*)(xr + off), x1 = *(const f32x4*)(xr + off + 4); x[0] = x0[0]; x[1] = x0[1]; x[2] = x0[2]; x[3] = x0[3]; x[4] = x1[0]; x[5] = x1[1]; x[6] = x1[2]; x[7] = x1[3]; }
                    const f32x4 a0 = acc[ai][bj][m][0], a1 = acc[ai][bj][m][1];
#pragma unroll
                    for (int j = 0; j < 4; ++j) { x[j] += a0[j]; x[4 + j] += a1[j]; }
                    *(u32x4*)(XB1 + off) = pack8(x); }
                asm volatile("" ::: "memory"); }
    }
};
template <int MODE> struct EpiPle {
    static constexpr bool PERM = true, AFTER_DRAIN = false;
    bf16* TMP; const bf16* XB1; float* Y; bf16* XB0; float* rowss;
    __device__ __forceinline__ void operator()(const f32x4 (&acc)[2][2][4][2], const pg8::Unit& u, int wr, int wc, int, int) const {
        const int hl_ = hw_lane(), fr = hl_ & 15, fq = hl_ >> 4;
        const int row0 = u.pm * 256 + wr * 64 + fr, col0 = u.pn * 256 + wc * 32 + 8 * fq;
#pragma unroll
        for (int ai = 0; ai < 2; ++ai)
#pragma unroll
            for (int m = 0; m < 4; ++m) { const int row = row0 + ai * 128 + m * 16; float ssq = 0.f;
#pragma unroll
                for (int bj = 0; bj < 2; ++bj) { const unsigned off = (unsigned)row * DM + (unsigned)(col0 + bj * 128);
                    const f32x4 a0 = acc[ai][bj][m][0], a1 = acc[ai][bj][m][1];
                    if (MODE == 0) { float r[8];
#pragma unroll
                        for (int j = 0; j < 4; ++j) { r[j] = sigmoidf_(a0[j]); r[4 + j] = sigmoidf_(a1[j]); }
                        *(u32x4*)(TMP + off) = pack8(r); }
                    else { float t[8], x[8]; unpack8(*(const u32x4*)(TMP + off), t); unpack8(*(const u32x4*)(XB1 + off), x);
#pragma unroll
                        for (int j = 0; j < 4; ++j) { x[j] += t[j] * a0[j]; x[4 + j] += t[4 + j] * a1[j]; }
                        if (MODE == 2) { *(f32x4*)(Y + off) = (f32x4){x[0], x[1], x[2], x[3]}; *(f32x4*)(Y + off + 4) = (f32x4){x[4], x[5], x[6], x[7]}; }
                        *(u32x4*)(XB0 + off) = pack8(x);
                        if (MODE == 1) {
#pragma unroll
                            for (int j = 0; j < 8; ++j) ssq += x[j] * x[j]; } }
                    asm volatile("" ::: "memory"); }
                if (MODE == 1) { const int ln_ = fr + 16 * fq; ssq += shx<16>(ssq, ln_); ssq += shx<32>(ssq, ln_); if (fq == 0) atomicAdd(rowss + row, ssq); }
                asm volatile("" ::: "memory"); }
    }
};
__device__ __forceinline__ void p0_transpose_item(const float* W, int ldw, int K, const float* gain, bf16* WT, int nblk, int item, bool win_map, LAS float* scr, int lane) {
    const int kb = item / nblk, nb = item % nblk, k0 = 64 * kb, n0 = 32 * nb;
    const int np = n0 + (lane & 31); int n = np; bool valid = true;
    if (win_map) { n = win_orig_col(np); valid = n >= 0; if (!valid) n = 0; }
#pragma unroll 8
    for (int i = 0; i < 32; ++i) { const int kk = 2 * i + (lane >> 5); float v = valid ? W[(size_t)(k0 + kk) * ldw + n] : 0.f; if (gain) v *= gain[k0 + kk]; scr[kk * 33 + (lane & 31)] = v; }
    LDS_WAIT(); asm volatile("" ::: "memory");
    const int c = lane & 7;
#pragma unroll
    for (int j = 0; j < 4; ++j) { const int nn = (lane >> 3) + 8 * j; const LAS float* s = scr + (8 * c) * 33 + nn;
        u32x4 o; o.x = pk2(s[0 * 33], s[1 * 33]); o.y = pk2(s[2 * 33], s[3 * 33]); o.z = pk2(s[4 * 33], s[5 * 33]); o.w = pk2(s[6 * 33], s[7 * 33]);
        *(u32x4*)(WT + (size_t)(n0 + nn) * K + k0 + 8 * c) = o; }
    LDS_WAIT(); asm volatile("" ::: "memory");
}
__device__ __forceinline__ void p0_prologue(PK P, const Ctx& C) {
    unsigned char* ws = P->ws;
    LAS float* scr = (LAS float*)(C.lds + C.wave * 16384);
    constexpr int I_IN = 16 * (NZ / 32), I_OR = 8 * 32, I_OUT = 16 * 32, I_PPJ = 4 * 32, I_LAYER = I_IN + 2 * I_OR + 2 * I_OUT + I_PPJ;
    for (int it = C.gw; it < DEPTH * I_LAYER; it += C.ngw) {
        const int L = it / I_LAYER; int r = it % I_LAYER;
        if (r < I_IN) { p0_transpose_item(P->in[I_WIN] + (size_t)L * DM * WIN_N, WIN_N, DM, P->in[I_GAIN] + L * DM, (bf16*)(ws + WS_WIN) + (size_t)L * NZ * DM, NZ / 32, r, true, scr, C.lane); continue; } r -= I_IN;
        if (r < I_OR) { p0_transpose_item(P->in[I_WOR] + (size_t)L * 512 * DM, DM, 512, nullptr, (bf16*)(ws + WS_WOR) + (size_t)L * DM * 512, 32, r, false, scr, C.lane); continue; } r -= I_OR;
        if (r < I_OR) { p0_transpose_item(P->in[I_WOA] + (size_t)L * 512 * DM, DM, 512, nullptr, (bf16*)(ws + WS_WOA) + (size_t)L * DM * 512, 32, r, false, scr, C.lane); continue; } r -= I_OR;
        if (r < I_OUT) { p0_transpose_item(P->in[I_WOUT] + (size_t)L * DM * DM, DM, DM, nullptr, (bf16*)(ws + WS_WOUT) + (size_t)L * DM * DM, 32, r, false, scr, C.lane); continue; } r -= I_OUT;
        if (r < I_OUT) { p0_transpose_item(P->in[I_WPG] + (size_t)L * DM * DM, DM, DM, nullptr, (bf16*)(ws + WS_WPG) + (size_t)L * DM * DM, 32, r, false, scr, C.lane); continue; } r -= I_OUT;
        p0_transpose_item(P->in[I_WPP] + (size_t)L * 256 * DM, DM, 256, nullptr, (bf16*)(ws + WS_WPP) + (size_t)L * DM * 256, 32, r, false, scr, C.lane);
    }
    bf16* XB0 = (bf16*)(ws + WS_XB0); float* rowss0 = (float*)(ws + WS_ROWSS0);
    for (int row = C.gw; row < MT; row += C.ngw) {
        const float* xr = (row < MP) ? P->in[I_XP] + (size_t)row * DM : P->in[I_XS] + (size_t)(row - MP) * DM;
        float ss = 0.f;
#pragma unroll
        for (int j = 0; j < 4; ++j) { const f32x4 v = *(const f32x4*)(xr + 256 * j + 4 * C.lane); ss += (v[0] * v[0] + v[1] * v[1]) + (v[2] * v[2] + v[3] * v[3]);
            u32x2 w; w.x = pk2(v[0], v[1]); w.y = pk2(v[2], v[3]); *(u32x2*)(XB0 + (size_t)row * DM + 256 * j + 4 * C.lane) = w; }
        ss = wave_sum(ss, C.lane);
        if (C.lane == 0) rowss0[row] = ss;
    }
    for (int r = C.gw; r < DEPTH * MT; r += C.ngw) { const int L = r / MT, row = r - L * MT;
        const float* pr = (row < MP) ? P->in[I_PP] + ((size_t)L * MP + row) * 256 : P->in[I_PS] + ((size_t)L * MS + (row - MP)) * 256;
        const f32x4 v = *(const f32x4*)(pr + 4 * C.lane); u32x2 w; w.x = pk2(v[0], v[1]); w.y = pk2(v[2], v[3]); *(u32x2*)((bf16*)(ws + WS_PB) + ((size_t)L * MT + row) * 256 + 4 * C.lane) = w; }
    f32x2* rr = (f32x2*)(ws + WS_ROPER); f32x2* ra = (f32x2*)(ws + WS_ROPEA);
    for (int i = C.blk * NTHREADS + C.tid; i < 4096 * 64; i += C.nblk * NTHREADS) { const int pos = i >> 6, k = i & 63;
        const float fr = expf((-9.210340371976184f * (float)k) / 64.0f), ang = (float)pos * fr; rr[i] = (f32x2){cosf(ang), sinf(ang)}; }
    for (int i = C.blk * NTHREADS + C.tid; i < 4096 * 8; i += C.nblk * NTHREADS) { const int pos = i >> 3, k = i & 7;
        const float fr = expf((-13.122363377404328f * (float)k) / 8.0f), ang = (float)pos * fr; ra[i] = (f32x2){cosf(ang), sinf(ang)}; }
}

constexpr int LDT = 272;
__device__ __forceinline__ void post_ret_tile(PK P, const Ctx& C, int unit) {
    unsigned char* ws = P->ws; const bf16* Z = (const bf16*)(ws + WS_Z);
    const int b = unit >> 7, h = (unit >> 5) & 3, n = unit & 31, t0 = n * 128; const int bh = b * 4 + h;
    LAS unsigned char* TK = C.lds; LAS unsigned char* TV = C.lds + 128 * LDT;
    const f32x2* ropeR = (const f32x2*)(ws + WS_ROPER);
    bf16* RQ = (bf16*)(ws + WS_RQ); bf16* RK = (bf16*)(ws + WS_RK);
    const float lg2 = ret_log2g(h);
#pragma unroll
    for (int u = 0; u < 2; ++u) {
        const int idx = C.tid + 512 * u, r = idx >> 3, j = idx & 7, t = t0 + r; const size_t grow = (size_t)b * SEQ + t;
        float cs[8], sn[8];
#pragma unroll
        for (int e = 0; e < 8; e += 2) { const f32x4 v = *(const f32x4*)(ropeR + (size_t)t * 64 + 8 * j + e); cs[e] = v[0]; sn[e] = v[1]; cs[e + 1] = v[2]; sn[e + 1] = v[3]; }
        { float x1[8], x2[8], o1[8], o2[8]; unpack8(*(const u32x4*)(Z + grow * NZ + ZC_RQ + h * 128 + 8 * j), x1); unpack8(*(const u32x4*)(Z + grow * NZ + ZC_RQ + h * 128 + 64 + 8 * j), x2);
#pragma unroll
          for (int e = 0; e < 8; ++e) { o1[e] = x1[e] * cs[e] - x2[e] * sn[e]; o2[e] = x2[e] * cs[e] + x1[e] * sn[e]; }
          *(u32x4*)(RQ + grow * 512 + h * 128 + 8 * j) = pack8(o1); *(u32x4*)(RQ + grow * 512 + h * 128 + 64 + 8 * j) = pack8(o2); }
        { float x1[8], x2[8], o1[8], o2[8]; unpack8(*(const u32x4*)(Z + grow * NZ + ZC_RK + h * 128 + 8 * j), x1); unpack8(*(const u32x4*)(Z + grow * NZ + ZC_RK + h * 128 + 64 + 8 * j), x2);
          const float sc = 0.08838834764831845f, dk = __builtin_amdgcn_exp2f((float)(127 - r) * lg2);
#pragma unroll
          for (int e = 0; e < 8; ++e) { o1[e] = (x1[e] * cs[e] - x2[e] * sn[e]) * sc; o2[e] = (x2[e] * cs[e] + x1[e] * sn[e]) * sc; }
          *(u32x4*)(RK + grow * 512 + h * 128 + 8 * j) = pack8(o1); *(u32x4*)(RK + grow * 512 + h * 128 + 64 + 8 * j) = pack8(o2);
#pragma unroll
          for (int e = 0; e < 8; ++e) { *(LAS bf16*)(TK + (8 * j + e) * LDT + 2 * r) = (bf16)(pk2(o1[e] * dk, 0.f) & 0xffffu); *(LAS bf16*)(TK + (64 + 8 * j + e) * LDT + 2 * r) = (bf16)(pk2(o2[e] * dk, 0.f) & 0xffffu); } }
    }
#pragma unroll
    for (int u = 0; u < 4; ++u) {
        const int idx = C.tid + 512 * u, r = idx >> 4, c = idx & 15; const size_t grow = (size_t)b * SEQ + t0 + r;
        const u32x4 w = *(const u32x4*)(Z + grow * NZ + ZC_RV + h * 128 + 8 * c);
        const unsigned ww[4] = {w.x, w.y, w.z, w.w};
#pragma unroll
        for (int e = 0; e < 4; ++e) { *(LAS bf16*)(TV + (8 * c + 2 * e) * LDT + 2 * r) = (bf16)(ww[e] & 0xffffu); *(LAS bf16*)(TV + (8 * c + 2 * e + 1) * LDT + 2 * r) = (bf16)(ww[e] >> 16); }
    }
    __syncthreads();
    bf16* RKT = (bf16*)(ws + WS_RKT); bf16* RVT = (bf16*)(ws + WS_RVT);
#pragma unroll
    for (int u = 0; u < 4; ++u) {
        const int idx = C.tid + 512 * u, d = idx >> 4, c = idx & 15;
        const u32x4 a = *(const LAS u32x4*)(TK + d * LDT + 16 * c), v = *(const LAS u32x4*)(TV + d * LDT + 16 * c);
        *(u32x4*)(RKT + ((size_t)bh * 128 + d) * SEQ + t0 + 8 * c) = a; *(u32x4*)(RVT + ((size_t)bh * 128 + d) * SEQ + t0 + 8 * c) = v;
    }
    __syncthreads();
}
__device__ __forceinline__ void post_token(PK P, const Ctx& C, int L, int row) {
    unsigned char* ws = P->ws; const bf16* Zr = (const bf16*)(ws + WS_Z) + (size_t)row * NZ; const int lane = C.lane;
    const bool prompt = row < MP; const int sb = (row - MP) >> 3, sc = (row - MP) & 7;
    const int pos = prompt ? (row & (SEQ - 1)) : PAST + sc;
    const f32x2* ropeA = (const f32x2*)(ws + WS_ROPEA) + (size_t)pos * 8;
    const int c8 = lane & 7;
    float cs[8], sn[8];
#pragma unroll
    for (int e = 0; e < 8; e += 2) { const f32x4 v = *(const f32x4*)(ropeA + e); cs[e] = v[0]; sn[e] = v[1]; cs[e + 1] = v[2]; sn[e + 1] = v[3]; }
    { float x[8]; unpack8(*(const u32x4*)(Zr + ZC_AQ + 8 * lane), x);
      float ss = 0.f;
#pragma unroll
      for (int e = 0; e < 8; ++e) ss += x[e] * x[e];
      ss += shx<1>(ss, lane); ss += shx<2>(ss, lane); ss += shx<4>(ss, lane);
      const float rs = __builtin_amdgcn_rsqf(ss * (1.0f / 64.0f) + 1e-6f);
      const float* qg = P->in[I_QG] + L * 64 + 8 * c8; float o[8];
#pragma unroll
      for (int e = 0; e < 8; ++e) { const float y = x[e] * rs * qg[e]; const float pr = shx<1>(y, lane); o[e] = (c8 == 0) ? y * cs[e] - pr * sn[e] : (c8 == 1) ? y * cs[e] + pr * sn[e] : y; }
      *(u32x4*)((bf16*)(ws + WS_AQ) + (size_t)row * 512 + 8 * lane) = pack8(o); }
    { float x[8]; unpack8(*(const u32x4*)(Zr + ZC_AK + 8 * (lane & 31)), x);
      float ss = 0.f;
#pragma unroll
      for (int e = 0; e < 8; ++e) ss += x[e] * x[e];
      ss += shx<1>(ss, lane); ss += shx<2>(ss, lane); ss += shx<4>(ss, lane);
      const float rs = __builtin_amdgcn_rsqf(ss * (1.0f / 64.0f) + 1e-6f);
      const float* kg = P->in[I_KG] + L * 64 + 8 * c8; float o[8]; const bool isk = (lane & 31) < 16;
#pragma unroll
      for (int e = 0; e < 8; ++e) { const float y = isk ? x[e] * rs * kg[e] : x[e]; const float pr = shx<1>(y, lane); o[e] = (isk && c8 == 0) ? y * cs[e] - pr * sn[e] : (isk && c8 == 1) ? y * cs[e] + pr * sn[e] : y; }
      if (lane < 32) {
          const int l16 = lane & 15;
          float* dst = isk ? (prompt ? P->out + O_KP + ((size_t)L * MP + row) * 128 : P->out + O_KS + ((size_t)L * MS + (row - MP)) * 128)
                           : (prompt ? P->out + O_VP + ((size_t)L * MP + row) * 128 : P->out + O_VS + ((size_t)L * MS + (row - MP)) * 128);
          *(f32x4*)(dst + 8 * l16) = (f32x4){o[0], o[1], o[2], o[3]}; *(f32x4*)(dst + 8 * l16 + 4) = (f32x4){o[4], o[5], o[6], o[7]};
          if (prompt) { bf16* d2 = (bf16*)(ws + (isk ? WS_KB : WS_VB)) + (size_t)row * 128 + 8 * l16; *(u32x4*)d2 = pack8(o); } } }
    { const int l40 = lane < 40 ? lane : 39; float x[8]; unpack8(*(const u32x4*)(Zr + ZC_IQ + 8 * l40), x); float o[8];
#pragma unroll
      for (int e = 0; e < 8; ++e) { const float y = x[e]; const float pr = shx<1>(y, lane); o[e] = (c8 == 0) ? y * cs[e] - pr * sn[e] : (c8 == 1) ? y * cs[e] + pr * sn[e] : y; }
      if (lane < 32) *(u32x4*)((bf16*)(ws + WS_IQ) + (size_t)row * 256 + 8 * lane) = pack8(o);
      else if (lane < 40) { const int l8 = lane - 32;
          float* dst = prompt ? P->out + O_IKP + ((size_t)L * MP + row) * 64 : P->out + O_IKS + ((size_t)L * MS + (row - MP)) * 64;
          *(f32x4*)(dst + 8 * l8) = (f32x4){o[0], o[1], o[2], o[3]}; *(f32x4*)(dst + 8 * l8 + 4) = (f32x4){o[4], o[5], o[6], o[7]};
          if (prompt) *(u32x4*)((bf16*)(ws + WS_IKB) + (size_t)row * 64 + 8 * l8) = pack8(o); } }
    if (lane < 4) ((float*)(ws + WS_IW))[(size_t)row * 4 + lane] = bf2f(Zr[ZC_IW + lane]) * 0.0625f;
    { const float* pr = prompt ? P->in[I_PP] + ((size_t)L * MP + row) * 256 : P->in[I_PS] + ((size_t)L * MS + (row - MP)) * 256;
      const f32x4 v = *(const f32x4*)(pr + 4 * lane); u32x2 w; w.x = pk2(v[0], v[1]); w.y = pk2(v[2], v[3]); *(u32x2*)((bf16*)(ws + WS_PB) + (size_t)row * 256 + 4 * lane) = w; }
    (void)sb;
}
__device__ __forceinline__ void phase_post(PK P, const Ctx& C, int L) {
    for (int u = C.blk; u < 512; u += C.nblk) post_ret_tile(P, C, u);
    for (int row = C.gw; row < MT; row += 2 * C.ngw) { post_token(P, C, L, row); if (row + C.ngw < MT) post_token(P, C, L, row + C.ngw); }
}

__device__ __forceinline__ void ret_state_item(PK P, const Ctx& C, int L, int item) {
    unsigned char* ws = P->ws; const bf16* RKT = (const bf16*)(ws + WS_RKT); const bf16* RVT = (const bf16*)(ws + WS_RVT); bf16* ST = (bf16*)(ws + WS_ST);
    const int bh = item >> 6, et = (item >> 3) & 7, dt = item & 7, lane = C.lane, r16 = lane & 15, g = lane >> 4;
    const float dec = __builtin_amdgcn_exp2f(128.0f * ret_log2g(bh & 3));
    LAS unsigned char* img = C.lds + 36864 + (C.wave & 3) * 8704;
    const int tq = lane >> 4, c16 = lane & 15;
    const bf16* vp = RVT + ((size_t)bh * 128 + 16 * et + tq) * SEQ + 8 * c16;
    const bf16* kp = RKT + ((size_t)bh * 128 + 16 * dt + tq) * SEQ + 8 * c16;
    f32x4 S = {0.f, 0.f, 0.f, 0.f};
    u32x4 rv[2][2][4], rk[2][2][4];
#define RS_LOAD(buf_, n0_) do { _Pragma("unroll") for (int i = 0; i < 2; ++i) _Pragma("unroll") for (int q = 0; q < 4; ++q) { \
        rv[buf_][i][q] = *(const u32x4*)(vp + (size_t)(4 * q) * SEQ + ((n0_) + i) * 128); rk[buf_][i][q] = *(const u32x4*)(kp + (size_t)(4 * q) * SEQ + ((n0_) + i) * 128); } } while (0)
#define RS_CHUNK(buf_, i_, n_, refill_) do { \
        _Pragma("unroll") for (int q = 0; q < 4; ++q) { *(LAS u32x4*)(img + (tq + 4 * q) * 272 + 16 * c16) = rv[buf_][i_][q]; *(LAS u32x4*)(img + (16 + tq + 4 * q) * 272 + 16 * c16) = rk[buf_][i_][q]; } \
        refill_; \
        LDS_WAIT(); asm volatile("" ::: "memory"); \
        f32x4 acc = {0.f, 0.f, 0.f, 0.f}; \
        _Pragma("unroll") for (int kk = 0; kk < 4; ++kk) { const bf16x8 a = *(const LAS bf16x8*)(img + r16 * 272 + 64 * kk + 16 * g), b = *(const LAS bf16x8*)(img + (16 + r16) * 272 + 64 * kk + 16 * g); acc = mfma16(a, b, acc); } \
        LDS_WAIT(); asm volatile("" ::: "memory"); \
        bf16* st = ST + (((size_t)bh * 32 + (n_)) * 128 + 16 * et + 4 * g) * 128 + 16 * dt + r16; \
        _Pragma("unroll") for (int r = 0; r < 4; ++r) st[r * 128] = (bf16)(pk2(S[r], 0.f) & 0xffffu); \
        S = S * dec + acc; } while (0)
    RS_LOAD(0, 0); RS_LOAD(1, 2);
    asm volatile("" ::: "memory");
#pragma unroll 1
    for (int n0 = 0; n0 < 32; n0 += 4) {
        RS_CHUNK(0, 0, n0, (void)0);
        RS_CHUNK(0, 1, n0 + 1, if (n0 + 4 < 32) RS_LOAD(0, n0 + 4));
        RS_CHUNK(1, 0, n0 + 2, (void)0);
        RS_CHUNK(1, 1, n0 + 3, if (n0 + 6 < 32) RS_LOAD(1, n0 + 6));
        asm volatile("" : "+v"(S));
    }
#undef RS_LOAD
#undef RS_CHUNK
    float* o = P->out + O_RSP + ((size_t)L * 16 + bh) * 16384 + (size_t)(16 * dt + r16) * 128 + 16 * et + 4 * g;
    *(f32x4*)o = S;
}
__device__ __forceinline__ void ret_sample_unit(PK P, const Ctx& C, int L, int unit) {
    unsigned char* ws = P->ws; const bf16* Z = (const bf16*)(ws + WS_Z);
    const int b = unit >> 2, h = unit & 3, tid = C.tid; const int r0 = MP + b * 8;
    LAS float* q = (LAS float*)C.lds;
    LAS float* kp = q + 1024;
    LAS float* v = kp + 1024;
    LAS float* rz = v + 1024;
    LAS float* A = rz + 1024;
    LAS float* op = A + 64;
    const float lg2 = ret_log2g(h);
    { const int c = tid >> 6, i = tid & 63; const size_t row = (size_t)(r0 + c);
      const f32x2 cs = ((const f32x2*)(ws + WS_ROPER))[(size_t)(PAST + c) * 64 + i];
      const float q1 = bf2f(Z[row * NZ + ZC_RQ + h * 128 + i]), q2 = bf2f(Z[row * NZ + ZC_RQ + h * 128 + 64 + i]);
      q[i * 8 + c] = q1 * cs[0] - q2 * cs[1]; q[(64 + i) * 8 + c] = q2 * cs[0] + q1 * cs[1];
      const float k1 = bf2f(Z[row * NZ + ZC_RK + h * 128 + i]), k2 = bf2f(Z[row * NZ + ZC_RK + h * 128 + 64 + i]);
      const float ks = 0.08838834764831845f * __builtin_amdgcn_exp2f((float)(7 - c) * lg2);
      kp[i * 8 + c] = (k1 * cs[0] - k2 * cs[1]) * ks; kp[(64 + i) * 8 + c] = (k2 * cs[0] + k1 * cs[1]) * ks;
      v[c * 128 + i] = bf2f(Z[row * NZ + ZC_RV + h * 128 + i]); v[c * 128 + 64 + i] = bf2f(Z[row * NZ + ZC_RV + h * 128 + 64 + i]);
      rz[c * 128 + i] = bf2f(Z[row * NZ + ZC_RZ + h * 128 + i]); rz[c * 128 + 64 + i] = bf2f(Z[row * NZ + ZC_RZ + h * 128 + 64 + i]); }
    __syncthreads();
    { const int pr = tid >> 3, part = tid & 7, c = pr >> 3, s2 = pr & 7; float d = 0.f;
#pragma unroll
      for (int dd = 0; dd < 16; ++dd) d += q[(part * 16 + dd) * 8 + c] * kp[(part * 16 + dd) * 8 + s2];
      d += shx<1>(d, tid & 63); d += shx<2>(d, tid & 63); d += shx<4>(d, tid & 63);
      if (part == 0) A[pr] = (s2 <= c) ? d * __builtin_amdgcn_exp2f((float)(c - 7) * lg2) : 0.f; }
    { const int dq = tid >> 7, e = tid & 127; float vr[8], acc[8];
#pragma unroll
      for (int c = 0; c < 8; ++c) { vr[c] = v[c * 128 + e]; acc[c] = 0.f; }
      const float g8 = __builtin_amdgcn_exp2f(8.0f * lg2);
      const float* S0 = P->in[I_STATE] + (((size_t)L * DB + b) * 4 + h) * 16384; float* S1 = P->out + O_RSS + (((size_t)L * DB + b) * 4 + h) * 16384;
      float s0v[32];
#pragma unroll
      for (int dd = 0; dd < 32; ++dd) s0v[dd] = S0[(dq * 32 + dd) * 128 + e];
#pragma unroll
      for (int dd = 0; dd < 32; ++dd) { const int d = dq * 32 + dd; const float s0 = s0v[dd];
          const f32x4 qa = *(const LAS f32x4*)(q + d * 8), qb = *(const LAS f32x4*)(q + d * 8 + 4), ka = *(const LAS f32x4*)(kp + d * 8), kb = *(const LAS f32x4*)(kp + d * 8 + 4);
          float sn = s0 * g8;
#pragma unroll
          for (int c = 0; c < 4; ++c) { acc[c] += qa[c] * s0; acc[4 + c] += qb[c] * s0; sn += ka[c] * vr[c]; sn += kb[c] * vr[4 + c]; }
          S1[d * 128 + e] = sn; }
#pragma unroll
      for (int c = 0; c < 8; ++c) op[(dq * 8 + c) * 128 + e] = acc[c]; }
    __syncthreads();
    { const int c = tid >> 6, i = tid & 63; float o[2]; const float gq = __builtin_amdgcn_exp2f((float)(c + 1) * lg2);
#pragma unroll
      for (int u = 0; u < 2; ++u) { const int e = i + 64 * u; float s = (op[(0 * 8 + c) * 128 + e] + op[(1 * 8 + c) * 128 + e]) + (op[(2 * 8 + c) * 128 + e] + op[(3 * 8 + c) * 128 + e]); s *= gq;
          for (int sidx = 0; sidx <= c; ++sidx) s += A[c * 8 + sidx] * v[sidx * 128 + e];
          o[u] = s; }
      float sm = o[0] + o[1];
      sm = wave_sum(sm, i);
      const float mu = sm * (1.0f / 128.0f); float qv = (o[0] - mu) * (o[0] - mu) + (o[1] - mu) * (o[1] - mu);
      qv = wave_sum(qv, i);
      const float rstd = __builtin_amdgcn_rsqf(qv * (1.0f / 128.0f) + 1e-5f);
      bf16* og = (bf16*)(ws + WS_OGR) + (size_t)(r0 + c) * 512 + h * 128;
#pragma unroll
      for (int u = 0; u < 2; ++u) { const int e = i + 64 * u; og[e] = (bf16)(pk2((o[u] - mu) * rstd * siluf_(rz[c * 128 + e]), 0.f) & 0xffffu); } }
    __syncthreads();
}
template <bool SAMPLE>
__device__ __forceinline__ void score_item(PK P, const Ctx& C, int L, int b, int qblk, int kc) {
    constexpr int QG = SAMPLE ? 1 : 2;
    constexpr int TG = SAMPLE ? 4 : 5;
    unsigned char* ws = P->ws; const int lane = C.lane, r32 = lane & 31, hf = lane >> 5;
    const bf16* IQ = (const bf16*)(ws + WS_IQ); const float* IW = (const float*)(ws + WS_IW);
    const int q0 = SAMPLE ? 0 : qblk * 16;
    const size_t rowbase = SAMPLE ? (size_t)MP + b * 8 : (size_t)b * SEQ + q0;
    bf16x8 af[QG][4]; f32x4 wv[QG][4];
#pragma unroll
    for (int gq = 0; gq < QG; ++gq) {
#pragma unroll
        for (int s = 0; s < 4; ++s) af[gq][s] = *(const bf16x8*)(IQ + (rowbase + 8 * gq + (r32 >> 2)) * 256 + (r32 & 3) * 64 + 16 * s + 8 * hf);
#pragma unroll
        for (int i = 0; i < 4; ++i) wv[gq][i] = *(const f32x4*)(IW + (rowbase + 8 * gq + 2 * i + hf) * 4); }
    const int nkeys = SAMPLE ? PAST + DS : q0 + 16;
    const int kt_end = min(kc * 16 + 16, (nkeys + 31) >> 5);
    const int* pt = (const int*)P->in[I_PT] + b * NPAGES;
    const float* cik = P->in[I_CIK] + (size_t)L * NPOOL * 128 * 64; const float* nik = P->out + O_IKS + ((size_t)L * DB + b) * DS * 64;
    const bf16* ikb = (const bf16*)(ws + WS_IKB) + (size_t)b * SEQ * 64;
    u32x4 cur[TG][SAMPLE ? 8 : 4];
    auto load_group = [&](int kt0, u32x4 (&dst)[TG][SAMPLE ? 8 : 4]) {
#pragma unroll
        for (int j = 0; j < TG; ++j) { const int kt = min(kt0 + j, kt_end - 1); const int key = kt * 32 + r32;
            if (SAMPLE) { const int kcl = key < PAST + DS ? key : PAST + DS - 1;
                const float* kr = (kcl < PAST) ? cik + ((size_t)pt[(kt >> 2) & 15] * 128 + (kcl & 127)) * 64 : nik + (size_t)(kcl - PAST) * 64;
#pragma unroll
                for (int s = 0; s < 4; ++s) { dst[j][2 * s] = *(const u32x4*)(kr + 16 * s + 8 * hf); dst[j][2 * s + 1] = *(const u32x4*)(kr + 16 * s + 8 * hf + 4); }
            } else { const bf16* kr = ikb + (size_t)key * 64;
#pragma unroll
                for (int s = 0; s < 4; ++s) dst[j][s] = *(const u32x4*)(kr + 16 * s + 8 * hf); } }
    };
    for (int kt0 = kc * 16; kt0 < kt_end; kt0 += TG) {
        load_group(kt0, cur);
#pragma unroll
        for (int j = 0; j < TG; ++j) { const int kt = kt0 + j;
            if (kt < kt_end) {
                const int key = kt * 32 + r32;
                bf16x8 bfr[4];
#pragma unroll
                for (int s = 0; s < 4; ++s) {
                    if (SAMPLE) { const f32x4 a = __builtin_bit_cast(f32x4, cur[j][2 * s]), c = __builtin_bit_cast(f32x4, cur[j][2 * s + 1]);
                        u32x4 w; w.x = pk2(a[0], a[1]); w.y = pk2(a[2], a[3]); w.z = pk2(c[0], c[1]); w.w = pk2(c[2], c[3]); bfr[s] = as_bf16x8(w); }
                    else bfr[s] = as_bf16x8(cur[j][s]); }
#pragma unroll
                for (int gq = 0; gq < QG; ++gq) {
                    f32x16 acc;
#pragma unroll
                    for (int i = 0; i < 16; ++i) acc[i] = 0.f;
#pragma unroll
                    for (int s = 0; s < 4; ++s) acc = mfma32(af[gq][s], bfr[s], acc);
                    float sc[4];
#pragma unroll
                    for (int i = 0; i < 4; ++i) {
                        float v = fmaxf(acc[4 * i + 0], 0.f) * wv[gq][i][0]; v += fmaxf(acc[4 * i + 1], 0.f) * wv[gq][i][1]; v += fmaxf(acc[4 * i + 2], 0.f) * wv[gq][i][2]; v += fmaxf(acc[4 * i + 3], 0.f) * wv[gq][i][3];
                        sc[i] = v + 0.0f; }
                    const bool odd = (lane & 1) != 0;
#pragma unroll
                    for (int i = 0; i < 4; i += 2) {
                        const float snd = odd ? sc[i] : sc[i + 1], rcv = shx<1>(snd, lane);
                        const float lo = odd ? rcv : sc[i], hi = odd ? sc[i + 1] : rcv;
                        const unsigned w = (unsigned)__builtin_bit_cast(unsigned short, (_Float16)lo) | ((unsigned)__builtin_bit_cast(unsigned short, (_Float16)hi) << 16);
                        const int ql = 8 * gq + 2 * (odd ? i + 1 : i) + hf, k0 = key & ~1;
                        if (SAMPLE) { if (k0 < PAST + DS) *(unsigned*)((unsigned short*)(ws + WS_SS) + ((size_t)b * 8 + ql) * SS_LD + k0) = w; }
                        else *(unsigned*)((unsigned short*)(ws + WS_SP) + ((size_t)b * SEQ + q0 + ql) * SEQ + k0) = w;
                    }
                }
            }
        }
        asm volatile("" ::: "memory");
    }
}
__device__ __forceinline__ void score_item_dma(PK P, const Ctx& C, int L, int b, int qblk, int kc, LAS unsigned char* img) {
    constexpr int QG = 2, TG = 4;
    unsigned char* ws = P->ws; const int lane = C.lane, r32 = lane & 31, hf = lane >> 5;
    const bf16* IQ = (const bf16*)(ws + WS_IQ); const float* IW = (const float*)(ws + WS_IW);
    const int q0 = qblk * 16;
    const size_t rowbase = (size_t)b * SEQ + q0;
    bf16x8 af[QG][4]; f32x4 wv[QG][4];
#pragma unroll
    for (int gq = 0; gq < QG; ++gq) {
#pragma unroll
        for (int s = 0; s < 4; ++s) af[gq][s] = *(const bf16x8*)(IQ + (rowbase + 8 * gq + (r32 >> 2)) * 256 + (r32 & 3) * 64 + 16 * s + 8 * hf);
#pragma unroll
        for (int i = 0; i < 4; ++i) wv[gq][i] = *(const f32x4*)(IW + (rowbase + 8 * gq + 2 * i + hf) * 4); }
    const int kt_end = min(kc * 16 + 16, (q0 + 16 + 31) >> 5);
    const unsigned char* ikb = ws + WS_IKB + (size_t)b * SEQ * 128;
    int voff[4], roff[4];
#pragma unroll
    for (int i = 0; i < 4; ++i) { voff[i] = (8 * i + (lane >> 3)) * 128 + 16 * ((lane & 7) ^ ((4 * i + (lane >> 4)) & 7)); roff[i] = r32 * 128 + 16 * ((2 * i + hf) ^ ((r32 >> 1) & 7)); }
#define SC_ISSUE(kt0_) do { _Pragma("unroll") for (int j = 0; j < TG; ++j) { const int kt_ = min((kt0_) + j, kt_end - 1); _Pragma("unroll") for (int i = 0; i < 4; ++i) \
        __builtin_amdgcn_global_load_lds((const unsigned*)(ikb + (size_t)kt_ * 4096 + voff[i]), (LAS unsigned*)(img + j * 4096 + i * 1024), 16, 0, 0); } } while (0)
    SC_ISSUE(kc * 16);
    for (int kt0 = kc * 16; kt0 < kt_end; kt0 += TG) {
        asm volatile("s_waitcnt vmcnt(0)" ::: "memory");
        u32x4 cur[TG][4];
#pragma unroll
        for (int j = 0; j < TG; ++j) {
#pragma unroll
            for (int s = 0; s < 4; ++s) cur[j][s] = *(const LAS u32x4*)(img + j * 4096 + roff[s]); }
        asm volatile("s_waitcnt lgkmcnt(0)" ::: "memory");
        if (kt0 + TG < kt_end) SC_ISSUE(kt0 + TG);
        asm volatile("" ::: "memory");
#pragma unroll
        for (int j = 0; j < TG; ++j) { const int kt = kt0 + j;
            if (kt < kt_end) {
                const int key = kt * 32 + r32;
#pragma unroll
                for (int gq = 0; gq < QG; ++gq) {
                    f32x16 acc;
#pragma unroll
                    for (int i = 0; i < 16; ++i) acc[i] = 0.f;
#pragma unroll
                    for (int s = 0; s < 4; ++s) acc = mfma32(af[gq][s], as_bf16x8(cur[j][s]), acc);
                    float sc[4];
#pragma unroll
                    for (int i = 0; i < 4; ++i) {
                        float v = fmaxf(acc[4 * i + 0], 0.f) * wv[gq][i][0]; v += fmaxf(acc[4 * i + 1], 0.f) * wv[gq][i][1]; v += fmaxf(acc[4 * i + 2], 0.f) * wv[gq][i][2]; v += fmaxf(acc[4 * i + 3], 0.f) * wv[gq][i][3];
                        sc[i] = v + 0.0f; }
                    const bool odd = (lane & 1) != 0;
#pragma unroll
                    for (int i = 0; i < 4; i += 2) {
                        const float snd = odd ? sc[i] : sc[i + 1], rcv = shx<1>(snd, lane);
                        const float lo = odd ? rcv : sc[i], hi = odd ? sc[i + 1] : rcv;
                        const unsigned w = (unsigned)__builtin_bit_cast(unsigned short, (_Float16)lo) | ((unsigned)__builtin_bit_cast(unsigned short, (_Float16)hi) << 16);
                        const int ql = 8 * gq + 2 * (odd ? i + 1 : i) + hf, k0 = key & ~1;
                        *(unsigned*)((unsigned short*)(ws + WS_SP) + ((size_t)b * SEQ + q0 + ql) * SEQ + k0) = w;
                    }
                }
            }
        }
        asm volatile("" ::: "memory");
    }
#undef SC_ISSUE
}
__device__ __forceinline__ void score_item_sdma(PK P, const Ctx& C, int L, int b, int kc, LAS unsigned char* img) {
    constexpr int TG = 2;
    unsigned char* ws = P->ws; const int lane = C.lane, r32 = lane & 31, hf = lane >> 5;
    const bf16* IQ = (const bf16*)(ws + WS_IQ); const float* IW = (const float*)(ws + WS_IW);
    const size_t rowbase = (size_t)MP + b * 8;
    bf16x8 af[4]; f32x4 wv[4];
#pragma unroll
    for (int s = 0; s < 4; ++s) af[s] = *(const bf16x8*)(IQ + (rowbase + (r32 >> 2)) * 256 + (r32 & 3) * 64 + 16 * s + 8 * hf);
#pragma unroll
    for (int i = 0; i < 4; ++i) wv[i] = *(const f32x4*)(IW + (rowbase + 2 * i + hf) * 4);
    const int kt_end = min(kc * 16 + 16, (PAST + DS + 31) >> 5);
    const int* pt = (const int*)P->in[I_PT] + b * NPAGES;
    const float* cik = P->in[I_CIK] + (size_t)L * NPOOL * 128 * 64; const float* nik = P->out + O_IKS + ((size_t)L * DB + b) * DS * 64;
    const int dr = lane >> 4, dq = lane & 15;
#define SS_ISSUE(kt0_) do { _Pragma("unroll") for (int j = 0; j < TG; ++j) { const int kt_ = min((kt0_) + j, kt_end - 1); const float* pg_ = cik + ((size_t)pt[(kt_ >> 2) & 15] * 128 + (kt_ & 3) * 32) * 64; \
        _Pragma("unroll") for (int i = 0; i < 8; ++i) { const int row_ = 4 * i + dr, key_ = kt_ * 32 + row_, kcl_ = key_ < PAST + DS ? key_ : PAST + DS - 1; \
            const float* src_ = (kcl_ < PAST ? pg_ + row_ * 64 : nik + (kcl_ - PAST) * 64) + 4 * (dq ^ (row_ & 15)); \
            __builtin_amdgcn_global_load_lds((const unsigned*)src_, (LAS unsigned*)(img + j * 8192 + i * 1024), 16, 0, 0); } } } while (0)
    SS_ISSUE(kc * 16);
    for (int kt0 = kc * 16; kt0 < kt_end; kt0 += TG) {
        asm volatile("s_waitcnt vmcnt(0)" ::: "memory");
        u32x4 cur[TG][8];
#pragma unroll
        for (int j = 0; j < TG; ++j) {
#pragma unroll
            for (int s = 0; s < 8; ++s) cur[j][s] = *(const LAS u32x4*)(img + j * 8192 + r32 * 256 + 16 * ((4 * (s >> 1) + 2 * hf + (s & 1)) ^ (r32 & 15))); }
        asm volatile("s_waitcnt lgkmcnt(0)" ::: "memory");
        if (kt0 + TG < kt_end) SS_ISSUE(kt0 + TG);
        asm volatile("" ::: "memory");
#pragma unroll
        for (int j = 0; j < TG; ++j) { const int kt = kt0 + j;
            if (kt < kt_end) {
                const int key = kt * 32 + r32;
                f32x16 acc;
#pragma unroll
                for (int i = 0; i < 16; ++i) acc[i] = 0.f;
#pragma unroll
                for (int s = 0; s < 4; ++s) { const f32x4 a = __builtin_bit_cast(f32x4, cur[j][2 * s]), c = __builtin_bit_cast(f32x4, cur[j][2 * s + 1]);
                    u32x4 w; w.x = pk2(a[0], a[1]); w.y = pk2(a[2], a[3]); w.z = pk2(c[0], c[1]); w.w = pk2(c[2], c[3]);
                    acc = mfma32(af[s], as_bf16x8(w), acc); }
                float sc[4];
#pragma unroll
                for (int i = 0; i < 4; ++i) {
                    float v = fmaxf(acc[4 * i + 0], 0.f) * wv[i][0]; v += fmaxf(acc[4 * i + 1], 0.f) * wv[i][1]; v += fmaxf(acc[4 * i + 2], 0.f) * wv[i][2]; v += fmaxf(acc[4 * i + 3], 0.f) * wv[i][3];
                    sc[i] = v + 0.0f; }
                const bool odd = (lane & 1) != 0;
#pragma unroll
                for (int i = 0; i < 4; i += 2) {
                    const float snd = odd ? sc[i] : sc[i + 1], rcv = shx<1>(snd, lane);
                    const float lo = odd ? rcv : sc[i], hi = odd ? sc[i + 1] : rcv;
                    const unsigned w = (unsigned)__builtin_bit_cast(unsigned short, (_Float16)lo) | ((unsigned)__builtin_bit_cast(unsigned short, (_Float16)hi) << 16);
                    const int ql = 2 * (odd ? i + 1 : i) + hf, k0 = key & ~1;
                    if (k0 < PAST + DS) *(unsigned*)((unsigned short*)(ws + WS_SS) + ((size_t)b * 8 + ql) * SS_LD + k0) = w;
                }
            }
        }
        asm volatile("" ::: "memory");
    }
#undef SS_ISSUE
}
__device__ __forceinline__ void phase_c(PK P, const Ctx& C, int L, int sel = 15) {
    LAS unsigned char* imgw = C.lds + C.wave * 16384;
    if (C.nblk == 256) {
        const int q1 = C.blk & 127, n1 = q1 / 32 + 1;
        if (C.wave < 4) { if (sel & 1) for (int it = C.blk * 4 + C.wave; it < 1024; it += C.nblk * 4) ret_state_item(P, C, L, it); }
        else { const int k = C.wave & 3, f = (C.blk >> 7) * 4 + k; LAS unsigned char* imgf = C.lds + (k < 3 ? 71680 + k * 16384 : XPOSE_OFF);
            if ((sel & 8) && f < 5) score_item_sdma(P, C, L, q1, f, imgf);
            if ((sel & 4) && f >= 4) { const int j = f == 4 ? 35 : 27 + f; const int b = j / 9, c = j - 9 * b; if (c < n1) score_item_dma(P, C, L, b, q1, c, imgf); else score_item_dma(P, C, L, b, 255 - q1, c - n1, imgf); } }
        if (sel & 2) for (int u = C.blk; u < 512; u += C.nblk) ret_sample_unit(P, C, L, u);
        if (sel & 4) { const int wp = (C.blk >> 7) * NWAVES + C.wave;
            for (int j = wp; j < 32; j += 16) { const int b = j / 9, c = j - 9 * b; if (c < n1) score_item_dma(P, C, L, b, q1, c, imgw); else score_item_dma(P, C, L, b, 255 - q1, c - n1, imgw); } }
    } else {
        if ((sel & 1) && C.wave < 4) for (int it = C.blk * 4 + C.wave; it < 1024; it += C.nblk * 4) ret_state_item(P, C, L, it);
        if (sel & 2) for (int u = C.blk; u < 512; u += C.nblk) ret_sample_unit(P, C, L, u);
        if (sel & 4) for (int it = C.gw; it < NB * 256 * 8; it += C.ngw) { const int kc = it & 7, qb = (it >> 3) & 255, b = it >> 11; if (kc * 512 <= qb * 16 + 15) score_item_dma(P, C, L, b, qb, kc, imgw); }
        if ((sel & 8) && C.wave >= 4) for (int it = C.blk * 4 + (C.wave & 3); it < DB * 5; it += C.nblk * 4) score_item_sdma(P, C, L, it / 5, it % 5, imgw);
    }
}

__device__ __forceinline__ void ret_scan_item(PK P, const Ctx& C, int L, int item) {
    unsigned char* ws = P->ws; const float* KVT = (const float*)(ws + WS_KVT); bf16* ST = (bf16*)(ws + WS_ST);
    const int e0 = item * 1024 + C.tid * 2, bh = e0 >> 14, rem = e0 & 16383, h = bh & 3;
    const float dec = __builtin_amdgcn_exp2f(128.0f * ret_log2g(h));
    float s0 = 0.f, s1 = 0.f;
#pragma unroll 8
    for (int n = 0; n < 32; ++n) { const f32x2 kv = *(const f32x2*)(KVT + ((size_t)bh * 32 + n) * 16384 + rem);
        *(unsigned*)(ST + ((size_t)bh * 32 + n) * 16384 + rem) = pk2(s0, s1); s0 = s0 * dec + kv[0]; s1 = s1 * dec + kv[1]; }
    const int e = rem >> 7, d = rem & 127;
    float* o = P->out + O_RSP + ((size_t)L * 16 + bh) * 16384; o[d * 128 + e] = s0; o[(d + 1) * 128 + e] = s1;
}
template <int G>
__device__ __forceinline__ void cnt_ge4(const unsigned (&kp)[32], unsigned cm1, unsigned& c0, unsigned& c1) {
    unsigned t0, t1, t2, t3;
    asm("v_pk_sub_u16 %2, %6, %10 clamp\n\tv_pk_sub_u16 %3, %7, %10 clamp\n\tv_pk_sub_u16 %4, %8, %10 clamp\n\tv_pk_sub_u16 %5, %9, %10 clamp\n\t"
        "v_pk_min_u16 %2, %2, %11\n\tv_pk_min_u16 %3, %3, %11\n\tv_pk_min_u16 %4, %4, %11\n\tv_pk_min_u16 %5, %5, %11\n\t"
        "v_pk_add_u16 %0, %0, %2\n\tv_pk_add_u16 %1, %1, %3\n\tv_pk_add_u16 %0, %0, %4\n\tv_pk_add_u16 %1, %1, %5"
        : "+v"(c0), "+v"(c1), "=&v"(t0), "=&v"(t1), "=&v"(t2), "=&v"(t3)
        : "v"(kp[4 * G + 0]), "v"(kp[4 * G + 1]), "v"(kp[4 * G + 2]), "v"(kp[4 * G + 3]), "s"(cm1), "s"(0x00010001u));
}
__device__ __forceinline__ int wave_sum_dpp(int v) {
    v += __builtin_amdgcn_update_dpp(0, v, 0x111, 0xf, 0xf, true);
    v += __builtin_amdgcn_update_dpp(0, v, 0x112, 0xf, 0xf, true);
    v += __builtin_amdgcn_update_dpp(0, v, 0x114, 0xf, 0xf, true);
    v += __builtin_amdgcn_update_dpp(0, v, 0x118, 0xf, 0xf, true);
    v += __builtin_amdgcn_update_dpp(0, v, 0x142, 0xa, 0xf, true);
    v += __builtin_amdgcn_update_dpp(0, v, 0x143, 0xc, 0xf, true);
    return __builtin_amdgcn_readlane(v, 63);
}
__device__ __forceinline__ unsigned cnt_ge_lane(const unsigned (&kp)[32], unsigned cand, int ng) {
    const unsigned cm1 = (cand - 1u) * 0x00010001u; unsigned c0 = 0u, c1 = 0u;
    cnt_ge4<0>(kp, cm1, c0, c1);
    if (ng > 1) cnt_ge4<1>(kp, cm1, c0, c1);
    if (ng > 2) cnt_ge4<2>(kp, cm1, c0, c1);
    if (ng > 3) cnt_ge4<3>(kp, cm1, c0, c1);
    if (ng > 4) cnt_ge4<4>(kp, cm1, c0, c1);
    if (ng > 5) cnt_ge4<5>(kp, cm1, c0, c1);
    if (ng > 6) cnt_ge4<6>(kp, cm1, c0, c1);
    if (ng > 7) cnt_ge4<7>(kp, cm1, c0, c1);
    const unsigned c = c0 + c1;
    return (c & 0xffffu) + (c >> 16);
}
__device__ __forceinline__ int cnt_ge(const unsigned (&kp)[32], unsigned cand, int ng) { return wave_sum_dpp((int)cnt_ge_lane(kp, cand, ng)); }
__device__ __forceinline__ void bit_transpose16(unsigned (&x)[16]) {
#define BT_STAGE(J, M) _Pragma("unroll") for (int r = 0; r < 16; ++r) if ((r & (J)) == 0) { const unsigned a = x[r], b = x[r + (J)]; x[r] = (a & (M)) | ((b << (J)) & ~(M)); x[r + (J)] = ((a >> (J)) & (M)) | (b & ~(M)); }
    BT_STAGE(8, 0x00ff00ffu) BT_STAGE(4, 0x0f0f0f0fu) BT_STAGE(2, 0x33333333u) BT_STAGE(1, 0x55555555u)
#undef BT_STAGE
}
__device__ __forceinline__ void select_topk(const unsigned short* srow, int Lk, LAS unsigned* list, int lane, int mode = 3) {
    const int ng = (Lk + 511) >> 9;
    unsigned kp[32];
    const unsigned* sl = (const unsigned*)srow + lane;
    if (ng > 4) {
#pragma unroll
        for (int j = 0; j < 32; ++j) kp[j] = sl[j * 64];
    } else {
#pragma unroll
        for (int j = 0; j < 16; ++j) kp[j] = sl[j * 64];
#pragma unroll
        for (int j = 16; j < 32; ++j) kp[j] = 0u;
    }
    typedef short s16x2 __attribute__((ext_vector_type(2)));
#pragma unroll
    for (int j = 0; j < 32; ++j) { const unsigned w = kp[j];
        const unsigned sg = __builtin_bit_cast(unsigned, __builtin_bit_cast(s16x2, w) >> (s16x2){15, 15});
        unsigned kk = w ^ (sg | 0x80008000u);
        const int rem = Lk - 128 * j;
        if (rem < 128) kk &= ((2 * lane < rem) ? 0xffffu : 0u) | ((2 * lane + 1 < rem) ? 0xffff0000u : 0u);
        kp[j] = kk; }
    unsigned p0[16], p1[16];
#pragma unroll
    for (int j = 0; j < 16; ++j) { p0[j] = kp[j]; p1[j] = 0u; }
    bit_transpose16(p0);
    if (ng > 4) {
#pragma unroll
        for (int j = 0; j < 16; ++j) p1[j] = kp[16 + j];
        bit_transpose16(p1); }
    unsigned act0 = ~0u, act1 = ~0u, gt0 = 0u, gt1 = 0u; int G = 0;
#pragma unroll
    for (int bit = 15; bit >= 0; --bit) {
        const unsigned t0 = act0 & p0[bit], t1 = act1 & p1[bit];
        const int c = __builtin_popcount(t0) + __builtin_popcount(t1);
        const int tot = wave_sum_dpp(c);
        const bool take = G + tot >= TOPK;
        if (take) { act0 = t0; act1 = t1; } else { G += tot; gt0 |= t0; gt1 |= t1; act0 ^= t0; act1 ^= t1; }
    }
    const int neq = wave_sum_dpp(__builtin_popcount(act0) + __builtin_popcount(act1));
    unsigned sel0, sel1;
    if (G + neq == TOPK) { sel0 = gt0 | act0; sel1 = gt1 | act1; }
    else {
        const int need_eq = TOPK - G; int jc = 0, base = 0;
#define SEL_MASKR(m_) ((m_) <= 0 ? 0u : (m_) >= 16 ? 0xffffffffu : ((1u << (m_)) - 1u) * 0x00010001u)
#pragma unroll
        for (int s = 16; s >= 1; s >>= 1) { const int jm = jc + s; const unsigned m0 = SEL_MASKR(jm), m1 = SEL_MASKR(jm - 16);
            const int cb = wave_sum_dpp(__builtin_popcount(act0 & m0) + __builtin_popcount(act1 & m1));
            if (cb < need_eq) { jc = jm; base = cb; } }
        const int rc = jc & 15; const unsigned aw = jc >= 16 ? act1 : act0;
        const bool e0 = ((aw >> rc) & 1u) != 0u, e1 = ((aw >> (16 + rc)) & 1u) != 0u;
        const unsigned long long b0 = __ballot(e0), b1 = __ballot(e1);
        const int rk = base + mbcnt64(b0) + mbcnt64(b1);
        const bool s0 = e0 && rk < need_eq, s1 = e1 && (rk + (e0 ? 1 : 0)) < need_eq;
        const unsigned add = ((s0 ? 1u : 0u) << rc) | ((s1 ? 1u : 0u) << (16 + rc));
        const unsigned m0 = SEL_MASKR(jc), m1 = SEL_MASKR(jc - 16);
        sel0 = gt0 | (act0 & m0) | (jc < 16 ? add : 0u);
        sel1 = gt1 | (act1 & m1) | (jc >= 16 ? add : 0u);
#undef SEL_MASKR
    }
    { const int cl = __builtin_popcount(sel0) + __builtin_popcount(sel1);
      int inc = cl;
      inc += __builtin_amdgcn_update_dpp(0, inc, 0x111, 0xf, 0xf, true);
      inc += __builtin_amdgcn_update_dpp(0, inc, 0x112, 0xf, 0xf, true);
      inc += __builtin_amdgcn_update_dpp(0, inc, 0x114, 0xf, 0xf, true);
      inc += __builtin_amdgcn_update_dpp(0, inc, 0x118, 0xf, 0xf, true);
      inc += __builtin_amdgcn_update_dpp(0, inc, 0x142, 0xa, 0xf, true);
      inc += __builtin_amdgcn_update_dpp(0, inc, 0x143, 0xc, 0xf, true);
      int off = inc - cl; unsigned m0 = sel0, m1 = sel1;
      while (__ballot((m0 | m1) != 0u) != 0ull) {
          const bool has0 = m0 != 0u; const unsigned m = has0 ? m0 : m1; const bool valid = m != 0u;
          const int p = __builtin_ctz(m | 0x80000000u);
          const unsigned idx = (unsigned)((((p & 15) + (has0 ? 0 : 16)) << 7) + 2 * lane + (p >> 4));
          list[valid ? off : 2368 + lane] = idx;
          off += valid ? 1 : 0;
          const unsigned nm = m & (m - 1u);
          m0 = has0 ? nm : m0; m1 = has0 ? m1 : nm; }
    }
}
#ifndef SEL2
#define SEL2 0
#endif
#ifndef QK2
#define QK2 0
#endif
#ifndef PV2
#define PV2 0
#endif
#ifndef NOXCD
#define NOXCD 0
#endif
constexpr int ATT_WSTRIDE = 10496;
template <bool SAMPLE>
__device__ __forceinline__ void attend_query(PK P, const Ctx& C, int L, int row, int mode = 3) {
    int lane_ = C.lane; asm volatile("" : "+v"(lane_));
    unsigned char* ws = P->ws; const int lane = lane_;
    LAS unsigned* list = (LAS unsigned*)(C.lds + C.wave * ATT_WSTRIDE);
    int b, Lk; const unsigned short* srow;
    if (SAMPLE) { b = (row - MP) >> 3; const int j = (row - MP) & 7; Lk = PAST + j + 1; srow = (const unsigned short*)(ws + WS_SS) + (size_t)(row - MP) * SS_LD; }
    else { b = row >> 12; const int t = row & (SEQ - 1); Lk = t + 1; srow = (const unsigned short*)(ws + WS_SP) + (size_t)row * SEQ; }
    const int n16 = lane & 15, g = lane >> 4;
    u32x4 qraw[2]; qraw[0] = (u32x4){0u, 0u, 0u, 0u}; qraw[1] = qraw[0];
    if (n16 < 8) { qraw[0] = *(const u32x4*)((const bf16*)(ws + WS_AQ) + (size_t)row * 512 + n16 * 64 + 8 * g); qraw[1] = *(const u32x4*)((const bf16*)(ws + WS_AQ) + (size_t)row * 512 + n16 * 64 + 32 + 8 * g); }
    u32x2 azr[4];
#pragma unroll
    for (int dl = 0; dl < 4; ++dl) azr[dl] = *(const u32x2*)((const bf16*)(ws + WS_Z) + (size_t)row * NZ + ZC_AZ + (n16 & 7) * 64 + 16 * dl + 4 * g);
    int ptv = 0; if (SAMPLE) ptv = ((const int*)P->in[I_PT])[b * NPAGES + (lane & 15)];
    int count;
    if (Lk <= TOPK) { for (int i = lane; i < TOPK; i += 64) list[i] = i < Lk ? (unsigned)i : 0u; count = Lk; }
    else { select_topk(srow, Lk, list, lane, mode); if (SEL2) { LDS_WAIT(); asm volatile("" ::: "memory"); select_topk(srow, Lk, list, lane, mode); } count = TOPK; }
    LDS_WAIT(); asm volatile("" ::: "memory");
    if (mode == 1 || mode == 4 || mode == 5) return;
    {
#pragma unroll
      for (int i = 0; i < 4; ++i) { const unsigned k = list[lane + 64 * i]; unsigned phys;
          if (SAMPLE) { const unsigned pg = (unsigned)__builtin_amdgcn_ds_bpermute((int)(((k >> 7) & 15u) << 2), ptv); phys = (k < (unsigned)PAST) ? pg * 128u + (k & 127u) : (0x80000000u | (k - PAST)); }
          else phys = (unsigned)b * SEQ + k;
          list[lane + 64 * i] = phys; } }
    LDS_WAIT(); asm volatile("" ::: "memory");
    const float* ck = SAMPLE ? P->in[I_CK] + (size_t)L * NPOOL * 128 * 128 : nullptr; const float* cv = SAMPLE ? P->in[I_CV] + (size_t)L * NPOOL * 128 * 128 : nullptr;
    const float* nk = P->out + O_KS + ((size_t)L * DB + b) * DS * 128; const float* nv = P->out + O_VS + ((size_t)L * DB + b) * DS * 128;
    const bf16* KBp = (const bf16*)(ws + WS_KB); const bf16* VBp = (const bf16*)(ws + WS_VB);
    bf16x8 qf[2][2];
#pragma unroll
    for (int kvh = 0; kvh < 2; ++kvh)
#pragma unroll
        for (int s = 0; s < 2; ++s) { const u32x4 zz = {0u, 0u, 0u, 0u}; qf[kvh][s] = as_bf16x8(((n16 >> 2) == kvh) ? qraw[s] : zz); }
    f32x4 S[16];
    for (int rq_ = 0; rq_ < (QK2 ? 2 : 1); ++rq_) {
    { LAS unsigned char* kbuf = C.lds + C.wave * ATT_WSTRIDE + 1024; const int c16k = lane & 15, tqk = lane >> 4;
      constexpr int SB = SAMPLE ? 1 : 2, NBT = 8 / SB;
      u32x4 kraw[2][SB][SAMPLE ? 16 : 8];
#define ATT_KLOAD(buf_, k_) do { _Pragma("unroll") for (int q = 0; q < SB; ++q) _Pragma("unroll") for (int i = 0; i < 8; ++i) { const unsigned phys = list[32 * ((k_) * SB + q) + tqk + 4 * i]; \
                if (SAMPLE) { const float* kr = ((phys & 0x80000000u) ? nk + (size_t)(phys & 7u) * 128 : ck + (size_t)phys * 128) + 8 * c16k; kraw[buf_][q][2 * i] = *(const u32x4*)kr; kraw[buf_][q][2 * i + 1] = *(const u32x4*)(kr + 4); } \
                else kraw[buf_][q][i] = *(const u32x4*)(KBp + (size_t)phys * 128 + 8 * c16k); } } while (0)
      ATT_KLOAD(0, 0); ATT_KLOAD(1, 1);
      asm volatile("" ::: "memory");
#pragma unroll
      for (int k = 0; k < NBT; ++k) {
#pragma unroll
        for (int q = 0; q < SB; ++q) { const int st = k * SB + q;
#pragma unroll
            for (int i = 0; i < 8; ++i) { u32x4 w;
                if (SAMPLE) { const f32x4 a = __builtin_bit_cast(f32x4, kraw[k & 1][q][2 * i]), c = __builtin_bit_cast(f32x4, kraw[k & 1][q][2 * i + 1]); w.x = pk2(a[0], a[1]); w.y = pk2(a[2], a[3]); w.z = pk2(c[0], c[1]); w.w = pk2(c[2], c[3]); }
                else w = kraw[k & 1][q][i];
                *(LAS u32x4*)(kbuf + (tqk + 4 * i) * 288 + 16 * c16k) = w; }
            if (q == SB - 1 && k + 2 < NBT) ATT_KLOAD(k & 1, k + 2);
            LDS_WAIT(); asm volatile("" ::: "memory");
#pragma unroll
            for (int tt = 0; tt < 2; ++tt) { const LAS unsigned char* rp = kbuf + (16 * tt + n16) * 288 + 16 * g;
                const bf16x8 a00 = *(const LAS bf16x8*)rp, a01 = *(const LAS bf16x8*)(rp + 64), a10 = *(const LAS bf16x8*)(rp + 128), a11 = *(const LAS bf16x8*)(rp + 192);
                f32x4 acc = {0.f, 0.f, 0.f, 0.f};
                acc = mfma16(a00, qf[0][0], acc); acc = mfma16(a01, qf[0][1], acc); acc = mfma16(a10, qf[1][0], acc); acc = mfma16(a11, qf[1][1], acc); asm volatile("" : "+v"(acc)); S[2 * st + tt] = acc; }
            LDS_WAIT(); asm volatile("" ::: "memory"); }
      }
#undef ATT_KLOAD
    }
    asm volatile("" ::: "memory"); }
    LAS unsigned char* vbuf = C.lds + C.wave * ATT_WSTRIDE + 1024;
    const int c16 = lane & 15, tq = lane >> 4;
    constexpr int VD = SAMPLE ? 1 : 2;
    u32x4 vraw[VD][SAMPLE ? 16 : 8];
#define ATT_VLOAD(buf_, st_) do { _Pragma("unroll") for (int i = 0; i < 8; ++i) { const unsigned phys = list[32 * (st_) + tq + 4 * i]; \
            if (SAMPLE) { const float* vr = ((phys & 0x80000000u) ? nv + (size_t)(phys & 7u) * 128 : cv + (size_t)phys * 128) + 8 * c16; vraw[buf_][2 * i] = *(const u32x4*)vr; vraw[buf_][2 * i + 1] = *(const u32x4*)(vr + 4); } \
            else vraw[buf_][i] = *(const u32x4*)(VBp + (size_t)phys * 128 + 8 * c16); } } while (0)
    if (mode != 2) {
#pragma unroll
        for (int d = 0; d < VD; ++d) ATT_VLOAD(d, d); }
    asm volatile("" ::: "memory");
    float mx = -INFINITY;
#pragma unroll
    for (int i = 0; i < 16; ++i)
#pragma unroll
        for (int r = 0; r < 4; ++r) { const int slot = 16 * i + 4 * g + r; const float sv = slot < count ? S[i][r] * 0.125f : -INFINITY; S[i][r] = sv; mx = fmaxf(mx, sv); }
    mx = fmaxf(mx, shx<16>(mx, lane)); mx = fmaxf(mx, shx<32>(mx, lane));
    float sum = 0.f;
#pragma unroll
    for (int i = 0; i < 16; ++i)
#pragma unroll
        for (int r = 0; r < 4; ++r) { const float p = __builtin_amdgcn_exp2f((S[i][r] - mx) * 1.4426950408889634f); S[i][r] = p; sum += p; }
    sum += shx<16>(sum, lane); sum += shx<32>(sum, lane);
    if (mode == 2) return;
    f32x4 oacc[8];
    {
#pragma unroll
    for (int dt = 0; dt < 8; ++dt) oacc[dt] = (f32x4){0.f, 0.f, 0.f, 0.f};
    const unsigned tr_a = (unsigned)(4 * g + (c16 >> 2)) * 288u + (unsigned)(c16 & 3) * 8u;
#pragma unroll
    for (int st = 0; st < 8; ++st) {
#pragma unroll
        for (int i = 0; i < 8; ++i) { u32x4 w;
            if (SAMPLE) { const f32x4 a = __builtin_bit_cast(f32x4, vraw[st % VD][2 * i]), c = __builtin_bit_cast(f32x4, vraw[st % VD][2 * i + 1]); w.x = pk2(a[0], a[1]); w.y = pk2(a[2], a[3]); w.z = pk2(c[0], c[1]); w.w = pk2(c[2], c[3]); }
            else w = vraw[st % VD][i];
            *(LAS u32x4*)(vbuf + (tq + 4 * i) * 288 + 16 * c16) = w; }
        if (st + VD < 8) ATT_VLOAD(st % VD, st + VD);
        const f32x4 p0 = S[2 * st], p1 = S[2 * st + 1];
        u32x4 pw; pw.x = pk2(p0[0], p0[1]); pw.y = pk2(p0[2], p0[3]); pw.z = pk2(p1[0], p1[1]); pw.w = pk2(p1[2], p1[3]);
        const bf16x8 pf = as_bf16x8(pw);
        LDS_WAIT(); asm volatile("" ::: "memory");
#pragma unroll
        for (int dt = 0; dt < 8; ++dt) {
            typedef short v4i16_t __attribute__((ext_vector_type(4)));
            const v4i16_t lo = __builtin_amdgcn_ds_read_tr16_b64_v4i16((LAS v4i16_t*)(vbuf + tr_a + 32 * dt));
            const v4i16_t hi = __builtin_amdgcn_ds_read_tr16_b64_v4i16((LAS v4i16_t*)(vbuf + tr_a + 16 * 288 + 32 * dt));
            bf16x8 af; af[0] = lo[0]; af[1] = lo[1]; af[2] = lo[2]; af[3] = lo[3]; af[4] = hi[0]; af[5] = hi[1]; af[6] = hi[2]; af[7] = hi[3];
            oacc[dt] = mfma16(af, pf, oacc[dt]); }
        LDS_WAIT(); asm volatile("" ::: "memory");
    }
    asm volatile("" ::: "memory"); }
    { const float inv = 1.0f / sum;
#define ATT_EPI(base_) do { _Pragma("unroll") for (int dl = 0; dl < 4; ++dl) { const f32x4 v = oacc[(base_) + dl]; \
              const float y0 = v[0] * inv * siluf_(bflo(azr[dl].x)), y1 = v[1] * inv * siluf_(bfhi(azr[dl].x)), y2 = v[2] * inv * siluf_(bflo(azr[dl].y)), y3 = v[3] * inv * siluf_(bfhi(azr[dl].y)); \
              u32x2 ow; ow.x = pk2(y0, y1); ow.y = pk2(y2, y3); \
              *(u32x2*)((bf16*)(ws + WS_OGA) + (size_t)row * 512 + n16 * 64 + 16 * dl + 4 * g) = ow; } } while (0)
      if (n16 < 4) ATT_EPI(0); else if (n16 < 8) ATT_EPI(4);
#undef ATT_EPI
    }
    LDS_WAIT(); asm volatile("" ::: "memory");
#undef ATT_VLOAD
}
__device__ __forceinline__ void ret_out_unit(PK P, const Ctx& C, int unit, bool flip);
__device__ __forceinline__ void phase_d(PK P, const Ctx& C, int L, int mode = 3) {
    if (mode == 3) { bool flip = false; for (int u = C.blk; u < 512; u += C.nblk) { ret_out_unit(P, C, u, flip); flip = !flip; } __syncthreads(); }
#ifndef DSEL
#define DSEL 7
#endif
    if (!(DSEL & 2)) {} else
    if (C.nblk == 256 && !NOXCD) {
        const int x = C.blk & 7, b = x >> 1, wq = (((C.blk >> 3) * 2 + (x & 1)) * NWAVES + C.wave);
        for (int t = wq; t < SEQ; t += 512) attend_query<false>(P, C, L, b * SEQ + t, mode);
    } else for (int row = C.gw; row < MP; row += C.ngw) attend_query<false>(P, C, L, row, mode);
    if (DSEL & 4) for (int i = C.gw; i < 2 * MS; i += C.ngw) if ((i & 1) == 0) attend_query<true>(P, C, L, MP + (i >> 1), mode);
}

__device__ __forceinline__ void ret_out_unit(PK P, const Ctx& C, int unit, bool flip) {
    unsigned char* ws = P->ws; const bf16* RQ = (const bf16*)(ws + WS_RQ); const bf16* RK = (const bf16*)(ws + WS_RK); const bf16* RVT = (const bf16*)(ws + WS_RVT); const bf16* ST = (const bf16*)(ws + WS_ST);
    const int bh = unit >> 5, b = bh >> 2, h = bh & 3, n = unit & 31, r16 = C.lane & 15, g = C.lane >> 4, t0 = n * 128;
    const int w = flip ? 7 - C.wave : C.wave;
    const size_t rowbase = (size_t)b * SEQ + t0;
    const float lg2 = ret_log2g(h);
    constexpr int RS = 272; LAS unsigned char* Ks = C.lds; LAS unsigned char* Vs = C.lds + 128 * RS; LAS unsigned char* Ss = C.lds + 256 * RS;
    bf16x8 qf[4];
#pragma unroll
    for (int kk = 0; kk < 4; ++kk) qf[kk] = *(const bf16x8*)(RQ + (rowbase + 16 * w + r16) * 512 + h * 128 + 32 * kk + 8 * g);
    { const int pr = C.tid >> 4, pc = C.tid & 15;
      u32x4 rk[4], rv[4], rs_[4];
#pragma unroll
      for (int q = 0; q < 4; ++q) { const int r = pr + 32 * q;
          rk[q] = *(const u32x4*)(RK + (rowbase + r) * 512 + h * 128 + 8 * pc);
          rv[q] = *(const u32x4*)(RVT + ((size_t)bh * 128 + r) * SEQ + t0 + 8 * pc);
          rs_[q] = *(const u32x4*)(ST + (((size_t)bh * 32 + n) * 128 + r) * 128 + 8 * pc); }
      __syncthreads();
#pragma unroll
      for (int q = 0; q < 4; ++q) { const int r = pr + 32 * q; *(LAS u32x4*)(Ks + r * RS + 16 * pc) = rk[q]; *(LAS u32x4*)(Vs + r * RS + 16 * pc) = rv[q]; *(LAS u32x4*)(Ss + r * RS + 16 * pc) = rs_[q]; }
      __syncthreads(); }
    unsigned pt[8][2];
#pragma unroll
    for (int st = 0; st < 8; ++st) {
        pt[st][0] = 0u; pt[st][1] = 0u;
        if (st <= w) { f32x4 acc = {0.f, 0.f, 0.f, 0.f};
#pragma unroll
            for (int kk = 0; kk < 4; ++kk) { const bf16x8 kf = *(const LAS bf16x8*)(Ks + (16 * st + r16) * RS + 64 * kk + 16 * g); acc = mfma16(kf, qf[kk], acc); }
            float vals[4];
#pragma unroll
            for (int r = 0; r < 4; ++r) { const int dlt = (16 * w + r16) - (16 * st + 4 * g + r); vals[r] = dlt >= 0 ? acc[r] * __builtin_amdgcn_exp2f((float)dlt * lg2) : 0.f; }
            pt[st][0] = pk2(vals[0], vals[1]); pt[st][1] = pk2(vals[2], vals[3]); }
    }
    const float dq = __builtin_amdgcn_exp2f((float)(16 * w + r16 + 1) * lg2);
    f32x4 o[8];
#pragma unroll
    for (int et = 0; et < 8; ++et) {
        f32x4 a1 = {0.f, 0.f, 0.f, 0.f}, a2 = {0.f, 0.f, 0.f, 0.f};
        const LAS unsigned char* vrow = Vs + (16 * et + r16) * RS;
#pragma unroll
        for (int i = 0; i < 4; ++i) if (2 * i <= w) {
            const u32x2 lo = *(const LAS u32x2*)(vrow + 2 * (32 * i + 4 * g)), hi = *(const LAS u32x2*)(vrow + 2 * (32 * i + 16 + 4 * g));
            const u32x4 aw = {lo.x, lo.y, hi.x, hi.y}, bw = {pt[2 * i][0], pt[2 * i][1], pt[2 * i + 1][0], pt[2 * i + 1][1]};
            a1 = mfma16(as_bf16x8(aw), as_bf16x8(bw), a1); }
#pragma unroll
        for (int kk = 0; kk < 4; ++kk) { const bf16x8 sf = *(const LAS bf16x8*)(Ss + (16 * et + r16) * RS + 64 * kk + 16 * g); a2 = mfma16(sf, qf[kk], a2); }
        o[et] = a1 + a2 * dq;
    }
    float sm = 0.f;
#pragma unroll
    for (int et = 0; et < 8; ++et) sm += (o[et][0] + o[et][1]) + (o[et][2] + o[et][3]);
    sm += shx<16>(sm, C.lane); sm += shx<32>(sm, C.lane);
    const float mu = sm * (1.0f / 128.0f); float qv = 0.f;
#pragma unroll
    for (int et = 0; et < 8; ++et) { const f32x4 d = o[et] - mu; qv += (d[0] * d[0] + d[1] * d[1]) + (d[2] * d[2] + d[3] * d[3]); }
    qv += shx<16>(qv, C.lane); qv += shx<32>(qv, C.lane);
    const float rstd = __builtin_amdgcn_rsqf(qv * (1.0f / 128.0f) + 1e-5f);
    const size_t row = rowbase + 16 * w + r16;
    const bf16* zr = (const bf16*)(ws + WS_Z) + row * NZ + ZC_RZ + h * 128; bf16* og = (bf16*)(ws + WS_OGR) + row * 512 + h * 128;
#pragma unroll
    for (int et = 0; et < 8; ++et) { const u32x2 zw = *(const u32x2*)(zr + 16 * et + 4 * g);
        const float y0 = (o[et][0] - mu) * rstd * siluf_(bflo(zw.x)), y1 = (o[et][1] - mu) * rstd * siluf_(bfhi(zw.x)), y2 = (o[et][2] - mu) * rstd * siluf_(bflo(zw.y)), y3 = (o[et][3] - mu) * rstd * siluf_(bfhi(zw.y));
        u32x2 ow; ow.x = pk2(y0, y1); ow.y = pk2(y2, y3); *(u32x2*)(og + 16 * et + 4 * g) = ow; }
}

template <int K>
__device__ __forceinline__ void mini_mma(const bf16* A, const bf16* Bt, int row0, int col0, const Ctx& C, f32x4 (&acc)[2]) {
    constexpr int RS = 272, BUF = 2 * 64 * RS;
    constexpr int NC = K / 128, PF = NC < 4 ? NC : 4;
    const int tid = C.tid, lane = C.lane, rt = C.wave >> 1, ch = C.wave & 1, r16 = lane & 15, g = lane >> 4;
    LAS unsigned char* sm = C.lds;
    const int pr0 = tid >> 4, pc = tid & 15;
    const bf16* ga = A + (size_t)(row0 + pr0) * K + 8 * pc; const bf16* gb = Bt + (size_t)(col0 + pr0) * K + 8 * pc;
    acc[0] = (f32x4){0.f, 0.f, 0.f, 0.f}; acc[1] = (f32x4){0.f, 0.f, 0.f, 0.f};
    u32x4 rr[PF][4];
#pragma unroll
    for (int p = 0; p < PF; ++p) { rr[p][0] = *(const u32x4*)(ga + 128 * p); rr[p][1] = *(const u32x4*)(ga + (size_t)32 * K + 128 * p); rr[p][2] = *(const u32x4*)(gb + 128 * p); rr[p][3] = *(const u32x4*)(gb + (size_t)32 * K + 128 * p); }
    asm volatile("" ::: "memory");
    __syncthreads();
#pragma unroll
    for (int c = 0; c < NC; ++c) {
        { LAS unsigned char* w = sm + (c & 1) * BUF + pr0 * RS + 16 * pc; *(LAS u32x4*)w = rr[c % PF][0]; *(LAS u32x4*)(w + 32 * RS) = rr[c % PF][1]; *(LAS u32x4*)(w + 64 * RS) = rr[c % PF][2]; *(LAS u32x4*)(w + 96 * RS) = rr[c % PF][3]; }
        if (c + PF < NC) { const int n = c + PF; rr[c % PF][0] = *(const u32x4*)(ga + 128 * n); rr[c % PF][1] = *(const u32x4*)(ga + (size_t)32 * K + 128 * n); rr[c % PF][2] = *(const u32x4*)(gb + 128 * n); rr[c % PF][3] = *(const u32x4*)(gb + (size_t)32 * K + 128 * n); }
        asm volatile("" ::: "memory");
        __syncthreads();
        const LAS unsigned char* rd = sm + (c & 1) * BUF;
#pragma unroll
        for (int kk = 0; kk < 4; ++kk) {
            const bf16x8 a = *(const LAS bf16x8*)(rd + (16 * rt + r16) * RS + 64 * kk + 16 * g);
            const bf16x8 b0 = *(const LAS bf16x8*)(rd + (64 + 32 * ch + r16) * RS + 64 * kk + 16 * g), b1 = *(const LAS bf16x8*)(rd + (64 + 32 * ch + 16 + r16) * RS + 64 * kk + 16 * g);
            acc[0] = mfma16(a, b0, acc[0]); acc[1] = mfma16(a, b1, acc[1]); }
    }
    __syncthreads();
}
__device__ __forceinline__ void mini_oproj(PK P, const Ctx& C, int L) {
    unsigned char* ws = P->ws; const int lane = C.lane, rt = C.wave >> 1, ch = C.wave & 1, r16 = lane & 15, g = lane >> 4;
    for (int u = C.blk; u < 256; u += C.nblk) { const int row0 = MP + 64 * (u >> 4), col0 = 64 * (u & 15);
        f32x4 a1[2], a2[2];
        mini_mma<512>((const bf16*)(ws + WS_OGR), (const bf16*)(ws + WS_WOR) + (size_t)L * DM * 512, row0, col0, C, a1);
        mini_mma<512>((const bf16*)(ws + WS_OGA), (const bf16*)(ws + WS_WOA) + (size_t)L * DM * 512, row0, col0, C, a2);
        const bf16* Z = (const bf16*)(ws + WS_Z); bf16* MB = (bf16*)(ws + WS_MB);
#pragma unroll
        for (int j = 0; j < 2; ++j)
#pragma unroll
            for (int r = 0; r < 4; ++r) { const size_t row = (size_t)(row0 + 16 * rt + 4 * g + r); const int col = col0 + 32 * ch + 16 * j + r16;
                const float m = sigmoidf_(bf2f(Z[row * NZ + ZC_GR + col])) * a1[j][r] + sigmoidf_(bf2f(Z[row * NZ + ZC_GA + col])) * a2[j][r];
                MB[row * DM + col] = (bf16)(pk2(m, 0.f) & 0xffffu); } }
}
__device__ __forceinline__ void mini_wout(PK P, const Ctx& C, int L) {
    unsigned char* ws = P->ws; const int lane = C.lane, rt = C.wave >> 1, ch = C.wave & 1, r16 = lane & 15, g = lane >> 4;
    const float* xs = P->in[I_XS] - (size_t)MP * DM;
    const bf16* xh = (const bf16*)(ws + WS_XB0);
    for (int u = C.blk; u < 256; u += C.nblk) { const int row0 = MP + 64 * (u >> 4), col0 = 64 * (u & 15);
        f32x4 a1[2];
        mini_mma<1024>((const bf16*)(ws + WS_MB), (const bf16*)(ws + WS_WOUT) + (size_t)L * DM * DM, row0, col0, C, a1);
        bf16* XB1 = (bf16*)(ws + WS_XB1);
#pragma unroll
        for (int j = 0; j < 2; ++j)
#pragma unroll
            for (int r = 0; r < 4; ++r) { const size_t row = (size_t)(row0 + 16 * rt + 4 * g + r); const int col = col0 + 32 * ch + 16 * j + r16;
                const float x = (L == 0) ? xs[row * DM + col] : bf2f(xh[row * DM + col]);
                XB1[row * DM + col] = (bf16)(pk2(x + a1[j][r], 0.f) & 0xffffu); } }
}
__device__ __forceinline__ void mini_ple(PK P, const Ctx& C, int L, bool do_ss = true) {
    unsigned char* ws = P->ws; const int lane = C.lane, rt = C.wave >> 1, ch = C.wave & 1, r16 = lane & 15, g = lane >> 4;
    float* rowss = (L + 1 < DEPTH && do_ss) ? (float*)(ws + WS_CTL) + CW_ROWSS1 : nullptr;
    for (int u = C.blk; u < 256; u += C.nblk) { const int row0 = MP + 64 * (u >> 4), col0 = 64 * (u & 15);
        f32x4 a1[2], a2[2];
        mini_mma<1024>((const bf16*)(ws + WS_XB1), (const bf16*)(ws + WS_WPG) + (size_t)L * DM * DM, row0, col0, C, a1);
        mini_mma<256>((const bf16*)(ws + WS_PB) + (size_t)L * MT * 256, (const bf16*)(ws + WS_WPP) + (size_t)L * DM * 256, row0, col0, C, a2);
        const bf16* XB1 = (const bf16*)(ws + WS_XB1); float* Y = P->out; bf16* XB0 = (bf16*)(ws + WS_XB0);
#pragma unroll
        for (int r = 0; r < 4; ++r) { const size_t row = (size_t)(row0 + 16 * rt + 4 * g + r); float ssq = 0.f;
#pragma unroll
            for (int j = 0; j < 2; ++j) { const int col = col0 + 32 * ch + 16 * j + r16;
                const float v = bf2f(XB1[row * DM + col]) + sigmoidf_(a1[j][r]) * a2[j][r]; if (L + 1 == DEPTH) Y[row * DM + col] = v; XB0[row * DM + col] = (bf16)(pk2(v, 0.f) & 0xffffu); ssq += v * v; }
            if (rowss != nullptr) { ssq += shx<1>(ssq, lane); ssq += shx<2>(ssq, lane); ssq += shx<4>(ssq, lane); ssq += shx<8>(ssq, lane); if (r16 == 0) atomicAdd(rowss + row, ssq); } } }
}


__device__ __forceinline__ void mini_inproj_gates(PK P, const Ctx& C, int L) {
    unsigned char* ws = P->ws; const int lane = C.lane, rt = C.wave >> 1, ch = C.wave & 1, r16 = lane & 15, g = lane >> 4;
    const float* rowss = (L == 0) ? (const float*)(ws + WS_ROWSS0) : (const float*)(ws + WS_CTL) + CW_ROWSS1;
    bf16* Z = (bf16*)(ws + WS_Z);
    for (int u = C.blk; u < 16 * 30; u += C.nblk) { const int row0 = MP + 64 * (u / 30), col0 = 15 * 256 + 64 * (u % 30);
        f32x4 a1[2];
        mini_mma<1024>((const bf16*)(ws + WS_XB0), (const bf16*)(ws + WS_WIN) + (size_t)L * NZ * DM, row0, col0, C, a1);
#pragma unroll
        for (int r = 0; r < 4; ++r) { const size_t row = (size_t)(row0 + 16 * rt + 4 * g + r); const float rs = __builtin_amdgcn_rsqf(rowss[row] * (1.0f / 1024.0f) + 1e-6f);
#pragma unroll
            for (int j = 0; j < 2; ++j) Z[row * NZ + col0 + 32 * ch + 16 * j + r16] = (bf16)(pk2(a1[j][r] * rs, 0.f) & 0xffffu); } }
}
__global__ void __launch_bounds__(NTHREADS, 2) mk_fwd(Params Pval) {
    extern __shared__ __attribute__((aligned(16))) unsigned char lds_raw[];
    LAS unsigned char* lds = (LAS unsigned char*)lds_raw;
    volatile LAS unsigned* MISC = (volatile LAS unsigned*)(lds + MISC_OFF);
    const int wave_s = __builtin_amdgcn_readfirstlane((int)threadIdx.x >> 6);
    for (int u = wave_s * 64 + hw_lane(); u < (LDS_BYTES - RING_BYTES) / 4; u += NTHREADS) ((LAS unsigned*)(lds + RING_BYTES))[u] = 0u;
    __syncthreads();
    const int lo = Pval.ph_lo, hi = Pval.ph_hi;
    XcdBarrier bar; bar.bar = (unsigned*)(Pval.ws + WS_CTL) + CW_BAR + Pval.li * XCD_BAR_WORDS; bar.x = 0; bar.st = MISC + 8;
    if (hi - lo > 1) bar = xcd_barrier_post(bar.bar, MISC + 8, wave_s == 0 && hw_lane() == 0);
#ifndef STEPSEL
#define STEPSEL(j) true
#endif
#define IN(k) (lo <= (k) && (k) < hi)
#ifndef DUPMASK
#define DUPMASK 0
#endif
#ifndef XBAR2
#define XBAR2 0
#endif
#ifndef MINI2
#define MINI2 0
#endif
#ifndef DUPMODE
#define DUPMODE 3
#endif
#ifndef CSEL
#define CSEL 15
#endif
#define INL(j) (STEPSEL(j) && IN(pb + (j)))
#define NREP(j) (((DUPMASK) >> (j)) & 1 ? 2 : 1)
#define SEAM(k) do { if (IN((k) + 1)) { XcdBarrier b2_ = bar; asm volatile("" : "+s"(b2_.bar), "+s"(b2_.x)); int t0_ = wave_s * 64 + hw_lane(salt_); asm volatile("" : "+v"(t0_)); xcd_barrier(b2_, t0_ == 0); if (XBAR2) xcd_barrier(b2_, t0_ == 0); } } while (0)
#define PH_ENTER() PK P = phase_args(); const Ctx C = phase_ctx(lds, wave_s, salt_); unsigned char* ws = P->ws; (void)ws; (void)C
    #ifndef PRODUP
#define PRODUP 1
#endif
    const int salt_ = 0;
    if (STEPSEL(-1) && IN(0)) { for (int rep = 0; rep < PRODUP; ++rep) { PH_ENTER(); p0_prologue(P, C); __syncthreads(); } SEAM(0); }
#pragma unroll 1
    for (int L = 0; L < DEPTH; ++L) {
        const int pb = 1 + 8 * L; const int salt_ = pb;
        if (INL(0)) {
            if (blockIdx.x & 1) for (int rm = 0; rm < (MINI2 ? 2 : 1); ++rm) { PH_ENTER(); mini_inproj_gates(P, C, L); }
            for (int rep = 0; rep < NREP(0); ++rep) { PH_ENTER();
            pg8::Gemm g{(const bf16*)(ws + WS_XB0), (const bf16*)(ws + WS_WIN) + (size_t)L * NZ * DM, MT, NZ, DM}; InProjOrder S; S.init(C.nblk, C.blk);
            EpiZ E{ws, P->out, L == 0 ? (const float*)(ws + WS_ROWSS0) : (const float*)(ws + WS_CTL) + CW_ROWSS1, P->in[I_QG] + L * 64, P->in[I_KG] + L * 64, L, lds + XPOSE_OFF};
            pg8::gemm_phase<EpiZ, InProjOrder, true, true>(lds, g, S, E, C.tid); }
            if (!(blockIdx.x & 1)) for (int rm = 0; rm < (MINI2 ? 2 : 1); ++rm) { PH_ENTER(); mini_inproj_gates(P, C, L); }
            SEAM(pb + 0); }
        if (INL(1)) { for (int rep = 0; rep < NREP(1); ++rep) { PH_ENTER(); (void)P; (void)C; }   }
        if (INL(2)) { for (int rep = 0; rep < NREP(2); ++rep) { PH_ENTER(); phase_c(P, C, L, rep == 0 ? 15 : CSEL); __syncthreads(); } SEAM(pb + 2); }
        if (INL(3)) { for (int rep = 0; rep < NREP(3); ++rep) { PH_ENTER(); phase_d(P, C, L, rep == 0 ? 3 : DUPMODE); __syncthreads(); } SEAM(pb + 3); }
        if (INL(4)) {   }
        if (INL(5)) {
            for (int rep = 0; rep < NREP(5); ++rep) {
            { PH_ENTER(); mini_oproj(P, C, L); }
            { PH_ENTER(); pg8::StaticOrder S; S.init(MP, DM, C.nblk, C.blk);
              pg8::Gemm g{(const bf16*)(ws + WS_OGR), (const bf16*)(ws + WS_WOR) + (size_t)L * DM * 512, MP, DM, 512}; EpiGate<0> E{(const bf16*)(ws + WS_Z), ZC_GR, (bf16*)(ws + WS_TMP), (bf16*)(ws + WS_MB)};
              pg8::gemm_phase<EpiGate<0>, pg8::StaticOrder, true, true>(lds, g, S, E, C.tid); }
            { PH_ENTER(); pg8::StaticOrder S; S.init(MP, DM, C.nblk, C.blk);
              pg8::Gemm g{(const bf16*)(ws + WS_OGA), (const bf16*)(ws + WS_WOA) + (size_t)L * DM * 512, MP, DM, 512}; EpiGate<1> E{(const bf16*)(ws + WS_Z), ZC_GA, (bf16*)(ws + WS_TMP), (bf16*)(ws + WS_MB)};
              pg8::gemm_phase<EpiGate<1>, pg8::StaticOrder, true, true>(lds, g, S, E, C.tid); } }
            SEAM(pb + 5); }
        if (INL(6)) {
            for (int rep = 0; rep < NREP(6); ++rep) {
            { PH_ENTER(); mini_wout(P, C, L); }
            { PH_ENTER(); pg8::StaticOrder S; S.init(MP, DM, C.nblk, C.blk);
            pg8::Gemm g{(const bf16*)(ws + WS_MB), (const bf16*)(ws + WS_WOUT) + (size_t)L * DM * DM, MP, DM, DM};
            EpiRes E{P->in[I_XP], P->in[I_XS], L == 0 ? (const bf16*)nullptr : (const bf16*)(ws + WS_XB0), (bf16*)(ws + WS_XB1)};
            pg8::gemm_phase<EpiRes, pg8::StaticOrder, true, true>(lds, g, S, E, C.tid); } }
            SEAM(pb + 6); }
        if (INL(7)) {
            for (int rep = 0; rep < NREP(7); ++rep) {
            { PH_ENTER(); mini_ple(P, C, L, rep == NREP(7) - 1); }
            { PH_ENTER(); pg8::StaticOrder S; S.init(MP, DM, C.nblk, C.blk);
              pg8::Gemm g{(const bf16*)(ws + WS_XB1), (const bf16*)(ws + WS_WPG) + (size_t)L * DM * DM, MP, DM, DM}; EpiPle<0> E{(bf16*)(ws + WS_TMP), (const bf16*)(ws + WS_XB1), nullptr, (bf16*)(ws + WS_XB0), nullptr};
              pg8::gemm_phase<EpiPle<0>, pg8::StaticOrder, true, true>(lds, g, S, E, C.tid); }
            if (L + 1 < DEPTH) { PH_ENTER(); pg8::StaticOrder S; S.init(MP, DM, C.nblk, C.blk);
                pg8::Gemm g{(const bf16*)(ws + WS_PB) + (size_t)L * MT * 256, (const bf16*)(ws + WS_WPP) + (size_t)L * DM * 256, MP, DM, 256};
                EpiPle<1> E{(bf16*)(ws + WS_TMP), (const bf16*)(ws + WS_XB1), P->out, (bf16*)(ws + WS_XB0), (float*)(ws + WS_CTL) + CW_ROWSS1};
                pg8::gemm_phase<EpiPle<1>, pg8::StaticOrder, true, true>(lds, g, S, E, C.tid); }
            else { PH_ENTER(); pg8::StaticOrder S; S.init(MP, DM, C.nblk, C.blk);
                pg8::Gemm g{(const bf16*)(ws + WS_PB) + (size_t)L * MT * 256, (const bf16*)(ws + WS_WPP) + (size_t)L * DM * 256, MP, DM, 256};
                EpiPle<2> E{(bf16*)(ws + WS_TMP), (const bf16*)(ws + WS_XB1), P->out, (bf16*)(ws + WS_XB0), (float*)(ws + WS_CTL) + CW_ROWSS1};
                pg8::gemm_phase<EpiPle<2>, pg8::StaticOrder, true, true>(lds, g, S, E, C.tid); } }
            SEAM(pb + 7); }
    }
#undef IN
#undef INL
#undef SEAM
#undef PH_ENTER
}

#ifndef MK_N_LAUNCHES
#define MK_N_LAUNCHES 1
#endif
extern "C" void kernel_launch(void* const* d_in, const int* in_sizes, int n_in, void* d_out, int out_size, void* d_ws, size_t ws_size, hipStream_t stream) {
    static int grid = 0;
    if (grid == 0) {
        if (n_in != 18 || out_size != (int)O_END || ws_size < WS_END) { fprintf(stderr, "kernel_launch: unexpected problem: n_in %d out %d ws %zu; nothing launched\n", n_in, out_size, ws_size); grid = -1; return; }
        int dev = 0, cus = 0, per_cu = 0;
        if (hipGetDevice(&dev) != hipSuccess || hipDeviceGetAttribute(&cus, hipDeviceAttributeMultiprocessorCount, dev) != hipSuccess) { grid = -1; return; }
        if (hipFuncSetAttribute((const void*)mk_fwd, hipFuncAttributeMaxDynamicSharedMemorySize, LDS_BYTES) != hipSuccess) { fprintf(stderr, "kernel_launch: hipFuncSetAttribute failed\n"); grid = -1; return; }
        if (hipOccupancyMaxActiveBlocksPerMultiprocessor(&per_cu, (const void*)mk_fwd, NTHREADS, LDS_BYTES) != hipSuccess || per_cu < 1) { fprintf(stderr, "kernel_launch: occupancy query says %d blocks per CU\n", per_cu); grid = -1; (void)hipGetLastError(); return; }
        grid = cus;
    }
    if (grid < 0) return;
    (void)hipMemsetAsync((char*)d_ws + WS_CTL, 0, CTL_ZERO_BYTES, stream);
    Params a{};
    for (int i = 0; i < 18; ++i) a.in[i] = (const float*)d_in[i];
    a.out = (float*)d_out; a.ws = (unsigned char*)d_ws;
#if MK_N_LAUNCHES == 1
    a.ph_lo = 0; a.ph_hi = N_PHASES; a.li = 0;
    hipLaunchKernelGGL(mk_fwd, dim3(grid), dim3(NTHREADS), LDS_BYTES, stream, a);
#else
    for (int li = 0; li < N_PHASES; ++li) { a.ph_lo = li; a.ph_hi = li + 1; a.li = 0; hipLaunchKernelGGL(mk_fwd, dim3(grid), dim3(NTHREADS), LDS_BYTES, stream, a); }
#endif
    (void)in_sizes;
}
```

```cpp
#include <hip/hip_runtime.h>
#include <cstdio>
#include <cstdint>
namespace pg8 {
#define PG8_LAS __attribute__((address_space(3)))
typedef unsigned short bf16_t;
typedef short bf16x8 __attribute__((ext_vector_type(8)));
typedef float f32x4 __attribute__((ext_vector_type(4)));
typedef unsigned u32x4 __attribute__((ext_vector_type(4)));
constexpr int BM = 256, BK = 64, HALF = 128, HTB = HALF * BK * 2  , STAGE_BYTES = 8 * HTB, NXCD = 8, WGM = 8;

__host__ __device__ __forceinline__ int lds_byte(int r, int c) { const int st = (r >> 4) * 2 + (c >> 5), rr = r & 15, cc = c & 31, ob = rr * 64 + cc * 2; return st * 1024 + (ob ^ (((ob >> 9) & 1) << 5)); }
__host__ __device__ __forceinline__ void stage_rc(int b, int& R, int& C) { const int st = b / 1024, sb = b % 1024, swz = sb ^ (((sb >> 9) & 1) << 5); R = (st >> 1) * 16 + swz / 64; C = (st & 1) * 32 + (swz % 64) / 2; }
__host__ __device__ __forceinline__ int perm32(int rho) { const int n = rho >> 4, i = rho & 15; return 8 * (i >> 2) + 4 * n + (i & 3); }

struct Unit { int pm, pn; };
struct Gemm { const bf16_t* A; const bf16_t* Bt; int M, N, K; };

struct StaticOrder {
    int nM, nN, nwg, G, c;
    __host__ __device__ void init(int M, int N, int G_, int c_) { nM = M / BM; nN = N / BM; nwg = nM * nN; G = G_; c = c_; }
    __host__ __device__ bool next(int i, Unit& u) const {
        const int L = i * G + c; if (L >= nwg) return false;
        int wgid = L; { const int q = nwg / NXCD, r = nwg % NXCD, xcd = wgid % NXCD, off = wgid / NXCD; wgid = (xcd < r ? xcd * (q + 1) : r * (q + 1) + (xcd - r) * q) + off; }
        const int nig = WGM * nN, gid = wgid / nig, fm = gid * WGM, gsz = (nM - fm) < WGM ? (nM - fm) : WGM;
        u.pm = fm + ((wgid % nig) % gsz); u.pn = (wgid % nig) / gsz; return true;
    }
    __device__ __forceinline__ void a_ready(const Unit&) const {}
    __device__ __forceinline__ void done(const Unit&) const {}
};
__device__ __forceinline__ unsigned cvt_pk_bf16(float lo, float hi) { unsigned r; asm volatile("v_cvt_pk_bf16_f32 %0, %1, %2" : "=v"(r) : "v"(lo), "v"(hi)); return r; }

template <class Epi, class Sched, bool ALIGN_EPI = false, bool SP2 = false>
__device__ __forceinline__ void gemm_phase(PG8_LAS unsigned char* lds, const Gemm g, const Sched& S, const Epi& E, int tid_) {
    asm volatile("" : "+v"(tid_)); const int tid = tid_, wid = __builtin_amdgcn_readfirstlane(tid >> 6), lane = tid & 63, wr = wid >> 2, wc = wid & 3, fr = lane & 15, fq = lane >> 4;
    const int K = g.K, nt = K / BK;
    unsigned voffA[2], voffB[2];
#pragma unroll
    for (int i = 0; i < 2; ++i) { int R, C; stage_rc(tid * 16 + i * 8192, R, C); const int Rb = Epi::PERM ? ((R & ~31) + perm32(R & 31)) : R;
        voffA[i] = (unsigned)(R * K + C) * 2u; voffB[i] = (unsigned)(Rb * K + C) * 2u; }
    const size_t kstep = (size_t)(BK * 2);
    const size_t hstep = (size_t)HALF * K * 2;
    const size_t tstep = 2 * hstep;
    const unsigned ldsw = (unsigned)wid * 1024u;
    const int aoff = lds_byte(wr * 64 + fr, fq * 8), boff = lds_byte(wc * 32 + fr, fq * 8);
#define PG8_SA(b, h) (((b) * 2 + (h)) * HTB)
#define PG8_SB(b, h) ((4 + (b) * 2 + (h)) * HTB)
#define PG8_STAGE(bufoff, gbase, voff) do { _Pragma("unroll") for (int _i = 0; _i < 2; ++_i) \
        __builtin_amdgcn_global_load_lds((const unsigned*)((const char*)(gbase) + (voff)[_i]), (PG8_LAS unsigned*)(lds + (bufoff) + ldsw + _i * 8192), 16, 0, 0); } while (0)
#define PG8_LDA(dst, b, h) do { _Pragma("unroll") for (int m = 0; m < 4; ++m) _Pragma("unroll") for (int k = 0; k < 2; ++k) dst[m][k] = *(const PG8_LAS bf16x8*)(lds + PG8_SA(b, h) + aoff + m * 2048 + k * 1024); } while (0)
#define PG8_LDB(dst, b, h) do { _Pragma("unroll") for (int n = 0; n < 2; ++n) _Pragma("unroll") for (int k = 0; k < 2; ++k) dst[n][k] = *(const PG8_LAS bf16x8*)(lds + PG8_SB(b, h) + boff + n * 2048 + k * 1024); } while (0)
#define PG8_MMA(ai, bj, At, Bt) do { __builtin_amdgcn_s_setprio(1); _Pragma("unroll") for (int m = 0; m < 4; ++m) _Pragma("unroll") for (int n = 0; n < 2; ++n) _Pragma("unroll") for (int k = 0; k < 2; ++k) \
        acc[ai][bj][m][n] = __builtin_amdgcn_mfma_f32_16x16x32_bf16(Bt[n][k], At[m][k], acc[ai][bj][m][n], 0, 0, 0); __builtin_amdgcn_s_setprio(0); } while (0)
#define PG8_WAIT_V(n) asm volatile("s_waitcnt vmcnt(" #n ")" ::: "memory")
#define PG8_WAIT_L(n) asm volatile("s_waitcnt lgkmcnt(" #n ")" ::: "memory")
#define PG8_BAR __builtin_amdgcn_s_barrier()
#define PG8_SCHED __builtin_amdgcn_sched_barrier(0)
    Unit cur, nxt; int ui = 0;
    if (!S.next(0, cur)) return;
    f32x4 acc[2][2][4][2];
#pragma unroll
    for (int a = 0; a < 2; ++a)
#pragma unroll
        for (int b = 0; b < 2; ++b)
#pragma unroll
            for (int m = 0; m < 4; ++m)
#pragma unroll
                for (int n = 0; n < 2; ++n) acc[a][b][m][n] = (f32x4){0.f, 0.f, 0.f, 0.f};
    bf16x8 At[4][2], B0[2][2], B1[2][2];
    const char* cA = (const char*)g.A + (size_t)cur.pm * tstep; const char* cB = (const char*)g.Bt + (size_t)cur.pn * tstep;
    S.a_ready(cur);
    if constexpr (SP2) {
        PG8_STAGE(PG8_SB(0, 0), cB, voffB); PG8_STAGE(PG8_SB(0, 1), cB + hstep, voffB); PG8_STAGE(PG8_SA(0, 0), cA, voffA); PG8_STAGE(PG8_SA(0, 1), cA + hstep, voffA);
        if (wr == 1) PG8_BAR;
        PG8_WAIT_V(2); PG8_BAR;
        PG8_STAGE(PG8_SB(1, 0), cB + kstep, voffB); PG8_STAGE(PG8_SA(1, 0), cA + kstep, voffA); PG8_STAGE(PG8_SB(1, 1), cB + hstep + kstep, voffB);
        PG8_WAIT_V(6); PG8_BAR;
    } else {
        PG8_STAGE(PG8_SB(0, 0), cB, voffB); PG8_STAGE(PG8_SA(0, 0), cA, voffA); PG8_STAGE(PG8_SB(0, 1), cB + hstep, voffB); PG8_STAGE(PG8_SA(0, 1), cA + hstep, voffA);
        if (wr == 1) PG8_BAR;
        PG8_WAIT_V(4); PG8_BAR;
        PG8_STAGE(PG8_SB(1, 0), cB + kstep, voffB); PG8_STAGE(PG8_SA(1, 0), cA + kstep, voffA); PG8_STAGE(PG8_SB(1, 1), cB + hstep + kstep, voffB);
        PG8_WAIT_V(6); PG8_BAR;
    }
    for (;;) {
        const bool has_next = S.next(ui + 1, nxt);
        const char* nA = has_next ? (const char*)g.A + (size_t)nxt.pm * tstep : cA; const char* nB = has_next ? (const char*)g.Bt + (size_t)nxt.pn * tstep : cB;
        for (int t = 0; t < nt; t += 2) {
            const bool last = (t == nt - 2);
            const char* a1 = cA + (size_t)(t + 1) * kstep;
            const char* a2 = last ? nA : cA + (size_t)(t + 2) * kstep; const char* b2 = last ? nB : cB + (size_t)(t + 2) * kstep;
            const char* a3 = a2 + kstep; const char* b3 = b2 + kstep;
            if (last && has_next) S.a_ready(nxt);
            if constexpr (SP2) {
            PG8_LDB(B0, 0, 0); PG8_LDB(B1, 0, 1); PG8_SCHED; PG8_LDA(At, 0, 0); PG8_STAGE(PG8_SA(1, 1), a1 + hstep, voffA);
            PG8_WAIT_V(8); PG8_WAIT_L(0); PG8_BAR; PG8_MMA(0, 0, At, B0); PG8_MMA(0, 1, At, B1); PG8_BAR; PG8_SCHED;
            PG8_LDA(At, 0, 1); PG8_STAGE(PG8_SB(0, 0), b2, voffB); PG8_STAGE(PG8_SB(0, 1), b2 + hstep, voffB); PG8_STAGE(PG8_SA(0, 0), a2, voffA);
            PG8_WAIT_V(8); PG8_WAIT_L(0); PG8_BAR; PG8_MMA(1, 0, At, B0); PG8_MMA(1, 1, At, B1); PG8_BAR; PG8_SCHED;
            PG8_LDB(B0, 1, 0); PG8_LDB(B1, 1, 1); PG8_SCHED; PG8_LDA(At, 1, 0); PG8_STAGE(PG8_SA(0, 1), a2 + hstep, voffA);
            PG8_WAIT_V(8); PG8_WAIT_L(0); PG8_BAR; PG8_MMA(0, 0, At, B0); PG8_MMA(0, 1, At, B1); PG8_BAR; PG8_SCHED;
            PG8_LDA(At, 1, 1); PG8_STAGE(PG8_SB(1, 0), b3, voffB); PG8_STAGE(PG8_SB(1, 1), b3 + hstep, voffB); PG8_STAGE(PG8_SA(1, 0), a3, voffA);
            PG8_WAIT_V(8); PG8_WAIT_L(0); PG8_BAR; PG8_MMA(1, 0, At, B0); PG8_MMA(1, 1, At, B1); PG8_BAR; PG8_SCHED;
            } else {
            PG8_LDB(B0, 0, 0); PG8_SCHED; PG8_LDA(At, 0, 0); PG8_STAGE(PG8_SA(1, 1), a1 + hstep, voffA);
            PG8_WAIT_L(8); PG8_BAR; PG8_WAIT_L(0); PG8_MMA(0, 0, At, B0); PG8_BAR; PG8_SCHED;
            PG8_LDB(B1, 0, 1); PG8_STAGE(PG8_SB(0, 0), b2, voffB);
            PG8_BAR; PG8_WAIT_L(0); PG8_MMA(0, 1, At, B1); PG8_BAR;
            PG8_LDA(At, 0, 1); PG8_STAGE(PG8_SA(0, 0), a2, voffA);
            PG8_BAR; PG8_WAIT_L(0); PG8_MMA(1, 0, At, B0); PG8_BAR; PG8_SCHED;
            PG8_STAGE(PG8_SB(0, 1), b2 + hstep, voffB);
            PG8_WAIT_V(6); PG8_BAR; PG8_MMA(1, 1, At, B1); PG8_BAR;
            PG8_LDB(B0, 1, 0); PG8_SCHED; PG8_LDA(At, 1, 0); PG8_STAGE(PG8_SA(0, 1), a2 + hstep, voffA);
            PG8_WAIT_L(8); PG8_BAR; PG8_WAIT_L(0); PG8_MMA(0, 0, At, B0); PG8_BAR; PG8_SCHED;
            PG8_LDB(B1, 1, 1); PG8_STAGE(PG8_SB(1, 0), b3, voffB);
            PG8_BAR; PG8_WAIT_L(0); PG8_MMA(0, 1, At, B1); PG8_BAR;
            PG8_LDA(At, 1, 1); PG8_STAGE(PG8_SA(1, 0), a3, voffA);
            PG8_BAR; PG8_WAIT_L(0); PG8_MMA(1, 0, At, B0); PG8_BAR; PG8_SCHED;
            PG8_STAGE(PG8_SB(1, 1), b3 + hstep, voffB);
            PG8_WAIT_V(6); PG8_BAR; PG8_MMA(1, 1, At, B1); PG8_BAR;
            }
        }
        if constexpr (ALIGN_EPI) { if (wr == 0) PG8_BAR; }
        if constexpr (!Epi::AFTER_DRAIN) { E(acc, cur, wr, wc, fr, fq); S.done(cur); }
        if (!has_next) break;
#pragma unroll
        for (int a = 0; a < 2; ++a)
#pragma unroll
            for (int b = 0; b < 2; ++b)
#pragma unroll
                for (int m = 0; m < 4; ++m)
#pragma unroll
                    for (int n = 0; n < 2; ++n) acc[a][b][m][n] = (f32x4){0.f, 0.f, 0.f, 0.f};
        cur = nxt; cA = nA; cB = nB; ++ui;
        if constexpr (ALIGN_EPI) { if (wr == 1) PG8_BAR; }
    }
    PG8_WAIT_V(0);
    if constexpr (!ALIGN_EPI) { if (wr == 0) PG8_BAR; }
    PG8_BAR;
    if constexpr (Epi::AFTER_DRAIN) { E.fused(acc, cur, wr, wc, fr, fq, lds, wid, lane); S.done(cur); }
#undef PG8_SA
#undef PG8_SB
#undef PG8_STAGE
#undef PG8_LDA
#undef PG8_LDB
#undef PG8_MMA
#undef PG8_WAIT_V
#undef PG8_WAIT_L
#undef PG8_BAR
#undef PG8_SCHED
}
}

#define GAS __attribute__((address_space(1)))
#define LAS __attribute__((address_space(3)))
typedef unsigned short bf16;
typedef float f32x4 __attribute__((ext_vector_type(4)));
typedef float f32x2 __attribute__((ext_vector_type(2)));
typedef float f32x16 __attribute__((ext_vector_type(16)));
typedef short bf16x8 __attribute__((ext_vector_type(8)));
typedef unsigned u32x4 __attribute__((ext_vector_type(4)));
typedef unsigned u32x2 __attribute__((ext_vector_type(2)));

constexpr int NWAVES = 8, NTHREADS = 512;
constexpr int DM = 1024, NB = 4, SEQ = 4096, DEPTH = 2, DB = 128, DS = 8, PAST = 2048, NPAGES = 16, NPOOL = 2560;
constexpr int MP = NB * SEQ, MS = DB * DS, MT = MP + MS;
constexpr int NZ = 5888;
constexpr int WIN_N = 5700;
constexpr int ZC_RQ = 0, ZC_RK = 512, ZC_RV = 1024, ZC_RZ = 1536, ZC_AQ = 2048, ZC_AK = 2560, ZC_AV = 2688, ZC_AZ = 2816, ZC_IQ = 3328, ZC_IK = 3584, ZC_IW = 3648, ZC_GR = 3712, ZC_GA = 4736;
constexpr int SS_LD = 2064;
constexpr int TOPK = 256;
constexpr size_t O_Y = 0, O_KP = 17825792, O_VP = 22020096, O_IKP = 26214400, O_RSP = 28311552, O_KS = 28835840, O_VS = 29097984, O_IKS = 29360128, O_RSS = 29491200, O_END = 46268416;
constexpr size_t MiB = 1u << 20;
constexpr size_t WS_CTL = 0, CTL_ZERO_BYTES = 1 * MiB;
constexpr size_t WS_WIN = 1 * MiB, WS_WOR = 24 * MiB, WS_WOA = 26 * MiB, WS_WOUT = 28 * MiB, WS_WPG = 32 * MiB, WS_WPP = 36 * MiB;
constexpr size_t WS_ROPER = 37 * MiB, WS_ROPEA = 39 * MiB, WS_ROWSS0 = 39 * MiB + 256 * 1024, WS_IW = 39 * MiB + 512 * 1024;
constexpr size_t WS_XB0 = 40 * MiB, WS_XB1 = 74 * MiB, WS_X1 = 108 * MiB, WS_TMP = 176 * MiB, WS_MB = 244 * MiB, WS_Z = 278 * MiB;
constexpr size_t WS_RQ = 474 * MiB, WS_RK = 490 * MiB, WS_RKT = 506 * MiB, WS_RVT = 522 * MiB, WS_AQ = 538 * MiB, WS_KB = 555 * MiB, WS_VB = 559 * MiB;
constexpr size_t WS_IQ = 563 * MiB, WS_IKB = 572 * MiB, WS_PB = 930 * MiB, WS_KVT = 583 * MiB, WS_ST = 615 * MiB, WS_OGR = 631 * MiB, WS_OGA = 648 * MiB;
constexpr size_t WS_SS = 665 * MiB, WS_SP = 674 * MiB, WS_END = 948 * MiB;
static_assert(WS_Z + (size_t)MT * NZ * 2 <= WS_RQ && WS_SS + (size_t)MS * SS_LD * 4 <= WS_SP && WS_IW + (size_t)MT * 16 <= WS_XB0, "ws map");
constexpr int CW_TMO = 0, CW_BAR = 4096, CW_ROWSS1 = 131072;
constexpr int N_PHASES = 1 + 8 * DEPTH;
constexpr int RING_BYTES = 131072, MISC_OFF = RING_BYTES + 320, XPOSE_OFF = RING_BYTES + 1024, LDS_BYTES = XPOSE_OFF + 8 * 2048;

#define LDS_WAIT() asm volatile("s_waitcnt lgkmcnt(0)" ::: "memory")
#define VM_WAIT() asm volatile("s_waitcnt vmcnt(0)" ::: "memory")
__device__ __forceinline__ unsigned pk2(float lo, float hi) { unsigned r; asm("v_cvt_pk_bf16_f32 %0, %1, %2" : "=v"(r) : "v"(lo), "v"(hi)); return r; }
__device__ __forceinline__ float bflo(unsigned w) { return __uint_as_float(w << 16); }
__device__ __forceinline__ float bfhi(unsigned w) { return __uint_as_float(w & 0xffff0000u); }
__device__ __forceinline__ float bf2f(bf16 b) { return __uint_as_float(((unsigned)b) << 16); }
__device__ __forceinline__ float sigmoidf_(float x) { return __builtin_amdgcn_rcpf(1.0f + __builtin_amdgcn_exp2f(x * -1.4426950408889634f)); }
__device__ __forceinline__ float siluf_(float x) { return x * sigmoidf_(x); }
__device__ __forceinline__ void unpack8(const u32x4 w, float (&f)[8]) { f[0] = bflo(w.x); f[1] = bfhi(w.x); f[2] = bflo(w.y); f[3] = bfhi(w.y); f[4] = bflo(w.z); f[5] = bfhi(w.z); f[6] = bflo(w.w); f[7] = bfhi(w.w); }
__device__ __forceinline__ u32x4 pack8(const float (&f)[8]) { u32x4 w; w.x = pk2(f[0], f[1]); w.y = pk2(f[2], f[3]); w.z = pk2(f[4], f[5]); w.w = pk2(f[6], f[7]); return w; }
__device__ __forceinline__ bf16x8 as_bf16x8(const u32x4 w) { return __builtin_bit_cast(bf16x8, w); }
__device__ __forceinline__ f32x4 mfma16(bf16x8 a, bf16x8 b, f32x4 c) { return __builtin_amdgcn_mfma_f32_16x16x32_bf16(a, b, c, 0, 0, 0); }
__device__ __forceinline__ f32x16 mfma32(bf16x8 a, bf16x8 b, f32x16 c) { return __builtin_amdgcn_mfma_f32_32x32x16_bf16(a, b, c, 0, 0, 0); }
__device__ __forceinline__ float ret_log2g(int h) { return h == 0 ? -0.04580369f : h == 1 ? -0.022720076f : h == 2 ? -0.011315313f : -0.0056465627f; }
__device__ __forceinline__ int mbcnt64(unsigned long long m) { return (int)__builtin_amdgcn_mbcnt_hi((unsigned)(m >> 32), __builtin_amdgcn_mbcnt_lo((unsigned)m, 0u)); }

template <int M> __device__ __forceinline__ float shx(float v, int lane) {
    if constexpr (M < 32) return __int_as_float(__builtin_amdgcn_ds_swizzle(__float_as_int(v), 0x1F | (M << 10)));
    else return __int_as_float(__builtin_amdgcn_ds_bpermute((lane ^ 32) << 2, __float_as_int(v)));
}
__device__ __forceinline__ float wave_sum(float v, int lane) { v += shx<1>(v, lane); v += shx<2>(v, lane); v += shx<4>(v, lane); v += shx<8>(v, lane); v += shx<16>(v, lane); v += shx<32>(v, lane); return v; }

#define XB_TMO      128
#define XB_XCNT(j)  (256  + 64 * (j))
#define XB_XSUB(j)  (1280 + 64 * (j))
#define XB_XGEN(j)  (2304 + 64 * (j))
#define XB_TOP      3328
#define XB_TOPGEN   3392
#define XCD_BAR_WORDS 3456
#define XB_SPIN_CAP (1u << 18)
__device__ __forceinline__ unsigned xb_ld(unsigned* p)              { return __hip_atomic_load(p, __ATOMIC_RELAXED, __HIP_MEMORY_SCOPE_AGENT); }
__device__ __forceinline__ unsigned xb_add(unsigned* p, unsigned v) { return __hip_atomic_fetch_add(p, v, __ATOMIC_RELAXED, __HIP_MEMORY_SCOPE_AGENT); }
__device__ __forceinline__ unsigned xb_xcc_id() { return (unsigned)__builtin_amdgcn_s_getreg((3 << 11) | 20) & 0xFu; }
#define XB_SPIN(cond, bar) do { unsigned _sp = 0; while (cond) { __builtin_amdgcn_s_sleep(1); \
    if ((++_sp & 255u) == 0u) { if (xb_ld(&(bar)[XB_TMO])) break; if (_sp > XB_SPIN_CAP) { atomicAdd(&(bar)[XB_TMO], 1u); break; } } } } while (0)
struct XcdBarrier { unsigned* bar; unsigned x; volatile LAS unsigned* st; };
__device__ __forceinline__ XcdBarrier xcd_barrier_post(unsigned* bar, volatile LAS unsigned* st, bool leader) {
    XcdBarrier b; b.bar = bar; b.x = xb_xcc_id(); b.st = st;
    if (leader) (void)xb_add(&bar[XB_XCNT(b.x)], 1u);
    return b;
}
__device__ __forceinline__ void xcd_barrier_complete(unsigned* bar, unsigned x, unsigned& nloc, unsigned& nx) {
    const unsigned G = gridDim.x * gridDim.y * gridDim.z;
    unsigned sum, cnt, mine, sp = 0u;
    for (;;) {
        sum = 0u; cnt = 0u; mine = 0u;
#pragma unroll
        for (unsigned j = 0; j < 16; ++j) { const unsigned c = xb_ld(&bar[XB_XCNT(j)]); sum += c; cnt += (c > 0u) ? 1u : 0u; mine = (j == x) ? c : mine; }
        if (sum == G) break;
        __builtin_amdgcn_s_sleep(1);
        if ((++sp & 255u) == 0u) { if (xb_ld(&bar[XB_TMO])) break; if (sp > XB_SPIN_CAP) { atomicAdd(&bar[XB_TMO], 1u); break; } }
    }
    nloc = mine > 0u ? mine : 1u; nx = cnt > 0u ? cnt : 1u;
}
__device__ __forceinline__ void xcd_barrier(const XcdBarrier& b, bool leader) {
    asm volatile("s_waitcnt vmcnt(0)" ::: "memory");
    __syncthreads();
    if (leader) {
        unsigned* bar = b.bar;
        __builtin_amdgcn_s_waitcnt(0);
        unsigned nloc = b.st[0], nx = b.st[1];
        if (nloc == 0u) { xcd_barrier_complete(bar, b.x, nloc, nx); b.st[0] = nloc; b.st[1] = nx; }
        const unsigned old = xb_add(&bar[XB_XSUB(b.x)], 1u);
        const unsigned gen = old / nloc;
        if (old + 1u == (gen + 1u) * nloc) {
            __builtin_amdgcn_fence(__ATOMIC_RELEASE, "agent");
            asm volatile("s_waitcnt vmcnt(0)" ::: "memory");
            const unsigned og = xb_add(&bar[XB_TOP], 1u);
            const unsigned tg = og / nx;
            if (og + 1u == (tg + 1u) * nx) xb_add(&bar[XB_TOPGEN], 1u);
            else XB_SPIN(xb_ld(&bar[XB_TOPGEN]) == tg, bar);
            __builtin_amdgcn_fence(__ATOMIC_ACQUIRE, "agent");
            xb_add(&bar[XB_XGEN(b.x)], 1u);
            asm volatile("s_waitcnt vmcnt(0)" ::: "memory");
        } else {
            XB_SPIN(xb_ld(&bar[XB_XGEN(b.x)]) == gen, bar);
            __builtin_amdgcn_fence(__ATOMIC_ACQUIRE, "agent");
            asm volatile("s_waitcnt vmcnt(0)" ::: "memory");
        }
    }
    __syncthreads();
}

struct Params { const float* in[18]; float* out; unsigned char* ws; int ph_lo, ph_hi, li, pad; };
enum { I_XP = 0, I_XS, I_CK, I_CV, I_CIK, I_STATE, I_PT, I_PP, I_PS, I_GAIN, I_WIN, I_QG, I_KG, I_WOR, I_WOA, I_WOUT, I_WPG, I_WPP };
struct Ctx { int tid, lane, wave, gw, ngw, nblk, blk; LAS unsigned char* lds; };
typedef const __attribute__((address_space(4))) Params* PK;
__device__ __forceinline__ PK phase_args() { PK p = (PK)__builtin_amdgcn_kernarg_segment_ptr(); asm volatile("" : "+s"(p)); return p; }
__device__ __forceinline__ int hw_lane(int salt = 0) { int l; asm volatile("v_mbcnt_lo_u32_b32 %0, -1, 0 ; %1\n\tv_mbcnt_hi_u32_b32 %0, -1, %0" : "=v"(l) : "s"(salt)); return l; }
__device__ __forceinline__ Ctx phase_ctx(LAS unsigned char* lds, int wave_s, int salt) { Ctx C; int tid = wave_s * 64 + hw_lane(salt); asm volatile("" : "+v"(tid)); C.lds = lds; C.tid = tid; C.lane = tid & 63; C.wave = __builtin_amdgcn_readfirstlane(tid >> 6);
    int bx = blockIdx.x; asm volatile("" : "+s"(bx)); C.nblk = gridDim.x; C.blk = bx; C.gw = C.blk * NWAVES + C.wave; C.ngw = C.nblk * NWAVES; return C; }

__device__ __forceinline__ int win_orig_col(int np) {
    const int pn = np >> 8, c = np & 255, bj = c >> 7, cc = c & 127, wc = cc >> 5, l8 = cc & 31;
    if (pn < 4) { const int head = 2 * (pn & 1) + bj, dim = (cc >> 1) + 64 * (cc & 1); return (pn < 2 ? 0 : 512) + head * 128 + dim; }
    if (pn < 8) return np;
    if (pn == 11 || pn == 12) return np;
    if (pn <= 10 || pn == 13) { const int dimp = 32 * bj + l8; const bool rope = !(pn == 10 && wc >= 2);
        const int dim = (rope && dimp < 16) ? (dimp >> 1) + 8 * (dimp & 1) : dimp;
        if (pn < 10) return 2048 + (4 * (pn - 8) + wc) * 64 + dim;
        if (pn == 10) return 2560 + wc * 64 + dim;
        return 3328 + wc * 64 + dim; }
    if (np < 3584 + 64) { const int dimp = np - 3584; return 3584 + (dimp < 16 ? (dimp >> 1) + 8 * (dimp & 1) : dimp); }
    if (np < 3652) return np;
    if (np < ZC_GR) return -1;
    if (np < ZC_GR + 2048) return np - (ZC_GR - 3652);
    return -1;
}
struct EpiZ {
    static constexpr bool PERM = true, AFTER_DRAIN = false;
    unsigned char* ws; float* out; const float* rowss; const float* qgain; const float* kgain; int L; LAS unsigned char* xl;
    __device__ __forceinline__ void rope16(float (&x)[8], const f32x2* ropeA, int fq, int hl) const {
        float lo[4], hi[4];
#pragma unroll
        for (int k = 0; k < 4; ++k) { const f32x2 cs = ropeA[(fq & 1) * 4 + k]; lo[k] = x[2 * k] * cs[0] - x[2 * k + 1] * cs[1]; hi[k] = x[2 * k + 1] * cs[0] + x[2 * k] * cs[1]; }
        float rc[4];
#pragma unroll
        for (int k = 0; k < 4; ++k) rc[k] = shx<16>(fq == 0 ? hi[k] : lo[k], hl);
        if (fq == 0) {
#pragma unroll
            for (int k = 0; k < 4; ++k) { x[k] = lo[k]; x[4 + k] = rc[k]; } }
        else if (fq == 1) {
#pragma unroll
            for (int k = 0; k < 4; ++k) { x[k] = rc[k]; x[4 + k] = hi[k]; } }
    }
    __device__ __forceinline__ void operator()(const f32x4 (&acc)[2][2][4][2], const pg8::Unit& u, int wr, int wc, int, int) const {
        const int hl = hw_lane(), fr = hl & 15, fq = hl >> 4;
        const int pn = u.pn; const bool prompt = u.pm < MP / 256;
        const int row0 = u.pm * 256 + wr * 64 + fr;
        bf16* Z = (bf16*)(ws + WS_Z);
        if (prompt && pn >= 2 && pn < 6) {
            const bool isk = pn < 4; LAS unsigned char* xt = xl + (wr * 4 + wc) * 2048;
            const int b = (u.pm * 256) >> 12, tpan = (u.pm * 256) & (SEQ - 1);
#pragma unroll
            for (int ai = 0; ai < 2; ++ai)
#pragma unroll
                for (int bj = 0; bj < 2; ++bj) { const int head = 2 * (pn & 1) + bj;
#pragma unroll
                    for (int mp = 0; mp < 2; ++mp) {
#pragma unroll
                        for (int mm = 0; mm < 2; ++mm) { const int m = 2 * mp + mm; const int row = row0 + ai * 128 + m * 16, t = row & (SEQ - 1);
                            const float rs = __builtin_amdgcn_rsqf(rowss[row] * (1.0f / 1024.0f) + 1e-6f);
                            float x[8];
#pragma unroll
                            for (int j = 0; j < 4; ++j) { x[j] = acc[ai][bj][m][0][j] * rs; x[4 + j] = acc[ai][bj][m][1][j] * rs; }
                            const int t32 = 16 * mm + fr;
                            if (isk) { const int p0 = 16 * wc + 4 * fq; const f32x2* rr = (const f32x2*)(ws + WS_ROPER) + (size_t)t * 64 + p0; float lo[4], hi[4];
#pragma unroll
                                for (int k = 0; k < 4; ++k) { const f32x2 cs = rr[k]; lo[k] = (x[2 * k] * cs[0] - x[2 * k + 1] * cs[1]) * 0.08838834764831845f; hi[k] = (x[2 * k + 1] * cs[0] + x[2 * k] * cs[1]) * 0.08838834764831845f; }
                                bf16* q = (bf16*)(ws + WS_RK) + (size_t)row * 512 + head * 128 + p0;
                                u32x2 a, c; a.x = pk2(lo[0], lo[1]); a.y = pk2(lo[2], lo[3]); c.x = pk2(hi[0], hi[1]); c.y = pk2(hi[2], hi[3]); *(u32x2*)q = a; *(u32x2*)(q + 64) = c;
                                const float dk = __builtin_amdgcn_exp2f((float)(127 - (t & 127)) * ret_log2g(head));
#pragma unroll
                                for (int k = 0; k < 4; ++k) { *(LAS bf16*)(xt + (4 * fq + k) * 64 + 2 * t32) = (bf16)(pk2(lo[k] * dk, 0.f) & 0xffffu); *(LAS bf16*)(xt + (16 + 4 * fq + k) * 64 + 2 * t32) = (bf16)(pk2(hi[k] * dk, 0.f) & 0xffffu); }
                            } else {
#pragma unroll
                                for (int j = 0; j < 8; ++j) *(LAS bf16*)(xt + (8 * fq + j) * 64 + 2 * t32) = (bf16)(pk2(x[j], 0.f) & 0xffffu); } }
                        asm volatile("s_waitcnt lgkmcnt(0)" ::: "memory");
#pragma unroll
                        for (int i = 0; i < 2; ++i) { const int c = hl + 64 * i, dl = c >> 2, q4 = c & 3; const u32x4 v = *(const LAS u32x4*)(xt + dl * 64 + 16 * q4);
                            const int d = isk ? 16 * wc + (dl & 15) + 64 * (dl >> 4) : 32 * wc + dl;
                            bf16* dst = (bf16*)(ws + (isk ? WS_RKT : WS_RVT)) + ((size_t)(b * 4 + head) * 128 + d) * SEQ + tpan + 128 * ai + 64 * wr + 32 * mp + 8 * q4;
                            *(u32x4*)dst = v; }
                        asm volatile("s_waitcnt lgkmcnt(0)" ::: "memory"); } }
            return;
        }
#define EZ_X(bj_, xv_) float xv_[8]; _Pragma("unroll") for (int j_ = 0; j_ < 4; ++j_) { xv_[j_] = acc[ai][bj_][m][0][j_] * rs; xv_[4 + j_] = acc[ai][bj_][m][1][j_] * rs; }
#pragma unroll
        for (int ai = 0; ai < 2; ++ai)
#pragma unroll
            for (int m = 0; m < 4; ++m) {
                const int row = row0 + ai * 128 + m * 16; const float rs = __builtin_amdgcn_rsqf(rowss[row] * (1.0f / 1024.0f) + 1e-6f);
                const int pos = prompt ? (row & (SEQ - 1)) : PAST + ((row - MP) & 7);
                const unsigned zrow = (unsigned)row * NZ;
                if (pn < 4) {
                    const int p0 = 16 * wc + 4 * fq; const bool isk = pn >= 2;
                    if (!prompt) {
#pragma unroll
                        for (int bj = 0; bj < 2; ++bj) { EZ_X(bj, x) const int hc = (isk ? ZC_RK : ZC_RQ) + (2 * (pn & 1) + bj) * 128;
                            u32x2 a, b; a.x = pk2(x[0], x[2]); a.y = pk2(x[4], x[6]); b.x = pk2(x[1], x[3]); b.y = pk2(x[5], x[7]);
                            *(u32x2*)(Z + zrow + hc + p0) = a; *(u32x2*)(Z + zrow + hc + 64 + p0) = b; }
                    } else {
                        const f32x2* rr = (const f32x2*)(ws + WS_ROPER) + (size_t)pos * 64 + p0; const int b = row >> 12, t = row & (SEQ - 1);
                        f32x2 cs[4];
#pragma unroll
                        for (int k = 0; k < 4; ++k) cs[k] = rr[k];
#pragma unroll
                        for (int bj = 0; bj < 2; ++bj) { EZ_X(bj, x) const int head = 2 * (pn & 1) + bj; float lo[4], hi[4];
#pragma unroll
                            for (int k = 0; k < 4; ++k) { lo[k] = x[2 * k] * cs[k][0] - x[2 * k + 1] * cs[k][1]; hi[k] = x[2 * k + 1] * cs[k][0] + x[2 * k] * cs[k][1]; }
                            if (!isk) { bf16* q = (bf16*)(ws + WS_RQ) + (size_t)row * 512 + head * 128 + p0;
                                u32x2 a, c; a.x = pk2(lo[0], lo[1]); a.y = pk2(lo[2], lo[3]); c.x = pk2(hi[0], hi[1]); c.y = pk2(hi[2], hi[3]); *(u32x2*)q = a; *(u32x2*)(q + 64) = c; }
                            else { const float sc = 0.08838834764831845f;
#pragma unroll
                                for (int k = 0; k < 4; ++k) { lo[k] *= sc; hi[k] *= sc; }
                                bf16* q = (bf16*)(ws + WS_RK) + (size_t)row * 512 + head * 128 + p0;
                                u32x2 a, c; a.x = pk2(lo[0], lo[1]); a.y = pk2(lo[2], lo[3]); c.x = pk2(hi[0], hi[1]); c.y = pk2(hi[2], hi[3]); *(u32x2*)q = a; *(u32x2*)(q + 64) = c;
                                const float dk = __builtin_amdgcn_exp2f((float)(127 - (t & 127)) * ret_log2g(head));
                                bf16* kt = (bf16*)(ws + WS_RKT) + ((size_t)(b * 4 + head) * 128 + p0) * SEQ + t;
#pragma unroll
                                for (int k = 0; k < 4; ++k) { kt[(size_t)k * SEQ] = (bf16)(pk2(lo[k] * dk, 0.f) & 0xffffu); kt[(size_t)(64 + k) * SEQ] = (bf16)(pk2(hi[k] * dk, 0.f) & 0xffffu); } } }
                    }
                } else if (pn < 6 && prompt) {
                    const int b = row >> 12, t = row & (SEQ - 1);
#pragma unroll
                    for (int bj = 0; bj < 2; ++bj) { EZ_X(bj, x) bf16* vt = (bf16*)(ws + WS_RVT) + ((size_t)(b * 4 + 2 * (pn & 1) + bj) * 128 + 32 * wc + 8 * fq) * SEQ + t;
#pragma unroll
                        for (int j = 0; j < 8; ++j) vt[(size_t)j * SEQ] = (bf16)(pk2(x[j], 0.f) & 0xffffu); }
                } else if (pn == 8 || pn == 9 || pn == 10 || pn == 13) {
                    const bool norm = (pn < 10) || (pn == 10 && wc < 2), rope = norm || pn == 13;
                    EZ_X(0, x0) EZ_X(1, x1)
                    if (norm) { float ss = 0.f;
#pragma unroll
                        for (int j = 0; j < 8; ++j) ss += x0[j] * x0[j] + x1[j] * x1[j];
                        ss += shx<16>(ss, hl); ss += shx<32>(ss, hl);
                        const float rr = __builtin_amdgcn_rsqf(ss * (1.0f / 64.0f) + 1e-6f); const float* gn = (pn < 10) ? qgain : kgain;
#pragma unroll
                        for (int j = 0; j < 8; ++j) { const int d0 = (fq < 2) ? 4 * fq + (j >> 1) + 8 * (j & 1) : 8 * fq + j; x0[j] *= rr * gn[d0]; x1[j] *= rr * gn[32 + 8 * fq + j]; } }
                    if (rope) rope16(x0, (const f32x2*)(ws + WS_ROPEA) + (size_t)pos * 8, fq, hl);
                    if (pn < 10) { bf16* q = (bf16*)(ws + WS_AQ) + (size_t)row * 512 + (4 * (pn - 8) + wc) * 64 + 8 * fq; *(u32x4*)q = pack8(x0); *(u32x4*)(q + 32) = pack8(x1); }
                    else if (pn == 13) { bf16* q = (bf16*)(ws + WS_IQ) + (size_t)row * 256 + wc * 64 + 8 * fq; *(u32x4*)q = pack8(x0); *(u32x4*)(q + 32) = pack8(x1); }
                    else { const bool isk = wc < 2; const int hk = wc & 1;
                        float* dst = (isk ? (prompt ? out + O_KP + ((size_t)L * MP + row) * 128 : out + O_KS + ((size_t)L * MS + (row - MP)) * 128)
                                          : (prompt ? out + O_VP + ((size_t)L * MP + row) * 128 : out + O_VS + ((size_t)L * MS + (row - MP)) * 128)) + hk * 64 + 8 * fq;
                        *(f32x4*)dst = (f32x4){x0[0], x0[1], x0[2], x0[3]}; *(f32x4*)(dst + 4) = (f32x4){x0[4], x0[5], x0[6], x0[7]};
                        *(f32x4*)(dst + 32) = (f32x4){x1[0], x1[1], x1[2], x1[3]}; *(f32x4*)(dst + 36) = (f32x4){x1[4], x1[5], x1[6], x1[7]};
                        if (prompt) { bf16* d2 = (bf16*)(ws + (isk ? WS_KB : WS_VB)) + (size_t)row * 128 + hk * 64 + 8 * fq; *(u32x4*)d2 = pack8(x0); *(u32x4*)(d2 + 32) = pack8(x1); } }
                } else if (pn == 14) {
                    { EZ_X(0, x0)
                      if (wc == 0) rope16(x0, (const f32x2*)(ws + WS_ROPEA) + (size_t)pos * 8, fq, hl);
                      if (wc < 2) { float* dst = (prompt ? out + O_IKP + ((size_t)L * MP + row) * 64 : out + O_IKS + ((size_t)L * MS + (row - MP)) * 64) + 32 * wc + 8 * fq;
                          *(f32x4*)dst = (f32x4){x0[0], x0[1], x0[2], x0[3]}; *(f32x4*)(dst + 4) = (f32x4){x0[4], x0[5], x0[6], x0[7]};
                          if (prompt) *(u32x4*)((bf16*)(ws + WS_IKB) + (size_t)row * 64 + 32 * wc + 8 * fq) = pack8(x0); }
                      else if (wc == 2 && fq == 0) *(f32x4*)((float*)(ws + WS_IW) + (size_t)row * 4) = (f32x4){x0[0] * 0.0625f, x0[1] * 0.0625f, x0[2] * 0.0625f, x0[3] * 0.0625f}; }
                    { EZ_X(1, x1) *(u32x4*)(Z + zrow + pn * 256 + 128 + 32 * wc + 8 * fq) = pack8(x1); }
                } else {
#pragma unroll
                    for (int bj = 0; bj < 2; ++bj) { EZ_X(bj, x) *(u32x4*)(Z + zrow + pn * 256 + 128 * bj + 32 * wc + 8 * fq) = pack8(x); }
                }
                asm volatile("" ::: "memory"); }
#undef EZ_X
    }
};

struct InProjOrder {
    pg8::StaticOrder base; int G, c;
    __device__ void init(int G_, int c_) { base.init(MP, NZ, G_, c_); G = G_; c = c_; }
    __device__ bool next(int i, pg8::Unit& u) const {
        const int L = i * G + c; const int np = (MP / 256) * (NZ / 256);
        if (L < np) return base.next(i, u);
        const int l2 = L - np; if (l2 >= 4 * 15) return false;
        u.pm = MP / 256 + l2 / 15; u.pn = l2 % 15; return true;
    }
    __device__ __forceinline__ void a_ready(const pg8::Unit&) const {}
    __device__ __forceinline__ void done(const pg8::Unit&) const {}
};
template <int MODE> struct EpiGate {
    static constexpr bool PERM = true, AFTER_DRAIN = false;
    const bf16* Z; int gcol; bf16* TMP; bf16* MB;
    __device__ __forceinline__ void operator()(const f32x4 (&acc)[2][2][4][2], const pg8::Unit& u, int wr, int wc, int, int) const {
        const int hl_ = hw_lane(), fr = hl_ & 15, fq = hl_ >> 4;
        const int row0 = u.pm * 256 + wr * 64 + fr, col0 = u.pn * 256 + wc * 32 + 8 * fq;
#pragma unroll
        for (int ai = 0; ai < 2; ++ai) {
            u32x4 gw[4][2], tw[4][2];
#pragma unroll
            for (int m = 0; m < 4; ++m)
#pragma unroll
                for (int bj = 0; bj < 2; ++bj) { const int row = row0 + ai * 128 + m * 16, col = col0 + bj * 128;
                    gw[m][bj] = *(const u32x4*)(Z + ((unsigned)row * NZ + (unsigned)(gcol + col)));
                    if (MODE == 1) tw[m][bj] = *(const u32x4*)(TMP + ((unsigned)row * DM + (unsigned)col)); }
            asm volatile("" ::: "memory");
#pragma unroll
            for (int m = 0; m < 4; ++m)
#pragma unroll
                for (int bj = 0; bj < 2; ++bj) { const int row = row0 + ai * 128 + m * 16, col = col0 + bj * 128; const unsigned off = (unsigned)row * DM + (unsigned)col;
                    float g[8]; unpack8(gw[m][bj], g);
                    const f32x4 a0 = acc[ai][bj][m][0], a1 = acc[ai][bj][m][1];
                    float r[8];
#pragma unroll
                    for (int j = 0; j < 4; ++j) { r[j] = sigmoidf_(g[j]) * a0[j]; r[4 + j] = sigmoidf_(g[4 + j]) * a1[j]; }
                    if (MODE == 0) *(u32x4*)(TMP + off) = pack8(r);
                    else { float t[8]; unpack8(tw[m][bj], t);
#pragma unroll
                        for (int j = 0; j < 8; ++j) r[j] += t[j];
                        *(u32x4*)(MB + off) = pack8(r); } }
            asm volatile("" ::: "memory"); }
    }
};
struct EpiRes {
    static constexpr bool PERM = true, AFTER_DRAIN = false;
    const float* xa; const float* xb; const bf16* xh; bf16* XB1;
    __device__ __forceinline__ void operator()(const f32x4 (&acc)[2][2][4][2], const pg8::Unit& u, int wr, int wc, int, int) const {
        const int hl_ = hw_lane(), fr = hl_ & 15, fq = hl_ >> 4;
        const int row0 = u.pm * 256 + wr * 64 + fr, col0 = u.pn * 256 + wc * 32 + 8 * fq;
        const float* xr = (u.pm < MP / 256) ? xa : xb - (size_t)MP * DM;
#pragma unroll
        for (int ai = 0; ai < 2; ++ai) {
            u32x4 xw[4][2][2];
#pragma unroll
            for (int m = 0; m < 4; ++m)
#pragma unroll
                for (int bj = 0; bj < 2; ++bj) { const unsigned off = (unsigned)(row0 + ai * 128 + m * 16) * DM + (unsigned)(col0 + bj * 128);
                    if (xh != nullptr) xw[m][bj][0] = *(const u32x4*)(xh + off);
                    else { xw[m][bj][0] = *(const u32x4*)(xr + off); xw[m][bj][1] = *(const u32x4*)(xr + off + 4); } }
            asm volatile("" ::: "memory");
#pragma unroll
            for (int m = 0; m < 4; ++m)
#pragma unroll
                for (int bj = 0; bj < 2; ++bj) { const unsigned off = (unsigned)(row0 + ai * 128 + m * 16) * DM + (unsigned)(col0 + bj * 128);
                    float x[8];
                    if (xh != nullptr) unpack8(xw[m][bj][0], x);
                    else { const f32x4 x0 = __builtin_bit_cast(f32x4, xw[m][bj][0]), x1 = __builtin_bit_cast(f32x4, xw[m][bj][1]); x[0] = x0[0]; x[1] = x0[1]; x[2] = x0[2]; x[3] = x0[3]; x[4] = x1[0]; x[5] = x1[1]; x[6] = x1[2]; x[7] = x1[3]; }
                    const f32x4 a0 = acc[ai][bj][m][0], a1 = acc[ai][bj][m][1];
#pragma unroll
                    for (int j = 0; j < 4; ++j) { x[j] += a0[j]; x[4 + j] += a1[j]; }
                    *(u32x4*)(XB1 + off) = pack8(x); }
            asm volatile("" ::: "memory"); }
    }
};
template <int MODE> struct EpiPle {
    static constexpr bool PERM = true, AFTER_DRAIN = false;
    bf16* TMP; const bf16* XB1; float* Y; bf16* XB0; float* rowss;
    __device__ __forceinline__ void operator()(const f32x4 (&acc)[2][2][4][2], const pg8::Unit& u, int wr, int wc, int, int) const {
        const int hl_ = hw_lane(), fr = hl_ & 15, fq = hl_ >> 4;
        const int row0 = u.pm * 256 + wr * 64 + fr, col0 = u.pn * 256 + wc * 32 + 8 * fq;
#pragma unroll
        for (int ai = 0; ai < 2; ++ai) {
            u32x4 tw[4][2], xw[4][2];
            if (MODE != 0) {
#pragma unroll
                for (int m = 0; m < 4; ++m)
#pragma unroll
                    for (int bj = 0; bj < 2; ++bj) { const unsigned off = (unsigned)(row0 + ai * 128 + m * 16) * DM + (unsigned)(col0 + bj * 128);
                        tw[m][bj] = *(const u32x4*)(TMP + off); xw[m][bj] = *(const u32x4*)(XB1 + off); }
                asm volatile("" ::: "memory"); }
#pragma unroll
            for (int m = 0; m < 4; ++m) { const int row = row0 + ai * 128 + m * 16; float ssq = 0.f;
#pragma unroll
                for (int bj = 0; bj < 2; ++bj) { const unsigned off = (unsigned)row * DM + (unsigned)(col0 + bj * 128);
                    const f32x4 a0 = acc[ai][bj][m][0], a1 = acc[ai][bj][m][1];
                    if (MODE == 0) { float r[8];
#pragma unroll
                        for (int j = 0; j < 4; ++j) { r[j] = sigmoidf_(a0[j]); r[4 + j] = sigmoidf_(a1[j]); }
                        *(u32x4*)(TMP + off) = pack8(r); }
                    else { float t[8], x[8]; unpack8(tw[m][bj], t); unpack8(xw[m][bj], x);
#pragma unroll
                        for (int j = 0; j < 4; ++j) { x[j] += t[j] * a0[j]; x[4 + j] += t[4 + j] * a1[j]; }
                        if (MODE == 2) { *(f32x4*)(Y + off) = (f32x4){x[0], x[1], x[2], x[3]}; *(f32x4*)(Y + off + 4) = (f32x4){x[4], x[5], x[6], x[7]}; }
                        *(u32x4*)(XB0 + off) = pack8(x);
                        if (MODE == 1) {
#pragma unroll
                            for (int j = 0; j < 8; ++j) ssq += x[j] * x[j]; } } }
                if (MODE == 1) { const int ln_ = fr + 16 * fq; ssq += shx<16>(ssq, ln_); ssq += shx<32>(ssq, ln_); if (fq == 0) atomicAdd(rowss + row, ssq); } }
            asm volatile("" ::: "memory"); }
    }
};
__device__ __forceinline__ void p0_transpose_item(const float* W, int ldw, int K, const float* gain, bf16* WT, int nblk, int item, bool win_map, LAS float* scr, int lane) {
    const int kb = item / nblk, nb = item % nblk, k0 = 64 * kb, n0 = 32 * nb;
    const int np = n0 + (lane & 31); int n = np; bool valid = true;
    if (win_map) { n = win_orig_col(np); valid = n >= 0; if (!valid) n = 0; }
#pragma unroll 8
    for (int i = 0; i < 32; ++i) { const int kk = 2 * i + (lane >> 5); float v = valid ? W[(size_t)(k0 + kk) * ldw + n] : 0.f; if (gain) v *= gain[k0 + kk]; scr[kk * 33 + (lane & 31)] = v; }
    LDS_WAIT(); asm volatile("" ::: "memory");
    const int c = lane & 7;
#pragma unroll
    for (int j = 0; j < 4; ++j) { const int nn = (lane >> 3) + 8 * j; const LAS float* s = scr + (8 * c) * 33 + nn;
        u32x4 o; o.x = pk2(s[0 * 33], s[1 * 33]); o.y = pk2(s[2 * 33], s[3 * 33]); o.z = pk2(s[4 * 33], s[5 * 33]); o.w = pk2(s[6 * 33], s[7 * 33]);
        *(u32x4*)(WT + (size_t)(n0 + nn) * K + k0 + 8 * c) = o; }
    LDS_WAIT(); asm volatile("" ::: "memory");
}
__device__ __forceinline__ void p0_prologue(PK P, const Ctx& C) {
    unsigned char* ws = P->ws;
    LAS float* scr = (LAS float*)(C.lds + C.wave * 16384);
    constexpr int I_IN = 16 * (NZ / 32), I_OR = 8 * 32, I_OUT = 16 * 32, I_PPJ = 4 * 32, I_LAYER = I_IN + 2 * I_OR + 2 * I_OUT + I_PPJ;
    for (int it = C.gw; it < DEPTH * I_LAYER; it += C.ngw) {
        const int L = it / I_LAYER; int r = it % I_LAYER;
        if (r < I_IN) { p0_transpose_item(P->in[I_WIN] + (size_t)L * DM * WIN_N, WIN_N, DM, P->in[I_GAIN] + L * DM, (bf16*)(ws + WS_WIN) + (size_t)L * NZ * DM, NZ / 32, r, true, scr, C.lane); continue; } r -= I_IN;
        if (r < I_OR) { p0_transpose_item(P->in[I_WOR] + (size_t)L * 512 * DM, DM, 512, nullptr, (bf16*)(ws + WS_WOR) + (size_t)L * DM * 512, 32, r, false, scr, C.lane); continue; } r -= I_OR;
        if (r < I_OR) { p0_transpose_item(P->in[I_WOA] + (size_t)L * 512 * DM, DM, 512, nullptr, (bf16*)(ws + WS_WOA) + (size_t)L * DM * 512, 32, r, false, scr, C.lane); continue; } r -= I_OR;
        if (r < I_OUT) { p0_transpose_item(P->in[I_WOUT] + (size_t)L * DM * DM, DM, DM, nullptr, (bf16*)(ws + WS_WOUT) + (size_t)L * DM * DM, 32, r, false, scr, C.lane); continue; } r -= I_OUT;
        if (r < I_OUT) { p0_transpose_item(P->in[I_WPG] + (size_t)L * DM * DM, DM, DM, nullptr, (bf16*)(ws + WS_WPG) + (size_t)L * DM * DM, 32, r, false, scr, C.lane); continue; } r -= I_OUT;
        p0_transpose_item(P->in[I_WPP] + (size_t)L * 256 * DM, DM, 256, nullptr, (bf16*)(ws + WS_WPP) + (size_t)L * DM * 256, 32, r, false, scr, C.lane);
    }
    bf16* XB0 = (bf16*)(ws + WS_XB0); float* rowss0 = (float*)(ws + WS_ROWSS0);
    for (int row = C.gw; row < MT; row += C.ngw) {
        const float* xr = (row < MP) ? P->in[I_XP] + (size_t)row * DM : P->in[I_XS] + (size_t)(row - MP) * DM;
        float ss = 0.f;
#pragma unroll
        for (int j = 0; j < 4; ++j) { const f32x4 v = *(const f32x4*)(xr + 256 * j + 4 * C.lane); ss += (v[0] * v[0] + v[1] * v[1]) + (v[2] * v[2] + v[3] * v[3]);
            u32x2 w; w.x = pk2(v[0], v[1]); w.y = pk2(v[2], v[3]); *(u32x2*)(XB0 + (size_t)row * DM + 256 * j + 4 * C.lane) = w; }
        ss = wave_sum(ss, C.lane);
        if (C.lane == 0) rowss0[row] = ss;
    }
    for (int r = C.gw; r < DEPTH * MT; r += C.ngw) { const int L = r / MT, row = r - L * MT;
        const float* pr = (row < MP) ? P->in[I_PP] + ((size_t)L * MP + row) * 256 : P->in[I_PS] + ((size_t)L * MS + (row - MP)) * 256;
        const f32x4 v = *(const f32x4*)(pr + 4 * C.lane); u32x2 w; w.x = pk2(v[0], v[1]); w.y = pk2(v[2], v[3]); *(u32x2*)((bf16*)(ws + WS_PB) + ((size_t)L * MT + row) * 256 + 4 * C.lane) = w; }
    f32x2* rr = (f32x2*)(ws + WS_ROPER); f32x2* ra = (f32x2*)(ws + WS_ROPEA);
    for (int i = C.blk * NTHREADS + C.tid; i < 4096 * 64; i += C.nblk * NTHREADS) { const int pos = i >> 6, k = i & 63;
        const float fr = expf((-9.210340371976184f * (float)k) / 64.0f), ang = (float)pos * fr; rr[i] = (f32x2){cosf(ang), sinf(ang)}; }
    for (int i = C.blk * NTHREADS + C.tid; i < 4096 * 8; i += C.nblk * NTHREADS) { const int pos = i >> 3, k = i & 7;
        const float fr = expf((-13.122363377404328f * (float)k) / 8.0f), ang = (float)pos * fr; ra[i] = (f32x2){cosf(ang), sinf(ang)}; }
}

constexpr int LDT = 272;
__device__ __forceinline__ void post_ret_tile(PK P, const Ctx& C, int unit) {
    unsigned char* ws = P->ws; const bf16* Z = (const bf16*)(ws + WS_Z);
    const int b = unit >> 7, h = (unit >> 5) & 3, n = unit & 31, t0 = n * 128; const int bh = b * 4 + h;
    LAS unsigned char* TK = C.lds; LAS unsigned char* TV = C.lds + 128 * LDT;
    const f32x2* ropeR = (const f32x2*)(ws + WS_ROPER);
    bf16* RQ = (bf16*)(ws + WS_RQ); bf16* RK = (bf16*)(ws + WS_RK);
    const float lg2 = ret_log2g(h);
#pragma unroll
    for (int u = 0; u < 2; ++u) {
        const int idx = C.tid + 512 * u, r = idx >> 3, j = idx & 7, t = t0 + r; const size_t grow = (size_t)b * SEQ + t;
        float cs[8], sn[8];
#pragma unroll
        for (int e = 0; e < 8; e += 2) { const f32x4 v = *(const f32x4*)(ropeR + (size_t)t * 64 + 8 * j + e); cs[e] = v[0]; sn[e] = v[1]; cs[e + 1] = v[2]; sn[e + 1] = v[3]; }
        { float x1[8], x2[8], o1[8], o2[8]; unpack8(*(const u32x4*)(Z + grow * NZ + ZC_RQ + h * 128 + 8 * j), x1); unpack8(*(const u32x4*)(Z + grow * NZ + ZC_RQ + h * 128 + 64 + 8 * j), x2);
#pragma unroll
          for (int e = 0; e < 8; ++e) { o1[e] = x1[e] * cs[e] - x2[e] * sn[e]; o2[e] = x2[e] * cs[e] + x1[e] * sn[e]; }
          *(u32x4*)(RQ + grow * 512 + h * 128 + 8 * j) = pack8(o1); *(u32x4*)(RQ + grow * 512 + h * 128 + 64 + 8 * j) = pack8(o2); }
        { float x1[8], x2[8], o1[8], o2[8]; unpack8(*(const u32x4*)(Z + grow * NZ + ZC_RK + h * 128 + 8 * j), x1); unpack8(*(const u32x4*)(Z + grow * NZ + ZC_RK + h * 128 + 64 + 8 * j), x2);
          const float sc = 0.08838834764831845f, dk = __builtin_amdgcn_exp2f((float)(127 - r) * lg2);
#pragma unroll
          for (int e = 0; e < 8; ++e) { o1[e] = (x1[e] * cs[e] - x2[e] * sn[e]) * sc; o2[e] = (x2[e] * cs[e] + x1[e] * sn[e]) * sc; }
          *(u32x4*)(RK + grow * 512 + h * 128 + 8 * j) = pack8(o1); *(u32x4*)(RK + grow * 512 + h * 128 + 64 + 8 * j) = pack8(o2);
#pragma unroll
          for (int e = 0; e < 8; ++e) { *(LAS bf16*)(TK + (8 * j + e) * LDT + 2 * r) = (bf16)(pk2(o1[e] * dk, 0.f) & 0xffffu); *(LAS bf16*)(TK + (64 + 8 * j + e) * LDT + 2 * r) = (bf16)(pk2(o2[e] * dk, 0.f) & 0xffffu); } }
    }
#pragma unroll
    for (int u = 0; u < 4; ++u) {
        const int idx = C.tid + 512 * u, r = idx >> 4, c = idx & 15; const size_t grow = (size_t)b * SEQ + t0 + r;
        const u32x4 w = *(const u32x4*)(Z + grow * NZ + ZC_RV + h * 128 + 8 * c);
        const unsigned ww[4] = {w.x, w.y, w.z, w.w};
#pragma unroll
        for (int e = 0; e < 4; ++e) { *(LAS bf16*)(TV + (8 * c + 2 * e) * LDT + 2 * r) = (bf16)(ww[e] & 0xffffu); *(LAS bf16*)(TV + (8 * c + 2 * e + 1) * LDT + 2 * r) = (bf16)(ww[e] >> 16); }
    }
    __syncthreads();
    bf16* RKT = (bf16*)(ws + WS_RKT); bf16* RVT = (bf16*)(ws + WS_RVT);
#pragma unroll
    for (int u = 0; u < 4; ++u) {
        const int idx = C.tid + 512 * u, d = idx >> 4, c = idx & 15;
        const u32x4 a = *(const LAS u32x4*)(TK + d * LDT + 16 * c), v = *(const LAS u32x4*)(TV + d * LDT + 16 * c);
        *(u32x4*)(RKT + ((size_t)bh * 128 + d) * SEQ + t0 + 8 * c) = a; *(u32x4*)(RVT + ((size_t)bh * 128 + d) * SEQ + t0 + 8 * c) = v;
    }
    __syncthreads();
}
__device__ __forceinline__ void post_token(PK P, const Ctx& C, int L, int row) {
    unsigned char* ws = P->ws; const bf16* Zr = (const bf16*)(ws + WS_Z) + (size_t)row * NZ; const int lane = C.lane;
    const bool prompt = row < MP; const int sb = (row - MP) >> 3, sc = (row - MP) & 7;
    const int pos = prompt ? (row & (SEQ - 1)) : PAST + sc;
    const f32x2* ropeA = (const f32x2*)(ws + WS_ROPEA) + (size_t)pos * 8;
    const int c8 = lane & 7;
    float cs[8], sn[8];
#pragma unroll
    for (int e = 0; e < 8; e += 2) { const f32x4 v = *(const f32x4*)(ropeA + e); cs[e] = v[0]; sn[e] = v[1]; cs[e + 1] = v[2]; sn[e + 1] = v[3]; }
    { float x[8]; unpack8(*(const u32x4*)(Zr + ZC_AQ + 8 * lane), x);
      float ss = 0.f;
#pragma unroll
      for (int e = 0; e < 8; ++e) ss += x[e] * x[e];
      ss += shx<1>(ss, lane); ss += shx<2>(ss, lane); ss += shx<4>(ss, lane);
      const float rs = __builtin_amdgcn_rsqf(ss * (1.0f / 64.0f) + 1e-6f);
      const float* qg = P->in[I_QG] + L * 64 + 8 * c8; float o[8];
#pragma unroll
      for (int e = 0; e < 8; ++e) { const float y = x[e] * rs * qg[e]; const float pr = shx<1>(y, lane); o[e] = (c8 == 0) ? y * cs[e] - pr * sn[e] : (c8 == 1) ? y * cs[e] + pr * sn[e] : y; }
      *(u32x4*)((bf16*)(ws + WS_AQ) + (size_t)row * 512 + 8 * lane) = pack8(o); }
    { float x[8]; unpack8(*(const u32x4*)(Zr + ZC_AK + 8 * (lane & 31)), x);
      float ss = 0.f;
#pragma unroll
      for (int e = 0; e < 8; ++e) ss += x[e] * x[e];
      ss += shx<1>(ss, lane); ss += shx<2>(ss, lane); ss += shx<4>(ss, lane);
      const float rs = __builtin_amdgcn_rsqf(ss * (1.0f / 64.0f) + 1e-6f);
      const float* kg = P->in[I_KG] + L * 64 + 8 * c8; float o[8]; const bool isk = (lane & 31) < 16;
#pragma unroll
      for (int e = 0; e < 8; ++e) { const float y = isk ? x[e] * rs * kg[e] : x[e]; const float pr = shx<1>(y, lane); o[e] = (isk && c8 == 0) ? y * cs[e] - pr * sn[e] : (isk && c8 == 1) ? y * cs[e] + pr * sn[e] : y; }
      if (lane < 32) {
          const int l16 = lane & 15;
          float* dst = isk ? (prompt ? P->out + O_KP + ((size_t)L * MP + row) * 128 : P->out + O_KS + ((size_t)L * MS + (row - MP)) * 128)
                           : (prompt ? P->out + O_VP + ((size_t)L * MP + row) * 128 : P->out + O_VS + ((size_t)L * MS + (row - MP)) * 128);
          *(f32x4*)(dst + 8 * l16) = (f32x4){o[0], o[1], o[2], o[3]}; *(f32x4*)(dst + 8 * l16 + 4) = (f32x4){o[4], o[5], o[6], o[7]};
          if (prompt) { bf16* d2 = (bf16*)(ws + (isk ? WS_KB : WS_VB)) + (size_t)row * 128 + 8 * l16; *(u32x4*)d2 = pack8(o); } } }
    { const int l40 = lane < 40 ? lane : 39; float x[8]; unpack8(*(const u32x4*)(Zr + ZC_IQ + 8 * l40), x); float o[8];
#pragma unroll
      for (int e = 0; e < 8; ++e) { const float y = x[e]; const float pr = shx<1>(y, lane); o[e] = (c8 == 0) ? y * cs[e] - pr * sn[e] : (c8 == 1) ? y * cs[e] + pr * sn[e] : y; }
      if (lane < 32) *(u32x4*)((bf16*)(ws + WS_IQ) + (size_t)row * 256 + 8 * lane) = pack8(o);
      else if (lane < 40) { const int l8 = lane - 32;
          float* dst = prompt ? P->out + O_IKP + ((size_t)L * MP + row) * 64 : P->out + O_IKS + ((size_t)L * MS + (row - MP)) * 64;
          *(f32x4*)(dst + 8 * l8) = (f32x4){o[0], o[1], o[2], o[3]}; *(f32x4*)(dst + 8 * l8 + 4) = (f32x4){o[4], o[5], o[6], o[7]};
          if (prompt) *(u32x4*)((bf16*)(ws + WS_IKB) + (size_t)row * 64 + 8 * l8) = pack8(o); } }
    if (lane < 4) ((float*)(ws + WS_IW))[(size_t)row * 4 + lane] = bf2f(Zr[ZC_IW + lane]) * 0.0625f;
    { const float* pr = prompt ? P->in[I_PP] + ((size_t)L * MP + row) * 256 : P->in[I_PS] + ((size_t)L * MS + (row - MP)) * 256;
      const f32x4 v = *(const f32x4*)(pr + 4 * lane); u32x2 w; w.x = pk2(v[0], v[1]); w.y = pk2(v[2], v[3]); *(u32x2*)((bf16*)(ws + WS_PB) + (size_t)row * 256 + 4 * lane) = w; }
    (void)sb;
}
__device__ __forceinline__ void phase_post(PK P, const Ctx& C, int L) {
    for (int u = C.blk; u < 512; u += C.nblk) post_ret_tile(P, C, u);
    for (int row = C.gw; row < MT; row += 2 * C.ngw) { post_token(P, C, L, row); if (row + C.ngw < MT) post_token(P, C, L, row + C.ngw); }
}

__device__ __forceinline__ void ret_state_item(PK P, const Ctx& C, int L, int item) {
    unsigned char* ws = P->ws; const bf16* RKT = (const bf16*)(ws + WS_RKT); const bf16* RVT = (const bf16*)(ws + WS_RVT); bf16* ST = (bf16*)(ws + WS_ST);
    const int bh = item >> 6, et = (item >> 3) & 7, dt = item & 7, lane = C.lane, r16 = lane & 15, g = lane >> 4;
    const float dec = __builtin_amdgcn_exp2f(128.0f * ret_log2g(bh & 3));
    LAS unsigned char* img = C.lds + 36864 + (C.wave & 3) * 8704;
    const int tq = lane >> 4, c16 = lane & 15;
    const bf16* vp = RVT + ((size_t)bh * 128 + 16 * et + tq) * SEQ + 8 * c16;
    const bf16* kp = RKT + ((size_t)bh * 128 + 16 * dt + tq) * SEQ + 8 * c16;
    f32x4 S = {0.f, 0.f, 0.f, 0.f};
    u32x4 rv[2][2][4], rk[2][2][4];
#define RS_LOAD(buf_, n0_) do { _Pragma("unroll") for (int i = 0; i < 2; ++i) _Pragma("unroll") for (int q = 0; q < 4; ++q) { \
        rv[buf_][i][q] = *(const u32x4*)(vp + (size_t)(4 * q) * SEQ + ((n0_) + i) * 128); rk[buf_][i][q] = *(const u32x4*)(kp + (size_t)(4 * q) * SEQ + ((n0_) + i) * 128); } } while (0)
#define RS_CHUNK(buf_, i_, n_, refill_) do { \
        _Pragma("unroll") for (int q = 0; q < 4; ++q) { *(LAS u32x4*)(img + (tq + 4 * q) * 272 + 16 * c16) = rv[buf_][i_][q]; *(LAS u32x4*)(img + (16 + tq + 4 * q) * 272 + 16 * c16) = rk[buf_][i_][q]; } \
        refill_; \
        LDS_WAIT(); asm volatile("" ::: "memory"); \
        f32x4 acc = {0.f, 0.f, 0.f, 0.f}; \
        _Pragma("unroll") for (int kk = 0; kk < 4; ++kk) { const bf16x8 a = *(const LAS bf16x8*)(img + r16 * 272 + 64 * kk + 16 * g), b = *(const LAS bf16x8*)(img + (16 + r16) * 272 + 64 * kk + 16 * g); acc = mfma16(a, b, acc); } \
        LDS_WAIT(); asm volatile("" ::: "memory"); \
        bf16* st = ST + (((size_t)bh * 32 + (n_)) * 128 + 16 * et + 4 * g) * 128 + 16 * dt + r16; \
        _Pragma("unroll") for (int r = 0; r < 4; ++r) st[r * 128] = (bf16)(pk2(S[r], 0.f) & 0xffffu); \
        S = S * dec + acc; } while (0)
    RS_LOAD(0, 0); RS_LOAD(1, 2);
    asm volatile("" ::: "memory");
#pragma unroll 1
    for (int n0 = 0; n0 < 32; n0 += 4) {
        RS_CHUNK(0, 0, n0, (void)0);
        RS_CHUNK(0, 1, n0 + 1, if (n0 + 4 < 32) RS_LOAD(0, n0 + 4));
        RS_CHUNK(1, 0, n0 + 2, (void)0);
        RS_CHUNK(1, 1, n0 + 3, if (n0 + 6 < 32) RS_LOAD(1, n0 + 6));
        asm volatile("" : "+v"(S));
    }
#undef RS_LOAD
#undef RS_CHUNK
    float* o = P->out + O_RSP + ((size_t)L * 16 + bh) * 16384 + (size_t)(16 * dt + r16) * 128 + 16 * et + 4 * g;
    *(f32x4*)o = S;
}
__device__ __forceinline__ void ret_sample_unit(PK P, const Ctx& C, int L, int unit) {
    unsigned char* ws = P->ws; const bf16* Z = (const bf16*)(ws + WS_Z);
    const int b = unit >> 2, h = unit & 3, tid = C.tid; const int r0 = MP + b * 8;
    LAS float* q = (LAS float*)C.lds;
    LAS float* kp = q + 1024;
    LAS float* v = kp + 1024;
    LAS float* rz = v + 1024;
    LAS float* A = rz + 1024;
    LAS float* op = A + 64;
    const float lg2 = ret_log2g(h);
    { const int c = tid >> 6, i = tid & 63; const size_t row = (size_t)(r0 + c);
      const f32x2 cs = ((const f32x2*)(ws + WS_ROPER))[(size_t)(PAST + c) * 64 + i];
      const float q1 = bf2f(Z[row * NZ + ZC_RQ + h * 128 + i]), q2 = bf2f(Z[row * NZ + ZC_RQ + h * 128 + 64 + i]);
      q[i * 8 + c] = q1 * cs[0] - q2 * cs[1]; q[(64 + i) * 8 + c] = q2 * cs[0] + q1 * cs[1];
      const float k1 = bf2f(Z[row * NZ + ZC_RK + h * 128 + i]), k2 = bf2f(Z[row * NZ + ZC_RK + h * 128 + 64 + i]);
      const float ks = 0.08838834764831845f * __builtin_amdgcn_exp2f((float)(7 - c) * lg2);
      kp[i * 8 + c] = (k1 * cs[0] - k2 * cs[1]) * ks; kp[(64 + i) * 8 + c] = (k2 * cs[0] + k1 * cs[1]) * ks;
      v[c * 128 + i] = bf2f(Z[row * NZ + ZC_RV + h * 128 + i]); v[c * 128 + 64 + i] = bf2f(Z[row * NZ + ZC_RV + h * 128 + 64 + i]);
      rz[c * 128 + i] = bf2f(Z[row * NZ + ZC_RZ + h * 128 + i]); rz[c * 128 + 64 + i] = bf2f(Z[row * NZ + ZC_RZ + h * 128 + 64 + i]); }
    __syncthreads();
    { const int pr = tid >> 3, part = tid & 7, c = pr >> 3, s2 = pr & 7; float d = 0.f;
#pragma unroll
      for (int dd = 0; dd < 16; ++dd) d += q[(part * 16 + dd) * 8 + c] * kp[(part * 16 + dd) * 8 + s2];
      d += shx<1>(d, tid & 63); d += shx<2>(d, tid & 63); d += shx<4>(d, tid & 63);
      if (part == 0) A[pr] = (s2 <= c) ? d * __builtin_amdgcn_exp2f((float)(c - 7) * lg2) : 0.f; }
    { const int dq = tid >> 7, e = tid & 127; float vr[8], acc[8];
#pragma unroll
      for (int c = 0; c < 8; ++c) { vr[c] = v[c * 128 + e]; acc[c] = 0.f; }
      const float g8 = __builtin_amdgcn_exp2f(8.0f * lg2);
      const float* S0 = P->in[I_STATE] + (((size_t)L * DB + b) * 4 + h) * 16384; float* S1 = P->out + O_RSS + (((size_t)L * DB + b) * 4 + h) * 16384;
      float s0v[32];
#pragma unroll
      for (int dd = 0; dd < 32; ++dd) s0v[dd] = S0[(dq * 32 + dd) * 128 + e];
#pragma unroll
      for (int dd = 0; dd < 32; ++dd) { const int d = dq * 32 + dd; const float s0 = s0v[dd];
          const f32x4 qa = *(const LAS f32x4*)(q + d * 8), qb = *(const LAS f32x4*)(q + d * 8 + 4), ka = *(const LAS f32x4*)(kp + d * 8), kb = *(const LAS f32x4*)(kp + d * 8 + 4);
          float sn = s0 * g8;
#pragma unroll
          for (int c = 0; c < 4; ++c) { acc[c] += qa[c] * s0; acc[4 + c] += qb[c] * s0; sn += ka[c] * vr[c]; sn += kb[c] * vr[4 + c]; }
          S1[d * 128 + e] = sn; }
#pragma unroll
      for (int c = 0; c < 8; ++c) op[(dq * 8 + c) * 128 + e] = acc[c]; }
    __syncthreads();
    { const int c = tid >> 6, i = tid & 63; float o[2]; const float gq = __builtin_amdgcn_exp2f((float)(c + 1) * lg2);
#pragma unroll
      for (int u = 0; u < 2; ++u) { const int e = i + 64 * u; float s = (op[(0 * 8 + c) * 128 + e] + op[(1 * 8 + c) * 128 + e]) + (op[(2 * 8 + c) * 128 + e] + op[(3 * 8 + c) * 128 + e]); s *= gq;
          for (int sidx = 0; sidx <= c; ++sidx) s += A[c * 8 + sidx] * v[sidx * 128 + e];
          o[u] = s; }
      float sm = o[0] + o[1];
      sm = wave_sum(sm, i);
      const float mu = sm * (1.0f / 128.0f); float qv = (o[0] - mu) * (o[0] - mu) + (o[1] - mu) * (o[1] - mu);
      qv = wave_sum(qv, i);
      const float rstd = __builtin_amdgcn_rsqf(qv * (1.0f / 128.0f) + 1e-5f);
      bf16* og = (bf16*)(ws + WS_OGR) + (size_t)(r0 + c) * 512 + h * 128;
#pragma unroll
      for (int u = 0; u < 2; ++u) { const int e = i + 64 * u; og[e] = (bf16)(pk2((o[u] - mu) * rstd * siluf_(rz[c * 128 + e]), 0.f) & 0xffffu); } }
    __syncthreads();
}
template <bool SAMPLE>
__device__ __forceinline__ void score_item(PK P, const Ctx& C, int L, int b, int qblk, int kc) {
    constexpr int QG = SAMPLE ? 1 : 2;
    constexpr int TG = SAMPLE ? 4 : 5;
    unsigned char* ws = P->ws; const int lane = C.lane, r32 = lane & 31, hf = lane >> 5;
    const bf16* IQ = (const bf16*)(ws + WS_IQ); const float* IW = (const float*)(ws + WS_IW);
    const int q0 = SAMPLE ? 0 : qblk * 16;
    const size_t rowbase = SAMPLE ? (size_t)MP + b * 8 : (size_t)b * SEQ + q0;
    bf16x8 af[QG][4]; f32x4 wv[QG][4];
#pragma unroll
    for (int gq = 0; gq < QG; ++gq) {
#pragma unroll
        for (int s = 0; s < 4; ++s) af[gq][s] = *(const bf16x8*)(IQ + (rowbase + 8 * gq + (r32 >> 2)) * 256 + (r32 & 3) * 64 + 16 * s + 8 * hf);
#pragma unroll
        for (int i = 0; i < 4; ++i) wv[gq][i] = *(const f32x4*)(IW + (rowbase + 8 * gq + 2 * i + hf) * 4); }
    const int nkeys = SAMPLE ? PAST + DS : q0 + 16;
    const int kt_end = min(kc * 16 + 16, (nkeys + 31) >> 5);
    const int* pt = (const int*)P->in[I_PT] + b * NPAGES;
    const float* cik = P->in[I_CIK] + (size_t)L * NPOOL * 128 * 64; const float* nik = P->out + O_IKS + ((size_t)L * DB + b) * DS * 64;
    const bf16* ikb = (const bf16*)(ws + WS_IKB) + (size_t)b * SEQ * 64;
    u32x4 cur[TG][SAMPLE ? 8 : 4];
    auto load_group = [&](int kt0, u32x4 (&dst)[TG][SAMPLE ? 8 : 4]) {
#pragma unroll
        for (int j = 0; j < TG; ++j) { const int kt = min(kt0 + j, kt_end - 1); const int key = kt * 32 + r32;
            if (SAMPLE) { const int kcl = key < PAST + DS ? key : PAST + DS - 1;
                const float* kr = (kcl < PAST) ? cik + ((size_t)pt[(kt >> 2) & 15] * 128 + (kcl & 127)) * 64 : nik + (size_t)(kcl - PAST) * 64;
#pragma unroll
                for (int s = 0; s < 4; ++s) { dst[j][2 * s] = *(const u32x4*)(kr + 16 * s + 8 * hf); dst[j][2 * s + 1] = *(const u32x4*)(kr + 16 * s + 8 * hf + 4); }
            } else { const bf16* kr = ikb + (size_t)key * 64;
#pragma unroll
                for (int s = 0; s < 4; ++s) dst[j][s] = *(const u32x4*)(kr + 16 * s + 8 * hf); } }
    };
    for (int kt0 = kc * 16; kt0 < kt_end; kt0 += TG) {
        load_group(kt0, cur);
#pragma unroll
        for (int j = 0; j < TG; ++j) { const int kt = kt0 + j;
            if (kt < kt_end) {
                const int key = kt * 32 + r32;
                bf16x8 bfr[4];
#pragma unroll
                for (int s = 0; s < 4; ++s) {
                    if (SAMPLE) { const f32x4 a = __builtin_bit_cast(f32x4, cur[j][2 * s]), c = __builtin_bit_cast(f32x4, cur[j][2 * s + 1]);
                        u32x4 w; w.x = pk2(a[0], a[1]); w.y = pk2(a[2], a[3]); w.z = pk2(c[0], c[1]); w.w = pk2(c[2], c[3]); bfr[s] = as_bf16x8(w); }
                    else bfr[s] = as_bf16x8(cur[j][s]); }
#pragma unroll
                for (int gq = 0; gq < QG; ++gq) {
                    f32x16 acc;
#pragma unroll
                    for (int i = 0; i < 16; ++i) acc[i] = 0.f;
#pragma unroll
                    for (int s = 0; s < 4; ++s) acc = mfma32(af[gq][s], bfr[s], acc);
                    float sc[4];
#pragma unroll
                    for (int i = 0; i < 4; ++i) {
                        float v = fmaxf(acc[4 * i + 0], 0.f) * wv[gq][i][0]; v += fmaxf(acc[4 * i + 1], 0.f) * wv[gq][i][1]; v += fmaxf(acc[4 * i + 2], 0.f) * wv[gq][i][2]; v += fmaxf(acc[4 * i + 3], 0.f) * wv[gq][i][3];
                        sc[i] = v + 0.0f; }
                    const bool odd = (lane & 1) != 0;
#pragma unroll
                    for (int i = 0; i < 4; i += 2) {
                        const float snd = odd ? sc[i] : sc[i + 1], rcv = shx<1>(snd, lane);
                        const float lo = odd ? rcv : sc[i], hi = odd ? sc[i + 1] : rcv;
                        const unsigned w = (unsigned)__builtin_bit_cast(unsigned short, (_Float16)lo) | ((unsigned)__builtin_bit_cast(unsigned short, (_Float16)hi) << 16);
                        const int ql = 8 * gq + 2 * (odd ? i + 1 : i) + hf, k0 = key & ~1;
                        if (SAMPLE) { if (k0 < PAST + DS) *(unsigned*)((unsigned short*)(ws + WS_SS) + ((size_t)b * 8 + ql) * SS_LD + k0) = w; }
                        else *(unsigned*)((unsigned short*)(ws + WS_SP) + ((size_t)b * SEQ + q0 + ql) * SEQ + k0) = w;
                    }
                }
            }
        }
        asm volatile("" ::: "memory");
    }
}
__device__ __forceinline__ void score_item_dma(PK P, const Ctx& C, int L, int b, int qblk, int kc, LAS unsigned char* img) {
    constexpr int QG = 2, TG = 4;
    unsigned char* ws = P->ws; const int lane = C.lane, r32 = lane & 31, hf = lane >> 5;
    const bf16* IQ = (const bf16*)(ws + WS_IQ); const float* IW = (const float*)(ws + WS_IW);
    const int q0 = qblk * 16;
    const size_t rowbase = (size_t)b * SEQ + q0;
    bf16x8 af[QG][4]; f32x4 wv[QG][4];
#pragma unroll
    for (int gq = 0; gq < QG; ++gq) {
#pragma unroll
        for (int s = 0; s < 4; ++s) af[gq][s] = *(const bf16x8*)(IQ + (rowbase + 8 * gq + (r32 >> 2)) * 256 + (r32 & 3) * 64 + 16 * s + 8 * hf);
#pragma unroll
        for (int i = 0; i < 4; ++i) wv[gq][i] = *(const f32x4*)(IW + (rowbase + 8 * gq + 2 * i + hf) * 4); }
    const int kt_end = min(kc * 16 + 16, (q0 + 16 + 31) >> 5);
    const unsigned char* ikb = ws + WS_IKB + (size_t)b * SEQ * 128;
    int voff[4], roff[4];
#pragma unroll
    for (int i = 0; i < 4; ++i) { voff[i] = (8 * i + (lane >> 3)) * 128 + 16 * ((lane & 7) ^ ((4 * i + (lane >> 4)) & 7)); roff[i] = r32 * 128 + 16 * ((2 * i + hf) ^ ((r32 >> 1) & 7)); }
#define SC_ISSUE(kt0_) do { _Pragma("unroll") for (int j = 0; j < TG; ++j) { const int kt_ = min((kt0_) + j, kt_end - 1); _Pragma("unroll") for (int i = 0; i < 4; ++i) \
        __builtin_amdgcn_global_load_lds((const unsigned*)(ikb + (size_t)kt_ * 4096 + voff[i]), (LAS unsigned*)(img + j * 4096 + i * 1024), 16, 0, 0); } } while (0)
    SC_ISSUE(kc * 16);
    for (int kt0 = kc * 16; kt0 < kt_end; kt0 += TG) {
        asm volatile("s_waitcnt vmcnt(0)" ::: "memory");
        u32x4 cur[TG][4];
#pragma unroll
        for (int j = 0; j < TG; ++j) {
#pragma unroll
            for (int s = 0; s < 4; ++s) cur[j][s] = *(const LAS u32x4*)(img + j * 4096 + roff[s]); }
        asm volatile("s_waitcnt lgkmcnt(0)" ::: "memory");
        if (kt0 + TG < kt_end) SC_ISSUE(kt0 + TG);
        asm volatile("" ::: "memory");
#pragma unroll
        for (int j = 0; j < TG; ++j) { const int kt = kt0 + j;
            if (kt < kt_end) {
                const int key = kt * 32 + r32;
#pragma unroll
                for (int gq = 0; gq < QG; ++gq) {
                    f32x16 acc;
#pragma unroll
                    for (int i = 0; i < 16; ++i) acc[i] = 0.f;
#pragma unroll
                    for (int s = 0; s < 4; ++s) acc = mfma32(af[gq][s], as_bf16x8(cur[j][s]), acc);
                    float sc[4];
#pragma unroll
                    for (int i = 0; i < 4; ++i) {
                        float v = fmaxf(acc[4 * i + 0], 0.f) * wv[gq][i][0]; v += fmaxf(acc[4 * i + 1], 0.f) * wv[gq][i][1]; v += fmaxf(acc[4 * i + 2], 0.f) * wv[gq][i][2]; v += fmaxf(acc[4 * i + 3], 0.f) * wv[gq][i][3];
                        sc[i] = v + 0.0f; }
                    const bool odd = (lane & 1) != 0;
#pragma unroll
                    for (int i = 0; i < 4; i += 2) {
                        const float snd = odd ? sc[i] : sc[i + 1], rcv = shx<1>(snd, lane);
                        const float lo = odd ? rcv : sc[i], hi = odd ? sc[i + 1] : rcv;
                        const unsigned w = (unsigned)__builtin_bit_cast(unsigned short, (_Float16)lo) | ((unsigned)__builtin_bit_cast(unsigned short, (_Float16)hi) << 16);
                        const int ql = 8 * gq + 2 * (odd ? i + 1 : i) + hf, k0 = key & ~1;
                        *(unsigned*)((unsigned short*)(ws + WS_SP) + ((size_t)b * SEQ + q0 + ql) * SEQ + k0) = w;
                    }
                }
            }
        }
        asm volatile("" ::: "memory");
    }
#undef SC_ISSUE
}
__device__ __forceinline__ void score_item_sdma(PK P, const Ctx& C, int L, int b, int kc, LAS unsigned char* img) {
    constexpr int TG = 2;
    unsigned char* ws = P->ws; const int lane = C.lane, r32 = lane & 31, hf = lane >> 5;
    const bf16* IQ = (const bf16*)(ws + WS_IQ); const float* IW = (const float*)(ws + WS_IW);
    const size_t rowbase = (size_t)MP + b * 8;
    bf16x8 af[4]; f32x4 wv[4];
#pragma unroll
    for (int s = 0; s < 4; ++s) af[s] = *(const bf16x8*)(IQ + (rowbase + (r32 >> 2)) * 256 + (r32 & 3) * 64 + 16 * s + 8 * hf);
#pragma unroll
    for (int i = 0; i < 4; ++i) wv[i] = *(const f32x4*)(IW + (rowbase + 2 * i + hf) * 4);
    const int kt_end = min(kc * 16 + 16, (PAST + DS + 31) >> 5);
    const int* pt = (const int*)P->in[I_PT] + b * NPAGES;
    const float* cik = P->in[I_CIK] + (size_t)L * NPOOL * 128 * 64; const float* nik = P->out + O_IKS + ((size_t)L * DB + b) * DS * 64;
    const int dr = lane >> 4, dq = lane & 15;
#define SS_ISSUE(kt0_) do { _Pragma("unroll") for (int j = 0; j < TG; ++j) { const int kt_ = min((kt0_) + j, kt_end - 1); const float* pg_ = cik + ((size_t)pt[(kt_ >> 2) & 15] * 128 + (kt_ & 3) * 32) * 64; \
        _Pragma("unroll") for (int i = 0; i < 8; ++i) { const int row_ = 4 * i + dr, key_ = kt_ * 32 + row_, kcl_ = key_ < PAST + DS ? key_ : PAST + DS - 1; \
            const float* src_ = (kcl_ < PAST ? pg_ + row_ * 64 : nik + (kcl_ - PAST) * 64) + 4 * (dq ^ (row_ & 15)); \
            __builtin_amdgcn_global_load_lds((const unsigned*)src_, (LAS unsigned*)(img + j * 8192 + i * 1024), 16, 0, 0); } } } while (0)
    SS_ISSUE(kc * 16);
    for (int kt0 = kc * 16; kt0 < kt_end; kt0 += TG) {
        asm volatile("s_waitcnt vmcnt(0)" ::: "memory");
        u32x4 cur[TG][8];
#pragma unroll
        for (int j = 0; j < TG; ++j) {
#pragma unroll
            for (int s = 0; s < 8; ++s) cur[j][s] = *(const LAS u32x4*)(img + j * 8192 + r32 * 256 + 16 * ((4 * (s >> 1) + 2 * hf + (s & 1)) ^ (r32 & 15))); }
        asm volatile("s_waitcnt lgkmcnt(0)" ::: "memory");
        if (kt0 + TG < kt_end) SS_ISSUE(kt0 + TG);
        asm volatile("" ::: "memory");
#pragma unroll
        for (int j = 0; j < TG; ++j) { const int kt = kt0 + j;
            if (kt < kt_end) {
                const int key = kt * 32 + r32;
                f32x16 acc;
#pragma unroll
                for (int i = 0; i < 16; ++i) acc[i] = 0.f;
#pragma unroll
                for (int s = 0; s < 4; ++s) { const f32x4 a = __builtin_bit_cast(f32x4, cur[j][2 * s]), c = __builtin_bit_cast(f32x4, cur[j][2 * s + 1]);
                    u32x4 w; w.x = pk2(a[0], a[1]); w.y = pk2(a[2], a[3]); w.z = pk2(c[0], c[1]); w.w = pk2(c[2], c[3]);
                    acc = mfma32(af[s], as_bf16x8(w), acc); }
                float sc[4];
#pragma unroll
                for (int i = 0; i < 4; ++i) {
                    float v = fmaxf(acc[4 * i + 0], 0.f) * wv[i][0]; v += fmaxf(acc[4 * i + 1], 0.f) * wv[i][1]; v += fmaxf(acc[4 * i + 2], 0.f) * wv[i][2]; v += fmaxf(acc[4 * i + 3], 0.f) * wv[i][3];
                    sc[i] = v + 0.0f; }
                const bool odd = (lane & 1) != 0;
#pragma unroll
                for (int i = 0; i < 4; i += 2) {
                    const float snd = odd ? sc[i] : sc[i + 1], rcv = shx<1>(snd, lane);
                    const float lo = odd ? rcv : sc[i], hi = odd ? sc[i + 1] : rcv;
                    const unsigned w = (unsigned)__builtin_bit_cast(unsigned short, (_Float16)lo) | ((unsigned)__builtin_bit_cast(unsigned short, (_Float16)hi) << 16);
                    const int ql = 2 * (odd ? i + 1 : i) + hf, k0 = key & ~1;
                    if (k0 < PAST + DS) *(unsigned*)((unsigned short*)(ws + WS_SS) + ((size_t)b * 8 + ql) * SS_LD + k0) = w;
                }
            }
        }
        asm volatile("" ::: "memory");
    }
#undef SS_ISSUE
}
__device__ __forceinline__ void phase_c(PK P, const Ctx& C, int L, int sel = 15) {
    LAS unsigned char* imgw = C.lds + C.wave * 16384;
    if (C.nblk == 256) {
        const int q1 = C.blk & 127, n1 = q1 / 32 + 1;
        if (C.wave < 4) { if (sel & 1) for (int it = C.blk * 4 + C.wave; it < 1024; it += C.nblk * 4) ret_state_item(P, C, L, it); }
        else { const int k = C.wave & 3, f = (C.blk >> 7) * 4 + k; LAS unsigned char* imgf = C.lds + (k < 3 ? 71680 + k * 16384 : XPOSE_OFF);
            if ((sel & 8) && f < 5) score_item_sdma(P, C, L, q1, f, imgf);
            if ((sel & 4) && f >= 4) { const int j = f == 4 ? 35 : 27 + f; const int b = j / 9, c = j - 9 * b; if (c < n1) score_item_dma(P, C, L, b, q1, c, imgf); else score_item_dma(P, C, L, b, 255 - q1, c - n1, imgf); } }
        if (sel & 2) for (int u = C.blk; u < 512; u += C.nblk) ret_sample_unit(P, C, L, u);
        if (sel & 4) { const int wp = (C.blk >> 7) * NWAVES + C.wave;
            for (int j = wp; j < 32; j += 16) { const int b = j / 9, c = j - 9 * b; if (c < n1) score_item_dma(P, C, L, b, q1, c, imgw); else score_item_dma(P, C, L, b, 255 - q1, c - n1, imgw); } }
    } else {
        if ((sel & 1) && C.wave < 4) for (int it = C.blk * 4 + C.wave; it < 1024; it += C.nblk * 4) ret_state_item(P, C, L, it);
        if (sel & 2) for (int u = C.blk; u < 512; u += C.nblk) ret_sample_unit(P, C, L, u);
        if (sel & 4) for (int it = C.gw; it < NB * 256 * 8; it += C.ngw) { const int kc = it & 7, qb = (it >> 3) & 255, b = it >> 11; if (kc * 512 <= qb * 16 + 15) score_item_dma(P, C, L, b, qb, kc, imgw); }
        if ((sel & 8) && C.wave >= 4) for (int it = C.blk * 4 + (C.wave & 3); it < DB * 5; it += C.nblk * 4) score_item_sdma(P, C, L, it / 5, it % 5, imgw);
    }
}

__device__ __forceinline__ void ret_scan_item(PK P, const Ctx& C, int L, int item) {
    unsigned char* ws = P->ws; const float* KVT = (const float*)(ws + WS_KVT); bf16* ST = (bf16*)(ws + WS_ST);
    const int e0 = item * 1024 + C.tid * 2, bh = e0 >> 14, rem = e0 & 16383, h = bh & 3;
    const float dec = __builtin_amdgcn_exp2f(128.0f * ret_log2g(h));
    float s0 = 0.f, s1 = 0.f;
#pragma unroll 8
    for (int n = 0; n < 32; ++n) { const f32x2 kv = *(const f32x2*)(KVT + ((size_t)bh * 32 + n) * 16384 + rem);
        *(unsigned*)(ST + ((size_t)bh * 32 + n) * 16384 + rem) = pk2(s0, s1); s0 = s0 * dec + kv[0]; s1 = s1 * dec + kv[1]; }
    const int e = rem >> 7, d = rem & 127;
    float* o = P->out + O_RSP + ((size_t)L * 16 + bh) * 16384; o[d * 128 + e] = s0; o[(d + 1) * 128 + e] = s1;
}
template <int G>
__device__ __forceinline__ void cnt_ge4(const unsigned (&kp)[32], unsigned cm1, unsigned& c0, unsigned& c1) {
    unsigned t0, t1, t2, t3;
    asm("v_pk_sub_u16 %2, %6, %10 clamp\n\tv_pk_sub_u16 %3, %7, %10 clamp\n\tv_pk_sub_u16 %4, %8, %10 clamp\n\tv_pk_sub_u16 %5, %9, %10 clamp\n\t"
        "v_pk_min_u16 %2, %2, %11\n\tv_pk_min_u16 %3, %3, %11\n\tv_pk_min_u16 %4, %4, %11\n\tv_pk_min_u16 %5, %5, %11\n\t"
        "v_pk_add_u16 %0, %0, %2\n\tv_pk_add_u16 %1, %1, %3\n\tv_pk_add_u16 %0, %0, %4\n\tv_pk_add_u16 %1, %1, %5"
        : "+v"(c0), "+v"(c1), "=&v"(t0), "=&v"(t1), "=&v"(t2), "=&v"(t3)
        : "v"(kp[4 * G + 0]), "v"(kp[4 * G + 1]), "v"(kp[4 * G + 2]), "v"(kp[4 * G + 3]), "s"(cm1), "s"(0x00010001u));
}
__device__ __forceinline__ int wave_sum_dpp(int v) {
    v += __builtin_amdgcn_update_dpp(0, v, 0x111, 0xf, 0xf, true);
    v += __builtin_amdgcn_update_dpp(0, v, 0x112, 0xf, 0xf, true);
    v += __builtin_amdgcn_update_dpp(0, v, 0x114, 0xf, 0xf, true);
    v += __builtin_amdgcn_update_dpp(0, v, 0x118, 0xf, 0xf, true);
    v += __builtin_amdgcn_update_dpp(0, v, 0x142, 0xa, 0xf, true);
    v += __builtin_amdgcn_update_dpp(0, v, 0x143, 0xc, 0xf, true);
    return __builtin_amdgcn_readlane(v, 63);
}
__device__ __forceinline__ unsigned cnt_ge_lane(const unsigned (&kp)[32], unsigned cand, int ng) {
    const unsigned cm1 = (cand - 1u) * 0x00010001u; unsigned c0 = 0u, c1 = 0u;
    cnt_ge4<0>(kp, cm1, c0, c1);
    if (ng > 1) cnt_ge4<1>(kp, cm1, c0, c1);
    if (ng > 2) cnt_ge4<2>(kp, cm1, c0, c1);
    if (ng > 3) cnt_ge4<3>(kp, cm1, c0, c1);
    if (ng > 4) cnt_ge4<4>(kp, cm1, c0, c1);
    if (ng > 5) cnt_ge4<5>(kp, cm1, c0, c1);
    if (ng > 6) cnt_ge4<6>(kp, cm1, c0, c1);
    if (ng > 7) cnt_ge4<7>(kp, cm1, c0, c1);
    const unsigned c = c0 + c1;
    return (c & 0xffffu) + (c >> 16);
}
__device__ __forceinline__ int cnt_ge(const unsigned (&kp)[32], unsigned cand, int ng) { return wave_sum_dpp((int)cnt_ge_lane(kp, cand, ng)); }
__device__ __forceinline__ void bit_transpose16(unsigned (&x)[16]) {
#define BT_STAGE(J, M) _Pragma("unroll") for (int r = 0; r < 16; ++r) if ((r & (J)) == 0) { const unsigned a = x[r], b = x[r + (J)]; x[r] = (a & (M)) | ((b << (J)) & ~(M)); x[r + (J)] = ((a >> (J)) & (M)) | (b & ~(M)); }
    BT_STAGE(8, 0x00ff00ffu) BT_STAGE(4, 0x0f0f0f0fu) BT_STAGE(2, 0x33333333u) BT_STAGE(1, 0x55555555u)
#undef BT_STAGE
}
__device__ __forceinline__ void select_topk(const unsigned short* srow, int Lk, LAS unsigned* list, int lane, int mode = 3) {
    const int ng = (Lk + 511) >> 9;
    unsigned kp[32];
    const unsigned* sl = (const unsigned*)srow + lane;
    if (ng > 4) {
#pragma unroll
        for (int j = 0; j < 32; ++j) kp[j] = sl[j * 64];
    } else {
#pragma unroll
        for (int j = 0; j < 16; ++j) kp[j] = sl[j * 64];
#pragma unroll
        for (int j = 16; j < 32; ++j) kp[j] = 0u;
    }
    typedef short s16x2 __attribute__((ext_vector_type(2)));
#pragma unroll
    for (int j = 0; j < 32; ++j) { const unsigned w = kp[j];
        const unsigned sg = __builtin_bit_cast(unsigned, __builtin_bit_cast(s16x2, w) >> (s16x2){15, 15});
        unsigned kk = w ^ (sg | 0x80008000u);
        const int rem = Lk - 128 * j;
        if (rem < 128) kk &= ((2 * lane < rem) ? 0xffffu : 0u) | ((2 * lane + 1 < rem) ? 0xffff0000u : 0u);
        kp[j] = kk; }
    unsigned p0[16], p1[16];
#pragma unroll
    for (int j = 0; j < 16; ++j) { p0[j] = kp[j]; p1[j] = 0u; }
    bit_transpose16(p0);
    if (ng > 4) {
#pragma unroll
        for (int j = 0; j < 16; ++j) p1[j] = kp[16 + j];
        bit_transpose16(p1); }
    unsigned act0 = ~0u, act1 = ~0u, gt0 = 0u, gt1 = 0u; int G = 0;
#pragma unroll
    for (int bit = 15; bit >= 0; --bit) {
        const unsigned t0 = act0 & p0[bit], t1 = act1 & p1[bit];
        const int c = __builtin_popcount(t0) + __builtin_popcount(t1);
        const int tot = wave_sum_dpp(c);
        const bool take = G + tot >= TOPK;
        if (take) { act0 = t0; act1 = t1; } else { G += tot; gt0 |= t0; gt1 |= t1; act0 ^= t0; act1 ^= t1; }
    }
    const int neq = wave_sum_dpp(__builtin_popcount(act0) + __builtin_popcount(act1));
    unsigned sel0, sel1;
    if (G + neq == TOPK) { sel0 = gt0 | act0; sel1 = gt1 | act1; }
    else {
        const int need_eq = TOPK - G; int jc = 0, base = 0;
#define SEL_MASKR(m_) ((m_) <= 0 ? 0u : (m_) >= 16 ? 0xffffffffu : ((1u << (m_)) - 1u) * 0x00010001u)
#pragma unroll
        for (int s = 16; s >= 1; s >>= 1) { const int jm = jc + s; const unsigned m0 = SEL_MASKR(jm), m1 = SEL_MASKR(jm - 16);
            const int cb = wave_sum_dpp(__builtin_popcount(act0 & m0) + __builtin_popcount(act1 & m1));
            if (cb < need_eq) { jc = jm; base = cb; } }
        const int rc = jc & 15; const unsigned aw = jc >= 16 ? act1 : act0;
        const bool e0 = ((aw >> rc) & 1u) != 0u, e1 = ((aw >> (16 + rc)) & 1u) != 0u;
        const unsigned long long b0 = __ballot(e0), b1 = __ballot(e1);
        const int rk = base + mbcnt64(b0) + mbcnt64(b1);
        const bool s0 = e0 && rk < need_eq, s1 = e1 && (rk + (e0 ? 1 : 0)) < need_eq;
        const unsigned add = ((s0 ? 1u : 0u) << rc) | ((s1 ? 1u : 0u) << (16 + rc));
        const unsigned m0 = SEL_MASKR(jc), m1 = SEL_MASKR(jc - 16);
        sel0 = gt0 | (act0 & m0) | (jc < 16 ? add : 0u);
        sel1 = gt1 | (act1 & m1) | (jc >= 16 ? add : 0u);
#undef SEL_MASKR
    }
    { const int cl = __builtin_popcount(sel0) + __builtin_popcount(sel1);
      int inc = cl;
      inc += __builtin_amdgcn_update_dpp(0, inc, 0x111, 0xf, 0xf, true);
      inc += __builtin_amdgcn_update_dpp(0, inc, 0x112, 0xf, 0xf, true);
      inc += __builtin_amdgcn_update_dpp(0, inc, 0x114, 0xf, 0xf, true);
      inc += __builtin_amdgcn_update_dpp(0, inc, 0x118, 0xf, 0xf, true);
      inc += __builtin_amdgcn_update_dpp(0, inc, 0x142, 0xa, 0xf, true);
      inc += __builtin_amdgcn_update_dpp(0, inc, 0x143, 0xc, 0xf, true);
      int off = inc - cl; unsigned m0 = sel0, m1 = sel1;
      while (__ballot((m0 | m1) != 0u) != 0ull) {
          const bool has0 = m0 != 0u; const unsigned m = has0 ? m0 : m1; const bool valid = m != 0u;
          const int p = __builtin_ctz(m | 0x80000000u);
          const unsigned idx = (unsigned)((((p & 15) + (has0 ? 0 : 16)) << 7) + 2 * lane + (p >> 4));
          list[valid ? off : 2368 + lane] = idx;
          off += valid ? 1 : 0;
          const unsigned nm = m & (m - 1u);
          m0 = has0 ? nm : m0; m1 = has0 ? m1 : nm; }
    }
}
#ifndef SEL2
#define SEL2 0
#endif
#ifndef QK2
#define QK2 0
#endif
#ifndef PV2
#define PV2 0
#endif
#ifndef NOXCD
#define NOXCD 0
#endif
constexpr int ATT_WSTRIDE = 10496;
template <bool SAMPLE>
__device__ __forceinline__ void attend_query(PK P, const Ctx& C, int L, int row, int mode = 3) {
    int lane_ = C.lane; asm volatile("" : "+v"(lane_));
    unsigned char* ws = P->ws; const int lane = lane_;
    LAS unsigned* list = (LAS unsigned*)(C.lds + C.wave * ATT_WSTRIDE);
    int b, Lk; const unsigned short* srow;
    if (SAMPLE) { b = (row - MP) >> 3; const int j = (row - MP) & 7; Lk = PAST + j + 1; srow = (const unsigned short*)(ws + WS_SS) + (size_t)(row - MP) * SS_LD; }
    else { b = row >> 12; const int t = row & (SEQ - 1); Lk = t + 1; srow = (const unsigned short*)(ws + WS_SP) + (size_t)row * SEQ; }
    const int n16 = lane & 15, g = lane >> 4;
    u32x4 qraw[2]; qraw[0] = (u32x4){0u, 0u, 0u, 0u}; qraw[1] = qraw[0];
    if (n16 < 8) { qraw[0] = *(const u32x4*)((const bf16*)(ws + WS_AQ) + (size_t)row * 512 + n16 * 64 + 8 * g); qraw[1] = *(const u32x4*)((const bf16*)(ws + WS_AQ) + (size_t)row * 512 + n16 * 64 + 32 + 8 * g); }
    u32x2 azr[4];
#pragma unroll
    for (int dl = 0; dl < 4; ++dl) azr[dl] = *(const u32x2*)((const bf16*)(ws + WS_Z) + (size_t)row * NZ + ZC_AZ + (n16 & 7) * 64 + 16 * dl + 4 * g);
    int ptv = 0; if (SAMPLE) ptv = ((const int*)P->in[I_PT])[b * NPAGES + (lane & 15)];
    int count;
    if (Lk <= TOPK) { for (int i = lane; i < TOPK; i += 64) list[i] = i < Lk ? (unsigned)i : 0u; count = Lk; }
    else { select_topk(srow, Lk, list, lane, mode); if (SEL2) { LDS_WAIT(); asm volatile("" ::: "memory"); select_topk(srow, Lk, list, lane, mode); } count = TOPK; }
    LDS_WAIT(); asm volatile("" ::: "memory");
    if (mode == 1 || mode == 4 || mode == 5) return;
    {
#pragma unroll
      for (int i = 0; i < 4; ++i) { const unsigned k = list[lane + 64 * i]; unsigned phys;
          if (SAMPLE) { const unsigned pg = (unsigned)__builtin_amdgcn_ds_bpermute((int)(((k >> 7) & 15u) << 2), ptv); phys = (k < (unsigned)PAST) ? pg * 128u + (k & 127u) : (0x80000000u | (k - PAST)); }
          else phys = (unsigned)b * SEQ + k;
          list[lane + 64 * i] = phys; } }
    LDS_WAIT(); asm volatile("" ::: "memory");
    const float* ck = SAMPLE ? P->in[I_CK] + (size_t)L * NPOOL * 128 * 128 : nullptr; const float* cv = SAMPLE ? P->in[I_CV] + (size_t)L * NPOOL * 128 * 128 : nullptr;
    const float* nk = P->out + O_KS + ((size_t)L * DB + b) * DS * 128; const float* nv = P->out + O_VS + ((size_t)L * DB + b) * DS * 128;
    const bf16* KBp = (const bf16*)(ws + WS_KB); const bf16* VBp = (const bf16*)(ws + WS_VB);
    bf16x8 qf[2][2];
#pragma unroll
    for (int kvh = 0; kvh < 2; ++kvh)
#pragma unroll
        for (int s = 0; s < 2; ++s) { const u32x4 zz = {0u, 0u, 0u, 0u}; qf[kvh][s] = as_bf16x8(((n16 >> 2) == kvh) ? qraw[s] : zz); }
    f32x4 S[16];
    for (int rq_ = 0; rq_ < (QK2 ? 2 : 1); ++rq_) {
    { LAS unsigned char* kbuf = C.lds + C.wave * ATT_WSTRIDE + 1024; const int c16k = lane & 15, tqk = lane >> 4;
      constexpr int SB = SAMPLE ? 1 : 2, NBT = 8 / SB;
      u32x4 kraw[2][SB][SAMPLE ? 16 : 8];
#define ATT_KLOAD(buf_, k_) do { _Pragma("unroll") for (int q = 0; q < SB; ++q) _Pragma("unroll") for (int i = 0; i < 8; ++i) { const unsigned phys = list[32 * ((k_) * SB + q) + tqk + 4 * i]; \
                if (SAMPLE) { const float* kr = ((phys & 0x80000000u) ? nk + (size_t)(phys & 7u) * 128 : ck + (size_t)phys * 128) + 8 * c16k; kraw[buf_][q][2 * i] = *(const u32x4*)kr; kraw[buf_][q][2 * i + 1] = *(const u32x4*)(kr + 4); } \
                else kraw[buf_][q][i] = *(const u32x4*)(KBp + (size_t)phys * 128 + 8 * c16k); } } while (0)
      ATT_KLOAD(0, 0); ATT_KLOAD(1, 1);
      asm volatile("" ::: "memory");
#pragma unroll
      for (int k = 0; k < NBT; ++k) {
#pragma unroll
        for (int q = 0; q < SB; ++q) { const int st = k * SB + q;
#pragma unroll
            for (int i = 0; i < 8; ++i) { u32x4 w;
                if (SAMPLE) { const f32x4 a = __builtin_bit_cast(f32x4, kraw[k & 1][q][2 * i]), c = __builtin_bit_cast(f32x4, kraw[k & 1][q][2 * i + 1]); w.x = pk2(a[0], a[1]); w.y = pk2(a[2], a[3]); w.z = pk2(c[0], c[1]); w.w = pk2(c[2], c[3]); }
                else w = kraw[k & 1][q][i];
                *(LAS u32x4*)(kbuf + (tqk + 4 * i) * 288 + 16 * c16k) = w; }
            if (q == SB - 1 && k + 2 < NBT) ATT_KLOAD(k & 1, k + 2);
            LDS_WAIT(); asm volatile("" ::: "memory");
#pragma unroll
            for (int tt = 0; tt < 2; ++tt) { const LAS unsigned char* rp = kbuf + (16 * tt + n16) * 288 + 16 * g;
                const bf16x8 a00 = *(const LAS bf16x8*)rp, a01 = *(const LAS bf16x8*)(rp + 64), a10 = *(const LAS bf16x8*)(rp + 128), a11 = *(const LAS bf16x8*)(rp + 192);
                f32x4 acc = {0.f, 0.f, 0.f, 0.f};
                acc = mfma16(a00, qf[0][0], acc); acc = mfma16(a01, qf[0][1], acc); acc = mfma16(a10, qf[1][0], acc); acc = mfma16(a11, qf[1][1], acc); asm volatile("" : "+v"(acc)); S[2 * st + tt] = acc; }
            LDS_WAIT(); asm volatile("" ::: "memory"); }
      }
#undef ATT_KLOAD
    }
    asm volatile("" ::: "memory"); }
    LAS unsigned char* vbuf = C.lds + C.wave * ATT_WSTRIDE + 1024;
    const int c16 = lane & 15, tq = lane >> 4;
    constexpr int VD = SAMPLE ? 1 : 2;
    u32x4 vraw[VD][SAMPLE ? 16 : 8];
#define ATT_VLOAD(buf_, st_) do { _Pragma("unroll") for (int i = 0; i < 8; ++i) { const unsigned phys = list[32 * (st_) + tq + 4 * i]; \
            if (SAMPLE) { const float* vr = ((phys & 0x80000000u) ? nv + (size_t)(phys & 7u) * 128 : cv + (size_t)phys * 128) + 8 * c16; vraw[buf_][2 * i] = *(const u32x4*)vr; vraw[buf_][2 * i + 1] = *(const u32x4*)(vr + 4); } \
            else vraw[buf_][i] = *(const u32x4*)(VBp + (size_t)phys * 128 + 8 * c16); } } while (0)
    if (mode != 2) {
#pragma unroll
        for (int d = 0; d < VD; ++d) ATT_VLOAD(d, d); }
    asm volatile("" ::: "memory");
    float mx = -INFINITY;
#pragma unroll
    for (int i = 0; i < 16; ++i)
#pragma unroll
        for (int r = 0; r < 4; ++r) { const int slot = 16 * i + 4 * g + r; const float sv = slot < count ? S[i][r] * 0.125f : -INFINITY; S[i][r] = sv; mx = fmaxf(mx, sv); }
    mx = fmaxf(mx, shx<16>(mx, lane)); mx = fmaxf(mx, shx<32>(mx, lane));
    float sum = 0.f;
#pragma unroll
    for (int i = 0; i < 16; ++i)
#pragma unroll
        for (int r = 0; r < 4; ++r) { const float p = __builtin_amdgcn_exp2f((S[i][r] - mx) * 1.4426950408889634f); S[i][r] = p; sum += p; }
    sum += shx<16>(sum, lane); sum += shx<32>(sum, lane);
    if (mode == 2) return;
    f32x4 oacc[8];
    {
#pragma unroll
    for (int dt = 0; dt < 8; ++dt) oacc[dt] = (f32x4){0.f, 0.f, 0.f, 0.f};
    const unsigned tr_a = (unsigned)(4 * g + (c16 >> 2)) * 288u + (unsigned)(c16 & 3) * 8u;
#pragma unroll
    for (int st = 0; st < 8; ++st) {
#pragma unroll
        for (int i = 0; i < 8; ++i) { u32x4 w;
            if (SAMPLE) { const f32x4 a = __builtin_bit_cast(f32x4, vraw[st % VD][2 * i]), c = __builtin_bit_cast(f32x4, vraw[st % VD][2 * i + 1]); w.x = pk2(a[0], a[1]); w.y = pk2(a[2], a[3]); w.z = pk2(c[0], c[1]); w.w = pk2(c[2], c[3]); }
            else w = vraw[st % VD][i];
            *(LAS u32x4*)(vbuf + (tq + 4 * i) * 288 + 16 * c16) = w; }
        if (st + VD < 8) ATT_VLOAD(st % VD, st + VD);
        const f32x4 p0 = S[2 * st], p1 = S[2 * st + 1];
        u32x4 pw; pw.x = pk2(p0[0], p0[1]); pw.y = pk2(p0[2], p0[3]); pw.z = pk2(p1[0], p1[1]); pw.w = pk2(p1[2], p1[3]);
        const bf16x8 pf = as_bf16x8(pw);
        LDS_WAIT(); asm volatile("" ::: "memory");
#pragma unroll
        for (int dt = 0; dt < 8; ++dt) {
            typedef short v4i16_t __attribute__((ext_vector_type(4)));
            const v4i16_t lo = __builtin_amdgcn_ds_read_tr16_b64_v4i16((LAS v4i16_t*)(vbuf + tr_a + 32 * dt));
            const v4i16_t hi = __builtin_amdgcn_ds_read_tr16_b64_v4i16((LAS v4i16_t*)(vbuf + tr_a + 16 * 288 + 32 * dt));
            bf16x8 af; af[0] = lo[0]; af[1] = lo[1]; af[2] = lo[2]; af[3] = lo[3]; af[4] = hi[0]; af[5] = hi[1]; af[6] = hi[2]; af[7] = hi[3];
            oacc[dt] = mfma16(af, pf, oacc[dt]); }
        LDS_WAIT(); asm volatile("" ::: "memory");
    }
    asm volatile("" ::: "memory"); }
    { const float inv = 1.0f / sum;
#define ATT_EPI(base_) do { _Pragma("unroll") for (int dl = 0; dl < 4; ++dl) { const f32x4 v = oacc[(base_) + dl]; \
              const float y0 = v[0] * inv * siluf_(bflo(azr[dl].x)), y1 = v[1] * inv * siluf_(bfhi(azr[dl].x)), y2 = v[2] * inv * siluf_(bflo(azr[dl].y)), y3 = v[3] * inv * siluf_(bfhi(azr[dl].y)); \
              u32x2 ow; ow.x = pk2(y0, y1); ow.y = pk2(y2, y3); \
              *(u32x2*)((bf16*)(ws + WS_OGA) + (size_t)row * 512 + n16 * 64 + 16 * dl + 4 * g) = ow; } } while (0)
      if (n16 < 4) ATT_EPI(0); else if (n16 < 8) ATT_EPI(4);
#undef ATT_EPI
    }
    LDS_WAIT(); asm volatile("" ::: "memory");
#undef ATT_VLOAD
}
__device__ __forceinline__ void ret_out_unit(PK P, const Ctx& C, int unit, bool flip);
__device__ __forceinline__ void phase_d(PK P, const Ctx& C, int L, int mode = 3) {
    if (mode == 3) { bool flip = false; for (int u = C.blk; u < 512; u += C.nblk) { ret_out_unit(P, C, u, flip); flip = !flip; } __syncthreads(); }
#ifndef DSEL
#define DSEL 7
#endif
    if (!(DSEL & 2)) {} else
    if (C.nblk == 256 && !NOXCD) {
        const int x = C.blk & 7, b = x >> 1, wq = (((C.blk >> 3) * 2 + (x & 1)) * NWAVES + C.wave);
        for (int t = wq; t < SEQ; t += 512) attend_query<false>(P, C, L, b * SEQ + t, mode);
    } else for (int row = C.gw; row < MP; row += C.ngw) attend_query<false>(P, C, L, row, mode);
    if (DSEL & 4) for (int i = C.gw; i < 2 * MS; i += C.ngw) if ((i & 1) == 0) attend_query<true>(P, C, L, MP + (i >> 1), mode);
}

__device__ __forceinline__ void ret_out_unit(PK P, const Ctx& C, int unit, bool flip) {
    unsigned char* ws = P->ws; const bf16* RQ = (const bf16*)(ws + WS_RQ); const bf16* RK = (const bf16*)(ws + WS_RK); const bf16* RVT = (const bf16*)(ws + WS_RVT); const bf16* ST = (const bf16*)(ws + WS_ST);
    const int bh = unit >> 5, b = bh >> 2, h = bh & 3, n = unit & 31, r16 = C.lane & 15, g = C.lane >> 4, t0 = n * 128;
    const int w = flip ? 7 - C.wave : C.wave;
    const size_t rowbase = (size_t)b * SEQ + t0;
    const float lg2 = ret_log2g(h);
    constexpr int RS = 272; LAS unsigned char* Ks = C.lds; LAS unsigned char* Vs = C.lds + 128 * RS; LAS unsigned char* Ss = C.lds + 256 * RS;
    bf16x8 qf[4];
#pragma unroll
    for (int kk = 0; kk < 4; ++kk) qf[kk] = *(const bf16x8*)(RQ + (rowbase + 16 * w + r16) * 512 + h * 128 + 32 * kk + 8 * g);
    { const int pr = C.tid >> 4, pc = C.tid & 15;
      u32x4 rk[4], rv[4], rs_[4];
#pragma unroll
      for (int q = 0; q < 4; ++q) { const int r = pr + 32 * q;
          rk[q] = *(const u32x4*)(RK + (rowbase + r) * 512 + h * 128 + 8 * pc);
          rv[q] = *(const u32x4*)(RVT + ((size_t)bh * 128 + r) * SEQ + t0 + 8 * pc);
          rs_[q] = *(const u32x4*)(ST + (((size_t)bh * 32 + n) * 128 + r) * 128 + 8 * pc); }
      __syncthreads();
#pragma unroll
      for (int q = 0; q < 4; ++q) { const int r = pr + 32 * q; *(LAS u32x4*)(Ks + r * RS + 16 * pc) = rk[q]; *(LAS u32x4*)(Vs + r * RS + 16 * pc) = rv[q]; *(LAS u32x4*)(Ss + r * RS + 16 * pc) = rs_[q]; }
      __syncthreads(); }
    unsigned pt[8][2];
#pragma unroll
    for (int st = 0; st < 8; ++st) {
        pt[st][0] = 0u; pt[st][1] = 0u;
        if (st <= w) { f32x4 acc = {0.f, 0.f, 0.f, 0.f};
#pragma unroll
            for (int kk = 0; kk < 4; ++kk) { const bf16x8 kf = *(const LAS bf16x8*)(Ks + (16 * st + r16) * RS + 64 * kk + 16 * g); acc = mfma16(kf, qf[kk], acc); }
            float vals[4];
#pragma unroll
            for (int r = 0; r < 4; ++r) { const int dlt = (16 * w + r16) - (16 * st + 4 * g + r); vals[r] = dlt >= 0 ? acc[r] * __builtin_amdgcn_exp2f((float)dlt * lg2) : 0.f; }
            pt[st][0] = pk2(vals[0], vals[1]); pt[st][1] = pk2(vals[2], vals[3]); }
    }
    const float dq = __builtin_amdgcn_exp2f((float)(16 * w + r16 + 1) * lg2);
    f32x4 o[8];
#pragma unroll
    for (int et = 0; et < 8; ++et) {
        f32x4 a1 = {0.f, 0.f, 0.f, 0.f}, a2 = {0.f, 0.f, 0.f, 0.f};
        const LAS unsigned char* vrow = Vs + (16 * et + r16) * RS;
#pragma unroll
        for (int i = 0; i < 4; ++i) if (2 * i <= w) {
            const u32x2 lo = *(const LAS u32x2*)(vrow + 2 * (32 * i + 4 * g)), hi = *(const LAS u32x2*)(vrow + 2 * (32 * i + 16 + 4 * g));
            const u32x4 aw = {lo.x, lo.y, hi.x, hi.y}, bw = {pt[2 * i][0], pt[2 * i][1], pt[2 * i + 1][0], pt[2 * i + 1][1]};
            a1 = mfma16(as_bf16x8(aw), as_bf16x8(bw), a1); }
#pragma unroll
        for (int kk = 0; kk < 4; ++kk) { const bf16x8 sf = *(const LAS bf16x8*)(Ss + (16 * et + r16) * RS + 64 * kk + 16 * g); a2 = mfma16(sf, qf[kk], a2); }
        o[et] = a1 + a2 * dq;
    }
    float sm = 0.f;
#pragma unroll
    for (int et = 0; et < 8; ++et) sm += (o[et][0] + o[et][1]) + (o[et][2] + o[et][3]);
    sm += shx<16>(sm, C.lane); sm += shx<32>(sm, C.lane);
    const float mu = sm * (1.0f / 128.0f); float qv = 0.f;
#pragma unroll
    for (int et = 0; et < 8; ++et) { const f32x4 d = o[et] - mu; qv += (d[0] * d[0] + d[1] * d[1]) + (d[2] * d[2] + d[3] * d[3]); }
    qv += shx<16>(qv, C.lane); qv += shx<32>(qv, C.lane);
    const float rstd = __builtin_amdgcn_rsqf(qv * (1.0f / 128.0f) + 1e-5f);
    const size_t row = rowbase + 16 * w + r16;
    const bf16* zr = (const bf16*)(ws + WS_Z) + row * NZ + ZC_RZ + h * 128; bf16* og = (bf16*)(ws + WS_OGR) + row * 512 + h * 128;
#pragma unroll
    for (int et = 0; et < 8; ++et) { const u32x2 zw = *(const u32x2*)(zr + 16 * et + 4 * g);
        const float y0 = (o[et][0] - mu) * rstd * siluf_(bflo(zw.x)), y1 = (o[et][1] - mu) * rstd * siluf_(bfhi(zw.x)), y2 = (o[et][2] - mu) * rstd * siluf_(bflo(zw.y)), y3 = (o[et][3] - mu) * rstd * siluf_(bfhi(zw.y));
        u32x2 ow; ow.x = pk2(y0, y1); ow.y = pk2(y2, y3); *(u32x2*)(og + 16 * et + 4 * g) = ow; }
}

template <int K>
__device__ __forceinline__ void mini_mma(const bf16* A, const bf16* Bt, int row0, int col0, const Ctx& C, f32x4 (&acc)[2]) {
    constexpr int RS = 272, BUF = 2 * 64 * RS;
    constexpr int NC = K / 128, PF = NC < 4 ? NC : 4;
    const int tid = C.tid, lane = C.lane, rt = C.wave >> 1, ch = C.wave & 1, r16 = lane & 15, g = lane >> 4;
    LAS unsigned char* sm = C.lds;
    const int pr0 = tid >> 4, pc = tid & 15;
    const bf16* ga = A + (size_t)(row0 + pr0) * K + 8 * pc; const bf16* gb = Bt + (size_t)(col0 + pr0) * K + 8 * pc;
    acc[0] = (f32x4){0.f, 0.f, 0.f, 0.f}; acc[1] = (f32x4){0.f, 0.f, 0.f, 0.f};
    u32x4 rr[PF][4];
#pragma unroll
    for (int p = 0; p < PF; ++p) { rr[p][0] = *(const u32x4*)(ga + 128 * p); rr[p][1] = *(const u32x4*)(ga + (size_t)32 * K + 128 * p); rr[p][2] = *(const u32x4*)(gb + 128 * p); rr[p][3] = *(const u32x4*)(gb + (size_t)32 * K + 128 * p); }
    asm volatile("" ::: "memory");
    __syncthreads();
#pragma unroll
    for (int c = 0; c < NC; ++c) {
        { LAS unsigned char* w = sm + (c & 1) * BUF + pr0 * RS + 16 * pc; *(LAS u32x4*)w = rr[c % PF][0]; *(LAS u32x4*)(w + 32 * RS) = rr[c % PF][1]; *(LAS u32x4*)(w + 64 * RS) = rr[c % PF][2]; *(LAS u32x4*)(w + 96 * RS) = rr[c % PF][3]; }
        if (c + PF < NC) { const int n = c + PF; rr[c % PF][0] = *(const u32x4*)(ga + 128 * n); rr[c % PF][1] = *(const u32x4*)(ga + (size_t)32 * K + 128 * n); rr[c % PF][2] = *(const u32x4*)(gb + 128 * n); rr[c % PF][3] = *(const u32x4*)(gb + (size_t)32 * K + 128 * n); }
        asm volatile("" ::: "memory");
        __syncthreads();
        const LAS unsigned char* rd = sm + (c & 1) * BUF;
#pragma unroll
        for (int kk = 0; kk < 4; ++kk) {
            const bf16x8 a = *(const LAS bf16x8*)(rd + (16 * rt + r16) * RS + 64 * kk + 16 * g);
            const bf16x8 b0 = *(const LAS bf16x8*)(rd + (64 + 32 * ch + r16) * RS + 64 * kk + 16 * g), b1 = *(const LAS bf16x8*)(rd + (64 + 32 * ch + 16 + r16) * RS + 64 * kk + 16 * g);
            acc[0] = mfma16(a, b0, acc[0]); acc[1] = mfma16(a, b1, acc[1]); }
    }
    __syncthreads();
}
__device__ __forceinline__ void mini_oproj(PK P, const Ctx& C, int L) {
    unsigned char* ws = P->ws; const int lane = C.lane, rt = C.wave >> 1, ch = C.wave & 1, r16 = lane & 15, g = lane >> 4;
    for (int u = C.blk; u < 256; u += C.nblk) { const int row0 = MP + 64 * (u >> 4), col0 = 64 * (u & 15);
        f32x4 a1[2], a2[2];
        mini_mma<512>((const bf16*)(ws + WS_OGR), (const bf16*)(ws + WS_WOR) + (size_t)L * DM * 512, row0, col0, C, a1);
        mini_mma<512>((const bf16*)(ws + WS_OGA), (const bf16*)(ws + WS_WOA) + (size_t)L * DM * 512, row0, col0, C, a2);
        const bf16* Z = (const bf16*)(ws + WS_Z); bf16* MB = (bf16*)(ws + WS_MB);
#pragma unroll
        for (int j = 0; j < 2; ++j)
#pragma unroll
            for (int r = 0; r < 4; ++r) { const size_t row = (size_t)(row0 + 16 * rt + 4 * g + r); const int col = col0 + 32 * ch + 16 * j + r16;
                const float m = sigmoidf_(bf2f(Z[row * NZ + ZC_GR + col])) * a1[j][r] + sigmoidf_(bf2f(Z[row * NZ + ZC_GA + col])) * a2[j][r];
                MB[row * DM + col] = (bf16)(pk2(m, 0.f) & 0xffffu); } }
}
__device__ __forceinline__ void mini_wout(PK P, const Ctx& C, int L) {
    unsigned char* ws = P->ws; const int lane = C.lane, rt = C.wave >> 1, ch = C.wave & 1, r16 = lane & 15, g = lane >> 4;
    const float* xs = P->in[I_XS] - (size_t)MP * DM;
    const bf16* xh = (const bf16*)(ws + WS_XB0);
    for (int u = C.blk; u < 256; u += C.nblk) { const int row0 = MP + 64 * (u >> 4), col0 = 64 * (u & 15);
        f32x4 a1[2];
        mini_mma<1024>((const bf16*)(ws + WS_MB), (const bf16*)(ws + WS_WOUT) + (size_t)L * DM * DM, row0, col0, C, a1);
        bf16* XB1 = (bf16*)(ws + WS_XB1);
#pragma unroll
        for (int j = 0; j < 2; ++j)
#pragma unroll
            for (int r = 0; r < 4; ++r) { const size_t row = (size_t)(row0 + 16 * rt + 4 * g + r); const int col = col0 + 32 * ch + 16 * j + r16;
                const float x = (L == 0) ? xs[row * DM + col] : bf2f(xh[row * DM + col]);
                XB1[row * DM + col] = (bf16)(pk2(x + a1[j][r], 0.f) & 0xffffu); } }
}
__device__ __forceinline__ void mini_ple(PK P, const Ctx& C, int L, bool do_ss = true) {
    unsigned char* ws = P->ws; const int lane = C.lane, rt = C.wave >> 1, ch = C.wave & 1, r16 = lane & 15, g = lane >> 4;
    float* rowss = (L + 1 < DEPTH && do_ss) ? (float*)(ws + WS_CTL) + CW_ROWSS1 : nullptr;
    for (int u = C.blk; u < 256; u += C.nblk) { const int row0 = MP + 64 * (u >> 4), col0 = 64 * (u & 15);
        f32x4 a1[2], a2[2];
        mini_mma<1024>((const bf16*)(ws + WS_XB1), (const bf16*)(ws + WS_WPG) + (size_t)L * DM * DM, row0, col0, C, a1);
        mini_mma<256>((const bf16*)(ws + WS_PB) + (size_t)L * MT * 256, (const bf16*)(ws + WS_WPP) + (size_t)L * DM * 256, row0, col0, C, a2);
        const bf16* XB1 = (const bf16*)(ws + WS_XB1); float* Y = P->out; bf16* XB0 = (bf16*)(ws + WS_XB0);
#pragma unroll
        for (int r = 0; r < 4; ++r) { const size_t row = (size_t)(row0 + 16 * rt + 4 * g + r); float ssq = 0.f;
#pragma unroll
            for (int j = 0; j < 2; ++j) { const int col = col0 + 32 * ch + 16 * j + r16;
                const float v = bf2f(XB1[row * DM + col]) + sigmoidf_(a1[j][r]) * a2[j][r]; if (L + 1 == DEPTH) Y[row * DM + col] = v; XB0[row * DM + col] = (bf16)(pk2(v, 0.f) & 0xffffu); ssq += v * v; }
            if (rowss != nullptr) { ssq += shx<1>(ssq, lane); ssq += shx<2>(ssq, lane); ssq += shx<4>(ssq, lane); ssq += shx<8>(ssq, lane); if (r16 == 0) atomicAdd(rowss + row, ssq); } } }
}


__device__ __forceinline__ void mini_inproj_gates(PK P, const Ctx& C, int L) {
    unsigned char* ws = P->ws; const int lane = C.lane, rt = C.wave >> 1, ch = C.wave & 1, r16 = lane & 15, g = lane >> 4;
    const float* rowss = (L == 0) ? (const float*)(ws + WS_ROWSS0) : (const float*)(ws + WS_CTL) + CW_ROWSS1;
    bf16* Z = (bf16*)(ws + WS_Z);
    for (int u = C.blk; u < 16 * 30; u += C.nblk) { const int row0 = MP + 64 * (u / 30), col0 = 15 * 256 + 64 * (u % 30);
        f32x4 a1[2];
        mini_mma<1024>((const bf16*)(ws + WS_XB0), (const bf16*)(ws + WS_WIN) + (size_t)L * NZ * DM, row0, col0, C, a1);
#pragma unroll
        for (int r = 0; r < 4; ++r) { const size_t row = (size_t)(row0 + 16 * rt + 4 * g + r); const float rs = __builtin_amdgcn_rsqf(rowss[row] * (1.0f / 1024.0f) + 1e-6f);
#pragma unroll
            for (int j = 0; j < 2; ++j) Z[row * NZ + col0 + 32 * ch + 16 * j + r16] = (bf16)(pk2(a1[j][r] * rs, 0.f) & 0xffffu); } }
}
__global__ void __launch_bounds__(NTHREADS, 2) mk_fwd(Params Pval) {
    extern __shared__ __attribute__((aligned(16))) unsigned char lds_raw[];
    LAS unsigned char* lds = (LAS unsigned char*)lds_raw;
    volatile LAS unsigned* MISC = (volatile LAS unsigned*)(lds + MISC_OFF);
    const int wave_s = __builtin_amdgcn_readfirstlane((int)threadIdx.x >> 6);
    for (int u = wave_s * 64 + hw_lane(); u < (LDS_BYTES - RING_BYTES) / 4; u += NTHREADS) ((LAS unsigned*)(lds + RING_BYTES))[u] = 0u;
    __syncthreads();
    const int lo = Pval.ph_lo, hi = Pval.ph_hi;
    XcdBarrier bar; bar.bar = (unsigned*)(Pval.ws + WS_CTL) + CW_BAR + Pval.li * XCD_BAR_WORDS; bar.x = 0; bar.st = MISC + 8;
    if (hi - lo > 1) bar = xcd_barrier_post(bar.bar, MISC + 8, wave_s == 0 && hw_lane() == 0);
#ifndef STEPSEL
#define STEPSEL(j) true
#endif
#define IN(k) (lo <= (k) && (k) < hi)
#ifndef DUPMASK
#define DUPMASK 0
#endif
#ifndef XBAR2
#define XBAR2 0
#endif
#ifndef MINI2
#define MINI2 0
#endif
#ifndef DUPMODE
#define DUPMODE 3
#endif
#ifndef CSEL
#define CSEL 15
#endif
#define INL(j) (STEPSEL(j) && IN(pb + (j)))
#define NREP(j) (((DUPMASK) >> (j)) & 1 ? 2 : 1)
#define SEAM(k) do { if (IN((k) + 1)) { XcdBarrier b2_ = bar; asm volatile("" : "+s"(b2_.bar), "+s"(b2_.x)); int t0_ = wave_s * 64 + hw_lane(salt_); asm volatile("" : "+v"(t0_)); xcd_barrier(b2_, t0_ == 0); if (XBAR2) xcd_barrier(b2_, t0_ == 0); } } while (0)
#define PH_ENTER() PK P = phase_args(); const Ctx C = phase_ctx(lds, wave_s, salt_); unsigned char* ws = P->ws; (void)ws; (void)C
    #ifndef PRODUP
#define PRODUP 1
#endif
    const int salt_ = 0;
    if (STEPSEL(-1) && IN(0)) { for (int rep = 0; rep < PRODUP; ++rep) { PH_ENTER(); p0_prologue(P, C); __syncthreads(); } SEAM(0); }
#pragma unroll 1
    for (int L = 0; L < DEPTH; ++L) {
        const int pb = 1 + 8 * L; const int salt_ = pb;
        if (INL(0)) {
            if (blockIdx.x & 1) for (int rm = 0; rm < (MINI2 ? 2 : 1); ++rm) { PH_ENTER(); mini_inproj_gates(P, C, L); }
            for (int rep = 0; rep < NREP(0); ++rep) { PH_ENTER();
            pg8::Gemm g{(const bf16*)(ws + WS_XB0), (const bf16*)(ws + WS_WIN) + (size_t)L * NZ * DM, MT, NZ, DM}; InProjOrder S; S.init(C.nblk, C.blk);
            EpiZ E{ws, P->out, L == 0 ? (const float*)(ws + WS_ROWSS0) : (const float*)(ws + WS_CTL) + CW_ROWSS1, P->in[I_QG] + L * 64, P->in[I_KG] + L * 64, L, lds + XPOSE_OFF};
            pg8::gemm_phase<EpiZ, InProjOrder, true, true>(lds, g, S, E, C.tid); }
            if (!(blockIdx.x & 1)) for (int rm = 0; rm < (MINI2 ? 2 : 1); ++rm) { PH_ENTER(); mini_inproj_gates(P, C, L); }
            SEAM(pb + 0); }
        if (INL(1)) { for (int rep = 0; rep < NREP(1); ++rep) { PH_ENTER(); (void)P; (void)C; }   }
        if (INL(2)) { for (int rep = 0; rep < NREP(2); ++rep) { PH_ENTER(); phase_c(P, C, L, rep == 0 ? 15 : CSEL); __syncthreads(); } SEAM(pb + 2); }
        if (INL(3)) { for (int rep = 0; rep < NREP(3); ++rep) { PH_ENTER(); phase_d(P, C, L, rep == 0 ? 3 : DUPMODE); __syncthreads(); } SEAM(pb + 3); }
        if (INL(4)) {   }
        if (INL(5)) {
            for (int rep = 0; rep < NREP(5); ++rep) {
            { PH_ENTER(); mini_oproj(P, C, L); }
            { PH_ENTER(); pg8::StaticOrder S; S.init(MP, DM, C.nblk, C.blk);
              pg8::Gemm g{(const bf16*)(ws + WS_OGR), (const bf16*)(ws + WS_WOR) + (size_t)L * DM * 512, MP, DM, 512}; EpiGate<0> E{(const bf16*)(ws + WS_Z), ZC_GR, (bf16*)(ws + WS_TMP), (bf16*)(ws + WS_MB)};
              pg8::gemm_phase<EpiGate<0>, pg8::StaticOrder, true, true>(lds, g, S, E, C.tid); }
            { PH_ENTER(); pg8::StaticOrder S; S.init(MP, DM, C.nblk, C.blk);
              pg8::Gemm g{(const bf16*)(ws + WS_OGA), (const bf16*)(ws + WS_WOA) + (size_t)L * DM * 512, MP, DM, 512}; EpiGate<1> E{(const bf16*)(ws + WS_Z), ZC_GA, (bf16*)(ws + WS_TMP), (bf16*)(ws + WS_MB)};
              pg8::gemm_phase<EpiGate<1>, pg8::StaticOrder, true, true>(lds, g, S, E, C.tid); } }
            SEAM(pb + 5); }
        if (INL(6)) {
            for (int rep = 0; rep < NREP(6); ++rep) {
            { PH_ENTER(); mini_wout(P, C, L); }
            { PH_ENTER(); pg8::StaticOrder S; S.init(MP, DM, C.nblk, C.blk);
            pg8::Gemm g{(const bf16*)(ws + WS_MB), (const bf16*)(ws + WS_WOUT) + (size_t)L * DM * DM, MP, DM, DM};
            EpiRes E{P->in[I_XP], P->in[I_XS], L == 0 ? (const bf16*)nullptr : (const bf16*)(ws + WS_XB0), (bf16*)(ws + WS_XB1)};
            pg8::gemm_phase<EpiRes, pg8::StaticOrder, true, true>(lds, g, S, E, C.tid); } }
            SEAM(pb + 6); }
        if (INL(7)) {
            for (int rep = 0; rep < NREP(7); ++rep) {
            { PH_ENTER(); mini_ple(P, C, L, rep == NREP(7) - 1); }
            { PH_ENTER(); pg8::StaticOrder S; S.init(MP, DM, C.nblk, C.blk);
              pg8::Gemm g{(const bf16*)(ws + WS_XB1), (const bf16*)(ws + WS_WPG) + (size_t)L * DM * DM, MP, DM, DM}; EpiPle<0> E{(bf16*)(ws + WS_TMP), (const bf16*)(ws + WS_XB1), nullptr, (bf16*)(ws + WS_XB0), nullptr};
              pg8::gemm_phase<EpiPle<0>, pg8::StaticOrder, true, true>(lds, g, S, E, C.tid); }
            if (L + 1 < DEPTH) { PH_ENTER(); pg8::StaticOrder S; S.init(MP, DM, C.nblk, C.blk);
                pg8::Gemm g{(const bf16*)(ws + WS_PB) + (size_t)L * MT * 256, (const bf16*)(ws + WS_WPP) + (size_t)L * DM * 256, MP, DM, 256};
                EpiPle<1> E{(bf16*)(ws + WS_TMP), (const bf16*)(ws + WS_XB1), P->out, (bf16*)(ws + WS_XB0), (float*)(ws + WS_CTL) + CW_ROWSS1};
                pg8::gemm_phase<EpiPle<1>, pg8::StaticOrder, true, true>(lds, g, S, E, C.tid); }
            else { PH_ENTER(); pg8::StaticOrder S; S.init(MP, DM, C.nblk, C.blk);
                pg8::Gemm g{(const bf16*)(ws + WS_PB) + (size_t)L * MT * 256, (const bf16*)(ws + WS_WPP) + (size_t)L * DM * 256, MP, DM, 256};
                EpiPle<2> E{(bf16*)(ws + WS_TMP), (const bf16*)(ws + WS_XB1), P->out, (bf16*)(ws + WS_XB0), (float*)(ws + WS_CTL) + CW_ROWSS1};
                pg8::gemm_phase<EpiPle<2>, pg8::StaticOrder, true, true>(lds, g, S, E, C.tid); } }
            SEAM(pb + 7); }
    }
#undef IN
#undef INL
#undef SEAM
#undef PH_ENTER
}

#ifndef MK_N_LAUNCHES
#define MK_N_LAUNCHES 1
#endif
extern "C" void kernel_launch(void* const* d_in, const int* in_sizes, int n_in, void* d_out, int out_size, void* d_ws, size_t ws_size, hipStream_t stream) {
    static int grid = 0;
    if (grid == 0) {
        if (n_in != 18 || out_size != (int)O_END || ws_size < WS_END) { fprintf(stderr, "kernel_launch: unexpected problem: n_in %d out %d ws %zu; nothing launched\n", n_in, out_size, ws_size); grid = -1; return; }
        int dev = 0, cus = 0, per_cu = 0;
        if (hipGetDevice(&dev) != hipSuccess || hipDeviceGetAttribute(&cus, hipDeviceAttributeMultiprocessorCount, dev) != hipSuccess) { grid = -1; return; }
        if (hipFuncSetAttribute((const void*)mk_fwd, hipFuncAttributeMaxDynamicSharedMemorySize, LDS_BYTES) != hipSuccess) { fprintf(stderr, "kernel_launch: hipFuncSetAttribute failed\n"); grid = -1; return; }
        if (hipOccupancyMaxActiveBlocksPerMultiprocessor(&per_cu, (const void*)mk_fwd, NTHREADS, LDS_BYTES) != hipSuccess || per_cu < 1) { fprintf(stderr, "kernel_launch: occupancy query says %d blocks per CU\n", per_cu); grid = -1; (void)hipGetLastError(); return; }
        grid = cus;
    }
    if (grid < 0) return;
    (void)hipMemsetAsync((char*)d_ws + WS_CTL, 0, CTL_ZERO_BYTES, stream);
    Params a{};
    for (int i = 0; i < 18; ++i) a.in[i] = (const float*)d_in[i];
    a.out = (float*)d_out; a.ws = (unsigned char*)d_ws;
#if MK_N_LAUNCHES == 1
    a.ph_lo = 0; a.ph_hi = N_PHASES; a.li = 0;
    hipLaunchKernelGGL(mk_fwd, dim3(grid), dim3(NTHREADS), LDS_BYTES, stream, a);
#else
    for (int li = 0; li < N_PHASES; ++li) { a.ph_lo = li; a.ph_hi = li + 1; a.li = 0; hipLaunchKernelGGL(mk_fwd, dim3(grid), dim3(NTHREADS), LDS_BYTES, stream, a); }
#endif
    (void)in_sizes;
}
```

```cpp
#include <hip/hip_runtime.h>
#include <cstdio>
#include <cstdint>
namespace pg8 {
#define PG8_LAS __attribute__((address_space(3)))
typedef unsigned short bf16_t;
typedef short bf16x8 __attribute__((ext_vector_type(8)));
typedef float f32x4 __attribute__((ext_vector_type(4)));
typedef unsigned u32x4 __attribute__((ext_vector_type(4)));
constexpr int BM = 256, BK = 64, HALF = 128, HTB = HALF * BK * 2  , STAGE_BYTES = 8 * HTB, NXCD = 8, WGM = 8;

__host__ __device__ __forceinline__ int lds_byte(int r, int c) { const int st = (r >> 4) * 2 + (c >> 5), rr = r & 15, cc = c & 31, ob = rr * 64 + cc * 2; return st * 1024 + (ob ^ (((ob >> 9) & 1) << 5)); }
__host__ __device__ __forceinline__ void stage_rc(int b, int& R, int& C) { const int st = b / 1024, sb = b % 1024, swz = sb ^ (((sb >> 9) & 1) << 5); R = (st >> 1) * 16 + swz / 64; C = (st & 1) * 32 + (swz % 64) / 2; }
__host__ __device__ __forceinline__ int perm32(int rho) { const int n = rho >> 4, i = rho & 15; return 8 * (i >> 2) + 4 * n + (i & 3); }

struct Unit { int pm, pn; };
struct Gemm { const bf16_t* A; const bf16_t* Bt; int M, N, K; };

struct StaticOrder {
    int nM, nN, nwg, G, c;
    __host__ __device__ void init(int M, int N, int G_, int c_) { nM = M / BM; nN = N / BM; nwg = nM * nN; G = G_; c = c_; }
    __host__ __device__ bool next(int i, Unit& u) const {
        const int L = i * G + c; if (L >= nwg) return false;
        int wgid = L; { const int q = nwg / NXCD, r = nwg % NXCD, xcd = wgid % NXCD, off = wgid / NXCD; wgid = (xcd < r ? xcd * (q + 1) : r * (q + 1) + (xcd - r) * q) + off; }
        const int nig = WGM * nN, gid = wgid / nig, fm = gid * WGM, gsz = (nM - fm) < WGM ? (nM - fm) : WGM;
        u.pm = fm + ((wgid % nig) % gsz); u.pn = (wgid % nig) / gsz; return true;
    }
    __device__ __forceinline__ void a_ready(const Unit&) const {}
    __device__ __forceinline__ void done(const Unit&) const {}
};
__device__ __forceinline__ unsigned cvt_pk_bf16(float lo, float hi) { unsigned r; asm volatile("v_cvt_pk_bf16_f32 %0, %1, %2" : "=v"(r) : "v"(lo), "v"(hi)); return r; }

template <class Epi, class Sched, bool ALIGN_EPI = false, bool SP2 = false>
__device__ __forceinline__ void gemm_phase(PG8_LAS unsigned char* lds, const Gemm g, const Sched& S, const Epi& E, int tid_) {
    asm volatile("" : "+v"(tid_)); const int tid = tid_, wid = __builtin_amdgcn_readfirstlane(tid >> 6), lane = tid & 63, wr = wid >> 2, wc = wid & 3, fr = lane & 15, fq = lane >> 4;
    const int K = g.K, nt = K / BK;
    unsigned voffA[2], voffB[2];
#pragma unroll
    for (int i = 0; i < 2; ++i) { int R, C; stage_rc(tid * 16 + i * 8192, R, C); const int Rb = Epi::PERM ? ((R & ~31) + perm32(R & 31)) : R;
        voffA[i] = (unsigned)(R * K + C) * 2u; voffB[i] = (unsigned)(Rb * K + C) * 2u; }
    const size_t kstep = (size_t)(BK * 2);
    const size_t hstep = (size_t)HALF * K * 2;
    const size_t tstep = 2 * hstep;
    const unsigned ldsw = (unsigned)wid * 1024u;
    const int aoff = lds_byte(wr * 64 + fr, fq * 8), boff = lds_byte(wc * 32 + fr, fq * 8);
#define PG8_SA(b, h) (((b) * 2 + (h)) * HTB)
#define PG8_SB(b, h) ((4 + (b) * 2 + (h)) * HTB)
#define PG8_STAGE(bufoff, gbase, voff) do { _Pragma("unroll") for (int _i = 0; _i < 2; ++_i) \
        __builtin_amdgcn_global_load_lds((const unsigned*)((const char*)(gbase) + (voff)[_i]), (PG8_LAS unsigned*)(lds + (bufoff) + ldsw + _i * 8192), 16, 0, 0); } while (0)
#define PG8_LDA(dst, b, h) do { _Pragma("unroll") for (int m = 0; m < 4; ++m) _Pragma("unroll") for (int k = 0; k < 2; ++k) dst[m][k] = *(const PG8_LAS bf16x8*)(lds + PG8_SA(b, h) + aoff + m * 2048 + k * 1024); } while (0)
#define PG8_LDB(dst, b, h) do { _Pragma("unroll") for (int n = 0; n < 2; ++n) _Pragma("unroll") for (int k = 0; k < 2; ++k) dst[n][k] = *(const PG8_LAS bf16x8*)(lds + PG8_SB(b, h) + boff + n * 2048 + k * 1024); } while (0)
#define PG8_MMA(ai, bj, At, Bt) do { __builtin_amdgcn_s_setprio(1); _Pragma("unroll") for (int m = 0; m < 4; ++m) _Pragma("unroll") for (int n = 0; n < 2; ++n) _Pragma("unroll") for (int k = 0; k < 2; ++k) \
        acc[ai][bj][m][n] = __builtin_amdgcn_mfma_f32_16x16x32_bf16(Bt[n][k], At[m][k], acc[ai][bj][m][n], 0, 0, 0); __builtin_amdgcn_s_setprio(0); } while (0)
#define PG8_WAIT_V(n) asm volatile("s_waitcnt vmcnt(" #n ")" ::: "memory")
#define PG8_WAIT_L(n) asm volatile("s_waitcnt lgkmcnt(" #n ")" ::: "memory")
#define PG8_BAR __builtin_amdgcn_s_barrier()
#define PG8_SCHED __builtin_amdgcn_sched_barrier(0)
    Unit cur, nxt; int ui = 0;
    if (!S.next(0, cur)) return;
    f32x4 acc[2][2][4][2];
#pragma unroll
    for (int a = 0; a < 2; ++a)
#pragma unroll
        for (int b = 0; b < 2; ++b)
#pragma unroll
            for (int m = 0; m < 4; ++m)
#pragma unroll
                for (int n = 0; n < 2; ++n) acc[a][b][m][n] = (f32x4){0.f, 0.f, 0.f, 0.f};
    bf16x8 At[4][2], B0[2][2], B1[2][2];
    const char* cA = (const char*)g.A + (size_t)cur.pm * tstep; const char* cB = (const char*)g.Bt + (size_t)cur.pn * tstep;
    S.a_ready(cur);
    if constexpr (SP2) {
        PG8_STAGE(PG8_SB(0, 0), cB, voffB); PG8_STAGE(PG8_SB(0, 1), cB + hstep, voffB); PG8_STAGE(PG8_SA(0, 0), cA, voffA); PG8_STAGE(PG8_SA(0, 1), cA + hstep, voffA);
        if (wr == 1) PG8_BAR;
        PG8_WAIT_V(2); PG8_BAR;
        PG8_STAGE(PG8_SB(1, 0), cB + kstep, voffB); PG8_STAGE(PG8_SA(1, 0), cA + kstep, voffA); PG8_STAGE(PG8_SB(1, 1), cB + hstep + kstep, voffB);
        PG8_WAIT_V(6); PG8_BAR;
    } else {
        PG8_STAGE(PG8_SB(0, 0), cB, voffB); PG8_STAGE(PG8_SA(0, 0), cA, voffA); PG8_STAGE(PG8_SB(0, 1), cB + hstep, voffB); PG8_STAGE(PG8_SA(0, 1), cA + hstep, voffA);
        if (wr == 1) PG8_BAR;
        PG8_WAIT_V(4); PG8_BAR;
        PG8_STAGE(PG8_SB(1, 0), cB + kstep, voffB); PG8_STAGE(PG8_SA(1, 0), cA + kstep, voffA); PG8_STAGE(PG8_SB(1, 1), cB + hstep + kstep, voffB);
        PG8_WAIT_V(6); PG8_BAR;
    }
    for (;;) {
        const bool has_next = S.next(ui + 1, nxt);
        const char* nA = has_next ? (const char*)g.A + (size_t)nxt.pm * tstep : cA; const char* nB = has_next ? (const char*)g.Bt + (size_t)nxt.pn * tstep : cB;
        for (int t = 0; t < nt; t += 2) {
            const bool last = (t == nt - 2);
            const char* a1 = cA + (size_t)(t + 1) * kstep;
            const char* a2 = last ? nA : cA + (size_t)(t + 2) * kstep; const char* b2 = last ? nB : cB + (size_t)(t + 2) * kstep;
            const char* a3 = a2 + kstep; const char* b3 = b2 + kstep;
            if (last && has_next) S.a_ready(nxt);
            if constexpr (SP2) {
            PG8_LDB(B0, 0, 0); PG8_LDB(B1, 0, 1); PG8_SCHED; PG8_LDA(At, 0, 0); PG8_STAGE(PG8_SA(1, 1), a1 + hstep, voffA);
            PG8_WAIT_V(8); PG8_WAIT_L(0); PG8_BAR; PG8_MMA(0, 0, At, B0); PG8_MMA(0, 1, At, B1); PG8_BAR; PG8_SCHED;
            PG8_LDA(At, 0, 1); PG8_STAGE(PG8_SB(0, 0), b2, voffB); PG8_STAGE(PG8_SB(0, 1), b2 + hstep, voffB); PG8_STAGE(PG8_SA(0, 0), a2, voffA);
            PG8_WAIT_V(8); PG8_WAIT_L(0); PG8_BAR; PG8_MMA(1, 0, At, B0); PG8_MMA(1, 1, At, B1); PG8_BAR; PG8_SCHED;
            PG8_LDB(B0, 1, 0); PG8_LDB(B1, 1, 1); PG8_SCHED; PG8_LDA(At, 1, 0); PG8_STAGE(PG8_SA(0, 1), a2 + hstep, voffA);
            PG8_WAIT_V(8); PG8_WAIT_L(0); PG8_BAR; PG8_MMA(0, 0, At, B0); PG8_MMA(0, 1, At, B1); PG8_BAR; PG8_SCHED;
            PG8_LDA(At, 1, 1); PG8_STAGE(PG8_SB(1, 0), b3, voffB); PG8_STAGE(PG8_SB(1, 1), b3 + hstep, voffB); PG8_STAGE(PG8_SA(1, 0), a3, voffA);
            PG8_WAIT_V(8); PG8_WAIT_L(0); PG8_BAR; PG8_MMA(1, 0, At, B0); PG8_MMA(1, 1, At, B1); PG8_BAR; PG8_SCHED;
            } else {
            PG8_LDB(B0, 0, 0); PG8_SCHED; PG8_LDA(At, 0, 0); PG8_STAGE(PG8_SA(1, 1), a1 + hstep, voffA);
            PG8_WAIT_L(8); PG8_BAR; PG8_WAIT_L(0); PG8_MMA(0, 0, At, B0); PG8_BAR; PG8_SCHED;
            PG8_LDB(B1, 0, 1); PG8_STAGE(PG8_SB(0, 0), b2, voffB);
            PG8_BAR; PG8_WAIT_L(0); PG8_MMA(0, 1, At, B1); PG8_BAR;
            PG8_LDA(At, 0, 1); PG8_STAGE(PG8_SA(0, 0), a2, voffA);
            PG8_BAR; PG8_WAIT_L(0); PG8_MMA(1, 0, At, B0); PG8_BAR; PG8_SCHED;
            PG8_STAGE(PG8_SB(0, 1), b2 + hstep, voffB);
            PG8_WAIT_V(6); PG8_BAR; PG8_MMA(1, 1, At, B1); PG8_BAR;
            PG8_LDB(B0, 1, 0); PG8_SCHED; PG8_LDA(At, 1, 0); PG8_STAGE(PG8_SA(0, 1), a2 + hstep, voffA);
            PG8_WAIT_L(8); PG8_BAR; PG8_WAIT_L(0); PG8_MMA(0, 0, At, B0); PG8_BAR; PG8_SCHED;
            PG8_LDB(B1, 1, 1); PG8_STAGE(PG8_SB(1, 0), b3, voffB);
            PG8_BAR; PG8_WAIT_L(0); PG8_MMA(0, 1, At, B1); PG8_BAR;
            PG8_LDA(At, 1, 1); PG8_STAGE(PG8_SA(1, 0), a3, voffA);
            PG8_BAR; PG8_WAIT_L(0); PG8_MMA(1, 0, At, B0); PG8_BAR; PG8_SCHED;
            PG8_STAGE(PG8_SB(1, 1), b3 + hstep, voffB);
            PG8_WAIT_V(6); PG8_BAR; PG8_MMA(1, 1, At, B1); PG8_BAR;
            }
        }
        if constexpr (ALIGN_EPI) { if (wr == 0) PG8_BAR; }
        if constexpr (!Epi::AFTER_DRAIN) { E(acc, cur, wr, wc, fr, fq); S.done(cur); }
        if (!has_next) break;
#pragma unroll
        for (int a = 0; a < 2; ++a)
#pragma unroll
            for (int b = 0; b < 2; ++b)
#pragma unroll
                for (int m = 0; m < 4; ++m)
#pragma unroll
                    for (int n = 0; n < 2; ++n) acc[a][b][m][n] = (f32x4){0.f, 0.f, 0.f, 0.f};
        cur = nxt; cA = nA; cB = nB; ++ui;
        if constexpr (ALIGN_EPI) { if (wr == 1) PG8_BAR; }
    }
    PG8_WAIT_V(0);
    if constexpr (!ALIGN_EPI) { if (wr == 0) PG8_BAR; }
    PG8_BAR;
    if constexpr (Epi::AFTER_DRAIN) { E.fused(acc, cur, wr, wc, fr, fq, lds, wid, lane); S.done(cur); }
#undef PG8_SA
#undef PG8_SB
#undef PG8_STAGE
#undef PG8_LDA
#undef PG8_LDB
#undef PG8_MMA
#undef PG8_WAIT_V
#undef PG8_WAIT_L
#undef PG8_BAR
#undef PG8_SCHED
}
}

#define GAS __attribute__((address_space(1)))
#define LAS __attribute__((address_space(3)))
typedef unsigned short bf16;
typedef float f32x4 __attribute__((ext_vector_type(4)));
typedef float f32x2 __attribute__((ext_vector_type(2)));
typedef float f32x16 __attribute__((ext_vector_type(16)));
typedef short bf16x8 __attribute__((ext_vector_type(8)));
typedef unsigned u32x4 __attribute__((ext_vector_type(4)));
typedef unsigned u32x2 __attribute__((ext_vector_type(2)));

constexpr int NWAVES = 8, NTHREADS = 512;
constexpr int DM = 1024, NB = 4, SEQ = 4096, DEPTH = 2, DB = 128, DS = 8, PAST = 2048, NPAGES = 16, NPOOL = 2560;
constexpr int MP = NB * SEQ, MS = DB * DS, MT = MP + MS;
constexpr int NZ = 5888;
constexpr int WIN_N = 5700;
constexpr int ZC_RQ = 0, ZC_RK = 512, ZC_RV = 1024, ZC_RZ = 1536, ZC_AQ = 2048, ZC_AK = 2560, ZC_AV = 2688, ZC_AZ = 2816, ZC_IQ = 3328, ZC_IK = 3584, ZC_IW = 3648, ZC_GR = 3712, ZC_GA = 4736;
constexpr int SS_LD = 2064;
constexpr int TOPK = 256;
constexpr size_t O_Y = 0, O_KP = 17825792, O_VP = 22020096, O_IKP = 26214400, O_RSP = 28311552, O_KS = 28835840, O_VS = 29097984, O_IKS = 29360128, O_RSS = 29491200, O_END = 46268416;
constexpr size_t MiB = 1u << 20;
constexpr size_t WS_CTL = 0, CTL_ZERO_BYTES = 1 * MiB;
constexpr size_t WS_WIN = 1 * MiB, WS_WOR = 24 * MiB, WS_WOA = 26 * MiB, WS_WOUT = 28 * MiB, WS_WPG = 32 * MiB, WS_WPP = 36 * MiB;
constexpr size_t WS_ROPER = 37 * MiB, WS_ROPEA = 39 * MiB, WS_ROWSS0 = 39 * MiB + 256 * 1024, WS_IW = 39 * MiB + 512 * 1024;
constexpr size_t WS_XB0 = 40 * MiB, WS_XB1 = 74 * MiB, WS_X1 = 108 * MiB, WS_TMP = 176 * MiB, WS_MB = 244 * MiB, WS_Z = 278 * MiB;
constexpr size_t WS_RQ = 474 * MiB, WS_RK = 490 * MiB, WS_RKT = 506 * MiB, WS_RVT = 522 * MiB, WS_AQ = 538 * MiB, WS_KB = 555 * MiB, WS_VB = 559 * MiB;
constexpr size_t WS_IQ = 563 * MiB, WS_IKB = 572 * MiB, WS_PB = 930 * MiB, WS_KVT = 583 * MiB, WS_ST = 615 * MiB, WS_OGR = 631 * MiB, WS_OGA = 648 * MiB;
constexpr size_t WS_SS = 665 * MiB, WS_SP = 674 * MiB, WS_END = 948 * MiB;
static_assert(WS_Z + (size_t)MT * NZ * 2 <= WS_RQ && WS_SS + (size_t)MS * SS_LD * 4 <= WS_SP && WS_IW + (size_t)MT * 16 <= WS_XB0, "ws map");
constexpr int CW_TMO = 0, CW_BAR = 4096, CW_ROWSS1 = 131072;
constexpr int N_PHASES = 1 + 8 * DEPTH;
constexpr int RING_BYTES = 131072, MISC_OFF = RING_BYTES + 320, XPOSE_OFF = RING_BYTES + 1024, LDS_BYTES = XPOSE_OFF + 8 * 2048;

#define LDS_WAIT() asm volatile("s_waitcnt lgkmcnt(0)" ::: "memory")
#define VM_WAIT() asm volatile("s_waitcnt vmcnt(0)" ::: "memory")
__device__ __forceinline__ unsigned pk2(float lo, float hi) { unsigned r; asm("v_cvt_pk_bf16_f32 %0, %1, %2" : "=v"(r) : "v"(lo), "v"(hi)); return r; }
__device__ __forceinline__ float bflo(unsigned w) { return __uint_as_float(w << 16); }
__device__ __forceinline__ float bfhi(unsigned w) { return __uint_as_float(w & 0xffff0000u); }
__device__ __forceinline__ float bf2f(bf16 b) { return __uint_as_float(((unsigned)b) << 16); }
__device__ __forceinline__ float sigmoidf_(float x) { return __builtin_amdgcn_rcpf(1.0f + __builtin_amdgcn_exp2f(x * -1.4426950408889634f)); }
__device__ __forceinline__ float siluf_(float x) { return x * sigmoidf_(x); }
__device__ __forceinline__ void unpack8(const u32x4 w, float (&f)[8]) { f[0] = bflo(w.x); f[1] = bfhi(w.x); f[2] = bflo(w.y); f[3] = bfhi(w.y); f[4] = bflo(w.z); f[5] = bfhi(w.z); f[6] = bflo(w.w); f[7] = bfhi(w.w); }
__device__ __forceinline__ u32x4 pack8(const float (&f)[8]) { u32x4 w; w.x = pk2(f[0], f[1]); w.y = pk2(f[2], f[3]); w.z = pk2(f[4], f[5]); w.w = pk2(f[6], f[7]); return w; }
__device__ __forceinline__ bf16x8 as_bf16x8(const u32x4 w) { return __builtin_bit_cast(bf16x8, w); }
__device__ __forceinline__ f32x4 mfma16(bf16x8 a, bf16x8 b, f32x4 c) { return __builtin_amdgcn_mfma_f32_16x16x32_bf16(a, b, c, 0, 0, 0); }
__device__ __forceinline__ f32x16 mfma32(bf16x8 a, bf16x8 b, f32x16 c) { return __builtin_amdgcn_mfma_f32_32x32x16_bf16(a, b, c, 0, 0, 0); }
__device__ __forceinline__ float ret_log2g(int h) { return h == 0 ? -0.04580369f : h == 1 ? -0.022720076f : h == 2 ? -0.011315313f : -0.0056465627f; }
__device__ __forceinline__ int mbcnt64(unsigned long long m) { return (int)__builtin_amdgcn_mbcnt_hi((unsigned)(m >> 32), __builtin_amdgcn_mbcnt_lo((unsigned)m, 0u)); }

template <int M> __device__ __forceinline__ float shx(float v, int lane) {
    if constexpr (M < 32) return __int_as_float(__builtin_amdgcn_ds_swizzle(__float_as_int(v), 0x1F | (M << 10)));
    else return __int_as_float(__builtin_amdgcn_ds_bpermute((lane ^ 32) << 2, __float_as_int(v)));
}
__device__ __forceinline__ float wave_sum(float v, int lane) { v += shx<1>(v, lane); v += shx<2>(v, lane); v += shx<4>(v, lane); v += shx<8>(v, lane); v += shx<16>(v, lane); v += shx<32>(v, lane); return v; }

#define XB_TMO      128
#define XB_XCNT(j)  (256  + 64 * (j))
#define XB_XSUB(j)  (1280 + 64 * (j))
#define XB_XGEN(j)  (2304 + 64 * (j))
#define XB_TOP      3328
#define XB_TOPGEN   3392
#define XCD_BAR_WORDS 3456
#define XB_SPIN_CAP (1u << 18)
__device__ __forceinline__ unsigned xb_ld(unsigned* p)              { return __hip_atomic_load(p, __ATOMIC_RELAXED, __HIP_MEMORY_SCOPE_AGENT); }
__device__ __forceinline__ unsigned xb_add(unsigned* p, unsigned v) { return __hip_atomic_fetch_add(p, v, __ATOMIC_RELAXED, __HIP_MEMORY_SCOPE_AGENT); }
__device__ __forceinline__ unsigned xb_xcc_id() { return (unsigned)__builtin_amdgcn_s_getreg((3 << 11) | 20) & 0xFu; }
#define XB_SPIN(cond, bar) do { unsigned _sp = 0; while (cond) { __builtin_amdgcn_s_sleep(1); \
    if ((++_sp & 255u) == 0u) { if (xb_ld(&(bar)[XB_TMO])) break; if (_sp > XB_SPIN_CAP) { atomicAdd(&(bar)[XB_TMO], 1u); break; } } } } while (0)
struct XcdBarrier { unsigned* bar; unsigned x; volatile LAS unsigned* st; };
__device__ __forceinline__ XcdBarrier xcd_barrier_post(unsigned* bar, volatile LAS unsigned* st, bool leader) {
    XcdBarrier b; b.bar = bar; b.x = xb_xcc_id(); b.st = st;
    if (leader) (void)xb_add(&bar[XB_XCNT(b.x)], 1u);
    return b;
}
__device__ __forceinline__ void xcd_barrier_complete(unsigned* bar, unsigned x, unsigned& nloc, unsigned& nx) {
    const unsigned G = gridDim.x * gridDim.y * gridDim.z;
    unsigned sum, cnt, mine, sp = 0u;
    for (;;) {
        sum = 0u; cnt = 0u; mine = 0u;
#pragma unroll
        for (unsigned j = 0; j < 16; ++j) { const unsigned c = xb_ld(&bar[XB_XCNT(j)]); sum += c; cnt += (c > 0u) ? 1u : 0u; mine = (j == x) ? c : mine; }
        if (sum == G) break;
        __builtin_amdgcn_s_sleep(1);
        if ((++sp & 255u) == 0u) { if (xb_ld(&bar[XB_TMO])) break; if (sp > XB_SPIN_CAP) { atomicAdd(&bar[XB_TMO], 1u); break; } }
    }
    nloc = mine > 0u ? mine : 1u; nx = cnt > 0u ? cnt : 1u;
}
__device__ __forceinline__ void xcd_barrier(const XcdBarrier& b, bool leader) {
    asm volatile("s_waitcnt vmcnt(0)" ::: "memory");
    __syncthreads();
    if (leader) {
        unsigned* bar = b.bar;
        __builtin_amdgcn_s_waitcnt(0);
        unsigned nloc = b.st[0], nx = b.st[1];
        if (nloc == 0u) { xcd_barrier_complete(bar, b.x, nloc, nx); b.st[0] = nloc; b.st[1] = nx; }
        const unsigned old = xb_add(&bar[XB_XSUB(b.x)], 1u);
        const unsigned gen = old / nloc;
        if (old + 1u == (gen + 1u) * nloc) {
            __builtin_amdgcn_fence(__ATOMIC_RELEASE, "agent");
            asm volatile("s_waitcnt vmcnt(0)" ::: "memory");
            const unsigned og = xb_add(&bar[XB_TOP], 1u);
            const unsigned tg = og / nx;
            if (og + 1u == (tg + 1u) * nx) xb_add(&bar[XB_TOPGEN], 1u);
            else XB_SPIN(xb_ld(&bar[XB_TOPGEN]) == tg, bar);
            __builtin_amdgcn_fence(__ATOMIC_ACQUIRE, "agent");
            xb_add(&bar[XB_XGEN(b.x)], 1u);
            asm volatile("s_waitcnt vmcnt(0)" ::: "memory");
        } else {
            XB_SPIN(xb_ld(&bar[XB_XGEN(b.x)]) == gen, bar);
            __builtin_amdgcn_fence(__ATOMIC_ACQUIRE, "agent");
            asm volatile("s_waitcnt vmcnt(0)" ::: "memory");
        }
    }
    __syncthreads();
}

struct Params { const float* in[18]; float* out; unsigned char* ws; int ph_lo, ph_hi, li, pad; };
enum { I_XP = 0, I_XS, I_CK, I_CV, I_CIK, I_STATE, I_PT, I_PP, I_PS, I_GAIN, I_WIN, I_QG, I_KG, I_WOR, I_WOA, I_WOUT, I_WPG, I_WPP };
struct Ctx { int tid, lane, wave, gw, ngw, nblk, blk; LAS unsigned char* lds; };
typedef const __attribute__((address_space(4))) Params* PK;
__device__ __forceinline__ PK phase_args() { PK p = (PK)__builtin_amdgcn_kernarg_segment_ptr(); asm volatile("" : "+s"(p)); return p; }
__device__ __forceinline__ int hw_lane(int salt = 0) { int l; asm volatile("v_mbcnt_lo_u32_b32 %0, -1, 0 ; %1\n\tv_mbcnt_hi_u32_b32 %0, -1, %0" : "=v"(l) : "s"(salt)); return l; }
__device__ __forceinline__ Ctx phase_ctx(LAS unsigned char* lds, int wave_s, int salt) { Ctx C; int tid = wave_s * 64 + hw_lane(salt); asm volatile("" : "+v"(tid)); C.lds = lds; C.tid = tid; C.lane = tid & 63; C.wave = __builtin_amdgcn_readfirstlane(tid >> 6);
    int bx = blockIdx.x; asm volatile("" : "+s"(bx)); C.nblk = gridDim.x; C.blk = bx; C.gw = C.blk * NWAVES + C.wave; C.ngw = C.nblk * NWAVES; return C; }

__device__ __forceinline__ int win_orig_col(int np) {
    const int pn = np >> 8, c = np & 255, bj = c >> 7, cc = c & 127, wc = cc >> 5, l8 = cc & 31;
    if (pn < 4) { const int head = 2 * (pn & 1) + bj, dim = (cc >> 1) + 64 * (cc & 1); return (pn < 2 ? 0 : 512) + head * 128 + dim; }
    if (pn < 8) return np;
    if (pn == 11 || pn == 12) return np;
    if (pn <= 10 || pn == 13) { const int dimp = 32 * bj + l8; const bool rope = !(pn == 10 && wc >= 2);
        const int dim = (rope && dimp < 16) ? (dimp >> 1) + 8 * (dimp & 1) : dimp;
        if (pn < 10) return 2048 + (4 * (pn - 8) + wc) * 64 + dim;
        if (pn == 10) return 2560 + wc * 64 + dim;
        return 3328 + wc * 64 + dim; }
    if (np < 3584 + 64) { const int dimp = np - 3584; return 3584 + (dimp < 16 ? (dimp >> 1) + 8 * (dimp & 1) : dimp); }
    if (np < 3652) return np;
    if (np < ZC_GR) return -1;
    if (np < ZC_GR + 2048) return np - (ZC_GR - 3652);
    return -1;
}
struct EpiZ {
    static constexpr bool PERM = true, AFTER_DRAIN = false;
    unsigned char* ws; float* out; const float* rowss; const float* qgain; const float* kgain; int L; LAS unsigned char* xl;
    __device__ __forceinline__ void rope16(float (&x)[8], const f32x2* ropeA, int fq, int hl) const {
        float lo[4], hi[4];
#pragma unroll
        for (int k = 0; k < 4; ++k) { const f32x2 cs = ropeA[(fq & 1) * 4 + k]; lo[k] = x[2 * k] * cs[0] - x[2 * k + 1] * cs[1]; hi[k] = x[2 * k + 1] * cs[0] + x[2 * k] * cs[1]; }
        float rc[4];
#pragma unroll
        for (int k = 0; k < 4; ++k) rc[k] = shx<16>(fq == 0 ? hi[k] : lo[k], hl);
        if (fq == 0) {
#pragma unroll
            for (int k = 0; k < 4; ++k) { x[k] = lo[k]; x[4 + k] = rc[k]; } }
        else if (fq == 1) {
#pragma unroll
            for (int k = 0; k < 4; ++k) { x[k] = rc[k]; x[4 + k] = hi[k]; } }
    }
    __device__ __forceinline__ void operator()(const f32x4 (&acc)[2][2][4][2], const pg8::Unit& u, int wr, int wc, int, int) const {
        const int hl = hw_lane(), fr = hl & 15, fq = hl >> 4;
        const int pn = u.pn; const bool prompt = u.pm < MP / 256;
        const int row0 = u.pm * 256 + wr * 64 + fr;
        bf16* Z = (bf16*)(ws + WS_Z);
        float rsv[2][4];
#pragma unroll
        for (int ai = 0; ai < 2; ++ai)
#pragma unroll
            for (int m = 0; m < 4; ++m) rsv[ai][m] = rowss[row0 + ai * 128 + m * 16];
        asm volatile("" ::: "memory");
#pragma unroll
        for (int ai = 0; ai < 2; ++ai)
#pragma unroll
            for (int m = 0; m < 4; ++m) rsv[ai][m] = __builtin_amdgcn_rsqf(rsv[ai][m] * (1.0f / 1024.0f) + 1e-6f);
        if (prompt && pn >= 2 && pn < 6) {
            const bool isk = pn < 4; LAS unsigned char* xt = xl + (wr * 4 + wc) * 2048;
            const int b = (u.pm * 256) >> 12, tpan = (u.pm * 256) & (SEQ - 1);
#pragma unroll
            for (int ai = 0; ai < 2; ++ai)
#pragma unroll
                for (int bj = 0; bj < 2; ++bj) { const int head = 2 * (pn & 1) + bj;
#pragma unroll
                    for (int mp = 0; mp < 2; ++mp) {
#pragma unroll
                        for (int mm = 0; mm < 2; ++mm) { const int m = 2 * mp + mm; const int row = row0 + ai * 128 + m * 16, t = row & (SEQ - 1);
                            const float rs = rsv[ai][m];
                            float x[8];
#pragma unroll
                            for (int j = 0; j < 4; ++j) { x[j] = acc[ai][bj][m][0][j] * rs; x[4 + j] = acc[ai][bj][m][1][j] * rs; }
                            const int t32 = 16 * mm + fr;
                            if (isk) { const int p0 = 16 * wc + 4 * fq; const f32x2* rr = (const f32x2*)(ws + WS_ROPER) + (size_t)t * 64 + p0; float lo[4], hi[4];
#pragma unroll
                                for (int k = 0; k < 4; ++k) { const f32x2 cs = rr[k]; lo[k] = (x[2 * k] * cs[0] - x[2 * k + 1] * cs[1]) * 0.08838834764831845f; hi[k] = (x[2 * k + 1] * cs[0] + x[2 * k] * cs[1]) * 0.08838834764831845f; }
                                bf16* q = (bf16*)(ws + WS_RK) + (size_t)row * 512 + head * 128 + p0;
                                u32x2 a, c; a.x = pk2(lo[0], lo[1]); a.y = pk2(lo[2], lo[3]); c.x = pk2(hi[0], hi[1]); c.y = pk2(hi[2], hi[3]); *(u32x2*)q = a; *(u32x2*)(q + 64) = c;
                                const float dk = __builtin_amdgcn_exp2f((float)(127 - (t & 127)) * ret_log2g(head));
#pragma unroll
                                for (int k = 0; k < 4; ++k) { *(LAS bf16*)(xt + (4 * fq + k) * 64 + 2 * t32) = (bf16)(pk2(lo[k] * dk, 0.f) & 0xffffu); *(LAS bf16*)(xt + (16 + 4 * fq + k) * 64 + 2 * t32) = (bf16)(pk2(hi[k] * dk, 0.f) & 0xffffu); }
                            } else {
#pragma unroll
                                for (int j = 0; j < 8; ++j) *(LAS bf16*)(xt + (8 * fq + j) * 64 + 2 * t32) = (bf16)(pk2(x[j], 0.f) & 0xffffu); } }
                        asm volatile("s_waitcnt lgkmcnt(0)" ::: "memory");
#pragma unroll
                        for (int i = 0; i < 2; ++i) { const int c = hl + 64 * i, dl = c >> 2, q4 = c & 3; const u32x4 v = *(const LAS u32x4*)(xt + dl * 64 + 16 * q4);
                            const int d = isk ? 16 * wc + (dl & 15) + 64 * (dl >> 4) : 32 * wc + dl;
                            bf16* dst = (bf16*)(ws + (isk ? WS_RKT : WS_RVT)) + ((size_t)(b * 4 + head) * 128 + d) * SEQ + tpan + 128 * ai + 64 * wr + 32 * mp + 8 * q4;
                            *(u32x4*)dst = v; }
                        asm volatile("s_waitcnt lgkmcnt(0)" ::: "memory"); } }
            return;
        }
#define EZ_X(bj_, xv_) float xv_[8]; _Pragma("unroll") for (int j_ = 0; j_ < 4; ++j_) { xv_[j_] = acc[ai][bj_][m][0][j_] * rs; xv_[4 + j_] = acc[ai][bj_][m][1][j_] * rs; }
#pragma unroll
        for (int ai = 0; ai < 2; ++ai)
#pragma unroll
            for (int m = 0; m < 4; ++m) {
                const int row = row0 + ai * 128 + m * 16; const float rs = rsv[ai][m];
                const int pos = prompt ? (row & (SEQ - 1)) : PAST + ((row - MP) & 7);
                const unsigned zrow = (unsigned)row * NZ;
                if (pn < 4) {
                    const int p0 = 16 * wc + 4 * fq; const bool isk = pn >= 2;
                    if (!prompt) {
#pragma unroll
                        for (int bj = 0; bj < 2; ++bj) { EZ_X(bj, x) const int hc = (isk ? ZC_RK : ZC_RQ) + (2 * (pn & 1) + bj) * 128;
                            u32x2 a, b; a.x = pk2(x[0], x[2]); a.y = pk2(x[4], x[6]); b.x = pk2(x[1], x[3]); b.y = pk2(x[5], x[7]);
                            *(u32x2*)(Z + zrow + hc + p0) = a; *(u32x2*)(Z + zrow + hc + 64 + p0) = b; }
                    } else {
                        const f32x2* rr = (const f32x2*)(ws + WS_ROPER) + (size_t)pos * 64 + p0; const int b = row >> 12, t = row & (SEQ - 1);
                        f32x2 cs[4];
#pragma unroll
                        for (int k = 0; k < 4; ++k) cs[k] = rr[k];
#pragma unroll
                        for (int bj = 0; bj < 2; ++bj) { EZ_X(bj, x) const int head = 2 * (pn & 1) + bj; float lo[4], hi[4];
#pragma unroll
                            for (int k = 0; k < 4; ++k) { lo[k] = x[2 * k] * cs[k][0] - x[2 * k + 1] * cs[k][1]; hi[k] = x[2 * k + 1] * cs[k][0] + x[2 * k] * cs[k][1]; }
                            if (!isk) { bf16* q = (bf16*)(ws + WS_RQ) + (size_t)row * 512 + head * 128 + p0;
                                u32x2 a, c; a.x = pk2(lo[0], lo[1]); a.y = pk2(lo[2], lo[3]); c.x = pk2(hi[0], hi[1]); c.y = pk2(hi[2], hi[3]); *(u32x2*)q = a; *(u32x2*)(q + 64) = c; }
                            else { const float sc = 0.08838834764831845f;
#pragma unroll
                                for (int k = 0; k < 4; ++k) { lo[k] *= sc; hi[k] *= sc; }
                                bf16* q = (bf16*)(ws + WS_RK) + (size_t)row * 512 + head * 128 + p0;
                                u32x2 a, c; a.x = pk2(lo[0], lo[1]); a.y = pk2(lo[2], lo[3]); c.x = pk2(hi[0], hi[1]); c.y = pk2(hi[2], hi[3]); *(u32x2*)q = a; *(u32x2*)(q + 64) = c;
                                const float dk = __builtin_amdgcn_exp2f((float)(127 - (t & 127)) * ret_log2g(head));
                                bf16* kt = (bf16*)(ws + WS_RKT) + ((size_t)(b * 4 + head) * 128 + p0) * SEQ + t;
#pragma unroll
                                for (int k = 0; k < 4; ++k) { kt[(size_t)k * SEQ] = (bf16)(pk2(lo[k] * dk, 0.f) & 0xffffu); kt[(size_t)(64 + k) * SEQ] = (bf16)(pk2(hi[k] * dk, 0.f) & 0xffffu); } } }
                    }
                } else if (pn < 6 && prompt) {
                    const int b = row >> 12, t = row & (SEQ - 1);
#pragma unroll
                    for (int bj = 0; bj < 2; ++bj) { EZ_X(bj, x) bf16* vt = (bf16*)(ws + WS_RVT) + ((size_t)(b * 4 + 2 * (pn & 1) + bj) * 128 + 32 * wc + 8 * fq) * SEQ + t;
#pragma unroll
                        for (int j = 0; j < 8; ++j) vt[(size_t)j * SEQ] = (bf16)(pk2(x[j], 0.f) & 0xffffu); }
                } else if (pn == 8 || pn == 9 || pn == 10 || pn == 13) {
                    const bool norm = (pn < 10) || (pn == 10 && wc < 2), rope = norm || pn == 13;
                    EZ_X(0, x0) EZ_X(1, x1)
                    if (norm) { float ss = 0.f;
#pragma unroll
                        for (int j = 0; j < 8; ++j) ss += x0[j] * x0[j] + x1[j] * x1[j];
                        ss += shx<16>(ss, hl); ss += shx<32>(ss, hl);
                        const float rr = __builtin_amdgcn_rsqf(ss * (1.0f / 64.0f) + 1e-6f); const float* gn = (pn < 10) ? qgain : kgain;
#pragma unroll
                        for (int j = 0; j < 8; ++j) { const int d0 = (fq < 2) ? 4 * fq + (j >> 1) + 8 * (j & 1) : 8 * fq + j; x0[j] *= rr * gn[d0]; x1[j] *= rr * gn[32 + 8 * fq + j]; } }
                    if (rope) rope16(x0, (const f32x2*)(ws + WS_ROPEA) + (size_t)pos * 8, fq, hl);
                    if (pn < 10) { bf16* q = (bf16*)(ws + WS_AQ) + (size_t)row * 512 + (4 * (pn - 8) + wc) * 64 + 8 * fq; *(u32x4*)q = pack8(x0); *(u32x4*)(q + 32) = pack8(x1); }
                    else if (pn == 13) { bf16* q = (bf16*)(ws + WS_IQ) + (size_t)row * 256 + wc * 64 + 8 * fq; *(u32x4*)q = pack8(x0); *(u32x4*)(q + 32) = pack8(x1); }
                    else { const bool isk = wc < 2; const int hk = wc & 1;
                        float* dst = (isk ? (prompt ? out + O_KP + ((size_t)L * MP + row) * 128 : out + O_KS + ((size_t)L * MS + (row - MP)) * 128)
                                          : (prompt ? out + O_VP + ((size_t)L * MP + row) * 128 : out + O_VS + ((size_t)L * MS + (row - MP)) * 128)) + hk * 64 + 8 * fq;
                        *(f32x4*)dst = (f32x4){x0[0], x0[1], x0[2], x0[3]}; *(f32x4*)(dst + 4) = (f32x4){x0[4], x0[5], x0[6], x0[7]};
                        *(f32x4*)(dst + 32) = (f32x4){x1[0], x1[1], x1[2], x1[3]}; *(f32x4*)(dst + 36) = (f32x4){x1[4], x1[5], x1[6], x1[7]};
                        if (prompt) { bf16* d2 = (bf16*)(ws + (isk ? WS_KB : WS_VB)) + (size_t)row * 128 + hk * 64 + 8 * fq; *(u32x4*)d2 = pack8(x0); *(u32x4*)(d2 + 32) = pack8(x1); } }
                } else if (pn == 14) {
                    { EZ_X(0, x0)
                      if (wc == 0) rope16(x0, (const f32x2*)(ws + WS_ROPEA) + (size_t)pos * 8, fq, hl);
                      if (wc < 2) { float* dst = (prompt ? out + O_IKP + ((size_t)L * MP + row) * 64 : out + O_IKS + ((size_t)L * MS + (row - MP)) * 64) + 32 * wc + 8 * fq;
                          *(f32x4*)dst = (f32x4){x0[0], x0[1], x0[2], x0[3]}; *(f32x4*)(dst + 4) = (f32x4){x0[4], x0[5], x0[6], x0[7]};
                          if (prompt) *(u32x4*)((bf16*)(ws + WS_IKB) + (size_t)row * 64 + 32 * wc + 8 * fq) = pack8(x0); }
                      else if (wc == 2 && fq == 0) *(f32x4*)((float*)(ws + WS_IW) + (size_t)row * 4) = (f32x4){x0[0] * 0.0625f, x0[1] * 0.0625f, x0[2] * 0.0625f, x0[3] * 0.0625f}; }
                    { EZ_X(1, x1) *(u32x4*)(Z + zrow + pn * 256 + 128 + 32 * wc + 8 * fq) = pack8(x1); }
                } else {
#pragma unroll
                    for (int bj = 0; bj < 2; ++bj) { EZ_X(bj, x) *(u32x4*)(Z + zrow + pn * 256 + 128 * bj + 32 * wc + 8 * fq) = pack8(x); }
                }
                asm volatile("" ::: "memory"); }
#undef EZ_X
    }
};

struct InProjOrder {
    pg8::StaticOrder base; int G, c;
    __device__ void init(int G_, int c_) { base.init(MP, NZ, G_, c_); G = G_; c = c_; }
    __device__ bool next(int i, pg8::Unit& u) const {
        const int L = i * G + c; const int np = (MP / 256) * (NZ / 256);
        if (L < np) return base.next(i, u);
        const int l2 = L - np; if (l2 >= 4 * 15) return false;
        u.pm = MP / 256 + l2 / 15; u.pn = l2 % 15; return true;
    }
    __device__ __forceinline__ void a_ready(const pg8::Unit&) const {}
    __device__ __forceinline__ void done(const pg8::Unit&) const {}
};
template <int MODE> struct EpiGate {
    static constexpr bool PERM = true, AFTER_DRAIN = false;
    const bf16* Z; int gcol; bf16* TMP; bf16* MB;
    __device__ __forceinline__ void operator()(const f32x4 (&acc)[2][2][4][2], const pg8::Unit& u, int wr, int wc, int, int) const {
        const int hl_ = hw_lane(), fr = hl_ & 15, fq = hl_ >> 4;
        const int row0 = u.pm * 256 + wr * 64 + fr, col0 = u.pn * 256 + wc * 32 + 8 * fq;
#pragma unroll
        for (int ai = 0; ai < 2; ++ai) {
            u32x4 gw[4][2], tw[4][2];
#pragma unroll
            for (int m = 0; m < 4; ++m)
#pragma unroll
                for (int bj = 0; bj < 2; ++bj) { const int row = row0 + ai * 128 + m * 16, col = col0 + bj * 128;
                    gw[m][bj] = *(const u32x4*)(Z + ((unsigned)row * NZ + (unsigned)(gcol + col)));
                    if (MODE == 1) tw[m][bj] = *(const u32x4*)(TMP + ((unsigned)row * DM + (unsigned)col)); }
            asm volatile("" ::: "memory");
#pragma unroll
            for (int m = 0; m < 4; ++m)
#pragma unroll
                for (int bj = 0; bj < 2; ++bj) { const int row = row0 + ai * 128 + m * 16, col = col0 + bj * 128; const unsigned off = (unsigned)row * DM + (unsigned)col;
                    float g[8]; unpack8(gw[m][bj], g);
                    const f32x4 a0 = acc[ai][bj][m][0], a1 = acc[ai][bj][m][1];
                    float r[8];
#pragma unroll
                    for (int j = 0; j < 4; ++j) { r[j] = sigmoidf_(g[j]) * a0[j]; r[4 + j] = sigmoidf_(g[4 + j]) * a1[j]; }
                    if (MODE == 0) *(u32x4*)(TMP + off) = pack8(r);
                    else { float t[8]; unpack8(tw[m][bj], t);
#pragma unroll
                        for (int j = 0; j < 8; ++j) r[j] += t[j];
                        *(u32x4*)(MB + off) = pack8(r); } }
            asm volatile("" ::: "memory"); }
    }
};
struct EpiRes {
    static constexpr bool PERM = true, AFTER_DRAIN = false;
    const float* xa; const float* xb; const bf16* xh; bf16* XB1;
    __device__ __forceinline__ void operator()(const f32x4 (&acc)[2][2][4][2], const pg8::Unit& u, int wr, int wc, int, int) const {
        const int hl_ = hw_lane(), fr = hl_ & 15, fq = hl_ >> 4;
        const int row0 = u.pm * 256 + wr * 64 + fr, col0 = u.pn * 256 + wc * 32 + 8 * fq;
        const float* xr = (u.pm < MP / 256) ? xa : xb - (size_t)MP * DM;
#pragma unroll
        for (int ai = 0; ai < 2; ++ai) {
            u32x4 xw[4][2][2];
#pragma unroll
            for (int m = 0; m < 4; ++m)
#pragma unroll
                for (int bj = 0; bj < 2; ++bj) { const unsigned off = (unsigned)(row0 + ai * 128 + m * 16) * DM + (unsigned)(col0 + bj * 128);
                    if (xh != nullptr) xw[m][bj][0] = *(const u32x4*)(xh + off);
                    else { xw[m][bj][0] = *(const u32x4*)(xr + off); xw[m][bj][1] = *(const u32x4*)(xr + off + 4); } }
            asm volatile("" ::: "memory");
#pragma unroll
            for (int m = 0; m < 4; ++m)
#pragma unroll
                for (int bj = 0; bj < 2; ++bj) { const unsigned off = (unsigned)(row0 + ai * 128 + m * 16) * DM + (unsigned)(col0 + bj * 128);
                    float x[8];
                    if (xh != nullptr) unpack8(xw[m][bj][0], x);
                    else { const f32x4 x0 = __builtin_bit_cast(f32x4, xw[m][bj][0]), x1 = __builtin_bit_cast(f32x4, xw[m][bj][1]); x[0] = x0[0]; x[1] = x0[1]; x[2] = x0[2]; x[3] = x0[3]; x[4] = x1[0]; x[5] = x1[1]; x[6] = x1[2]; x[7] = x1[3]; }
                    const f32x4 a0 = acc[ai][bj][m][0], a1 = acc[ai][bj][m][1];
#pragma unroll
                    for (int j = 0; j < 4; ++j) { x[j] += a0[j]; x[4 + j] += a1[j]; }
                    *(u32x4*)(XB1 + off) = pack8(x); }
            asm volatile("" ::: "memory"); }
    }
};
template <int MODE> struct EpiPle {
    static constexpr bool PERM = true, AFTER_DRAIN = false;
    bf16* TMP; const bf16* XB1; float* Y; bf16* XB0; float* rowss;
    __device__ __forceinline__ void operator()(const f32x4 (&acc)[2][2][4][2], const pg8::Unit& u, int wr, int wc, int, int) const {
        const int hl_ = hw_lane(), fr = hl_ & 15, fq = hl_ >> 4;
        const int row0 = u.pm * 256 + wr * 64 + fr, col0 = u.pn * 256 + wc * 32 + 8 * fq;
#pragma unroll
        for (int ai = 0; ai < 2; ++ai) {
            u32x4 tw[4][2], xw[4][2];
            if (MODE != 0) {
#pragma unroll
                for (int m = 0; m < 4; ++m)
#pragma unroll
                    for (int bj = 0; bj < 2; ++bj) { const unsigned off = (unsigned)(row0 + ai * 128 + m * 16) * DM + (unsigned)(col0 + bj * 128);
                        tw[m][bj] = *(const u32x4*)(TMP + off); xw[m][bj] = *(const u32x4*)(XB1 + off); }
                asm volatile("" ::: "memory"); }
#pragma unroll
            for (int m = 0; m < 4; ++m) { const int row = row0 + ai * 128 + m * 16; float ssq = 0.f;
#pragma unroll
                for (int bj = 0; bj < 2; ++bj) { const unsigned off = (unsigned)row * DM + (unsigned)(col0 + bj * 128);
                    const f32x4 a0 = acc[ai][bj][m][0], a1 = acc[ai][bj][m][1];
                    if (MODE == 0) { float r[8];
#pragma unroll
                        for (int j = 0; j < 4; ++j) { r[j] = sigmoidf_(a0[j]); r[4 + j] = sigmoidf_(a1[j]); }
                        *(u32x4*)(TMP + off) = pack8(r); }
                    else { float t[8], x[8]; unpack8(tw[m][bj], t); unpack8(xw[m][bj], x);
#pragma unroll
                        for (int j = 0; j < 4; ++j) { x[j] += t[j] * a0[j]; x[4 + j] += t[4 + j] * a1[j]; }
                        if (MODE == 2) { *(f32x4*)(Y + off) = (f32x4){x[0], x[1], x[2], x[3]}; *(f32x4*)(Y + off + 4) = (f32x4){x[4], x[5], x[6], x[7]}; }
                        *(u32x4*)(XB0 + off) = pack8(x);
                        if (MODE == 1) {
#pragma unroll
                            for (int j = 0; j < 8; ++j) ssq += x[j] * x[j]; } } }
                if (MODE == 1) { const int ln_ = fr + 16 * fq; ssq += shx<16>(ssq, ln_); ssq += shx<32>(ssq, ln_); if (fq == 0) atomicAdd(rowss + row, ssq); } }
            asm volatile("" ::: "memory"); }
    }
};
__device__ __forceinline__ void p0_transpose_item(const float* W, int ldw, int K, const float* gain, bf16* WT, int nblk, int item, bool win_map, LAS float* scr, int lane) {
    const int kb = item / nblk, nb = item % nblk, k0 = 64 * kb, n0 = 32 * nb;
    const int np = n0 + (lane & 31); int n = np; bool valid = true;
    if (win_map) { n = win_orig_col(np); valid = n >= 0; if (!valid) n = 0; }
#pragma unroll 8
    for (int i = 0; i < 32; ++i) { const int kk = 2 * i + (lane >> 5); float v = valid ? W[(size_t)(k0 + kk) * ldw + n] : 0.f; if (gain) v *= gain[k0 + kk]; scr[kk * 33 + (lane & 31)] = v; }
    LDS_WAIT(); asm volatile("" ::: "memory");
    const int c = lane & 7;
#pragma unroll
    for (int j = 0; j < 4; ++j) { const int nn = (lane >> 3) + 8 * j; const LAS float* s = scr + (8 * c) * 33 + nn;
        u32x4 o; o.x = pk2(s[0 * 33], s[1 * 33]); o.y = pk2(s[2 * 33], s[3 * 33]); o.z = pk2(s[4 * 33], s[5 * 33]); o.w = pk2(s[6 * 33], s[7 * 33]);
        *(u32x4*)(WT + (size_t)(n0 + nn) * K + k0 + 8 * c) = o; }
    LDS_WAIT(); asm volatile("" ::: "memory");
}
__device__ __forceinline__ void p0_prologue(PK P, const Ctx& C) {
    unsigned char* ws = P->ws;
    LAS float* scr = (LAS float*)(C.lds + C.wave * 16384);
    constexpr int I_IN = 16 * (NZ / 32), I_OR = 8 * 32, I_OUT = 16 * 32, I_PPJ = 4 * 32, I_LAYER = I_IN + 2 * I_OR + 2 * I_OUT + I_PPJ;
    for (int it = C.gw; it < DEPTH * I_LAYER; it += C.ngw) {
        const int L = it / I_LAYER; int r = it % I_LAYER;
        if (r < I_IN) { p0_transpose_item(P->in[I_WIN] + (size_t)L * DM * WIN_N, WIN_N, DM, P->in[I_GAIN] + L * DM, (bf16*)(ws + WS_WIN) + (size_t)L * NZ * DM, NZ / 32, r, true, scr, C.lane); continue; } r -= I_IN;
        if (r < I_OR) { p0_transpose_item(P->in[I_WOR] + (size_t)L * 512 * DM, DM, 512, nullptr, (bf16*)(ws + WS_WOR) + (size_t)L * DM * 512, 32, r, false, scr, C.lane); continue; } r -= I_OR;
        if (r < I_OR) { p0_transpose_item(P->in[I_WOA] + (size_t)L * 512 * DM, DM, 512, nullptr, (bf16*)(ws + WS_WOA) + (size_t)L * DM * 512, 32, r, false, scr, C.lane); continue; } r -= I_OR;
        if (r < I_OUT) { p0_transpose_item(P->in[I_WOUT] + (size_t)L * DM * DM, DM, DM, nullptr, (bf16*)(ws + WS_WOUT) + (size_t)L * DM * DM, 32, r, false, scr, C.lane); continue; } r -= I_OUT;
        if (r < I_OUT) { p0_transpose_item(P->in[I_WPG] + (size_t)L * DM * DM, DM, DM, nullptr, (bf16*)(ws + WS_WPG) + (size_t)L * DM * DM, 32, r, false, scr, C.lane); continue; } r -= I_OUT;
        p0_transpose_item(P->in[I_WPP] + (size_t)L * 256 * DM, DM, 256, nullptr, (bf16*)(ws + WS_WPP) + (size_t)L * DM * 256, 32, r, false, scr, C.lane);
    }
    bf16* XB0 = (bf16*)(ws + WS_XB0); float* rowss0 = (float*)(ws + WS_ROWSS0);
    for (int row = C.gw; row < MT; row += C.ngw) {
        const float* xr = (row < MP) ? P->in[I_XP] + (size_t)row * DM : P->in[I_XS] + (size_t)(row - MP) * DM;
        float ss = 0.f;
#pragma unroll
        for (int j = 0; j < 4; ++j) { const f32x4 v = *(const f32x4*)(xr + 256 * j + 4 * C.lane); ss += (v[0] * v[0] + v[1] * v[1]) + (v[2] * v[2] + v[3] * v[3]);
            u32x2 w; w.x = pk2(v[0], v[1]); w.y = pk2(v[2], v[3]); *(u32x2*)(XB0 + (size_t)row * DM + 256 * j + 4 * C.lane) = w; }
        ss = wave_sum(ss, C.lane);
        if (C.lane == 0) rowss0[row] = ss;
    }
    for (int r = C.gw; r < DEPTH * MT; r += C.ngw) { const int L = r / MT, row = r - L * MT;
        const float* pr = (row < MP) ? P->in[I_PP] + ((size_t)L * MP + row) * 256 : P->in[I_PS] + ((size_t)L * MS + (row - MP)) * 256;
        const f32x4 v = *(const f32x4*)(pr + 4 * C.lane); u32x2 w; w.x = pk2(v[0], v[1]); w.y = pk2(v[2], v[3]); *(u32x2*)((bf16*)(ws + WS_PB) + ((size_t)L * MT + row) * 256 + 4 * C.lane) = w; }
    f32x2* rr = (f32x2*)(ws + WS_ROPER); f32x2* ra = (f32x2*)(ws + WS_ROPEA);
    for (int i = C.blk * NTHREADS + C.tid; i < 4096 * 64; i += C.nblk * NTHREADS) { const int pos = i >> 6, k = i & 63;
        const float fr = expf((-9.210340371976184f * (float)k) / 64.0f), ang = (float)pos * fr; rr[i] = (f32x2){cosf(ang), sinf(ang)}; }
    for (int i = C.blk * NTHREADS + C.tid; i < 4096 * 8; i += C.nblk * NTHREADS) { const int pos = i >> 3, k = i & 7;
        const float fr = expf((-13.122363377404328f * (float)k) / 8.0f), ang = (float)pos * fr; ra[i] = (f32x2){cosf(ang), sinf(ang)}; }
}

constexpr int LDT = 272;
__device__ __forceinline__ void post_ret_tile(PK P, const Ctx& C, int unit) {
    unsigned char* ws = P->ws; const bf16* Z = (const bf16*)(ws + WS_Z);
    const int b = unit >> 7, h = (unit >> 5) & 3, n = unit & 31, t0 = n * 128; const int bh = b * 4 + h;
    LAS unsigned char* TK = C.lds; LAS unsigned char* TV = C.lds + 128 * LDT;
    const f32x2* ropeR = (const f32x2*)(ws + WS_ROPER);
    bf16* RQ = (bf16*)(ws + WS_RQ); bf16* RK = (bf16*)(ws + WS_RK);
    const float lg2 = ret_log2g(h);
#pragma unroll
    for (int u = 0; u < 2; ++u) {
        const int idx = C.tid + 512 * u, r = idx >> 3, j = idx & 7, t = t0 + r; const size_t grow = (size_t)b * SEQ + t;
        float cs[8], sn[8];
#pragma unroll
        for (int e = 0; e < 8; e += 2) { const f32x4 v = *(const f32x4*)(ropeR + (size_t)t * 64 + 8 * j + e); cs[e] = v[0]; sn[e] = v[1]; cs[e + 1] = v[2]; sn[e + 1] = v[3]; }
        { float x1[8], x2[8], o1[8], o2[8]; unpack8(*(const u32x4*)(Z + grow * NZ + ZC_RQ + h * 128 + 8 * j), x1); unpack8(*(const u32x4*)(Z + grow * NZ + ZC_RQ + h * 128 + 64 + 8 * j), x2);
#pragma unroll
          for (int e = 0; e < 8; ++e) { o1[e] = x1[e] * cs[e] - x2[e] * sn[e]; o2[e] = x2[e] * cs[e] + x1[e] * sn[e]; }
          *(u32x4*)(RQ + grow * 512 + h * 128 + 8 * j) = pack8(o1); *(u32x4*)(RQ + grow * 512 + h * 128 + 64 + 8 * j) = pack8(o2); }
        { float x1[8], x2[8], o1[8], o2[8]; unpack8(*(const u32x4*)(Z + grow * NZ + ZC_RK + h * 128 + 8 * j), x1); unpack8(*(const u32x4*)(Z + grow * NZ + ZC_RK + h * 128 + 64 + 8 * j), x2);
          const float sc = 0.08838834764831845f, dk = __builtin_amdgcn_exp2f((float)(127 - r) * lg2);
#pragma unroll
          for (int e = 0; e < 8; ++e) { o1[e] = (x1[e] * cs[e] - x2[e] * sn[e]) * sc; o2[e] = (x2[e] * cs[e] + x1[e] * sn[e]) * sc; }
          *(u32x4*)(RK + grow * 512 + h * 128 + 8 * j) = pack8(o1); *(u32x4*)(RK + grow * 512 + h * 128 + 64 + 8 * j) = pack8(o2);
#pragma unroll
          for (int e = 0; e < 8; ++e) { *(LAS bf16*)(TK + (8 * j + e) * LDT + 2 * r) = (bf16)(pk2(o1[e] * dk, 0.f) & 0xffffu); *(LAS bf16*)(TK + (64 + 8 * j + e) * LDT + 2 * r) = (bf16)(pk2(o2[e] * dk, 0.f) & 0xffffu); } }
    }
#pragma unroll
    for (int u = 0; u < 4; ++u) {
        const int idx = C.tid + 512 * u, r = idx >> 4, c = idx & 15; const size_t grow = (size_t)b * SEQ + t0 + r;
        const u32x4 w = *(const u32x4*)(Z + grow * NZ + ZC_RV + h * 128 + 8 * c);
        const unsigned ww[4] = {w.x, w.y, w.z, w.w};
#pragma unroll
        for (int e = 0; e < 4; ++e) { *(LAS bf16*)(TV + (8 * c + 2 * e) * LDT + 2 * r) = (bf16)(ww[e] & 0xffffu); *(LAS bf16*)(TV + (8 * c + 2 * e + 1) * LDT + 2 * r) = (bf16)(ww[e] >> 16); }
    }
    __syncthreads();
    bf16* RKT = (bf16*)(ws + WS_RKT); bf16* RVT = (bf16*)(ws + WS_RVT);
#pragma unroll
    for (int u = 0; u < 4; ++u) {
        const int idx = C.tid + 512 * u, d = idx >> 4, c = idx & 15;
        const u32x4 a = *(const LAS u32x4*)(TK + d * LDT + 16 * c), v = *(const LAS u32x4*)(TV + d * LDT + 16 * c);
        *(u32x4*)(RKT + ((size_t)bh * 128 + d) * SEQ + t0 + 8 * c) = a; *(u32x4*)(RVT + ((size_t)bh * 128 + d) * SEQ + t0 + 8 * c) = v;
    }
    __syncthreads();
}
__device__ __forceinline__ void post_token(PK P, const Ctx& C, int L, int row) {
    unsigned char* ws = P->ws; const bf16* Zr = (const bf16*)(ws + WS_Z) + (size_t)row * NZ; const int lane = C.lane;
    const bool prompt = row < MP; const int sb = (row - MP) >> 3, sc = (row - MP) & 7;
    const int pos = prompt ? (row & (SEQ - 1)) : PAST + sc;
    const f32x2* ropeA = (const f32x2*)(ws + WS_ROPEA) + (size_t)pos * 8;
    const int c8 = lane & 7;
    float cs[8], sn[8];
#pragma unroll
    for (int e = 0; e < 8; e += 2) { const f32x4 v = *(const f32x4*)(ropeA + e); cs[e] = v[0]; sn[e] = v[1]; cs[e + 1] = v[2]; sn[e + 1] = v[3]; }
    { float x[8]; unpack8(*(const u32x4*)(Zr + ZC_AQ + 8 * lane), x);
      float ss = 0.f;
#pragma unroll
      for (int e = 0; e < 8; ++e) ss += x[e] * x[e];
      ss += shx<1>(ss, lane); ss += shx<2>(ss, lane); ss += shx<4>(ss, lane);
      const float rs = __builtin_amdgcn_rsqf(ss * (1.0f / 64.0f) + 1e-6f);
      const float* qg = P->in[I_QG] + L * 64 + 8 * c8; float o[8];
#pragma unroll
      for (int e = 0; e < 8; ++e) { const float y = x[e] * rs * qg[e]; const float pr = shx<1>(y, lane); o[e] = (c8 == 0) ? y * cs[e] - pr * sn[e] : (c8 == 1) ? y * cs[e] + pr * sn[e] : y; }
      *(u32x4*)((bf16*)(ws + WS_AQ) + (size_t)row * 512 + 8 * lane) = pack8(o); }
    { float x[8]; unpack8(*(const u32x4*)(Zr + ZC_AK + 8 * (lane & 31)), x);
      float ss = 0.f;
#pragma unroll
      for (int e = 0; e < 8; ++e) ss += x[e] * x[e];
      ss += shx<1>(ss, lane); ss += shx<2>(ss, lane); ss += shx<4>(ss, lane);
      const float rs = __builtin_amdgcn_rsqf(ss * (1.0f / 64.0f) + 1e-6f);
      const float* kg = P->in[I_KG] + L * 64 + 8 * c8; float o[8]; const bool isk = (lane & 31) < 16;
#pragma unroll
      for (int e = 0; e < 8; ++e) { const float y = isk ? x[e] * rs * kg[e] : x[e]; const float pr = shx<1>(y, lane); o[e] = (isk && c8 == 0) ? y * cs[e] - pr * sn[e] : (isk && c8 == 1) ? y * cs[e] + pr * sn[e] : y; }
      if (lane < 32) {
          const int l16 = lane & 15;
          float* dst = isk ? (prompt ? P->out + O_KP + ((size_t)L * MP + row) * 128 : P->out + O_KS + ((size_t)L * MS + (row - MP)) * 128)
                           : (prompt ? P->out + O_VP + ((size_t)L * MP + row) * 128 : P->out + O_VS + ((size_t)L * MS + (row - MP)) * 128);
          *(f32x4*)(dst + 8 * l16) = (f32x4){o[0], o[1], o[2], o[3]}; *(f32x4*)(dst + 8 * l16 + 4) = (f32x4){o[4], o[5], o[6], o[7]};
          if (prompt) { bf16* d2 = (bf16*)(ws + (isk ? WS_KB : WS_VB)) + (size_t)row * 128 + 8 * l16; *(u32x4*)d2 = pack8(o); } } }
    { const int l40 = lane < 40 ? lane : 39; float x[8]; unpack8(*(const u32x4*)(Zr + ZC_IQ + 8 * l40), x); float o[8];
#pragma unroll
      for (int e = 0; e < 8; ++e) { const float y = x[e]; const float pr = shx<1>(y, lane); o[e] = (c8 == 0) ? y * cs[e] - pr * sn[e] : (c8 == 1) ? y * cs[e] + pr * sn[e] : y; }
      if (lane < 32) *(u32x4*)((bf16*)(ws + WS_IQ) + (size_t)row * 256 + 8 * lane) = pack8(o);
      else if (lane < 40) { const int l8 = lane - 32;
          float* dst = prompt ? P->out + O_IKP + ((size_t)L * MP + row) * 64 : P->out + O_IKS + ((size_t)L * MS + (row - MP)) * 64;
          *(f32x4*)(dst + 8 * l8) = (f32x4){o[0], o[1], o[2], o[3]}; *(f32x4*)(dst + 8 * l8 + 4) = (f32x4){o[4], o[5], o[6], o[7]};
          if (prompt) *(u32x4*)((bf16*)(ws + WS_IKB) + (size_t)row * 64 + 8 * l8) = pack8(o); } }
    if (lane < 4) ((float*)(ws + WS_IW))[(size_t)row * 4 + lane] = bf2f(Zr[ZC_IW + lane]) * 0.0625f;
    { const float* pr = prompt ? P->in[I_PP] + ((size_t)L * MP + row) * 256 : P->in[I_PS] + ((size_t)L * MS + (row - MP)) * 256;
      const f32x4 v = *(const f32x4*)(pr + 4 * lane); u32x2 w; w.x = pk2(v[0], v[1]); w.y = pk2(v[2], v[3]); *(u32x2*)((bf16*)(ws + WS_PB) + (size_t)row * 256 + 4 * lane) = w; }
    (void)sb;
}
__device__ __forceinline__ void phase_post(PK P, const Ctx& C, int L) {
    for (int u = C.blk; u < 512; u += C.nblk) post_ret_tile(P, C, u);
    for (int row = C.gw; row < MT; row += 2 * C.ngw) { post_token(P, C, L, row); if (row + C.ngw < MT) post_token(P, C, L, row + C.ngw); }
}

__device__ __forceinline__ void ret_state_item(PK P, const Ctx& C, int L, int item) {
    unsigned char* ws = P->ws; const bf16* RKT = (const bf16*)(ws + WS_RKT); const bf16* RVT = (const bf16*)(ws + WS_RVT); bf16* ST = (bf16*)(ws + WS_ST);
    const int bh = item >> 6, et = (item >> 3) & 7, dt = item & 7, lane = C.lane, r16 = lane & 15, g = lane >> 4;
    const float dec = __builtin_amdgcn_exp2f(128.0f * ret_log2g(bh & 3));
    LAS unsigned char* img = C.lds + 36864 + (C.wave & 3) * 8704;
    const int tq = lane >> 4, c16 = lane & 15;
    const bf16* vp = RVT + ((size_t)bh * 128 + 16 * et + tq) * SEQ + 8 * c16;
    const bf16* kp = RKT + ((size_t)bh * 128 + 16 * dt + tq) * SEQ + 8 * c16;
    f32x4 S = {0.f, 0.f, 0.f, 0.f};
    u32x4 rv[2][2][4], rk[2][2][4];
#define RS_LOAD(buf_, n0_) do { _Pragma("unroll") for (int i = 0; i < 2; ++i) _Pragma("unroll") for (int q = 0; q < 4; ++q) { \
        rv[buf_][i][q] = *(const u32x4*)(vp + (size_t)(4 * q) * SEQ + ((n0_) + i) * 128); rk[buf_][i][q] = *(const u32x4*)(kp + (size_t)(4 * q) * SEQ + ((n0_) + i) * 128); } } while (0)
#define RS_CHUNK(buf_, i_, n_, refill_) do { \
        _Pragma("unroll") for (int q = 0; q < 4; ++q) { *(LAS u32x4*)(img + (tq + 4 * q) * 272 + 16 * c16) = rv[buf_][i_][q]; *(LAS u32x4*)(img + (16 + tq + 4 * q) * 272 + 16 * c16) = rk[buf_][i_][q]; } \
        refill_; \
        LDS_WAIT(); asm volatile("" ::: "memory"); \
        f32x4 acc = {0.f, 0.f, 0.f, 0.f}; \
        _Pragma("unroll") for (int kk = 0; kk < 4; ++kk) { const bf16x8 a = *(const LAS bf16x8*)(img + r16 * 272 + 64 * kk + 16 * g), b = *(const LAS bf16x8*)(img + (16 + r16) * 272 + 64 * kk + 16 * g); acc = mfma16(a, b, acc); } \
        LDS_WAIT(); asm volatile("" ::: "memory"); \
        bf16* st = ST + (((size_t)bh * 32 + (n_)) * 128 + 16 * et + 4 * g) * 128 + 16 * dt + r16; \
        _Pragma("unroll") for (int r = 0; r < 4; ++r) st[r * 128] = (bf16)(pk2(S[r], 0.f) & 0xffffu); \
        S = S * dec + acc; } while (0)
    RS_LOAD(0, 0); RS_LOAD(1, 2);
    asm volatile("" ::: "memory");
#pragma unroll 1
    for (int n0 = 0; n0 < 32; n0 += 4) {
        RS_CHUNK(0, 0, n0, (void)0);
        RS_CHUNK(0, 1, n0 + 1, if (n0 + 4 < 32) RS_LOAD(0, n0 + 4));
        RS_CHUNK(1, 0, n0 + 2, (void)0);
        RS_CHUNK(1, 1, n0 + 3, if (n0 + 6 < 32) RS_LOAD(1, n0 + 6));
        asm volatile("" : "+v"(S));
    }
#undef RS_LOAD
#undef RS_CHUNK
    float* o = P->out + O_RSP + ((size_t)L * 16 + bh) * 16384 + (size_t)(16 * dt + r16) * 128 + 16 * et + 4 * g;
    *(f32x4*)o = S;
}
__device__ __forceinline__ void ret_sample_unit(PK P, const Ctx& C, int L, int unit) {
    unsigned char* ws = P->ws; const bf16* Z = (const bf16*)(ws + WS_Z);
    const int b = unit >> 2, h = unit & 3, tid = C.tid; const int r0 = MP + b * 8;
    LAS float* q = (LAS float*)C.lds;
    LAS float* kp = q + 1024;
    LAS float* v = kp + 1024;
    LAS float* rz = v + 1024;
    LAS float* A = rz + 1024;
    LAS float* op = A + 64;
    const float lg2 = ret_log2g(h);
    { const int c = tid >> 6, i = tid & 63; const size_t row = (size_t)(r0 + c);
      const f32x2 cs = ((const f32x2*)(ws + WS_ROPER))[(size_t)(PAST + c) * 64 + i];
      const float q1 = bf2f(Z[row * NZ + ZC_RQ + h * 128 + i]), q2 = bf2f(Z[row * NZ + ZC_RQ + h * 128 + 64 + i]);
      q[i * 8 + c] = q1 * cs[0] - q2 * cs[1]; q[(64 + i) * 8 + c] = q2 * cs[0] + q1 * cs[1];
      const float k1 = bf2f(Z[row * NZ + ZC_RK + h * 128 + i]), k2 = bf2f(Z[row * NZ + ZC_RK + h * 128 + 64 + i]);
      const float ks = 0.08838834764831845f * __builtin_amdgcn_exp2f((float)(7 - c) * lg2);
      kp[i * 8 + c] = (k1 * cs[0] - k2 * cs[1]) * ks; kp[(64 + i) * 8 + c] = (k2 * cs[0] + k1 * cs[1]) * ks;
      v[c * 128 + i] = bf2f(Z[row * NZ + ZC_RV + h * 128 + i]); v[c * 128 + 64 + i] = bf2f(Z[row * NZ + ZC_RV + h * 128 + 64 + i]);
      rz[c * 128 + i] = bf2f(Z[row * NZ + ZC_RZ + h * 128 + i]); rz[c * 128 + 64 + i] = bf2f(Z[row * NZ + ZC_RZ + h * 128 + 64 + i]); }
    __syncthreads();
    { const int pr = tid >> 3, part = tid & 7, c = pr >> 3, s2 = pr & 7; float d = 0.f;
#pragma unroll
      for (int dd = 0; dd < 16; ++dd) d += q[(part * 16 + dd) * 8 + c] * kp[(part * 16 + dd) * 8 + s2];
      d += shx<1>(d, tid & 63); d += shx<2>(d, tid & 63); d += shx<4>(d, tid & 63);
      if (part == 0) A[pr] = (s2 <= c) ? d * __builtin_amdgcn_exp2f((float)(c - 7) * lg2) : 0.f; }
    { const int dq = tid >> 7, e = tid & 127; float vr[8], acc[8];
#pragma unroll
      for (int c = 0; c < 8; ++c) { vr[c] = v[c * 128 + e]; acc[c] = 0.f; }
      const float g8 = __builtin_amdgcn_exp2f(8.0f * lg2);
      const float* S0 = P->in[I_STATE] + (((size_t)L * DB + b) * 4 + h) * 16384; float* S1 = P->out + O_RSS + (((size_t)L * DB + b) * 4 + h) * 16384;
      float s0v[32];
#pragma unroll
      for (int dd = 0; dd < 32; ++dd) s0v[dd] = S0[(dq * 32 + dd) * 128 + e];
#pragma unroll
      for (int dd = 0; dd < 32; ++dd) { const int d = dq * 32 + dd; const float s0 = s0v[dd];
          const f32x4 qa = *(const LAS f32x4*)(q + d * 8), qb = *(const LAS f32x4*)(q + d * 8 + 4), ka = *(const LAS f32x4*)(kp + d * 8), kb = *(const LAS f32x4*)(kp + d * 8 + 4);
          float sn = s0 * g8;
#pragma unroll
          for (int c = 0; c < 4; ++c) { acc[c] += qa[c] * s0; acc[4 + c] += qb[c] * s0; sn += ka[c] * vr[c]; sn += kb[c] * vr[4 + c]; }
          S1[d * 128 + e] = sn; }
#pragma unroll
      for (int c = 0; c < 8; ++c) op[(dq * 8 + c) * 128 + e] = acc[c]; }
    __syncthreads();
    { const int c = tid >> 6, i = tid & 63; float o[2]; const float gq = __builtin_amdgcn_exp2f((float)(c + 1) * lg2);
#pragma unroll
      for (int u = 0; u < 2; ++u) { const int e = i + 64 * u; float s = (op[(0 * 8 + c) * 128 + e] + op[(1 * 8 + c) * 128 + e]) + (op[(2 * 8 + c) * 128 + e] + op[(3 * 8 + c) * 128 + e]); s *= gq;
          for (int sidx = 0; sidx <= c; ++sidx) s += A[c * 8 + sidx] * v[sidx * 128 + e];
          o[u] = s; }
      float sm = o[0] + o[1];
      sm = wave_sum(sm, i);
      const float mu = sm * (1.0f / 128.0f); float qv = (o[0] - mu) * (o[0] - mu) + (o[1] - mu) * (o[1] - mu);
      qv = wave_sum(qv, i);
      const float rstd = __builtin_amdgcn_rsqf(qv * (1.0f / 128.0f) + 1e-5f);
      bf16* og = (bf16*)(ws + WS_OGR) + (size_t)(r0 + c) * 512 + h * 128;
#pragma unroll
      for (int u = 0; u < 2; ++u) { const int e = i + 64 * u; og[e] = (bf16)(pk2((o[u] - mu) * rstd * siluf_(rz[c * 128 + e]), 0.f) & 0xffffu); } }
    __syncthreads();
}
template <bool SAMPLE>
__device__ __forceinline__ void score_item(PK P, const Ctx& C, int L, int b, int qblk, int kc) {
    constexpr int QG = SAMPLE ? 1 : 2;
    constexpr int TG = SAMPLE ? 4 : 5;
    unsigned char* ws = P->ws; const int lane = C.lane, r32 = lane & 31, hf = lane >> 5;
    const bf16* IQ = (const bf16*)(ws + WS_IQ); const float* IW = (const float*)(ws + WS_IW);
    const int q0 = SAMPLE ? 0 : qblk * 16;
    const size_t rowbase = SAMPLE ? (size_t)MP + b * 8 : (size_t)b * SEQ + q0;
    bf16x8 af[QG][4]; f32x4 wv[QG][4];
#pragma unroll
    for (int gq = 0; gq < QG; ++gq) {
#pragma unroll
        for (int s = 0; s < 4; ++s) af[gq][s] = *(const bf16x8*)(IQ + (rowbase + 8 * gq + (r32 >> 2)) * 256 + (r32 & 3) * 64 + 16 * s + 8 * hf);
#pragma unroll
        for (int i = 0; i < 4; ++i) wv[gq][i] = *(const f32x4*)(IW + (rowbase + 8 * gq + 2 * i + hf) * 4); }
    const int nkeys = SAMPLE ? PAST + DS : q0 + 16;
    const int kt_end = min(kc * 16 + 16, (nkeys + 31) >> 5);
    const int* pt = (const int*)P->in[I_PT] + b * NPAGES;
    const float* cik = P->in[I_CIK] + (size_t)L * NPOOL * 128 * 64; const float* nik = P->out + O_IKS + ((size_t)L * DB + b) * DS * 64;
    const bf16* ikb = (const bf16*)(ws + WS_IKB) + (size_t)b * SEQ * 64;
    u32x4 cur[TG][SAMPLE ? 8 : 4];
    auto load_group = [&](int kt0, u32x4 (&dst)[TG][SAMPLE ? 8 : 4]) {
#pragma unroll
        for (int j = 0; j < TG; ++j) { const int kt = min(kt0 + j, kt_end - 1); const int key = kt * 32 + r32;
            if (SAMPLE) { const int kcl = key < PAST + DS ? key : PAST + DS - 1;
                const float* kr = (kcl < PAST) ? cik + ((size_t)pt[(kt >> 2) & 15] * 128 + (kcl & 127)) * 64 : nik + (size_t)(kcl - PAST) * 64;
#pragma unroll
                for (int s = 0; s < 4; ++s) { dst[j][2 * s] = *(const u32x4*)(kr + 16 * s + 8 * hf); dst[j][2 * s + 1] = *(const u32x4*)(kr + 16 * s + 8 * hf + 4); }
            } else { const bf16* kr = ikb + (size_t)key * 64;
#pragma unroll
                for (int s = 0; s < 4; ++s) dst[j][s] = *(const u32x4*)(kr + 16 * s + 8 * hf); } }
    };
    for (int kt0 = kc * 16; kt0 < kt_end; kt0 += TG) {
        load_group(kt0, cur);
#pragma unroll
        for (int j = 0; j < TG; ++j) { const int kt = kt0 + j;
            if (kt < kt_end) {
                const int key = kt * 32 + r32;
                bf16x8 bfr[4];
#pragma unroll
                for (int s = 0; s < 4; ++s) {
                    if (SAMPLE) { const f32x4 a = __builtin_bit_cast(f32x4, cur[j][2 * s]), c = __builtin_bit_cast(f32x4, cur[j][2 * s + 1]);
                        u32x4 w; w.x = pk2(a[0], a[1]); w.y = pk2(a[2], a[3]); w.z = pk2(c[0], c[1]); w.w = pk2(c[2], c[3]); bfr[s] = as_bf16x8(w); }
                    else bfr[s] = as_bf16x8(cur[j][s]); }
#pragma unroll
                for (int gq = 0; gq < QG; ++gq) {
                    f32x16 acc;
#pragma unroll
                    for (int i = 0; i < 16; ++i) acc[i] = 0.f;
#pragma unroll
                    for (int s = 0; s < 4; ++s) acc = mfma32(af[gq][s], bfr[s], acc);
                    float sc[4];
#pragma unroll
                    for (int i = 0; i < 4; ++i) {
                        float v = fmaxf(acc[4 * i + 0], 0.f) * wv[gq][i][0]; v += fmaxf(acc[4 * i + 1], 0.f) * wv[gq][i][1]; v += fmaxf(acc[4 * i + 2], 0.f) * wv[gq][i][2]; v += fmaxf(acc[4 * i + 3], 0.f) * wv[gq][i][3];
                        sc[i] = v + 0.0f; }
                    const bool odd = (lane & 1) != 0;
#pragma unroll
                    for (int i = 0; i < 4; i += 2) {
                        const float snd = odd ? sc[i] : sc[i + 1], rcv = shx<1>(snd, lane);
                        const float lo = odd ? rcv : sc[i], hi = odd ? sc[i + 1] : rcv;
                        const unsigned w = (unsigned)__builtin_bit_cast(unsigned short, (_Float16)lo) | ((unsigned)__builtin_bit_cast(unsigned short, (_Float16)hi) << 16);
                        const int ql = 8 * gq + 2 * (odd ? i + 1 : i) + hf, k0 = key & ~1;
                        if (SAMPLE) { if (k0 < PAST + DS) *(unsigned*)((unsigned short*)(ws + WS_SS) + ((size_t)b * 8 + ql) * SS_LD + k0) = w; }
                        else *(unsigned*)((unsigned short*)(ws + WS_SP) + ((size_t)b * SEQ + q0 + ql) * SEQ + k0) = w;
                    }
                }
            }
        }
        asm volatile("" ::: "memory");
    }
}
__device__ __forceinline__ void score_item_dma(PK P, const Ctx& C, int L, int b, int qblk, int kc, LAS unsigned char* img) {
    constexpr int QG = 2, TG = 4;
    unsigned char* ws = P->ws; const int lane = C.lane, r32 = lane & 31, hf = lane >> 5;
    const bf16* IQ = (const bf16*)(ws + WS_IQ); const float* IW = (const float*)(ws + WS_IW);
    const int q0 = qblk * 16;
    const size_t rowbase = (size_t)b * SEQ + q0;
    bf16x8 af[QG][4]; f32x4 wv[QG][4];
#pragma unroll
    for (int gq = 0; gq < QG; ++gq) {
#pragma unroll
        for (int s = 0; s < 4; ++s) af[gq][s] = *(const bf16x8*)(IQ + (rowbase + 8 * gq + (r32 >> 2)) * 256 + (r32 & 3) * 64 + 16 * s + 8 * hf);
#pragma unroll
        for (int i = 0; i < 4; ++i) wv[gq][i] = *(const f32x4*)(IW + (rowbase + 8 * gq + 2 * i + hf) * 4); }
    const int kt_end = min(kc * 16 + 16, (q0 + 16 + 31) >> 5);
    const unsigned char* ikb = ws + WS_IKB + (size_t)b * SEQ * 128;
    int voff[4], roff[4];
#pragma unroll
    for (int i = 0; i < 4; ++i) { voff[i] = (8 * i + (lane >> 3)) * 128 + 16 * ((lane & 7) ^ ((4 * i + (lane >> 4)) & 7)); roff[i] = r32 * 128 + 16 * ((2 * i + hf) ^ ((r32 >> 1) & 7)); }
#define SC_ISSUE(kt0_) do { _Pragma("unroll") for (int j = 0; j < TG; ++j) { const int kt_ = min((kt0_) + j, kt_end - 1); _Pragma("unroll") for (int i = 0; i < 4; ++i) \
        __builtin_amdgcn_global_load_lds((const unsigned*)(ikb + (size_t)kt_ * 4096 + voff[i]), (LAS unsigned*)(img + j * 4096 + i * 1024), 16, 0, 0); } } while (0)
    SC_ISSUE(kc * 16);
    for (int kt0 = kc * 16; kt0 < kt_end; kt0 += TG) {
        asm volatile("s_waitcnt vmcnt(0)" ::: "memory");
        u32x4 cur[TG][4];
#pragma unroll
        for (int j = 0; j < TG; ++j) {
#pragma unroll
            for (int s = 0; s < 4; ++s) cur[j][s] = *(const LAS u32x4*)(img + j * 4096 + roff[s]); }
        asm volatile("s_waitcnt lgkmcnt(0)" ::: "memory");
        if (kt0 + TG < kt_end) SC_ISSUE(kt0 + TG);
        asm volatile("" ::: "memory");
#pragma unroll
        for (int j = 0; j < TG; ++j) { const int kt = kt0 + j;
            if (kt < kt_end) {
                const int key = kt * 32 + r32;
#pragma unroll
                for (int gq = 0; gq < QG; ++gq) {
                    f32x16 acc;
#pragma unroll
                    for (int i = 0; i < 16; ++i) acc[i] = 0.f;
#pragma unroll
                    for (int s = 0; s < 4; ++s) acc = mfma32(af[gq][s], as_bf16x8(cur[j][s]), acc);
                    float sc[4];
#pragma unroll
                    for (int i = 0; i < 4; ++i) {
                        float v = fmaxf(acc[4 * i + 0], 0.f) * wv[gq][i][0]; v += fmaxf(acc[4 * i + 1], 0.f) * wv[gq][i][1]; v += fmaxf(acc[4 * i + 2], 0.f) * wv[gq][i][2]; v += fmaxf(acc[4 * i + 3], 0.f) * wv[gq][i][3];
                        sc[i] = v + 0.0f; }
                    const bool odd = (lane & 1) != 0;
#pragma unroll
                    for (int i = 0; i < 4; i += 2) {
                        const float snd = odd ? sc[i] : sc[i + 1], rcv = shx<1>(snd, lane);
                        const float lo = odd ? rcv : sc[i], hi = odd ? sc[i + 1] : rcv;
                        const unsigned w = (unsigned)__builtin_bit_cast(unsigned short, (_Float16)lo) | ((unsigned)__builtin_bit_cast(unsigned short, (_Float16)hi) << 16);
                        const int ql = 8 * gq + 2 * (odd ? i + 1 : i) + hf, k0 = key & ~1;
                        *(unsigned*)((unsigned short*)(ws + WS_SP) + ((size_t)b * SEQ + q0 + ql) * SEQ + k0) = w;
                    }
                }
            }
        }
        asm volatile("" ::: "memory");
    }
#undef SC_ISSUE
}
__device__ __forceinline__ void score_item_sdma(PK P, const Ctx& C, int L, int b, int kc, LAS unsigned char* img) {
    constexpr int TG = 2;
    unsigned char* ws = P->ws; const int lane = C.lane, r32 = lane & 31, hf = lane >> 5;
    const bf16* IQ = (const bf16*)(ws + WS_IQ); const float* IW = (const float*)(ws + WS_IW);
    const size_t rowbase = (size_t)MP + b * 8;
    bf16x8 af[4]; f32x4 wv[4];
#pragma unroll
    for (int s = 0; s < 4; ++s) af[s] = *(const bf16x8*)(IQ + (rowbase + (r32 >> 2)) * 256 + (r32 & 3) * 64 + 16 * s + 8 * hf);
#pragma unroll
    for (int i = 0; i < 4; ++i) wv[i] = *(const f32x4*)(IW + (rowbase + 2 * i + hf) * 4);
    const int kt_end = min(kc * 16 + 16, (PAST + DS + 31) >> 5);
    const int* pt = (const int*)P->in[I_PT] + b * NPAGES;
    const float* cik = P->in[I_CIK] + (size_t)L * NPOOL * 128 * 64; const float* nik = P->out + O_IKS + ((size_t)L * DB + b) * DS * 64;
    const int dr = lane >> 4, dq = lane & 15;
#define SS_ISSUE(kt0_) do { _Pragma("unroll") for (int j = 0; j < TG; ++j) { const int kt_ = min((kt0_) + j, kt_end - 1); const float* pg_ = cik + ((size_t)pt[(kt_ >> 2) & 15] * 128 + (kt_ & 3) * 32) * 64; \
        _Pragma("unroll") for (int i = 0; i < 8; ++i) { const int row_ = 4 * i + dr, key_ = kt_ * 32 + row_, kcl_ = key_ < PAST + DS ? key_ : PAST + DS - 1; \
            const float* src_ = (kcl_ < PAST ? pg_ + row_ * 64 : nik + (kcl_ - PAST) * 64) + 4 * (dq ^ (row_ & 15)); \
            __builtin_amdgcn_global_load_lds((const unsigned*)src_, (LAS unsigned*)(img + j * 8192 + i * 1024), 16, 0, 0); } } } while (0)
    SS_ISSUE(kc * 16);
    for (int kt0 = kc * 16; kt0 < kt_end; kt0 += TG) {
        asm volatile("s_waitcnt vmcnt(0)" ::: "memory");
        u32x4 cur[TG][8];
#pragma unroll
        for (int j = 0; j < TG; ++j) {
#pragma unroll
            for (int s = 0; s < 8; ++s) cur[j][s] = *(const LAS u32x4*)(img + j * 8192 + r32 * 256 + 16 * ((4 * (s >> 1) + 2 * hf + (s & 1)) ^ (r32 & 15))); }
        asm volatile("s_waitcnt lgkmcnt(0)" ::: "memory");
        if (kt0 + TG < kt_end) SS_ISSUE(kt0 + TG);
        asm volatile("" ::: "memory");
#pragma unroll
        for (int j = 0; j < TG; ++j) { const int kt = kt0 + j;
            if (kt < kt_end) {
                const int key = kt * 32 + r32;
                f32x16 acc;
#pragma unroll
                for (int i = 0; i < 16; ++i) acc[i] = 0.f;
#pragma unroll
                for (int s = 0; s < 4; ++s) { const f32x4 a = __builtin_bit_cast(f32x4, cur[j][2 * s]), c = __builtin_bit_cast(f32x4, cur[j][2 * s + 1]);
                    u32x4 w; w.x = pk2(a[0], a[1]); w.y = pk2(a[2], a[3]); w.z = pk2(c[0], c[1]); w.w = pk2(c[2], c[3]);
                    acc = mfma32(af[s], as_bf16x8(w), acc); }
                float sc[4];
#pragma unroll
                for (int i = 0; i < 4; ++i) {
                    float v = fmaxf(acc[4 * i + 0], 0.f) * wv[i][0]; v += fmaxf(acc[4 * i + 1], 0.f) * wv[i][1]; v += fmaxf(acc[4 * i + 2], 0.f) * wv[i][2]; v += fmaxf(acc[4 * i + 3], 0.f) * wv[i][3];
                    sc[i] = v + 0.0f; }
                const bool odd = (lane & 1) != 0;
#pragma unroll
                for (int i = 0; i < 4; i += 2) {
                    const float snd = odd ? sc[i] : sc[i + 1], rcv = shx<1>(snd, lane);
                    const float lo = odd ? rcv : sc[i], hi = odd ? sc[i + 1] : rcv;
                    const unsigned w = (unsigned)__builtin_bit_cast(unsigned short, (_Float16)lo) | ((unsigned)__builtin_bit_cast(unsigned short, (_Float16)hi) << 16);
                    const int ql = 2 * (odd ? i + 1 : i) + hf, k0 = key & ~1;
                    if (k0 < PAST + DS) *(unsigned*)((unsigned short*)(ws + WS_SS) + ((size_t)b * 8 + ql) * SS_LD + k0) = w;
                }
            }
        }
        asm volatile("" ::: "memory");
    }
#undef SS_ISSUE
}
__device__ __forceinline__ void phase_c(PK P, const Ctx& C, int L, int sel = 15) {
    LAS unsigned char* imgw = C.lds + C.wave * 16384;
    if (C.nblk == 256) {
        const int q1 = C.blk & 127, n1 = q1 / 32 + 1;
        if (C.wave < 4) { if (sel & 1) for (int it = C.blk * 4 + C.wave; it < 1024; it += C.nblk * 4) ret_state_item(P, C, L, it); }
        else { const int k = C.wave & 3, f = (C.blk >> 7) * 4 + k; LAS unsigned char* imgf = C.lds + (k < 3 ? 71680 + k * 16384 : XPOSE_OFF);
            if ((sel & 8) && f < 5) score_item_sdma(P, C, L, q1, f, imgf);
            if ((sel & 4) && f >= 4) { const int j = f == 4 ? 35 : 27 + f; const int b = j / 9, c = j - 9 * b; if (c < n1) score_item_dma(P, C, L, b, q1, c, imgf); else score_item_dma(P, C, L, b, 255 - q1, c - n1, imgf); } }
        if (sel & 2) for (int u = C.blk; u < 512; u += C.nblk) ret_sample_unit(P, C, L, u);
        if (sel & 4) { const int wp = (C.blk >> 7) * NWAVES + C.wave;
            for (int j = wp; j < 32; j += 16) { const int b = j / 9, c = j - 9 * b; if (c < n1) score_item_dma(P, C, L, b, q1, c, imgw); else score_item_dma(P, C, L, b, 255 - q1, c - n1, imgw); } }
    } else {
        if ((sel & 1) && C.wave < 4) for (int it = C.blk * 4 + C.wave; it < 1024; it += C.nblk * 4) ret_state_item(P, C, L, it);
        if (sel & 2) for (int u = C.blk; u < 512; u += C.nblk) ret_sample_unit(P, C, L, u);
        if (sel & 4) for (int it = C.gw; it < NB * 256 * 8; it += C.ngw) { const int kc = it & 7, qb = (it >> 3) & 255, b = it >> 11; if (kc * 512 <= qb * 16 + 15) score_item_dma(P, C, L, b, qb, kc, imgw); }
        if ((sel & 8) && C.wave >= 4) for (int it = C.blk * 4 + (C.wave & 3); it < DB * 5; it += C.nblk * 4) score_item_sdma(P, C, L, it / 5, it % 5, imgw);
    }
}

__device__ __forceinline__ void ret_scan_item(PK P, const Ctx& C, int L, int item) {
    unsigned char* ws = P->ws; const float* KVT = (const float*)(ws + WS_KVT); bf16* ST = (bf16*)(ws + WS_ST);
    const int e0 = item * 1024 + C.tid * 2, bh = e0 >> 14, rem = e0 & 16383, h = bh & 3;
    const float dec = __builtin_amdgcn_exp2f(128.0f * ret_log2g(h));
    float s0 = 0.f, s1 = 0.f;
#pragma unroll 8
    for (int n = 0; n < 32; ++n) { const f32x2 kv = *(const f32x2*)(KVT + ((size_t)bh * 32 + n) * 16384 + rem);
        *(unsigned*)(ST + ((size_t)bh * 32 + n) * 16384 + rem) = pk2(s0, s1); s0 = s0 * dec + kv[0]; s1 = s1 * dec + kv[1]; }
    const int e = rem >> 7, d = rem & 127;
    float* o = P->out + O_RSP + ((size_t)L * 16 + bh) * 16384; o[d * 128 + e] = s0; o[(d + 1) * 128 + e] = s1;
}
template <int G>
__device__ __forceinline__ void cnt_ge4(const unsigned (&kp)[32], unsigned cm1, unsigned& c0, unsigned& c1) {
    unsigned t0, t1, t2, t3;
    asm("v_pk_sub_u16 %2, %6, %10 clamp\n\tv_pk_sub_u16 %3, %7, %10 clamp\n\tv_pk_sub_u16 %4, %8, %10 clamp\n\tv_pk_sub_u16 %5, %9, %10 clamp\n\t"
        "v_pk_min_u16 %2, %2, %11\n\tv_pk_min_u16 %3, %3, %11\n\tv_pk_min_u16 %4, %4, %11\n\tv_pk_min_u16 %5, %5, %11\n\t"
        "v_pk_add_u16 %0, %0, %2\n\tv_pk_add_u16 %1, %1, %3\n\tv_pk_add_u16 %0, %0, %4\n\tv_pk_add_u16 %1, %1, %5"
        : "+v"(c0), "+v"(c1), "=&v"(t0), "=&v"(t1), "=&v"(t2), "=&v"(t3)
        : "v"(kp[4 * G + 0]), "v"(kp[4 * G + 1]), "v"(kp[4 * G + 2]), "v"(kp[4 * G + 3]), "s"(cm1), "s"(0x00010001u));
}
__device__ __forceinline__ int wave_sum_dpp(int v) {
    v += __builtin_amdgcn_update_dpp(0, v, 0x111, 0xf, 0xf, true);
    v += __builtin_amdgcn_update_dpp(0, v, 0x112, 0xf, 0xf, true);
    v += __builtin_amdgcn_update_dpp(0, v, 0x114, 0xf, 0xf, true);
    v += __builtin_amdgcn_update_dpp(0, v, 0x118, 0xf, 0xf, true);
    v += __builtin_amdgcn_update_dpp(0, v, 0x142, 0xa, 0xf, true);
    v += __builtin_amdgcn_update_dpp(0, v, 0x143, 0xc, 0xf, true);
    return __builtin_amdgcn_readlane(v, 63);
}
__device__ __forceinline__ unsigned cnt_ge_lane(const unsigned (&kp)[32], unsigned cand, int ng) {
    const unsigned cm1 = (cand - 1u) * 0x00010001u; unsigned c0 = 0u, c1 = 0u;
    cnt_ge4<0>(kp, cm1, c0, c1);
    if (ng > 1) cnt_ge4<1>(kp, cm1, c0, c1);
    if (ng > 2) cnt_ge4<2>(kp, cm1, c0, c1);
    if (ng > 3) cnt_ge4<3>(kp, cm1, c0, c1);
    if (ng > 4) cnt_ge4<4>(kp, cm1, c0, c1);
    if (ng > 5) cnt_ge4<5>(kp, cm1, c0, c1);
    if (ng > 6) cnt_ge4<6>(kp, cm1, c0, c1);
    if (ng > 7) cnt_ge4<7>(kp, cm1, c0, c1);
    const unsigned c = c0 + c1;
    return (c & 0xffffu) + (c >> 16);
}
__device__ __forceinline__ int cnt_ge(const unsigned (&kp)[32], unsigned cand, int ng) { return wave_sum_dpp((int)cnt_ge_lane(kp, cand, ng)); }
__device__ __forceinline__ void bit_transpose16(unsigned (&x)[16]) {
#define BT_STAGE(J, M) _Pragma("unroll") for (int r = 0; r < 16; ++r) if ((r & (J)) == 0) { const unsigned a = x[r], b = x[r + (J)]; x[r] = (a & (M)) | ((b << (J)) & ~(M)); x[r + (J)] = ((a >> (J)) & (M)) | (b & ~(M)); }
    BT_STAGE(8, 0x00ff00ffu) BT_STAGE(4, 0x0f0f0f0fu) BT_STAGE(2, 0x33333333u) BT_STAGE(1, 0x55555555u)
#undef BT_STAGE
}
__device__ __forceinline__ void select_topk(const unsigned short* srow, int Lk, LAS unsigned* list, int lane, int mode = 3) {
    const int ng = (Lk + 511) >> 9;
    unsigned kp[32];
    const unsigned* sl = (const unsigned*)srow + lane;
    if (ng > 4) {
#pragma unroll
        for (int j = 0; j < 32; ++j) kp[j] = sl[j * 64];
    } else {
#pragma unroll
        for (int j = 0; j < 16; ++j) kp[j] = sl[j * 64];
#pragma unroll
        for (int j = 16; j < 32; ++j) kp[j] = 0u;
    }
    typedef short s16x2 __attribute__((ext_vector_type(2)));
#pragma unroll
    for (int j = 0; j < 32; ++j) { const unsigned w = kp[j];
        const unsigned sg = __builtin_bit_cast(unsigned, __builtin_bit_cast(s16x2, w) >> (s16x2){15, 15});
        unsigned kk = w ^ (sg | 0x80008000u);
        const int rem = Lk - 128 * j;
        if (rem < 128) kk &= ((2 * lane < rem) ? 0xffffu : 0u) | ((2 * lane + 1 < rem) ? 0xffff0000u : 0u);
        kp[j] = kk; }
    unsigned p0[16], p1[16];
#pragma unroll
    for (int j = 0; j < 16; ++j) { p0[j] = kp[j]; p1[j] = 0u; }
    bit_transpose16(p0);
    if (ng > 4) {
#pragma unroll
        for (int j = 0; j < 16; ++j) p1[j] = kp[16 + j];
        bit_transpose16(p1); }
    unsigned act0 = ~0u, act1 = ~0u, gt0 = 0u, gt1 = 0u; int G = 0;
#pragma unroll
    for (int bit = 15; bit >= 0; --bit) {
        const unsigned t0 = act0 & p0[bit], t1 = act1 & p1[bit];
        const int c = __builtin_popcount(t0) + __builtin_popcount(t1);
        const int tot = wave_sum_dpp(c);
        const bool take = G + tot >= TOPK;
        if (take) { act0 = t0; act1 = t1; } else { G += tot; gt0 |= t0; gt1 |= t1; act0 ^= t0; act1 ^= t1; }
    }
    const int neq = wave_sum_dpp(__builtin_popcount(act0) + __builtin_popcount(act1));
    unsigned sel0, sel1;
    if (G + neq == TOPK) { sel0 = gt0 | act0; sel1 = gt1 | act1; }
    else {
        const int need_eq = TOPK - G; int jc = 0, base = 0;
#define SEL_MASKR(m_) ((m_) <= 0 ? 0u : (m_) >= 16 ? 0xffffffffu : ((1u << (m_)) - 1u) * 0x00010001u)
#pragma unroll
        for (int s = 16; s >= 1; s >>= 1) { const int jm = jc + s; const unsigned m0 = SEL_MASKR(jm), m1 = SEL_MASKR(jm - 16);
            const int cb = wave_sum_dpp(__builtin_popcount(act0 & m0) + __builtin_popcount(act1 & m1));
            if (cb < need_eq) { jc = jm; base = cb; } }
        const int rc = jc & 15; const unsigned aw = jc >= 16 ? act1 : act0;
        const bool e0 = ((aw >> rc) & 1u) != 0u, e1 = ((aw >> (16 + rc)) & 1u) != 0u;
        const unsigned long long b0 = __ballot(e0), b1 = __ballot(e1);
        const int rk = base + mbcnt64(b0) + mbcnt64(b1);
        const bool s0 = e0 && rk < need_eq, s1 = e1 && (rk + (e0 ? 1 : 0)) < need_eq;
        const unsigned add = ((s0 ? 1u : 0u) << rc) | ((s1 ? 1u : 0u) << (16 + rc));
        const unsigned m0 = SEL_MASKR(jc), m1 = SEL_MASKR(jc - 16);
        sel0 = gt0 | (act0 & m0) | (jc < 16 ? add : 0u);
        sel1 = gt1 | (act1 & m1) | (jc >= 16 ? add : 0u);
#undef SEL_MASKR
    }
    { const int cl = __builtin_popcount(sel0) + __builtin_popcount(sel1);
      int inc = cl;
      inc += __builtin_amdgcn_update_dpp(0, inc, 0x111, 0xf, 0xf, true);
      inc += __builtin_amdgcn_update_dpp(0, inc, 0x112, 0xf, 0xf, true);
      inc += __builtin_amdgcn_update_dpp(0, inc, 0x114, 0xf, 0xf, true);
      inc += __builtin_amdgcn_update_dpp(0, inc, 0x118, 0xf, 0xf, true);
      inc += __builtin_amdgcn_update_dpp(0, inc, 0x142, 0xa, 0xf, true);
      inc += __builtin_amdgcn_update_dpp(0, inc, 0x143, 0xc, 0xf, true);
      int off = inc - cl; unsigned m0 = sel0, m1 = sel1;
      while (__ballot((m0 | m1) != 0u) != 0ull) {
          const bool has0 = m0 != 0u; const unsigned m = has0 ? m0 : m1; const bool valid = m != 0u;
          const int p = __builtin_ctz(m | 0x80000000u);
          const unsigned idx = (unsigned)((((p & 15) + (has0 ? 0 : 16)) << 7) + 2 * lane + (p >> 4));
          list[valid ? off : 2368 + lane] = idx;
          off += valid ? 1 : 0;
          const unsigned nm = m & (m - 1u);
          m0 = has0 ? nm : m0; m1 = has0 ? m1 : nm; }
    }
}
#ifndef SEL2
#define SEL2 0
#endif
#ifndef QK2
#define QK2 0
#endif
#ifndef PV2
#define PV2 0
#endif
#ifndef NOXCD
#define NOXCD 0
#endif
constexpr int ATT_WSTRIDE = 10496;
template <bool SAMPLE>
__device__ __forceinline__ void attend_query(PK P, const Ctx& C, int L, int row, int mode = 3) {
    int lane_ = C.lane; asm volatile("" : "+v"(lane_));
    unsigned char* ws = P->ws; const int lane = lane_;
    LAS unsigned* list = (LAS unsigned*)(C.lds + C.wave * ATT_WSTRIDE);
    int b, Lk; const unsigned short* srow;
    if (SAMPLE) { b = (row - MP) >> 3; const int j = (row - MP) & 7; Lk = PAST + j + 1; srow = (const unsigned short*)(ws + WS_SS) + (size_t)(row - MP) * SS_LD; }
    else { b = row >> 12; const int t = row & (SEQ - 1); Lk = t + 1; srow = (const unsigned short*)(ws + WS_SP) + (size_t)row * SEQ; }
    const int n16 = lane & 15, g = lane >> 4;
    u32x4 qraw[2]; qraw[0] = (u32x4){0u, 0u, 0u, 0u}; qraw[1] = qraw[0];
    if (n16 < 8) { qraw[0] = *(const u32x4*)((const bf16*)(ws + WS_AQ) + (size_t)row * 512 + n16 * 64 + 8 * g); qraw[1] = *(const u32x4*)((const bf16*)(ws + WS_AQ) + (size_t)row * 512 + n16 * 64 + 32 + 8 * g); }
    u32x2 azr[4];
#pragma unroll
    for (int dl = 0; dl < 4; ++dl) azr[dl] = *(const u32x2*)((const bf16*)(ws + WS_Z) + (size_t)row * NZ + ZC_AZ + (n16 & 7) * 64 + 16 * dl + 4 * g);
    int ptv = 0; if (SAMPLE) ptv = ((const int*)P->in[I_PT])[b * NPAGES + (lane & 15)];
    int count;
    if (Lk <= TOPK) { for (int i = lane; i < TOPK; i += 64) list[i] = i < Lk ? (unsigned)i : 0u; count = Lk; }
    else { select_topk(srow, Lk, list, lane, mode); if (SEL2) { LDS_WAIT(); asm volatile("" ::: "memory"); select_topk(srow, Lk, list, lane, mode); } count = TOPK; }
    LDS_WAIT(); asm volatile("" ::: "memory");
    if (mode == 1 || mode == 4 || mode == 5) return;
    {
#pragma unroll
      for (int i = 0; i < 4; ++i) { const unsigned k = list[lane + 64 * i]; unsigned phys;
          if (SAMPLE) { const unsigned pg = (unsigned)__builtin_amdgcn_ds_bpermute((int)(((k >> 7) & 15u) << 2), ptv); phys = (k < (unsigned)PAST) ? pg * 128u + (k & 127u) : (0x80000000u | (k - PAST)); }
          else phys = (unsigned)b * SEQ + k;
          list[lane + 64 * i] = phys; } }
    LDS_WAIT(); asm volatile("" ::: "memory");
    const float* ck = SAMPLE ? P->in[I_CK] + (size_t)L * NPOOL * 128 * 128 : nullptr; const float* cv = SAMPLE ? P->in[I_CV] + (size_t)L * NPOOL * 128 * 128 : nullptr;
    const float* nk = P->out + O_KS + ((size_t)L * DB + b) * DS * 128; const float* nv = P->out + O_VS + ((size_t)L * DB + b) * DS * 128;
    const bf16* KBp = (const bf16*)(ws + WS_KB); const bf16* VBp = (const bf16*)(ws + WS_VB);
    bf16x8 qf[2][2];
#pragma unroll
    for (int kvh = 0; kvh < 2; ++kvh)
#pragma unroll
        for (int s = 0; s < 2; ++s) { const u32x4 zz = {0u, 0u, 0u, 0u}; qf[kvh][s] = as_bf16x8(((n16 >> 2) == kvh) ? qraw[s] : zz); }
    f32x4 S[16];
    for (int rq_ = 0; rq_ < (QK2 ? 2 : 1); ++rq_) {
    { LAS unsigned char* kbuf = C.lds + C.wave * ATT_WSTRIDE + 1024; const int c16k = lane & 15, tqk = lane >> 4;
      constexpr int SB = SAMPLE ? 1 : 2, NBT = 8 / SB;
      u32x4 kraw[2][SB][SAMPLE ? 16 : 8];
#define ATT_KLOAD(buf_, k_) do { _Pragma("unroll") for (int q = 0; q < SB; ++q) _Pragma("unroll") for (int i = 0; i < 8; ++i) { const unsigned phys = list[32 * ((k_) * SB + q) + tqk + 4 * i]; \
                if (SAMPLE) { const float* kr = ((phys & 0x80000000u) ? nk + (size_t)(phys & 7u) * 128 : ck + (size_t)phys * 128) + 8 * c16k; kraw[buf_][q][2 * i] = *(const u32x4*)kr; kraw[buf_][q][2 * i + 1] = *(const u32x4*)(kr + 4); } \
                else kraw[buf_][q][i] = *(const u32x4*)(KBp + (size_t)phys * 128 + 8 * c16k); } } while (0)
      ATT_KLOAD(0, 0); ATT_KLOAD(1, 1);
      asm volatile("" ::: "memory");
#pragma unroll
      for (int k = 0; k < NBT; ++k) {
#pragma unroll
        for (int q = 0; q < SB; ++q) { const int st = k * SB + q;
#pragma unroll
            for (int i = 0; i < 8; ++i) { u32x4 w;
                if (SAMPLE) { const f32x4 a = __builtin_bit_cast(f32x4, kraw[k & 1][q][2 * i]), c = __builtin_bit_cast(f32x4, kraw[k & 1][q][2 * i + 1]); w.x = pk2(a[0], a[1]); w.y = pk2(a[2], a[3]); w.z = pk2(c[0], c[1]); w.w = pk2(c[2], c[3]); }
                else w = kraw[k & 1][q][i];
                *(LAS u32x4*)(kbuf + (tqk + 4 * i) * 288 + 16 * c16k) = w; }
            if (q == SB - 1 && k + 2 < NBT) ATT_KLOAD(k & 1, k + 2);
            LDS_WAIT(); asm volatile("" ::: "memory");
#pragma unroll
            for (int tt = 0; tt < 2; ++tt) { const LAS unsigned char* rp = kbuf + (16 * tt + n16) * 288 + 16 * g;
                const bf16x8 a00 = *(const LAS bf16x8*)rp, a01 = *(const LAS bf16x8*)(rp + 64), a10 = *(const LAS bf16x8*)(rp + 128), a11 = *(const LAS bf16x8*)(rp + 192);
                f32x4 acc = {0.f, 0.f, 0.f, 0.f};
                acc = mfma16(a00, qf[0][0], acc); acc = mfma16(a01, qf[0][1], acc); acc = mfma16(a10, qf[1][0], acc); acc = mfma16(a11, qf[1][1], acc); asm volatile("" : "+v"(acc)); S[2 * st + tt] = acc; }
            LDS_WAIT(); asm volatile("" ::: "memory"); }
      }
#undef ATT_KLOAD
    }
    asm volatile("" ::: "memory"); }
    LAS unsigned char* vbuf = C.lds + C.wave * ATT_WSTRIDE + 1024;
    const int c16 = lane & 15, tq = lane >> 4;
    constexpr int VD = SAMPLE ? 1 : 2;
    u32x4 vraw[VD][SAMPLE ? 16 : 8];
#define ATT_VLOAD(buf_, st_) do { _Pragma("unroll") for (int i = 0; i < 8; ++i) { const unsigned phys = list[32 * (st_) + tq + 4 * i]; \
            if (SAMPLE) { const float* vr = ((phys & 0x80000000u) ? nv + (size_t)(phys & 7u) * 128 : cv + (size_t)phys * 128) + 8 * c16; vraw[buf_][2 * i] = *(const u32x4*)vr; vraw[buf_][2 * i + 1] = *(const u32x4*)(vr + 4); } \
            else vraw[buf_][i] = *(const u32x4*)(VBp + (size_t)phys * 128 + 8 * c16); } } while (0)
    if (mode != 2) {
#pragma unroll
        for (int d = 0; d < VD; ++d) ATT_VLOAD(d, d); }
    asm volatile("" ::: "memory");
    float mx = -INFINITY;
#pragma unroll
    for (int i = 0; i < 16; ++i)
#pragma unroll
        for (int r = 0; r < 4; ++r) { const int slot = 16 * i + 4 * g + r; const float sv = slot < count ? S[i][r] * 0.125f : -INFINITY; S[i][r] = sv; mx = fmaxf(mx, sv); }
    mx = fmaxf(mx, shx<16>(mx, lane)); mx = fmaxf(mx, shx<32>(mx, lane));
    float sum = 0.f;
#pragma unroll
    for (int i = 0; i < 16; ++i)
#pragma unroll
        for (int r = 0; r < 4; ++r) { const float p = __builtin_amdgcn_exp2f((S[i][r] - mx) * 1.4426950408889634f); S[i][r] = p; sum += p; }
    sum += shx<16>(sum, lane); sum += shx<32>(sum, lane);
    if (mode == 2) return;
    f32x4 oacc[8];
    {
#pragma unroll
    for (int dt = 0; dt < 8; ++dt) oacc[dt] = (f32x4){0.f, 0.f, 0.f, 0.f};
    const unsigned tr_a = (unsigned)(4 * g + (c16 >> 2)) * 288u + (unsigned)(c16 & 3) * 8u;
#pragma unroll
    for (int st = 0; st < 8; ++st) {
#pragma unroll
        for (int i = 0; i < 8; ++i) { u32x4 w;
            if (SAMPLE) { const f32x4 a = __builtin_bit_cast(f32x4, vraw[st % VD][2 * i]), c = __builtin_bit_cast(f32x4, vraw[st % VD][2 * i + 1]); w.x = pk2(a[0], a[1]); w.y = pk2(a[2], a[3]); w.z = pk2(c[0], c[1]); w.w = pk2(c[2], c[3]); }
            else w = vraw[st % VD][i];
            *(LAS u32x4*)(vbuf + (tq + 4 * i) * 288 + 16 * c16) = w; }
        if (st + VD < 8) ATT_VLOAD(st % VD, st + VD);
        const f32x4 p0 = S[2 * st], p1 = S[2 * st + 1];
        u32x4 pw; pw.x = pk2(p0[0], p0[1]); pw.y = pk2(p0[2], p0[3]); pw.z = pk2(p1[0], p1[1]); pw.w = pk2(p1[2], p1[3]);
        const bf16x8 pf = as_bf16x8(pw);
        LDS_WAIT(); asm volatile("" ::: "memory");
#pragma unroll
        for (int dt = 0; dt < 8; ++dt) {
            typedef short v4i16_t __attribute__((ext_vector_type(4)));
            const v4i16_t lo = __builtin_amdgcn_ds_read_tr16_b64_v4i16((LAS v4i16_t*)(vbuf + tr_a + 32 * dt));
            const v4i16_t hi = __builtin_amdgcn_ds_read_tr16_b64_v4i16((LAS v4i16_t*)(vbuf + tr_a + 16 * 288 + 32 * dt));
            bf16x8 af; af[0] = lo[0]; af[1] = lo[1]; af[2] = lo[2]; af[3] = lo[3]; af[4] = hi[0]; af[5] = hi[1]; af[6] = hi[2]; af[7] = hi[3];
            oacc[dt] = mfma16(af, pf, oacc[dt]); }
        LDS_WAIT(); asm volatile("" ::: "memory");
    }
    asm volatile("" ::: "memory"); }
    { const float inv = 1.0f / sum;
#define ATT_EPI(base_) do { _Pragma("unroll") for (int dl = 0; dl < 4; ++dl) { const f32x4 v = oacc[(base_) + dl]; \
              const float y0 = v[0] * inv * siluf_(bflo(azr[dl].x)), y1 = v[1] * inv * siluf_(bfhi(azr[dl].x)), y2 = v[2] * inv * siluf_(bflo(azr[dl].y)), y3 = v[3] * inv * siluf_(bfhi(azr[dl].y)); \
              u32x2 ow; ow.x = pk2(y0, y1); ow.y = pk2(y2, y3); \
              *(u32x2*)((bf16*)(ws + WS_OGA) + (size_t)row * 512 + n16 * 64 + 16 * dl + 4 * g) = ow; } } while (0)
      if (n16 < 4) ATT_EPI(0); else if (n16 < 8) ATT_EPI(4);
#undef ATT_EPI
    }
    LDS_WAIT(); asm volatile("" ::: "memory");
#undef ATT_VLOAD
}
__device__ __forceinline__ void ret_out_unit(PK P, const Ctx& C, int unit, bool flip);
__device__ __forceinline__ void phase_d(PK P, const Ctx& C, int L, int mode = 3) {
    if (mode == 3) { bool flip = false; for (int u = C.blk; u < 512; u += C.nblk) { ret_out_unit(P, C, u, flip); flip = !flip; } __syncthreads(); }
#ifndef DSEL
#define DSEL 7
#endif
    if (!(DSEL & 2)) {} else
    if (C.nblk == 256 && !NOXCD) {
        const int x = C.blk & 7, b = x >> 1, wq = (((C.blk >> 3) * 2 + (x & 1)) * NWAVES + C.wave);
        for (int t = wq; t < SEQ; t += 512) attend_query<false>(P, C, L, b * SEQ + t, mode);
    } else for (int row = C.gw; row < MP; row += C.ngw) attend_query<false>(P, C, L, row, mode);
    if (DSEL & 4) for (int i = C.gw; i < 2 * MS; i += C.ngw) if ((i & 1) == 0) attend_query<true>(P, C, L, MP + (i >> 1), mode);
}

__device__ __forceinline__ void ret_out_unit(PK P, const Ctx& C, int unit, bool flip) {
    unsigned char* ws = P->ws; const bf16* RQ = (const bf16*)(ws + WS_RQ); const bf16* RK = (const bf16*)(ws + WS_RK); const bf16* RVT = (const bf16*)(ws + WS_RVT); const bf16* ST = (const bf16*)(ws + WS_ST);
    const int bh = unit >> 5, b = bh >> 2, h = bh & 3, n = unit & 31, r16 = C.lane & 15, g = C.lane >> 4, t0 = n * 128;
    const int w = flip ? 7 - C.wave : C.wave;
    const size_t rowbase = (size_t)b * SEQ + t0;
    const float lg2 = ret_log2g(h);
    constexpr int RS = 272; LAS unsigned char* Ks = C.lds; LAS unsigned char* Vs = C.lds + 128 * RS; LAS unsigned char* Ss = C.lds + 256 * RS;
    bf16x8 qf[4];
#pragma unroll
    for (int kk = 0; kk < 4; ++kk) qf[kk] = *(const bf16x8*)(RQ + (rowbase + 16 * w + r16) * 512 + h * 128 + 32 * kk + 8 * g);
    { const int pr = C.tid >> 4, pc = C.tid & 15;
      u32x4 rk[4], rv[4], rs_[4];
#pragma unroll
      for (int q = 0; q < 4; ++q) { const int r = pr + 32 * q;
          rk[q] = *(const u32x4*)(RK + (rowbase + r) * 512 + h * 128 + 8 * pc);
          rv[q] = *(const u32x4*)(RVT + ((size_t)bh * 128 + r) * SEQ + t0 + 8 * pc);
          rs_[q] = *(const u32x4*)(ST + (((size_t)bh * 32 + n) * 128 + r) * 128 + 8 * pc); }
      __syncthreads();
#pragma unroll
      for (int q = 0; q < 4; ++q) { const int r = pr + 32 * q; *(LAS u32x4*)(Ks + r * RS + 16 * pc) = rk[q]; *(LAS u32x4*)(Vs + r * RS + 16 * pc) = rv[q]; *(LAS u32x4*)(Ss + r * RS + 16 * pc) = rs_[q]; }
      __syncthreads(); }
    unsigned pt[8][2];
#pragma unroll
    for (int st = 0; st < 8; ++st) {
        pt[st][0] = 0u; pt[st][1] = 0u;
        if (st <= w) { f32x4 acc = {0.f, 0.f, 0.f, 0.f};
#pragma unroll
            for (int kk = 0; kk < 4; ++kk) { const bf16x8 kf = *(const LAS bf16x8*)(Ks + (16 * st + r16) * RS + 64 * kk + 16 * g); acc = mfma16(kf, qf[kk], acc); }
            float vals[4];
#pragma unroll
            for (int r = 0; r < 4; ++r) { const int dlt = (16 * w + r16) - (16 * st + 4 * g + r); vals[r] = dlt >= 0 ? acc[r] * __builtin_amdgcn_exp2f((float)dlt * lg2) : 0.f; }
            pt[st][0] = pk2(vals[0], vals[1]); pt[st][1] = pk2(vals[2], vals[3]); }
    }
    const float dq = __builtin_amdgcn_exp2f((float)(16 * w + r16 + 1) * lg2);
    f32x4 o[8];
#pragma unroll
    for (int et = 0; et < 8; ++et) {
        f32x4 a1 = {0.f, 0.f, 0.f, 0.f}, a2 = {0.f, 0.f, 0.f, 0.f};
        const LAS unsigned char* vrow = Vs + (16 * et + r16) * RS;
#pragma unroll
        for (int i = 0; i < 4; ++i) if (2 * i <= w) {
            const u32x2 lo = *(const LAS u32x2*)(vrow + 2 * (32 * i + 4 * g)), hi = *(const LAS u32x2*)(vrow + 2 * (32 * i + 16 + 4 * g));
            const u32x4 aw = {lo.x, lo.y, hi.x, hi.y}, bw = {pt[2 * i][0], pt[2 * i][1], pt[2 * i + 1][0], pt[2 * i + 1][1]};
            a1 = mfma16(as_bf16x8(aw), as_bf16x8(bw), a1); }
#pragma unroll
        for (int kk = 0; kk < 4; ++kk) { const bf16x8 sf = *(const LAS bf16x8*)(Ss + (16 * et + r16) * RS + 64 * kk + 16 * g); a2 = mfma16(sf, qf[kk], a2); }
        o[et] = a1 + a2 * dq;
    }
    float sm = 0.f;
#pragma unroll
    for (int et = 0; et < 8; ++et) sm += (o[et][0] + o[et][1]) + (o[et][2] + o[et][3]);
    sm += shx<16>(sm, C.lane); sm += shx<32>(sm, C.lane);
    const float mu = sm * (1.0f / 128.0f); float qv = 0.f;
#pragma unroll
    for (int et = 0; et < 8; ++et) { const f32x4 d = o[et] - mu; qv += (d[0] * d[0] + d[1] * d[1]) + (d[2] * d[2] + d[3] * d[3]); }
    qv += shx<16>(qv, C.lane); qv += shx<32>(qv, C.lane);
    const float rstd = __builtin_amdgcn_rsqf(qv * (1.0f / 128.0f) + 1e-5f);
    const size_t row = rowbase + 16 * w + r16;
    const bf16* zr = (const bf16*)(ws + WS_Z) + row * NZ + ZC_RZ + h * 128; bf16* og = (bf16*)(ws + WS_OGR) + row * 512 + h * 128;
#pragma unroll
    for (int et = 0; et < 8; ++et) { const u32x2 zw = *(const u32x2*)(zr + 16 * et + 4 * g);
        const float y0 = (o[et][0] - mu) * rstd * siluf_(bflo(zw.x)), y1 = (o[et][1] - mu) * rstd * siluf_(bfhi(zw.x)), y2 = (o[et][2] - mu) * rstd * siluf_(bflo(zw.y)), y3 = (o[et][3] - mu) * rstd * siluf_(bfhi(zw.y));
        u32x2 ow; ow.x = pk2(y0, y1); ow.y = pk2(y2, y3); *(u32x2*)(og + 16 * et + 4 * g) = ow; }
}

template <int K>
__device__ __forceinline__ void mini_mma(const bf16* A, const bf16* Bt, int row0, int col0, const Ctx& C, f32x4 (&acc)[2]) {
    constexpr int RS = 272, BUF = 2 * 64 * RS;
    constexpr int NC = K / 128, PF = NC < 4 ? NC : 4;
    const int tid = C.tid, lane = C.lane, rt = C.wave >> 1, ch = C.wave & 1, r16 = lane & 15, g = lane >> 4;
    LAS unsigned char* sm = C.lds;
    const int pr0 = tid >> 4, pc = tid & 15;
    const bf16* ga = A + (size_t)(row0 + pr0) * K + 8 * pc; const bf16* gb = Bt + (size_t)(col0 + pr0) * K + 8 * pc;
    acc[0] = (f32x4){0.f, 0.f, 0.f, 0.f}; acc[1] = (f32x4){0.f, 0.f, 0.f, 0.f};
    u32x4 rr[PF][4];
#pragma unroll
    for (int p = 0; p < PF; ++p) { rr[p][0] = *(const u32x4*)(ga + 128 * p); rr[p][1] = *(const u32x4*)(ga + (size_t)32 * K + 128 * p); rr[p][2] = *(const u32x4*)(gb + 128 * p); rr[p][3] = *(const u32x4*)(gb + (size_t)32 * K + 128 * p); }
    asm volatile("" ::: "memory");
    __syncthreads();
#pragma unroll
    for (int c = 0; c < NC; ++c) {
        { LAS unsigned char* w = sm + (c & 1) * BUF + pr0 * RS + 16 * pc; *(LAS u32x4*)w = rr[c % PF][0]; *(LAS u32x4*)(w + 32 * RS) = rr[c % PF][1]; *(LAS u32x4*)(w + 64 * RS) = rr[c % PF][2]; *(LAS u32x4*)(w + 96 * RS) = rr[c % PF][3]; }
        if (c + PF < NC) { const int n = c + PF; rr[c % PF][0] = *(const u32x4*)(ga + 128 * n); rr[c % PF][1] = *(const u32x4*)(ga + (size_t)32 * K + 128 * n); rr[c % PF][2] = *(const u32x4*)(gb + 128 * n); rr[c % PF][3] = *(const u32x4*)(gb + (size_t)32 * K + 128 * n); }
        asm volatile("" ::: "memory");
        __syncthreads();
        const LAS unsigned char* rd = sm + (c & 1) * BUF;
#pragma unroll
        for (int kk = 0; kk < 4; ++kk) {
            const bf16x8 a = *(const LAS bf16x8*)(rd + (16 * rt + r16) * RS + 64 * kk + 16 * g);
            const bf16x8 b0 = *(const LAS bf16x8*)(rd + (64 + 32 * ch + r16) * RS + 64 * kk + 16 * g), b1 = *(const LAS bf16x8*)(rd + (64 + 32 * ch + 16 + r16) * RS + 64 * kk + 16 * g);
            acc[0] = mfma16(a, b0, acc[0]); acc[1] = mfma16(a, b1, acc[1]); }
    }
    __syncthreads();
}
__device__ __forceinline__ void mini_oproj(PK P, const Ctx& C, int L) {
    unsigned char* ws = P->ws; const int lane = C.lane, rt = C.wave >> 1, ch = C.wave & 1, r16 = lane & 15, g = lane >> 4;
    for (int u = C.blk; u < 256; u += C.nblk) { const int row0 = MP + 64 * (u >> 4), col0 = 64 * (u & 15);
        f32x4 a1[2], a2[2];
        mini_mma<512>((const bf16*)(ws + WS_OGR), (const bf16*)(ws + WS_WOR) + (size_t)L * DM * 512, row0, col0, C, a1);
        mini_mma<512>((const bf16*)(ws + WS_OGA), (const bf16*)(ws + WS_WOA) + (size_t)L * DM * 512, row0, col0, C, a2);
        const bf16* Z = (const bf16*)(ws + WS_Z); bf16* MB = (bf16*)(ws + WS_MB);
#pragma unroll
        for (int j = 0; j < 2; ++j)
#pragma unroll
            for (int r = 0; r < 4; ++r) { const size_t row = (size_t)(row0 + 16 * rt + 4 * g + r); const int col = col0 + 32 * ch + 16 * j + r16;
                const float m = sigmoidf_(bf2f(Z[row * NZ + ZC_GR + col])) * a1[j][r] + sigmoidf_(bf2f(Z[row * NZ + ZC_GA + col])) * a2[j][r];
                MB[row * DM + col] = (bf16)(pk2(m, 0.f) & 0xffffu); } }
}
__device__ __forceinline__ void mini_wout(PK P, const Ctx& C, int L) {
    unsigned char* ws = P->ws; const int lane = C.lane, rt = C.wave >> 1, ch = C.wave & 1, r16 = lane & 15, g = lane >> 4;
    const float* xs = P->in[I_XS] - (size_t)MP * DM;
    const bf16* xh = (const bf16*)(ws + WS_XB0);
    for (int u = C.blk; u < 256; u += C.nblk) { const int row0 = MP + 64 * (u >> 4), col0 = 64 * (u & 15);
        f32x4 a1[2];
        mini_mma<1024>((const bf16*)(ws + WS_MB), (const bf16*)(ws + WS_WOUT) + (size_t)L * DM * DM, row0, col0, C, a1);
        bf16* XB1 = (bf16*)(ws + WS_XB1);
#pragma unroll
        for (int j = 0; j < 2; ++j)
#pragma unroll
            for (int r = 0; r < 4; ++r) { const size_t row = (size_t)(row0 + 16 * rt + 4 * g + r); const int col = col0 + 32 * ch + 16 * j + r16;
                const float x = (L == 0) ? xs[row * DM + col] : bf2f(xh[row * DM + col]);
                XB1[row * DM + col] = (bf16)(pk2(x + a1[j][r], 0.f) & 0xffffu); } }
}
__device__ __forceinline__ void mini_ple(PK P, const Ctx& C, int L, bool do_ss = true) {
    unsigned char* ws = P->ws; const int lane = C.lane, rt = C.wave >> 1, ch = C.wave & 1, r16 = lane & 15, g = lane >> 4;
    float* rowss = (L + 1 < DEPTH && do_ss) ? (float*)(ws + WS_CTL) + CW_ROWSS1 : nullptr;
    for (int u = C.blk; u < 256; u += C.nblk) { const int row0 = MP + 64 * (u >> 4), col0 = 64 * (u & 15);
        f32x4 a1[2], a2[2];
        mini_mma<1024>((const bf16*)(ws + WS_XB1), (const bf16*)(ws + WS_WPG) + (size_t)L * DM * DM, row0, col0, C, a1);
        mini_mma<256>((const bf16*)(ws + WS_PB) + (size_t)L * MT * 256, (const bf16*)(ws + WS_WPP) + (size_t)L * DM * 256, row0, col0, C, a2);
        const bf16* XB1 = (const bf16*)(ws + WS_XB1); float* Y = P->out; bf16* XB0 = (bf16*)(ws + WS_XB0);
#pragma unroll
        for (int r = 0; r < 4; ++r) { const size_t row = (size_t)(row0 + 16 * rt + 4 * g + r); float ssq = 0.f;
#pragma unroll
            for (int j = 0; j < 2; ++j) { const int col = col0 + 32 * ch + 16 * j + r16;
                const float v = bf2f(XB1[row * DM + col]) + sigmoidf_(a1[j][r]) * a2[j][r]; if (L + 1 == DEPTH) Y[row * DM + col] = v; XB0[row * DM + col] = (bf16)(pk2(v, 0.f) & 0xffffu); ssq += v * v; }
            if (rowss != nullptr) { ssq += shx<1>(ssq, lane); ssq += shx<2>(ssq, lane); ssq += shx<4>(ssq, lane); ssq += shx<8>(ssq, lane); if (r16 == 0) atomicAdd(rowss + row, ssq); } } }
}


__device__ __forceinline__ void mini_inproj_gates(PK P, const Ctx& C, int L) {
    unsigned char* ws = P->ws; const int lane = C.lane, rt = C.wave >> 1, ch = C.wave & 1, r16 = lane & 15, g = lane >> 4;
    const float* rowss = (L == 0) ? (const float*)(ws + WS_ROWSS0) : (const float*)(ws + WS_CTL) + CW_ROWSS1;
    bf16* Z = (bf16*)(ws + WS_Z);
    for (int u = C.blk; u < 16 * 30; u += C.nblk) { const int row0 = MP + 64 * (u / 30), col0 = 15 * 256 + 64 * (u % 30);
        f32x4 a1[2];
        mini_mma<1024>((const bf16*)(ws + WS_XB0), (const bf16*)(ws + WS_WIN) + (size_t)L * NZ * DM, row0, col0, C, a1);
#pragma unroll
        for (int r = 0; r < 4; ++r) { const size_t row = (size_t)(row0 + 16 * rt + 4 * g + r); const float rs = __builtin_amdgcn_rsqf(rowss[row] * (1.0f / 1024.0f) + 1e-6f);
#pragma unroll
            for (int j = 0; j < 2; ++j) Z[row * NZ + col0 + 32 * ch + 16 * j + r16] = (bf16)(pk2(a1[j][r] * rs, 0.f) & 0xffffu); } }
}
__global__ void __launch_bounds__(NTHREADS, 2) mk_fwd(Params Pval) {
    extern __shared__ __attribute__((aligned(16))) unsigned char lds_raw[];
    LAS unsigned char* lds = (LAS unsigned char*)lds_raw;
    volatile LAS unsigned* MISC = (volatile LAS unsigned*)(lds + MISC_OFF);
    const int wave_s = __builtin_amdgcn_readfirstlane((int)threadIdx.x >> 6);
    for (int u = wave_s * 64 + hw_lane(); u < (LDS_BYTES - RING_BYTES) / 4; u += NTHREADS) ((LAS unsigned*)(lds + RING_BYTES))[u] = 0u;
    __syncthreads();
    const int lo = Pval.ph_lo, hi = Pval.ph_hi;
    XcdBarrier bar; bar.bar = (unsigned*)(Pval.ws + WS_CTL) + CW_BAR + Pval.li * XCD_BAR_WORDS; bar.x = 0; bar.st = MISC + 8;
    if (hi - lo > 1) bar = xcd_barrier_post(bar.bar, MISC + 8, wave_s == 0 && hw_lane() == 0);
#ifndef STEPSEL
#define STEPSEL(j) true
#endif
#define IN(k) (lo <= (k) && (k) < hi)
#ifndef DUPMASK
#define DUPMASK 0
#endif
#ifndef XBAR2
#define XBAR2 0
#endif
#ifndef MINI2
#define MINI2 0
#endif
#ifndef DUPMODE
#define DUPMODE 3
#endif
#ifndef CSEL
#define CSEL 15
#endif
#define INL(j) (STEPSEL(j) && IN(pb + (j)))
#define NREP(j) (((DUPMASK) >> (j)) & 1 ? 2 : 1)
#define SEAM(k) do { if (IN((k) + 1)) { XcdBarrier b2_ = bar; asm volatile("" : "+s"(b2_.bar), "+s"(b2_.x)); int t0_ = wave_s * 64 + hw_lane(salt_); asm volatile("" : "+v"(t0_)); xcd_barrier(b2_, t0_ == 0); if (XBAR2) xcd_barrier(b2_, t0_ == 0); } } while (0)
#define PH_ENTER() PK P = phase_args(); const Ctx C = phase_ctx(lds, wave_s, salt_); unsigned char* ws = P->ws; (void)ws; (void)C
    #ifndef PRODUP
#define PRODUP 1
#endif
    const int salt_ = 0;
    if (STEPSEL(-1) && IN(0)) { for (int rep = 0; rep < PRODUP; ++rep) { PH_ENTER(); p0_prologue(P, C); __syncthreads(); } SEAM(0); }
#pragma unroll 1
    for (int L = 0; L < DEPTH; ++L) {
        const int pb = 1 + 8 * L; const int salt_ = pb;
        if (INL(0)) {
            if (blockIdx.x & 1) for (int rm = 0; rm < (MINI2 ? 2 : 1); ++rm) { PH_ENTER(); mini_inproj_gates(P, C, L); }
            for (int rep = 0; rep < NREP(0); ++rep) { PH_ENTER();
            pg8::Gemm g{(const bf16*)(ws + WS_XB0), (const bf16*)(ws + WS_WIN) + (size_t)L * NZ * DM, MT, NZ, DM}; InProjOrder S; S.init(C.nblk, C.blk);
            EpiZ E{ws, P->out, L == 0 ? (const float*)(ws + WS_ROWSS0) : (const float*)(ws + WS_CTL) + CW_ROWSS1, P->in[I_QG] + L * 64, P->in[I_KG] + L * 64, L, lds + XPOSE_OFF};
            pg8::gemm_phase<EpiZ, InProjOrder, true, true>(lds, g, S, E, C.tid); }
            if (!(blockIdx.x & 1)) for (int rm = 0; rm < (MINI2 ? 2 : 1); ++rm) { PH_ENTER(); mini_inproj_gates(P, C, L); }
            SEAM(pb + 0); }
        if (INL(1)) { for (int rep = 0; rep < NREP(1); ++rep) { PH_ENTER(); (void)P; (void)C; }   }
        if (INL(2)) { for (int rep = 0; rep < NREP(2); ++rep) { PH_ENTER(); phase_c(P, C, L, rep == 0 ? 15 : CSEL); __syncthreads(); } SEAM(pb + 2); }
        if (INL(3)) { for (int rep = 0; rep < NREP(3); ++rep) { PH_ENTER(); phase_d(P, C, L, rep == 0 ? 3 : DUPMODE); __syncthreads(); } SEAM(pb + 3); }
        if (INL(4)) {   }
        if (INL(5)) {
            for (int rep = 0; rep < NREP(5); ++rep) {
            { PH_ENTER(); mini_oproj(P, C, L); }
            { PH_ENTER(); pg8::StaticOrder S; S.init(MP, DM, C.nblk, C.blk);
              pg8::Gemm g{(const bf16*)(ws + WS_OGR), (const bf16*)(ws + WS_WOR) + (size_t)L * DM * 512, MP, DM, 512}; EpiGate<0> E{(const bf16*)(ws + WS_Z), ZC_GR, (bf16*)(ws + WS_TMP), (bf16*)(ws + WS_MB)};
              pg8::gemm_phase<EpiGate<0>, pg8::StaticOrder, true, true>(lds, g, S, E, C.tid); }
            { PH_ENTER(); pg8::StaticOrder S; S.init(MP, DM, C.nblk, C.blk);
              pg8::Gemm g{(const bf16*)(ws + WS_OGA), (const bf16*)(ws + WS_WOA) + (size_t)L * DM * 512, MP, DM, 512}; EpiGate<1> E{(const bf16*)(ws + WS_Z), ZC_GA, (bf16*)(ws + WS_TMP), (bf16*)(ws + WS_MB)};
              pg8::gemm_phase<EpiGate<1>, pg8::StaticOrder, true, true>(lds, g, S, E, C.tid); } }
            SEAM(pb + 5); }
        if (INL(6)) {
            for (int rep = 0; rep < NREP(6); ++rep) {
            { PH_ENTER(); mini_wout(P, C, L); }
            { PH_ENTER(); pg8::StaticOrder S; S.init(MP, DM, C.nblk, C.blk);
            pg8::Gemm g{(const bf16*)(ws + WS_MB), (const bf16*)(ws + WS_WOUT) + (size_t)L * DM * DM, MP, DM, DM};
            EpiRes E{P->in[I_XP], P->in[I_XS], L == 0 ? (const bf16*)nullptr : (const bf16*)(ws + WS_XB0), (bf16*)(ws + WS_XB1)};
            pg8::gemm_phase<EpiRes, pg8::StaticOrder, true, true>(lds, g, S, E, C.tid); } }
            SEAM(pb + 6); }
        if (INL(7)) {
            for (int rep = 0; rep < NREP(7); ++rep) {
            { PH_ENTER(); mini_ple(P, C, L, rep == NREP(7) - 1); }
            { PH_ENTER(); pg8::StaticOrder S; S.init(MP, DM, C.nblk, C.blk);
              pg8::Gemm g{(const bf16*)(ws + WS_XB1), (const bf16*)(ws + WS_WPG) + (size_t)L * DM * DM, MP, DM, DM}; EpiPle<0> E{(bf16*)(ws + WS_TMP), (const bf16*)(ws + WS_XB1), nullptr, (bf16*)(ws + WS_XB0), nullptr};
              pg8::gemm_phase<EpiPle<0>, pg8::StaticOrder, true, true>(lds, g, S, E, C.tid); }
            if (L + 1 < DEPTH) { PH_ENTER(); pg8::StaticOrder S; S.init(MP, DM, C.nblk, C.blk);
                pg8::Gemm g{(const bf16*)(ws + WS_PB) + (size_t)L * MT * 256, (const bf16*)(ws + WS_WPP) + (size_t)L * DM * 256, MP, DM, 256};
                EpiPle<1> E{(bf16*)(ws + WS_TMP), (const bf16*)(ws + WS_XB1), P->out, (bf16*)(ws + WS_XB0), (float*)(ws + WS_CTL) + CW_ROWSS1};
                pg8::gemm_phase<EpiPle<1>, pg8::StaticOrder, true, true>(lds, g, S, E, C.tid); }
            else { PH_ENTER(); pg8::StaticOrder S; S.init(MP, DM, C.nblk, C.blk);
                pg8::Gemm g{(const bf16*)(ws + WS_PB) + (size_t)L * MT * 256, (const bf16*)(ws + WS_WPP) + (size_t)L * DM * 256, MP, DM, 256};
                EpiPle<2> E{(bf16*)(ws + WS_TMP), (const bf16*)(ws + WS_XB1), P->out, (bf16*)(ws + WS_XB0), (float*)(ws + WS_CTL) + CW_ROWSS1};
                pg8::gemm_phase<EpiPle<2>, pg8::StaticOrder, true, true>(lds, g, S, E, C.tid); } }
            SEAM(pb + 7); }
    }
#undef IN
#undef INL
#undef SEAM
#undef PH_ENTER
}

#ifndef MK_N_LAUNCHES
#define MK_N_LAUNCHES 1
#endif
extern "C" void kernel_launch(void* const* d_in, const int* in_sizes, int n_in, void* d_out, int out_size, void* d_ws, size_t ws_size, hipStream_t stream) {
    static int grid = 0;
    if (grid == 0) {
        if (n_in != 18 || out_size != (int)O_END || ws_size < WS_END) { fprintf(stderr, "kernel_launch: unexpected problem: n_in %d out %d ws %zu; nothing launched\n", n_in, out_size, ws_size); grid = -1; return; }
        int dev = 0, cus = 0, per_cu = 0;
        if (hipGetDevice(&dev) != hipSuccess || hipDeviceGetAttribute(&cus, hipDeviceAttributeMultiprocessorCount, dev) != hipSuccess) { grid = -1; return; }
        if (hipFuncSetAttribute((const void*)mk_fwd, hipFuncAttributeMaxDynamicSharedMemorySize, LDS_BYTES) != hipSuccess) { fprintf(stderr, "kernel_launch: hipFuncSetAttribute failed\n"); grid = -1; return; }
        if (hipOccupancyMaxActiveBlocksPerMultiprocessor(&per_cu, (const void*)mk_fwd, NTHREADS, LDS_BYTES) != hipSuccess || per_cu < 1) { fprintf(stderr, "kernel_launch: occupancy query says %d blocks per CU\n", per_cu); grid = -1; (void)hipGetLastError(); return; }
        grid = cus;
    }
    if (grid < 0) return;
    (void)hipMemsetAsync((char*)d_ws + WS_CTL, 0, CTL_ZERO_BYTES, stream);
    Params a{};
    for (int i = 0; i < 18; ++i) a.in[i] = (const float*)d_in[i];
    a.out = (float*)d_out; a.ws = (unsigned char*)d_ws;
#if MK_N_LAUNCHES == 1
    a.ph_lo = 0; a.ph_hi = N_PHASES; a.li = 0;
    hipLaunchKernelGGL(mk_fwd, dim3(grid), dim3(NTHREADS), LDS_BYTES, stream, a);
#else
    for (int li = 0; li < N_PHASES; ++li) { a.ph_lo = li; a.ph_hi = li + 1; a.li = 0; hipLaunchKernelGGL(mk_fwd, dim3(grid), dim3(NTHREADS), LDS_BYTES, stream, a); }
#endif
    (void)in_sizes;
}
```

```cpp
#include <hip/hip_runtime.h>
#include <cstdio>
#include <cstdint>
namespace pg8 {
#define PG8_LAS __attribute__((address_space(3)))
typedef unsigned short bf16_t;
typedef short bf16x8 __attribute__((ext_vector_type(8)));
typedef float f32x4 __attribute__((ext_vector_type(4)));
typedef unsigned u32x4 __attribute__((ext_vector_type(4)));
constexpr int BM = 256, BK = 64, HALF = 128, HTB = HALF * BK * 2  , STAGE_BYTES = 8 * HTB, NXCD = 8, WGM = 8;

__host__ __device__ __forceinline__ int lds_byte(int r, int c) { const int st = (r >> 4) * 2 + (c >> 5), rr = r & 15, cc = c & 31, ob = rr * 64 + cc * 2; return st * 1024 + (ob ^ (((ob >> 9) & 1) << 5)); }
__host__ __device__ __forceinline__ void stage_rc(int b, int& R, int& C) { const int st = b / 1024, sb = b % 1024, swz = sb ^ (((sb >> 9) & 1) << 5); R = (st >> 1) * 16 + swz / 64; C = (st & 1) * 32 + (swz % 64) / 2; }
__host__ __device__ __forceinline__ int perm32(int rho) { const int n = rho >> 4, i = rho & 15; return 8 * (i >> 2) + 4 * n + (i & 3); }

struct Unit { int pm, pn; };
struct Gemm { const bf16_t* A; const bf16_t* Bt; int M, N, K; };

struct StaticOrder {
    int nM, nN, nwg, G, c;
    __host__ __device__ void init(int M, int N, int G_, int c_) { nM = M / BM; nN = N / BM; nwg = nM * nN; G = G_; c = c_; }
    __host__ __device__ bool next(int i, Unit& u) const {
        const int L = i * G + c; if (L >= nwg) return false;
        int wgid = L; { const int q = nwg / NXCD, r = nwg % NXCD, xcd = wgid % NXCD, off = wgid / NXCD; wgid = (xcd < r ? xcd * (q + 1) : r * (q + 1) + (xcd - r) * q) + off; }
        const int nig = WGM * nN, gid = wgid / nig, fm = gid * WGM, gsz = (nM - fm) < WGM ? (nM - fm) : WGM;
        u.pm = fm + ((wgid % nig) % gsz); u.pn = (wgid % nig) / gsz; return true;
    }
    __device__ __forceinline__ void a_ready(const Unit&) const {}
    __device__ __forceinline__ void done(const Unit&) const {}
};
__device__ __forceinline__ unsigned cvt_pk_bf16(float lo, float hi) { unsigned r; asm volatile("v_cvt_pk_bf16_f32 %0, %1, %2" : "=v"(r) : "v"(lo), "v"(hi)); return r; }

template <class Epi, class Sched, bool ALIGN_EPI = false, bool SP2 = false>
__device__ __forceinline__ void gemm_phase(PG8_LAS unsigned char* lds, const Gemm g, const Sched& S, const Epi& E, int tid_) {
    asm volatile("" : "+v"(tid_)); const int tid = tid_, wid = __builtin_amdgcn_readfirstlane(tid >> 6), lane = tid & 63, wr = wid >> 2, wc = wid & 3, fr = lane & 15, fq = lane >> 4;
    const int K = g.K, nt = K / BK;
    unsigned voffA[2], voffB[2];
#pragma unroll
    for (int i = 0; i < 2; ++i) { int R, C; stage_rc(tid * 16 + i * 8192, R, C); const int Rb = Epi::PERM ? ((R & ~31) + perm32(R & 31)) : R;
        voffA[i] = (unsigned)(R * K + C) * 2u; voffB[i] = (unsigned)(Rb * K + C) * 2u; }
    const size_t kstep = (size_t)(BK * 2);
    const size_t hstep = (size_t)HALF * K * 2;
    const size_t tstep = 2 * hstep;
    const unsigned ldsw = (unsigned)wid * 1024u;
    const int aoff = lds_byte(wr * 64 + fr, fq * 8), boff = lds_byte(wc * 32 + fr, fq * 8);
#define PG8_SA(b, h) (((b) * 2 + (h)) * HTB)
#define PG8_SB(b, h) ((4 + (b) * 2 + (h)) * HTB)
#define PG8_STAGE(bufoff, gbase, voff) do { _Pragma("unroll") for (int _i = 0; _i < 2; ++_i) \
        __builtin_amdgcn_global_load_lds((const unsigned*)((const char*)(gbase) + (voff)[_i]), (PG8_LAS unsigned*)(lds + (bufoff) + ldsw + _i * 8192), 16, 0, 0); } while (0)
#define PG8_LDA(dst, b, h) do { _Pragma("unroll") for (int m = 0; m < 4; ++m) _Pragma("unroll") for (int k = 0; k < 2; ++k) dst[m][k] = *(const PG8_LAS bf16x8*)(lds + PG8_SA(b, h) + aoff + m * 2048 + k * 1024); } while (0)
#define PG8_LDB(dst, b, h) do { _Pragma("unroll") for (int n = 0; n < 2; ++n) _Pragma("unroll") for (int k = 0; k < 2; ++k) dst[n][k] = *(const PG8_LAS bf16x8*)(lds + PG8_SB(b, h) + boff + n * 2048 + k * 1024); } while (0)
#define PG8_MMA(ai, bj, At, Bt) do { __builtin_amdgcn_s_setprio(1); _Pragma("unroll") for (int m = 0; m < 4; ++m) _Pragma("unroll") for (int n = 0; n < 2; ++n) _Pragma("unroll") for (int k = 0; k < 2; ++k) \
        acc[ai][bj][m][n] = __builtin_amdgcn_mfma_f32_16x16x32_bf16(Bt[n][k], At[m][k], acc[ai][bj][m][n], 0, 0, 0); __builtin_amdgcn_s_setprio(0); } while (0)
#define PG8_WAIT_V(n) asm volatile("s_waitcnt vmcnt(" #n ")" ::: "memory")
#define PG8_WAIT_L(n) asm volatile("s_waitcnt lgkmcnt(" #n ")" ::: "memory")
#define PG8_BAR __builtin_amdgcn_s_barrier()
#define PG8_SCHED __builtin_amdgcn_sched_barrier(0)
    Unit cur, nxt; int ui = 0;
    if (!S.next(0, cur)) return;
    f32x4 acc[2][2][4][2];
#pragma unroll
    for (int a = 0; a < 2; ++a)
#pragma unroll
        for (int b = 0; b < 2; ++b)
#pragma unroll
            for (int m = 0; m < 4; ++m)
#pragma unroll
                for (int n = 0; n < 2; ++n) acc[a][b][m][n] = (f32x4){0.f, 0.f, 0.f, 0.f};
    bf16x8 At[4][2], B0[2][2], B1[2][2];
    const char* cA = (const char*)g.A + (size_t)cur.pm * tstep; const char* cB = (const char*)g.Bt + (size_t)cur.pn * tstep;
    S.a_ready(cur);
    if constexpr (SP2) {
        PG8_STAGE(PG8_SB(0, 0), cB, voffB); PG8_STAGE(PG8_SB(0, 1), cB + hstep, voffB); PG8_STAGE(PG8_SA(0, 0), cA, voffA); PG8_STAGE(PG8_SA(0, 1), cA + hstep, voffA);
        if (wr == 1) PG8_BAR;
        PG8_WAIT_V(2); PG8_BAR;
        PG8_STAGE(PG8_SB(1, 0), cB + kstep, voffB); PG8_STAGE(PG8_SA(1, 0), cA + kstep, voffA); PG8_STAGE(PG8_SB(1, 1), cB + hstep + kstep, voffB);
        PG8_WAIT_V(6); PG8_BAR;
    } else {
        PG8_STAGE(PG8_SB(0, 0), cB, voffB); PG8_STAGE(PG8_SA(0, 0), cA, voffA); PG8_STAGE(PG8_SB(0, 1), cB + hstep, voffB); PG8_STAGE(PG8_SA(0, 1), cA + hstep, voffA);
        if (wr == 1) PG8_BAR;
        PG8_WAIT_V(4); PG8_BAR;
        PG8_STAGE(PG8_SB(1, 0), cB + kstep, voffB); PG8_STAGE(PG8_SA(1, 0), cA + kstep, voffA); PG8_STAGE(PG8_SB(1, 1), cB + hstep + kstep, voffB);
        PG8_WAIT_V(6); PG8_BAR;
    }
    for (;;) {
        const bool has_next = S.next(ui + 1, nxt);
        const char* nA = has_next ? (const char*)g.A + (size_t)nxt.pm * tstep : cA; const char* nB = has_next ? (const char*)g.Bt + (size_t)nxt.pn * tstep : cB;
        for (int t = 0; t < nt; t += 2) {
            const bool last = (t == nt - 2);
            const char* a1 = cA + (size_t)(t + 1) * kstep;
            const char* a2 = last ? nA : cA + (size_t)(t + 2) * kstep; const char* b2 = last ? nB : cB + (size_t)(t + 2) * kstep;
            const char* a3 = a2 + kstep; const char* b3 = b2 + kstep;
            if (last && has_next) S.a_ready(nxt);
            if constexpr (SP2) {
            PG8_LDB(B0, 0, 0); PG8_LDB(B1, 0, 1); PG8_SCHED; PG8_LDA(At, 0, 0); PG8_STAGE(PG8_SA(1, 1), a1 + hstep, voffA);
            PG8_WAIT_V(8); PG8_WAIT_L(0); PG8_BAR; PG8_MMA(0, 0, At, B0); PG8_MMA(0, 1, At, B1); PG8_BAR; PG8_SCHED;
            PG8_LDA(At, 0, 1); PG8_STAGE(PG8_SB(0, 0), b2, voffB); PG8_STAGE(PG8_SB(0, 1), b2 + hstep, voffB); PG8_STAGE(PG8_SA(0, 0), a2, voffA);
            PG8_WAIT_V(8); PG8_WAIT_L(0); PG8_BAR; PG8_MMA(1, 0, At, B0); PG8_MMA(1, 1, At, B1); PG8_BAR; PG8_SCHED;
            PG8_LDB(B0, 1, 0); PG8_LDB(B1, 1, 1); PG8_SCHED; PG8_LDA(At, 1, 0); PG8_STAGE(PG8_SA(0, 1), a2 + hstep, voffA);
            PG8_WAIT_V(8); PG8_WAIT_L(0); PG8_BAR; PG8_MMA(0, 0, At, B0); PG8_MMA(0, 1, At, B1); PG8_BAR; PG8_SCHED;
            PG8_LDA(At, 1, 1); PG8_STAGE(PG8_SB(1, 0), b3, voffB); PG8_STAGE(PG8_SB(1, 1), b3 + hstep, voffB); PG8_STAGE(PG8_SA(1, 0), a3, voffA);
            PG8_WAIT_V(8); PG8_WAIT_L(0); PG8_BAR; PG8_MMA(1, 0, At, B0); PG8_MMA(1, 1, At, B1); PG8_BAR; PG8_SCHED;
            } else {
            PG8_LDB(B0, 0, 0); PG8_SCHED; PG8_LDA(At, 0, 0); PG8_STAGE(PG8_SA(1, 1), a1 + hstep, voffA);
            PG8_WAIT_L(8); PG8_BAR; PG8_WAIT_L(0); PG8_MMA(0, 0, At, B0); PG8_BAR; PG8_SCHED;
            PG8_LDB(B1, 0, 1); PG8_STAGE(PG8_SB(0, 0), b2, voffB);
            PG8_BAR; PG8_WAIT_L(0); PG8_MMA(0, 1, At, B1); PG8_BAR;
            PG8_LDA(At, 0, 1); PG8_STAGE(PG8_SA(0, 0), a2, voffA);
            PG8_BAR; PG8_WAIT_L(0); PG8_MMA(1, 0, At, B0); PG8_BAR; PG8_SCHED;
            PG8_STAGE(PG8_SB(0, 1), b2 + hstep, voffB);
            PG8_WAIT_V(6); PG8_BAR; PG8_MMA(1, 1, At, B1); PG8_BAR;
            PG8_LDB(B0, 1, 0); PG8_SCHED; PG8_LDA(At, 1, 0); PG8_STAGE(PG8_SA(0, 1), a2 + hstep, voffA);
            PG8_WAIT_L(8); PG8_BAR; PG8_WAIT_L(0); PG8_MMA(0, 0, At, B0); PG8_BAR; PG8_SCHED;
            PG8_LDB(B1, 1, 1); PG8_STAGE(PG8_SB(1, 0), b3, voffB);
            PG8_BAR; PG8_WAIT_L(0); PG8_MMA(0, 1, At, B1); PG8_BAR;
            PG8_LDA(At, 1, 1); PG8_STAGE(PG8_SA(1, 0), a3, voffA);
            PG8_BAR; PG8_WAIT_L(0); PG8_MMA(1, 0, At, B0); PG8_BAR; PG8_SCHED;
            PG8_STAGE(PG8_SB(1, 1), b3 + hstep, voffB);
            PG8_WAIT_V(6); PG8_BAR; PG8_MMA(1, 1, At, B1); PG8_BAR;
            }
        }
        if constexpr (ALIGN_EPI) { if (wr == 0) PG8_BAR; }
        if constexpr (!Epi::AFTER_DRAIN) { E(acc, cur, wr, wc, fr, fq); S.done(cur); }
        if (!has_next) break;
#pragma unroll
        for (int a = 0; a < 2; ++a)
#pragma unroll
            for (int b = 0; b < 2; ++b)
#pragma unroll
                for (int m = 0; m < 4; ++m)
#pragma unroll
                    for (int n = 0; n < 2; ++n) acc[a][b][m][n] = (f32x4){0.f, 0.f, 0.f, 0.f};
        cur = nxt; cA = nA; cB = nB; ++ui;
        if constexpr (ALIGN_EPI) { if (wr == 1) PG8_BAR; }
    }
    PG8_WAIT_V(0);
    if constexpr (!ALIGN_EPI) { if (wr == 0) PG8_BAR; }
    PG8_BAR;
    if constexpr (Epi::AFTER_DRAIN) { E.fused(acc, cur, wr, wc, fr, fq, lds, wid, lane); S.done(cur); }
#undef PG8_SA
#undef PG8_SB
#undef PG8_STAGE
#undef PG8_LDA
#undef PG8_LDB
#undef PG8_MMA
#undef PG8_WAIT_V
#undef PG8_WAIT_L
#undef PG8_BAR
#undef PG8_SCHED
}
}

#define GAS __attribute__((address_space(1)))
#define LAS __attribute__((address_space(3)))
typedef unsigned short bf16;
typedef float f32x4 __attribute__((ext_vector_type(4)));
typedef float f32x2 __attribute__((ext_vector_type(2)));
typedef float f32x16 __attribute__((ext_vector_type(16)));
typedef short bf16x8 __attribute__((ext_vector_type(8)));
typedef unsigned u32x4 __attribute__((ext_vector_type(4)));
typedef unsigned u32x2 __attribute__((ext_vector_type(2)));

constexpr int NWAVES = 8, NTHREADS = 512;
constexpr int DM = 1024, NB = 4, SEQ = 4096, DEPTH = 2, DB = 128, DS = 8, PAST = 2048, NPAGES = 16, NPOOL = 2560;
constexpr int MP = NB * SEQ, MS = DB * DS, MT = MP + MS;
constexpr int NZ = 5888;
constexpr int WIN_N = 5700;
constexpr int ZC_RQ = 0, ZC_RK = 512, ZC_RV = 1024, ZC_RZ = 1536, ZC_AQ = 2048, ZC_AK = 2560, ZC_AV = 2688, ZC_AZ = 2816, ZC_IQ = 3328, ZC_IK = 3584, ZC_IW = 3648, ZC_GR = 3712, ZC_GA = 4736;
constexpr int SS_LD = 2064;
constexpr int TOPK = 256;
constexpr size_t O_Y = 0, O_KP = 17825792, O_VP = 22020096, O_IKP = 26214400, O_RSP = 28311552, O_KS = 28835840, O_VS = 29097984, O_IKS = 29360128, O_RSS = 29491200, O_END = 46268416;
constexpr size_t MiB = 1u << 20;
constexpr size_t WS_CTL = 0, CTL_ZERO_BYTES = 1 * MiB;
constexpr size_t WS_WIN = 1 * MiB, WS_WOR = 24 * MiB, WS_WOA = 26 * MiB, WS_WOUT = 28 * MiB, WS_WPG = 32 * MiB, WS_WPP = 36 * MiB;
constexpr size_t WS_ROPER = 37 * MiB, WS_ROPEA = 39 * MiB, WS_ROWSS0 = 39 * MiB + 256 * 1024, WS_IW = 39 * MiB + 512 * 1024;
constexpr size_t WS_XB0 = 40 * MiB, WS_XB1 = 74 * MiB, WS_X1 = 108 * MiB, WS_TMP = 176 * MiB, WS_MB = 244 * MiB, WS_Z = 278 * MiB;
constexpr size_t WS_RQ = 474 * MiB, WS_RK = 490 * MiB, WS_RKT = 506 * MiB, WS_RVT = 522 * MiB, WS_AQ = 538 * MiB, WS_KB = 555 * MiB, WS_VB = 559 * MiB;
constexpr size_t WS_IQ = 563 * MiB, WS_IKB = 572 * MiB, WS_PB = 930 * MiB, WS_KVT = 583 * MiB, WS_ST = 615 * MiB, WS_OGR = 631 * MiB, WS_OGA = 648 * MiB;
constexpr size_t WS_SS = 665 * MiB, WS_SP = 674 * MiB, WS_END = 948 * MiB;
static_assert(WS_Z + (size_t)MT * NZ * 2 <= WS_RQ && WS_SS + (size_t)MS * SS_LD * 4 <= WS_SP && WS_IW + (size_t)MT * 16 <= WS_XB0, "ws map");
constexpr int CW_TMO = 0, CW_BAR = 4096, CW_ROWSS1 = 131072;
constexpr int N_PHASES = 1 + 8 * DEPTH;
constexpr int RING_BYTES = 131072, MISC_OFF = RING_BYTES + 320, XPOSE_OFF = RING_BYTES + 1024, LDS_BYTES = XPOSE_OFF + 8 * 2048;

#define LDS_WAIT() asm volatile("s_waitcnt lgkmcnt(0)" ::: "memory")
#define VM_WAIT() asm volatile("s_waitcnt vmcnt(0)" ::: "memory")
__device__ __forceinline__ unsigned pk2(float lo, float hi) { unsigned r; asm("v_cvt_pk_bf16_f32 %0, %1, %2" : "=v"(r) : "v"(lo), "v"(hi)); return r; }
__device__ __forceinline__ float bflo(unsigned w) { return __uint_as_float(w << 16); }
__device__ __forceinline__ float bfhi(unsigned w) { return __uint_as_float(w & 0xffff0000u); }
__device__ __forceinline__ float bf2f(bf16 b) { return __uint_as_float(((unsigned)b) << 16); }
__device__ __forceinline__ float sigmoidf_(float x) { return __builtin_amdgcn_rcpf(1.0f + __builtin_amdgcn_exp2f(x * -1.4426950408889634f)); }
__device__ __forceinline__ float siluf_(float x) { return x * sigmoidf_(x); }
__device__ __forceinline__ void unpack8(const u32x4 w, float (&f)[8]) { f[0] = bflo(w.x); f[1] = bfhi(w.x); f[2] = bflo(w.y); f[3] = bfhi(w.y); f[4] = bflo(w.z); f[5] = bfhi(w.z); f[6] = bflo(w.w); f[7] = bfhi(w.w); }
__device__ __forceinline__ u32x4 pack8(const float (&f)[8]) { u32x4 w; w.x = pk2(f[0], f[1]); w.y = pk2(f[2], f[3]); w.z = pk2(f[4], f[5]); w.w = pk2(f[6], f[7]); return w; }
__device__ __forceinline__ bf16x8 as_bf16x8(const u32x4 w) { return __builtin_bit_cast(bf16x8, w); }
__device__ __forceinline__ f32x4 mfma16(bf16x8 a, bf16x8 b, f32x4 c) { return __builtin_amdgcn_mfma_f32_16x16x32_bf16(a, b, c, 0, 0, 0); }
__device__ __forceinline__ f32x16 mfma32(bf16x8 a, bf16x8 b, f32x16 c) { return __builtin_amdgcn_mfma_f32_32x32x16_bf16(a, b, c, 0, 0, 0); }
__device__ __forceinline__ float ret_log2g(int h) { return h == 0 ? -0.04580369f : h == 1 ? -0.022720076f : h == 2 ? -0.011315313f : -0.0056465627f; }
__device__ __forceinline__ int mbcnt64(unsigned long long m) { return (int)__builtin_amdgcn_mbcnt_hi((unsigned)(m >> 32), __builtin_amdgcn_mbcnt_lo((unsigned)m, 0u)); }

template <int M> __device__ __forceinline__ float shx(float v, int lane) {
    if constexpr (M < 32) return __int_as_float(__builtin_amdgcn_ds_swizzle(__float_as_int(v), 0x1F | (M << 10)));
    else return __int_as_float(__builtin_amdgcn_ds_bpermute((lane ^ 32) << 2, __float_as_int(v)));
}
__device__ __forceinline__ float wave_sum(float v, int lane) { v += shx<1>(v, lane); v += shx<2>(v, lane); v += shx<4>(v, lane); v += shx<8>(v, lane); v += shx<16>(v, lane); v += shx<32>(v, lane); return v; }

#define XB_TMO      128
#define XB_XCNT(j)  (256  + 64 * (j))
#define XB_XSUB(j)  (1280 + 64 * (j))
#define XB_XGEN(j)  (2304 + 64 * (j))
#define XB_TOP      3328
#define XB_TOPGEN   3392
#define XCD_BAR_WORDS 3456
#define XB_SPIN_CAP (1u << 18)
__device__ __forceinline__ unsigned xb_ld(unsigned* p)              { return __hip_atomic_load(p, __ATOMIC_RELAXED, __HIP_MEMORY_SCOPE_AGENT); }
__device__ __forceinline__ unsigned xb_add(unsigned* p, unsigned v) { return __hip_atomic_fetch_add(p, v, __ATOMIC_RELAXED, __HIP_MEMORY_SCOPE_AGENT); }
__device__ __forceinline__ unsigned xb_xcc_id() { return (unsigned)__builtin_amdgcn_s_getreg((3 << 11) | 20) & 0xFu; }
#define XB_SPIN(cond, bar) do { unsigned _sp = 0; while (cond) { __builtin_amdgcn_s_sleep(1); \
    if ((++_sp & 255u) == 0u) { if (xb_ld(&(bar)[XB_TMO])) break; if (_sp > XB_SPIN_CAP) { atomicAdd(&(bar)[XB_TMO], 1u); break; } } } } while (0)
struct XcdBarrier { unsigned* bar; unsigned x; volatile LAS unsigned* st; };
__device__ __forceinline__ XcdBarrier xcd_barrier_post(unsigned* bar, volatile LAS unsigned* st, bool leader) {
    XcdBarrier b; b.bar = bar; b.x = xb_xcc_id(); b.st = st;
    if (leader) (void)xb_add(&bar[XB_XCNT(b.x)], 1u);
    return b;
}
__device__ __forceinline__ void xcd_barrier_complete(unsigned* bar, unsigned x, unsigned& nloc, unsigned& nx) {
    const unsigned G = gridDim.x * gridDim.y * gridDim.z;
    unsigned sum, cnt, mine, sp = 0u;
    for (;;) {
        sum = 0u; cnt = 0u; mine = 0u;
#pragma unroll
        for (unsigned j = 0; j < 16; ++j) { const unsigned c = xb_ld(&bar[XB_XCNT(j)]); sum += c; cnt += (c > 0u) ? 1u : 0u; mine = (j == x) ? c : mine; }
        if (sum == G) break;
        __builtin_amdgcn_s_sleep(1);
        if ((++sp & 255u) == 0u) { if (xb_ld(&bar[XB_TMO])) break; if (sp > XB_SPIN_CAP) { atomicAdd(&bar[XB_TMO], 1u); break; } }
    }
    nloc = mine > 0u ? mine : 1u; nx = cnt > 0u ? cnt : 1u;
}
__device__ __forceinline__ void xcd_barrier(const XcdBarrier& b, bool leader) {
    asm volatile("s_waitcnt vmcnt(0)" ::: "memory");
    __syncthreads();
    if (leader) {
        unsigned* bar = b.bar;
        __builtin_amdgcn_s_waitcnt(0);
        unsigned nloc = b.st[0], nx = b.st[1];
        if (nloc == 0u) { xcd_barrier_complete(bar, b.x, nloc, nx); b.st[0] = nloc; b.st[1] = nx; }
        const unsigned old = xb_add(&bar[XB_XSUB(b.x)], 1u);
        const unsigned gen = old / nloc;
        if (old + 1u == (gen + 1u) * nloc) {
            __builtin_amdgcn_fence(__ATOMIC_RELEASE, "agent");
            asm volatile("s_waitcnt vmcnt(0)" ::: "memory");
            const unsigned og = xb_add(&bar[XB_TOP], 1u);
            const unsigned tg = og / nx;
            if (og + 1u == (tg + 1u) * nx) xb_add(&bar[XB_TOPGEN], 1u);
            else XB_SPIN(xb_ld(&bar[XB_TOPGEN]) == tg, bar);
            __builtin_amdgcn_fence(__ATOMIC_ACQUIRE, "agent");
            xb_add(&bar[XB_XGEN(b.x)], 1u);
            asm volatile("s_waitcnt vmcnt(0)" ::: "memory");
        } else {
            XB_SPIN(xb_ld(&bar[XB_XGEN(b.x)]) == gen, bar);
            __builtin_amdgcn_fence(__ATOMIC_ACQUIRE, "agent");
            asm volatile("s_waitcnt vmcnt(0)" ::: "memory");
        }
    }
    __syncthreads();
}

struct Params { const float* in[18]; float* out; unsigned char* ws; int ph_lo, ph_hi, li, pad; };
enum { I_XP = 0, I_XS, I_CK, I_CV, I_CIK, I_STATE, I_PT, I_PP, I_PS, I_GAIN, I_WIN, I_QG, I_KG, I_WOR, I_WOA, I_WOUT, I_WPG, I_WPP };
struct Ctx { int tid, lane, wave, gw, ngw, nblk, blk; LAS unsigned char* lds; };
typedef const __attribute__((address_space(4))) Params* PK;
__device__ __forceinline__ PK phase_args() { PK p = (PK)__builtin_amdgcn_kernarg_segment_ptr(); asm volatile("" : "+s"(p)); return p; }
__device__ __forceinline__ int hw_lane(int salt = 0) { int l; asm volatile("v_mbcnt_lo_u32_b32 %0, -1, 0 ; %1\n\tv_mbcnt_hi_u32_b32 %0, -1, %0" : "=v"(l) : "s"(salt)); return l; }
__device__ __forceinline__ Ctx phase_ctx(LAS unsigned char* lds, int wave_s, int salt) { Ctx C; int tid = wave_s * 64 + hw_lane(salt); asm volatile("" : "+v"(tid)); C.lds = lds; C.tid = tid; C.lane = tid & 63; C.wave = __builtin_amdgcn_readfirstlane(tid >> 6);
    int bx = blockIdx.x; asm volatile("" : "+s"(bx)); C.nblk = gridDim.x; C.blk = bx; C.gw = C.blk * NWAVES + C.wave; C.ngw = C.nblk * NWAVES; return C; }

__device__ __forceinline__ int win_orig_col(int np) {
    const int pn = np >> 8, c = np & 255, bj = c >> 7, cc = c & 127, wc = cc >> 5, l8 = cc & 31;
    if (pn < 4) { const int head = 2 * (pn & 1) + bj, dim = (cc >> 1) + 64 * (cc & 1); return (pn < 2 ? 0 : 512) + head * 128 + dim; }
    if (pn < 8) return np;
    if (pn == 11 || pn == 12) return np;
    if (pn <= 10 || pn == 13) { const int dimp = 32 * bj + l8; const bool rope = !(pn == 10 && wc >= 2);
        const int dim = (rope && dimp < 16) ? (dimp >> 1) + 8 * (dimp & 1) : dimp;
        if (pn < 10) return 2048 + (4 * (pn - 8) + wc) * 64 + dim;
        if (pn == 10) return 2560 + wc * 64 + dim;
        return 3328 + wc * 64 + dim; }
    if (np < 3584 + 64) { const int dimp = np - 3584; return 3584 + (dimp < 16 ? (dimp >> 1) + 8 * (dimp & 1) : dimp); }
    if (np < 3652) return np;
    if (np < ZC_GR) return -1;
    if (np < ZC_GR + 2048) return np - (ZC_GR - 3652);
    return -1;
}
struct EpiZ {
    static constexpr bool PERM = true, AFTER_DRAIN = false;
    unsigned char* ws; float* out; const float* rowss; const float* qgain; const float* kgain; int L; LAS unsigned char* xl;
    __device__ __forceinline__ void rope16(float (&x)[8], const f32x2* ropeA, int fq, int hl) const {
        float lo[4], hi[4];
#pragma unroll
        for (int k = 0; k < 4; ++k) { const f32x2 cs = ropeA[(fq & 1) * 4 + k]; lo[k] = x[2 * k] * cs[0] - x[2 * k + 1] * cs[1]; hi[k] = x[2 * k + 1] * cs[0] + x[2 * k] * cs[1]; }
        float rc[4];
#pragma unroll
        for (int k = 0; k < 4; ++k) rc[k] = shx<16>(fq == 0 ? hi[k] : lo[k], hl);
        if (fq == 0) {
#pragma unroll
            for (int k = 0; k < 4; ++k) { x[k] = lo[k]; x[4 + k] = rc[k]; } }
        else if (fq == 1) {
#pragma unroll
            for (int k = 0; k < 4; ++k) { x[k] = rc[k]; x[4 + k] = hi[k]; } }
    }
    __device__ __forceinline__ void operator()(const f32x4 (&acc)[2][2][4][2], const pg8::Unit& u, int wr, int wc, int, int) const {
        const int hl = hw_lane(), fr = hl & 15, fq = hl >> 4;
        const int pn = u.pn; const bool prompt = u.pm < MP / 256;
        const int row0 = u.pm * 256 + wr * 64 + fr;
        bf16* Z = (bf16*)(ws + WS_Z);
        float rsv[2][4];
#pragma unroll
        for (int ai = 0; ai < 2; ++ai)
#pragma unroll
            for (int m = 0; m < 4; ++m) rsv[ai][m] = rowss[row0 + ai * 128 + m * 16];
        asm volatile("" ::: "memory");
#pragma unroll
        for (int ai = 0; ai < 2; ++ai)
#pragma unroll
            for (int m = 0; m < 4; ++m) rsv[ai][m] = __builtin_amdgcn_rsqf(rsv[ai][m] * (1.0f / 1024.0f) + 1e-6f);
        if (prompt && pn >= 2 && pn < 6) {
            const bool isk = pn < 4; LAS unsigned char* xt = xl + (wr * 4 + wc) * 2048;
            const int b = (u.pm * 256) >> 12, tpan = (u.pm * 256) & (SEQ - 1);
#pragma unroll
            for (int ai = 0; ai < 2; ++ai)
#pragma unroll
                for (int bj = 0; bj < 2; ++bj) { const int head = 2 * (pn & 1) + bj;
#pragma unroll
                    for (int mp = 0; mp < 2; ++mp) {
#pragma unroll
                        for (int mm = 0; mm < 2; ++mm) { const int m = 2 * mp + mm; const int row = row0 + ai * 128 + m * 16, t = row & (SEQ - 1);
                            const float rs = rsv[ai][m];
                            float x[8];
#pragma unroll
                            for (int j = 0; j < 4; ++j) { x[j] = acc[ai][bj][m][0][j] * rs; x[4 + j] = acc[ai][bj][m][1][j] * rs; }
                            const int t32 = 16 * mm + fr;
                            if (isk) { const int p0 = 16 * wc + 4 * fq; const f32x2* rr = (const f32x2*)(ws + WS_ROPER) + (size_t)t * 64 + p0; float lo[4], hi[4];
#pragma unroll
                                for (int k = 0; k < 4; ++k) { const f32x2 cs = rr[k]; lo[k] = (x[2 * k] * cs[0] - x[2 * k + 1] * cs[1]) * 0.08838834764831845f; hi[k] = (x[2 * k + 1] * cs[0] + x[2 * k] * cs[1]) * 0.08838834764831845f; }
                                bf16* q = (bf16*)(ws + WS_RK) + (size_t)row * 512 + head * 128 + p0;
                                u32x2 a, c; a.x = pk2(lo[0], lo[1]); a.y = pk2(lo[2], lo[3]); c.x = pk2(hi[0], hi[1]); c.y = pk2(hi[2], hi[3]); *(u32x2*)q = a; *(u32x2*)(q + 64) = c;
                                const float dk = __builtin_amdgcn_exp2f((float)(127 - (t & 127)) * ret_log2g(head));
#pragma unroll
                                for (int k = 0; k < 4; ++k) { *(LAS bf16*)(xt + (4 * fq + k) * 64 + 2 * t32) = (bf16)(pk2(lo[k] * dk, 0.f) & 0xffffu); *(LAS bf16*)(xt + (16 + 4 * fq + k) * 64 + 2 * t32) = (bf16)(pk2(hi[k] * dk, 0.f) & 0xffffu); }
                            } else {
#pragma unroll
                                for (int j = 0; j < 8; ++j) *(LAS bf16*)(xt + (8 * fq + j) * 64 + 2 * t32) = (bf16)(pk2(x[j], 0.f) & 0xffffu); } }
                        asm volatile("s_waitcnt lgkmcnt(0)" ::: "memory");
#pragma unroll
                        for (int i = 0; i < 2; ++i) { const int c = hl + 64 * i, dl = c >> 2, q4 = c & 3; const u32x4 v = *(const LAS u32x4*)(xt + dl * 64 + 16 * q4);
                            const int d = isk ? 16 * wc + (dl & 15) + 64 * (dl >> 4) : 32 * wc + dl;
                            bf16* dst = (bf16*)(ws + (isk ? WS_RKT : WS_RVT)) + ((size_t)(b * 4 + head) * 128 + d) * SEQ + tpan + 128 * ai + 64 * wr + 32 * mp + 8 * q4;
                            *(u32x4*)dst = v; }
                        asm volatile("s_waitcnt lgkmcnt(0)" ::: "memory"); } }
            return;
        }
#define EZ_X(bj_, xv_) float xv_[8]; _Pragma("unroll") for (int j_ = 0; j_ < 4; ++j_) { xv_[j_] = acc[ai][bj_][m][0][j_] * rs; xv_[4 + j_] = acc[ai][bj_][m][1][j_] * rs; }
#pragma unroll
        for (int ai = 0; ai < 2; ++ai)
#pragma unroll
            for (int m = 0; m < 4; ++m) {
                const int row = row0 + ai * 128 + m * 16; const float rs = rsv[ai][m];
                const int pos = prompt ? (row & (SEQ - 1)) : PAST + ((row - MP) & 7);
                const unsigned zrow = (unsigned)row * NZ;
                if (pn < 4) {
                    const int p0 = 16 * wc + 4 * fq; const bool isk = pn >= 2;
                    if (!prompt) {
#pragma unroll
                        for (int bj = 0; bj < 2; ++bj) { EZ_X(bj, x) const int hc = (isk ? ZC_RK : ZC_RQ) + (2 * (pn & 1) + bj) * 128;
                            u32x2 a, b; a.x = pk2(x[0], x[2]); a.y = pk2(x[4], x[6]); b.x = pk2(x[1], x[3]); b.y = pk2(x[5], x[7]);
                            *(u32x2*)(Z + zrow + hc + p0) = a; *(u32x2*)(Z + zrow + hc + 64 + p0) = b; }
                    } else {
                        const f32x2* rr = (const f32x2*)(ws + WS_ROPER) + (size_t)pos * 64 + p0; const int b = row >> 12, t = row & (SEQ - 1);
                        f32x2 cs[4];
#pragma unroll
                        for (int k = 0; k < 4; ++k) cs[k] = rr[k];
#pragma unroll
                        for (int bj = 0; bj < 2; ++bj) { EZ_X(bj, x) const int head = 2 * (pn & 1) + bj; float lo[4], hi[4];
#pragma unroll
                            for (int k = 0; k < 4; ++k) { lo[k] = x[2 * k] * cs[k][0] - x[2 * k + 1] * cs[k][1]; hi[k] = x[2 * k + 1] * cs[k][0] + x[2 * k] * cs[k][1]; }
                            if (!isk) { bf16* q = (bf16*)(ws + WS_RQ) + (size_t)row * 512 + head * 128 + p0;
                                u32x2 a, c; a.x = pk2(lo[0], lo[1]); a.y = pk2(lo[2], lo[3]); c.x = pk2(hi[0], hi[1]); c.y = pk2(hi[2], hi[3]); *(u32x2*)q = a; *(u32x2*)(q + 64) = c; }
                            else { const float sc = 0.08838834764831845f;
#pragma unroll
                                for (int k = 0; k < 4; ++k) { lo[k] *= sc; hi[k] *= sc; }
                                bf16* q = (bf16*)(ws + WS_RK) + (size_t)row * 512 + head * 128 + p0;
                                u32x2 a, c; a.x = pk2(lo[0], lo[1]); a.y = pk2(lo[2], lo[3]); c.x = pk2(hi[0], hi[1]); c.y = pk2(hi[2], hi[3]); *(u32x2*)q = a; *(u32x2*)(q + 64) = c;
                                const float dk = __builtin_amdgcn_exp2f((float)(127 - (t & 127)) * ret_log2g(head));
                                bf16* kt = (bf16*)(ws + WS_RKT) + ((size_t)(b * 4 + head) * 128 + p0) * SEQ + t;
#pragma unroll
                                for (int k = 0; k < 4; ++k) { kt[(size_t)k * SEQ] = (bf16)(pk2(lo[k] * dk, 0.f) & 0xffffu); kt[(size_t)(64 + k) * SEQ] = (bf16)(pk2(hi[k] * dk, 0.f) & 0xffffu); } } }
                    }
                } else if (pn < 6 && prompt) {
                    const int b = row >> 12, t = row & (SEQ - 1);
#pragma unroll
                    for (int bj = 0; bj < 2; ++bj) { EZ_X(bj, x) bf16* vt = (bf16*)(ws + WS_RVT) + ((size_t)(b * 4 + 2 * (pn & 1) + bj) * 128 + 32 * wc + 8 * fq) * SEQ + t;
#pragma unroll
                        for (int j = 0; j < 8; ++j) vt[(size_t)j * SEQ] = (bf16)(pk2(x[j], 0.f) & 0xffffu); }
                } else if (pn == 8 || pn == 9 || pn == 10 || pn == 13) {
                    const bool norm = (pn < 10) || (pn == 10 && wc < 2), rope = norm || pn == 13;
                    EZ_X(0, x0) EZ_X(1, x1)
                    if (norm) { float ss = 0.f;
#pragma unroll
                        for (int j = 0; j < 8; ++j) ss += x0[j] * x0[j] + x1[j] * x1[j];
                        ss += shx<16>(ss, hl); ss += shx<32>(ss, hl);
                        const float rr = __builtin_amdgcn_rsqf(ss * (1.0f / 64.0f) + 1e-6f); const float* gn = (pn < 10) ? qgain : kgain;
#pragma unroll
                        for (int j = 0; j < 8; ++j) { const int d0 = (fq < 2) ? 4 * fq + (j >> 1) + 8 * (j & 1) : 8 * fq + j; x0[j] *= rr * gn[d0]; x1[j] *= rr * gn[32 + 8 * fq + j]; } }
                    if (rope) rope16(x0, (const f32x2*)(ws + WS_ROPEA) + (size_t)pos * 8, fq, hl);
                    if (pn < 10) { bf16* q = (bf16*)(ws + WS_AQ) + (size_t)row * 512 + (4 * (pn - 8) + wc) * 64 + 8 * fq; *(u32x4*)q = pack8(x0); *(u32x4*)(q + 32) = pack8(x1); }
                    else if (pn == 13) { bf16* q = (bf16*)(ws + WS_IQ) + (size_t)row * 256 + wc * 64 + 8 * fq; *(u32x4*)q = pack8(x0); *(u32x4*)(q + 32) = pack8(x1); }
                    else { const bool isk = wc < 2; const int hk = wc & 1;
                        float* dst = (isk ? (prompt ? out + O_KP + ((size_t)L * MP + row) * 128 : out + O_KS + ((size_t)L * MS + (row - MP)) * 128)
                                          : (prompt ? out + O_VP + ((size_t)L * MP + row) * 128 : out + O_VS + ((size_t)L * MS + (row - MP)) * 128)) + hk * 64 + 8 * fq;
                        *(f32x4*)dst = (f32x4){x0[0], x0[1], x0[2], x0[3]}; *(f32x4*)(dst + 4) = (f32x4){x0[4], x0[5], x0[6], x0[7]};
                        *(f32x4*)(dst + 32) = (f32x4){x1[0], x1[1], x1[2], x1[3]}; *(f32x4*)(dst + 36) = (f32x4){x1[4], x1[5], x1[6], x1[7]};
                        if (prompt) { bf16* d2 = (bf16*)(ws + (isk ? WS_KB : WS_VB)) + (size_t)row * 128 + hk * 64 + 8 * fq; *(u32x4*)d2 = pack8(x0); *(u32x4*)(d2 + 32) = pack8(x1); } }
                } else if (pn == 14) {
                    { EZ_X(0, x0)
                      if (wc == 0) rope16(x0, (const f32x2*)(ws + WS_ROPEA) + (size_t)pos * 8, fq, hl);
                      if (wc < 2) { float* dst = (prompt ? out + O_IKP + ((size_t)L * MP + row) * 64 : out + O_IKS + ((size_t)L * MS + (row - MP)) * 64) + 32 * wc + 8 * fq;
                          *(f32x4*)dst = (f32x4){x0[0], x0[1], x0[2], x0[3]}; *(f32x4*)(dst + 4) = (f32x4){x0[4], x0[5], x0[6], x0[7]};
                          if (prompt) *(u32x4*)((bf16*)(ws + WS_IKB) + (size_t)row * 64 + 32 * wc + 8 * fq) = pack8(x0); }
                      else if (wc == 2 && fq == 0) *(f32x4*)((float*)(ws + WS_IW) + (size_t)row * 4) = (f32x4){x0[0] * 0.0625f, x0[1] * 0.0625f, x0[2] * 0.0625f, x0[3] * 0.0625f}; }
                    { EZ_X(1, x1) *(u32x4*)(Z + zrow + pn * 256 + 128 + 32 * wc + 8 * fq) = pack8(x1); }
                } else {
#pragma unroll
                    for (int bj = 0; bj < 2; ++bj) { EZ_X(bj, x) *(u32x4*)(Z + zrow + pn * 256 + 128 * bj + 32 * wc + 8 * fq) = pack8(x); }
                }
                asm volatile("" ::: "memory"); }
#undef EZ_X
    }
};

struct InProjOrder {
    pg8::StaticOrder base; int G, c;
    __device__ void init(int G_, int c_) { base.init(MP, NZ, G_, c_); G = G_; c = c_; }
    __device__ bool next(int i, pg8::Unit& u) const {
        const int L = i * G + c; const int np = (MP / 256) * (NZ / 256);
        if (L < np) return base.next(i, u);
        const int l2 = L - np; if (l2 >= 4 * 15) return false;
        u.pm = MP / 256 + l2 / 15; u.pn = l2 % 15; return true;
    }
    __device__ __forceinline__ void a_ready(const pg8::Unit&) const {}
    __device__ __forceinline__ void done(const pg8::Unit&) const {}
};
template <int MODE> struct EpiGate {
    static constexpr bool PERM = true, AFTER_DRAIN = false;
    const bf16* Z; int gcol; bf16* TMP; bf16* MB;
    __device__ __forceinline__ void operator()(const f32x4 (&acc)[2][2][4][2], const pg8::Unit& u, int wr, int wc, int, int) const {
        const int hl_ = hw_lane(), fr = hl_ & 15, fq = hl_ >> 4;
        const int row0 = u.pm * 256 + wr * 64 + fr, col0 = u.pn * 256 + wc * 32 + 8 * fq;
        constexpr int AB = (MODE == 0) ? 2 : 1;
#pragma unroll
        for (int a0 = 0; a0 < 2; a0 += AB) {
            u32x4 gw[AB][4][2], tw[AB][4][2];
#pragma unroll
            for (int aa = 0; aa < AB; ++aa)
#pragma unroll
                for (int m = 0; m < 4; ++m)
#pragma unroll
                    for (int bj = 0; bj < 2; ++bj) { const int row = row0 + (a0 + aa) * 128 + m * 16, col = col0 + bj * 128;
                        gw[aa][m][bj] = *(const u32x4*)(Z + ((unsigned)row * NZ + (unsigned)(gcol + col)));
                        if (MODE == 1) tw[aa][m][bj] = *(const u32x4*)(TMP + ((unsigned)row * DM + (unsigned)col)); }
            asm volatile("" ::: "memory");
#pragma unroll
            for (int aa = 0; aa < AB; ++aa)
#pragma unroll
                for (int m = 0; m < 4; ++m)
#pragma unroll
                    for (int bj = 0; bj < 2; ++bj) { const int ai = a0 + aa; const int row = row0 + ai * 128 + m * 16, col = col0 + bj * 128; const unsigned off = (unsigned)row * DM + (unsigned)col;
                        float g[8]; unpack8(gw[aa][m][bj], g);
                        const f32x4 a0v = acc[ai][bj][m][0], a1v = acc[ai][bj][m][1];
                        float r[8];
#pragma unroll
                        for (int j = 0; j < 4; ++j) { r[j] = sigmoidf_(g[j]) * a0v[j]; r[4 + j] = sigmoidf_(g[4 + j]) * a1v[j]; }
                        if (MODE == 0) *(u32x4*)(TMP + off) = pack8(r);
                        else { float t[8]; unpack8(tw[aa][m][bj], t);
#pragma unroll
                            for (int j = 0; j < 8; ++j) r[j] += t[j];
                            *(u32x4*)(MB + off) = pack8(r); } }
            asm volatile("" ::: "memory"); }
    }
};
struct EpiRes {
    static constexpr bool PERM = true, AFTER_DRAIN = false;
    const float* xa; const float* xb; const bf16* xh; bf16* XB1;
    __device__ __forceinline__ void operator()(const f32x4 (&acc)[2][2][4][2], const pg8::Unit& u, int wr, int wc, int, int) const {
        const int hl_ = hw_lane(), fr = hl_ & 15, fq = hl_ >> 4;
        const int row0 = u.pm * 256 + wr * 64 + fr, col0 = u.pn * 256 + wc * 32 + 8 * fq;
        const float* xr = (u.pm < MP / 256) ? xa : xb - (size_t)MP * DM;
#pragma unroll
        for (int ai = 0; ai < 2; ++ai) {
            u32x4 xw[4][2][2];
#pragma unroll
            for (int m = 0; m < 4; ++m)
#pragma unroll
                for (int bj = 0; bj < 2; ++bj) { const unsigned off = (unsigned)(row0 + ai * 128 + m * 16) * DM + (unsigned)(col0 + bj * 128);
                    if (xh != nullptr) xw[m][bj][0] = *(const u32x4*)(xh + off);
                    else { xw[m][bj][0] = *(const u32x4*)(xr + off); xw[m][bj][1] = *(const u32x4*)(xr + off + 4); } }
            asm volatile("" ::: "memory");
#pragma unroll
            for (int m = 0; m < 4; ++m)
#pragma unroll
                for (int bj = 0; bj < 2; ++bj) { const unsigned off = (unsigned)(row0 + ai * 128 + m * 16) * DM + (unsigned)(col0 + bj * 128);
                    float x[8];
                    if (xh != nullptr) unpack8(xw[m][bj][0], x);
                    else { const f32x4 x0 = __builtin_bit_cast(f32x4, xw[m][bj][0]), x1 = __builtin_bit_cast(f32x4, xw[m][bj][1]); x[0] = x0[0]; x[1] = x0[1]; x[2] = x0[2]; x[3] = x0[3]; x[4] = x1[0]; x[5] = x1[1]; x[6] = x1[2]; x[7] = x1[3]; }
                    const f32x4 a0 = acc[ai][bj][m][0], a1 = acc[ai][bj][m][1];
#pragma unroll
                    for (int j = 0; j < 4; ++j) { x[j] += a0[j]; x[4 + j] += a1[j]; }
                    *(u32x4*)(XB1 + off) = pack8(x); }
            asm volatile("" ::: "memory"); }
    }
};
template <int MODE> struct EpiPle {
    static constexpr bool PERM = true, AFTER_DRAIN = false;
    bf16* TMP; const bf16* XB1; float* Y; bf16* XB0; float* rowss;
    __device__ __forceinline__ void operator()(const f32x4 (&acc)[2][2][4][2], const pg8::Unit& u, int wr, int wc, int, int) const {
        const int hl_ = hw_lane(), fr = hl_ & 15, fq = hl_ >> 4;
        const int row0 = u.pm * 256 + wr * 64 + fr, col0 = u.pn * 256 + wc * 32 + 8 * fq;
#pragma unroll
        for (int ai = 0; ai < 2; ++ai) {
            u32x4 tw[4][2], xw[4][2];
            if (MODE != 0) {
#pragma unroll
                for (int m = 0; m < 4; ++m)
#pragma unroll
                    for (int bj = 0; bj < 2; ++bj) { const unsigned off = (unsigned)(row0 + ai * 128 + m * 16) * DM + (unsigned)(col0 + bj * 128);
                        tw[m][bj] = *(const u32x4*)(TMP + off); xw[m][bj] = *(const u32x4*)(XB1 + off); }
                asm volatile("" ::: "memory"); }
#pragma unroll
            for (int m = 0; m < 4; ++m) { const int row = row0 + ai * 128 + m * 16; float ssq = 0.f;
#pragma unroll
                for (int bj = 0; bj < 2; ++bj) { const unsigned off = (unsigned)row * DM + (unsigned)(col0 + bj * 128);
                    const f32x4 a0 = acc[ai][bj][m][0], a1 = acc[ai][bj][m][1];
                    if (MODE == 0) { float r[8];
#pragma unroll
                        for (int j = 0; j < 4; ++j) { r[j] = sigmoidf_(a0[j]); r[4 + j] = sigmoidf_(a1[j]); }
                        *(u32x4*)(TMP + off) = pack8(r); }
                    else { float t[8], x[8]; unpack8(tw[m][bj], t); unpack8(xw[m][bj], x);
#pragma unroll
                        for (int j = 0; j < 4; ++j) { x[j] += t[j] * a0[j]; x[4 + j] += t[4 + j] * a1[j]; }
                        if (MODE == 2) { *(f32x4*)(Y + off) = (f32x4){x[0], x[1], x[2], x[3]}; *(f32x4*)(Y + off + 4) = (f32x4){x[4], x[5], x[6], x[7]}; }
                        *(u32x4*)(XB0 + off) = pack8(x);
                        if (MODE == 1) {
#pragma unroll
                            for (int j = 0; j < 8; ++j) ssq += x[j] * x[j]; } } }
                if (MODE == 1) { const int ln_ = fr + 16 * fq; ssq += shx<16>(ssq, ln_); ssq += shx<32>(ssq, ln_); if (fq == 0) atomicAdd(rowss + row, ssq); } }
            asm volatile("" ::: "memory"); }
    }
};
__device__ __forceinline__ void p0_transpose_item(const float* W, int ldw, int K, const float* gain, bf16* WT, int nblk, int item, bool win_map, LAS float* scr, int lane) {
    const int kb = item / nblk, nb = item % nblk, k0 = 64 * kb, n0 = 32 * nb;
    const int np = n0 + (lane & 31); int n = np; bool valid = true;
    if (win_map) { n = win_orig_col(np); valid = n >= 0; if (!valid) n = 0; }
#pragma unroll 8
    for (int i = 0; i < 32; ++i) { const int kk = 2 * i + (lane >> 5); float v = valid ? W[(size_t)(k0 + kk) * ldw + n] : 0.f; if (gain) v *= gain[k0 + kk]; scr[kk * 33 + (lane & 31)] = v; }
    LDS_WAIT(); asm volatile("" ::: "memory");
    const int c = lane & 7;
#pragma unroll
    for (int j = 0; j < 4; ++j) { const int nn = (lane >> 3) + 8 * j; const LAS float* s = scr + (8 * c) * 33 + nn;
        u32x4 o; o.x = pk2(s[0 * 33], s[1 * 33]); o.y = pk2(s[2 * 33], s[3 * 33]); o.z = pk2(s[4 * 33], s[5 * 33]); o.w = pk2(s[6 * 33], s[7 * 33]);
        *(u32x4*)(WT + (size_t)(n0 + nn) * K + k0 + 8 * c) = o; }
    LDS_WAIT(); asm volatile("" ::: "memory");
}
__device__ __forceinline__ void p0_prologue(PK P, const Ctx& C) {
    unsigned char* ws = P->ws;
    LAS float* scr = (LAS float*)(C.lds + C.wave * 16384);
    constexpr int I_IN = 16 * (NZ / 32), I_OR = 8 * 32, I_OUT = 16 * 32, I_PPJ = 4 * 32, I_LAYER = I_IN + 2 * I_OR + 2 * I_OUT + I_PPJ;
    for (int it = C.gw; it < DEPTH * I_LAYER; it += C.ngw) {
        const int L = it / I_LAYER; int r = it % I_LAYER;
        if (r < I_IN) { p0_transpose_item(P->in[I_WIN] + (size_t)L * DM * WIN_N, WIN_N, DM, P->in[I_GAIN] + L * DM, (bf16*)(ws + WS_WIN) + (size_t)L * NZ * DM, NZ / 32, r, true, scr, C.lane); continue; } r -= I_IN;
        if (r < I_OR) { p0_transpose_item(P->in[I_WOR] + (size_t)L * 512 * DM, DM, 512, nullptr, (bf16*)(ws + WS_WOR) + (size_t)L * DM * 512, 32, r, false, scr, C.lane); continue; } r -= I_OR;
        if (r < I_OR) { p0_transpose_item(P->in[I_WOA] + (size_t)L * 512 * DM, DM, 512, nullptr, (bf16*)(ws + WS_WOA) + (size_t)L * DM * 512, 32, r, false, scr, C.lane); continue; } r -= I_OR;
        if (r < I_OUT) { p0_transpose_item(P->in[I_WOUT] + (size_t)L * DM * DM, DM, DM, nullptr, (bf16*)(ws + WS_WOUT) + (size_t)L * DM * DM, 32, r, false, scr, C.lane); continue; } r -= I_OUT;
        if (r < I_OUT) { p0_transpose_item(P->in[I_WPG] + (size_t)L * DM * DM, DM, DM, nullptr, (bf16*)(ws + WS_WPG) + (size_t)L * DM * DM, 32, r, false, scr, C.lane); continue; } r -= I_OUT;
        p0_transpose_item(P->in[I_WPP] + (size_t)L * 256 * DM, DM, 256, nullptr, (bf16*)(ws + WS_WPP) + (size_t)L * DM * 256, 32, r, false, scr, C.lane);
    }
    bf16* XB0 = (bf16*)(ws + WS_XB0); float* rowss0 = (float*)(ws + WS_ROWSS0);
    for (int row = C.gw; row < MT; row += C.ngw) {
        const float* xr = (row < MP) ? P->in[I_XP] + (size_t)row * DM : P->in[I_XS] + (size_t)(row - MP) * DM;
        float ss = 0.f;
#pragma unroll
        for (int j = 0; j < 4; ++j) { const f32x4 v = *(const f32x4*)(xr + 256 * j + 4 * C.lane); ss += (v[0] * v[0] + v[1] * v[1]) + (v[2] * v[2] + v[3] * v[3]);
            u32x2 w; w.x = pk2(v[0], v[1]); w.y = pk2(v[2], v[3]); *(u32x2*)(XB0 + (size_t)row * DM + 256 * j + 4 * C.lane) = w; }
        ss = wave_sum(ss, C.lane);
        if (C.lane == 0) rowss0[row] = ss;
    }
    for (int r = C.gw; r < DEPTH * MT; r += C.ngw) { const int L = r / MT, row = r - L * MT;
        const float* pr = (row < MP) ? P->in[I_PP] + ((size_t)L * MP + row) * 256 : P->in[I_PS] + ((size_t)L * MS + (row - MP)) * 256;
        const f32x4 v = *(const f32x4*)(pr + 4 * C.lane); u32x2 w; w.x = pk2(v[0], v[1]); w.y = pk2(v[2], v[3]); *(u32x2*)((bf16*)(ws + WS_PB) + ((size_t)L * MT + row) * 256 + 4 * C.lane) = w; }
    f32x2* rr = (f32x2*)(ws + WS_ROPER); f32x2* ra = (f32x2*)(ws + WS_ROPEA);
    for (int i = C.blk * NTHREADS + C.tid; i < 4096 * 64; i += C.nblk * NTHREADS) { const int pos = i >> 6, k = i & 63;
        const float fr = expf((-9.210340371976184f * (float)k) / 64.0f), ang = (float)pos * fr; rr[i] = (f32x2){cosf(ang), sinf(ang)}; }
    for (int i = C.blk * NTHREADS + C.tid; i < 4096 * 8; i += C.nblk * NTHREADS) { const int pos = i >> 3, k = i & 7;
        const float fr = expf((-13.122363377404328f * (float)k) / 8.0f), ang = (float)pos * fr; ra[i] = (f32x2){cosf(ang), sinf(ang)}; }
}

constexpr int LDT = 272;
__device__ __forceinline__ void post_ret_tile(PK P, const Ctx& C, int unit) {
    unsigned char* ws = P->ws; const bf16* Z = (const bf16*)(ws + WS_Z);
    const int b = unit >> 7, h = (unit >> 5) & 3, n = unit & 31, t0 = n * 128; const int bh = b * 4 + h;
    LAS unsigned char* TK = C.lds; LAS unsigned char* TV = C.lds + 128 * LDT;
    const f32x2* ropeR = (const f32x2*)(ws + WS_ROPER);
    bf16* RQ = (bf16*)(ws + WS_RQ); bf16* RK = (bf16*)(ws + WS_RK);
    const float lg2 = ret_log2g(h);
#pragma unroll
    for (int u = 0; u < 2; ++u) {
        const int idx = C.tid + 512 * u, r = idx >> 3, j = idx & 7, t = t0 + r; const size_t grow = (size_t)b * SEQ + t;
        float cs[8], sn[8];
#pragma unroll
        for (int e = 0; e < 8; e += 2) { const f32x4 v = *(const f32x4*)(ropeR + (size_t)t * 64 + 8 * j + e); cs[e] = v[0]; sn[e] = v[1]; cs[e + 1] = v[2]; sn[e + 1] = v[3]; }
        { float x1[8], x2[8], o1[8], o2[8]; unpack8(*(const u32x4*)(Z + grow * NZ + ZC_RQ + h * 128 + 8 * j), x1); unpack8(*(const u32x4*)(Z + grow * NZ + ZC_RQ + h * 128 + 64 + 8 * j), x2);
#pragma unroll
          for (int e = 0; e < 8; ++e) { o1[e] = x1[e] * cs[e] - x2[e] * sn[e]; o2[e] = x2[e] * cs[e] + x1[e] * sn[e]; }
          *(u32x4*)(RQ + grow * 512 + h * 128 + 8 * j) = pack8(o1); *(u32x4*)(RQ + grow * 512 + h * 128 + 64 + 8 * j) = pack8(o2); }
        { float x1[8], x2[8], o1[8], o2[8]; unpack8(*(const u32x4*)(Z + grow * NZ + ZC_RK + h * 128 + 8 * j), x1); unpack8(*(const u32x4*)(Z + grow * NZ + ZC_RK + h * 128 + 64 + 8 * j), x2);
          const float sc = 0.08838834764831845f, dk = __builtin_amdgcn_exp2f((float)(127 - r) * lg2);
#pragma unroll
          for (int e = 0; e < 8; ++e) { o1[e] = (x1[e] * cs[e] - x2[e] * sn[e]) * sc; o2[e] = (x2[e] * cs[e] + x1[e] * sn[e]) * sc; }
          *(u32x4*)(RK + grow * 512 + h * 128 + 8 * j) = pack8(o1); *(u32x4*)(RK + grow * 512 + h * 128 + 64 + 8 * j) = pack8(o2);
#pragma unroll
          for (int e = 0; e < 8; ++e) { *(LAS bf16*)(TK + (8 * j + e) * LDT + 2 * r) = (bf16)(pk2(o1[e] * dk, 0.f) & 0xffffu); *(LAS bf16*)(TK + (64 + 8 * j + e) * LDT + 2 * r) = (bf16)(pk2(o2[e] * dk, 0.f) & 0xffffu); } }
    }
#pragma unroll
    for (int u = 0; u < 4; ++u) {
        const int idx = C.tid + 512 * u, r = idx >> 4, c = idx & 15; const size_t grow = (size_t)b * SEQ + t0 + r;
        const u32x4 w = *(const u32x4*)(Z + grow * NZ + ZC_RV + h * 128 + 8 * c);
        const unsigned ww[4] = {w.x, w.y, w.z, w.w};
#pragma unroll
        for (int e = 0; e < 4; ++e) { *(LAS bf16*)(TV + (8 * c + 2 * e) * LDT + 2 * r) = (bf16)(ww[e] & 0xffffu); *(LAS bf16*)(TV + (8 * c + 2 * e + 1) * LDT + 2 * r) = (bf16)(ww[e] >> 16); }
    }
    __syncthreads();
    bf16* RKT = (bf16*)(ws + WS_RKT); bf16* RVT = (bf16*)(ws + WS_RVT);
#pragma unroll
    for (int u = 0; u < 4; ++u) {
        const int idx = C.tid + 512 * u, d = idx >> 4, c = idx & 15;
        const u32x4 a = *(const LAS u32x4*)(TK + d * LDT + 16 * c), v = *(const LAS u32x4*)(TV + d * LDT + 16 * c);
        *(u32x4*)(RKT + ((size_t)bh * 128 + d) * SEQ + t0 + 8 * c) = a; *(u32x4*)(RVT + ((size_t)bh * 128 + d) * SEQ + t0 + 8 * c) = v;
    }
    __syncthreads();
}
__device__ __forceinline__ void post_token(PK P, const Ctx& C, int L, int row) {
    unsigned char* ws = P->ws; const bf16* Zr = (const bf16*)(ws + WS_Z) + (size_t)row * NZ; const int lane = C.lane;
    const bool prompt = row < MP; const int sb = (row - MP) >> 3, sc = (row - MP) & 7;
    const int pos = prompt ? (row & (SEQ - 1)) : PAST + sc;
    const f32x2* ropeA = (const f32x2*)(ws + WS_ROPEA) + (size_t)pos * 8;
    const int c8 = lane & 7;
    float cs[8], sn[8];
#pragma unroll
    for (int e = 0; e < 8; e += 2) { const f32x4 v = *(const f32x4*)(ropeA + e); cs[e] = v[0]; sn[e] = v[1]; cs[e + 1] = v[2]; sn[e + 1] = v[3]; }
    { float x[8]; unpack8(*(const u32x4*)(Zr + ZC_AQ + 8 * lane), x);
      float ss = 0.f;
#pragma unroll
      for (int e = 0; e < 8; ++e) ss += x[e] * x[e];
      ss += shx<1>(ss, lane); ss += shx<2>(ss, lane); ss += shx<4>(ss, lane);
      const float rs = __builtin_amdgcn_rsqf(ss * (1.0f / 64.0f) + 1e-6f);
      const float* qg = P->in[I_QG] + L * 64 + 8 * c8; float o[8];
#pragma unroll
      for (int e = 0; e < 8; ++e) { const float y = x[e] * rs * qg[e]; const float pr = shx<1>(y, lane); o[e] = (c8 == 0) ? y * cs[e] - pr * sn[e] : (c8 == 1) ? y * cs[e] + pr * sn[e] : y; }
      *(u32x4*)((bf16*)(ws + WS_AQ) + (size_t)row * 512 + 8 * lane) = pack8(o); }
    { float x[8]; unpack8(*(const u32x4*)(Zr + ZC_AK + 8 * (lane & 31)), x);
      float ss = 0.f;
#pragma unroll
      for (int e = 0; e < 8; ++e) ss += x[e] * x[e];
      ss += shx<1>(ss, lane); ss += shx<2>(ss, lane); ss += shx<4>(ss, lane);
      const float rs = __builtin_amdgcn_rsqf(ss * (1.0f / 64.0f) + 1e-6f);
      const float* kg = P->in[I_KG] + L * 64 + 8 * c8; float o[8]; const bool isk = (lane & 31) < 16;
#pragma unroll
      for (int e = 0; e < 8; ++e) { const float y = isk ? x[e] * rs * kg[e] : x[e]; const float pr = shx<1>(y, lane); o[e] = (isk && c8 == 0) ? y * cs[e] - pr * sn[e] : (isk && c8 == 1) ? y * cs[e] + pr * sn[e] : y; }
      if (lane < 32) {
          const int l16 = lane & 15;
          float* dst = isk ? (prompt ? P->out + O_KP + ((size_t)L * MP + row) * 128 : P->out + O_KS + ((size_t)L * MS + (row - MP)) * 128)
                           : (prompt ? P->out + O_VP + ((size_t)L * MP + row) * 128 : P->out + O_VS + ((size_t)L * MS + (row - MP)) * 128);
          *(f32x4*)(dst + 8 * l16) = (f32x4){o[0], o[1], o[2], o[3]}; *(f32x4*)(dst + 8 * l16 + 4) = (f32x4){o[4], o[5], o[6], o[7]};
          if (prompt) { bf16* d2 = (bf16*)(ws + (isk ? WS_KB : WS_VB)) + (size_t)row * 128 + 8 * l16; *(u32x4*)d2 = pack8(o); } } }
    { const int l40 = lane < 40 ? lane : 39; float x[8]; unpack8(*(const u32x4*)(Zr + ZC_IQ + 8 * l40), x); float o[8];
#pragma unroll
      for (int e = 0; e < 8; ++e) { const float y = x[e]; const float pr = shx<1>(y, lane); o[e] = (c8 == 0) ? y * cs[e] - pr * sn[e] : (c8 == 1) ? y * cs[e] + pr * sn[e] : y; }
      if (lane < 32) *(u32x4*)((bf16*)(ws + WS_IQ) + (size_t)row * 256 + 8 * lane) = pack8(o);
      else if (lane < 40) { const int l8 = lane - 32;
          float* dst = prompt ? P->out + O_IKP + ((size_t)L * MP + row) * 64 : P->out + O_IKS + ((size_t)L * MS + (row - MP)) * 64;
          *(f32x4*)(dst + 8 * l8) = (f32x4){o[0], o[1], o[2], o[3]}; *(f32x4*)(dst + 8 * l8 + 4) = (f32x4){o[4], o[5], o[6], o[7]};
          if (prompt) *(u32x4*)((bf16*)(ws + WS_IKB) + (size_t)row * 64 + 8 * l8) = pack8(o); } }
    if (lane < 4) ((float*)(ws + WS_IW))[(size_t)row * 4 + lane] = bf2f(Zr[ZC_IW + lane]) * 0.0625f;
    { const float* pr = prompt ? P->in[I_PP] + ((size_t)L * MP + row) * 256 : P->in[I_PS] + ((size_t)L * MS + (row - MP)) * 256;
      const f32x4 v = *(const f32x4*)(pr + 4 * lane); u32x2 w; w.x = pk2(v[0], v[1]); w.y = pk2(v[2], v[3]); *(u32x2*)((bf16*)(ws + WS_PB) + (size_t)row * 256 + 4 * lane) = w; }
    (void)sb;
}
__device__ __forceinline__ void phase_post(PK P, const Ctx& C, int L) {
    for (int u = C.blk; u < 512; u += C.nblk) post_ret_tile(P, C, u);
    for (int row = C.gw; row < MT; row += 2 * C.ngw) { post_token(P, C, L, row); if (row + C.ngw < MT) post_token(P, C, L, row + C.ngw); }
}

__device__ __forceinline__ void ret_state_item(PK P, const Ctx& C, int L, int item) {
    unsigned char* ws = P->ws; const bf16* RKT = (const bf16*)(ws + WS_RKT); const bf16* RVT = (const bf16*)(ws + WS_RVT); bf16* ST = (bf16*)(ws + WS_ST);
    const int bh = item >> 6, et = (item >> 3) & 7, dt = item & 7, lane = C.lane, r16 = lane & 15, g = lane >> 4;
    const float dec = __builtin_amdgcn_exp2f(128.0f * ret_log2g(bh & 3));
    LAS unsigned char* img = C.lds + 36864 + (C.wave & 3) * 8704;
    const int tq = lane >> 4, c16 = lane & 15;
    const bf16* vp = RVT + ((size_t)bh * 128 + 16 * et + tq) * SEQ + 8 * c16;
    const bf16* kp = RKT + ((size_t)bh * 128 + 16 * dt + tq) * SEQ + 8 * c16;
    f32x4 S = {0.f, 0.f, 0.f, 0.f};
    u32x4 rv[2][2][4], rk[2][2][4];
#define RS_LOAD(buf_, n0_) do { _Pragma("unroll") for (int i = 0; i < 2; ++i) _Pragma("unroll") for (int q = 0; q < 4; ++q) { \
        rv[buf_][i][q] = *(const u32x4*)(vp + (size_t)(4 * q) * SEQ + ((n0_) + i) * 128); rk[buf_][i][q] = *(const u32x4*)(kp + (size_t)(4 * q) * SEQ + ((n0_) + i) * 128); } } while (0)
#define RS_CHUNK(buf_, i_, n_, refill_) do { \
        _Pragma("unroll") for (int q = 0; q < 4; ++q) { *(LAS u32x4*)(img + (tq + 4 * q) * 272 + 16 * c16) = rv[buf_][i_][q]; *(LAS u32x4*)(img + (16 + tq + 4 * q) * 272 + 16 * c16) = rk[buf_][i_][q]; } \
        refill_; \
        LDS_WAIT(); asm volatile("" ::: "memory"); \
        f32x4 acc = {0.f, 0.f, 0.f, 0.f}; \
        _Pragma("unroll") for (int kk = 0; kk < 4; ++kk) { const bf16x8 a = *(const LAS bf16x8*)(img + r16 * 272 + 64 * kk + 16 * g), b = *(const LAS bf16x8*)(img + (16 + r16) * 272 + 64 * kk + 16 * g); acc = mfma16(a, b, acc); } \
        LDS_WAIT(); asm volatile("" ::: "memory"); \
        bf16* st = ST + (((size_t)bh * 32 + (n_)) * 128 + 16 * et + 4 * g) * 128 + 16 * dt + r16; \
        _Pragma("unroll") for (int r = 0; r < 4; ++r) st[r * 128] = (bf16)(pk2(S[r], 0.f) & 0xffffu); \
        S = S * dec + acc; } while (0)
    RS_LOAD(0, 0); RS_LOAD(1, 2);
    asm volatile("" ::: "memory");
#pragma unroll 1
    for (int n0 = 0; n0 < 32; n0 += 4) {
        RS_CHUNK(0, 0, n0, (void)0);
        RS_CHUNK(0, 1, n0 + 1, if (n0 + 4 < 32) RS_LOAD(0, n0 + 4));
        RS_CHUNK(1, 0, n0 + 2, (void)0);
        RS_CHUNK(1, 1, n0 + 3, if (n0 + 6 < 32) RS_LOAD(1, n0 + 6));
        asm volatile("" : "+v"(S));
    }
#undef RS_LOAD
#undef RS_CHUNK
    float* o = P->out + O_RSP + ((size_t)L * 16 + bh) * 16384 + (size_t)(16 * dt + r16) * 128 + 16 * et + 4 * g;
    *(f32x4*)o = S;
}
__device__ __forceinline__ void ret_sample_unit(PK P, const Ctx& C, int L, int unit) {
    unsigned char* ws = P->ws; const bf16* Z = (const bf16*)(ws + WS_Z);
    const int b = unit >> 2, h = unit & 3, tid = C.tid; const int r0 = MP + b * 8;
    LAS float* q = (LAS float*)C.lds;
    LAS float* kp = q + 1024;
    LAS float* v = kp + 1024;
    LAS float* rz = v + 1024;
    LAS float* A = rz + 1024;
    LAS float* op = A + 64;
    const float lg2 = ret_log2g(h);
    { const int c = tid >> 6, i = tid & 63; const size_t row = (size_t)(r0 + c);
      const f32x2 cs = ((const f32x2*)(ws + WS_ROPER))[(size_t)(PAST + c) * 64 + i];
      const float q1 = bf2f(Z[row * NZ + ZC_RQ + h * 128 + i]), q2 = bf2f(Z[row * NZ + ZC_RQ + h * 128 + 64 + i]);
      q[i * 8 + c] = q1 * cs[0] - q2 * cs[1]; q[(64 + i) * 8 + c] = q2 * cs[0] + q1 * cs[1];
      const float k1 = bf2f(Z[row * NZ + ZC_RK + h * 128 + i]), k2 = bf2f(Z[row * NZ + ZC_RK + h * 128 + 64 + i]);
      const float ks = 0.08838834764831845f * __builtin_amdgcn_exp2f((float)(7 - c) * lg2);
      kp[i * 8 + c] = (k1 * cs[0] - k2 * cs[1]) * ks; kp[(64 + i) * 8 + c] = (k2 * cs[0] + k1 * cs[1]) * ks;
      v[c * 128 + i] = bf2f(Z[row * NZ + ZC_RV + h * 128 + i]); v[c * 128 + 64 + i] = bf2f(Z[row * NZ + ZC_RV + h * 128 + 64 + i]);
      rz[c * 128 + i] = bf2f(Z[row * NZ + ZC_RZ + h * 128 + i]); rz[c * 128 + 64 + i] = bf2f(Z[row * NZ + ZC_RZ + h * 128 + 64 + i]); }
    __syncthreads();
    { const int pr = tid >> 3, part = tid & 7, c = pr >> 3, s2 = pr & 7; float d = 0.f;
#pragma unroll
      for (int dd = 0; dd < 16; ++dd) d += q[(part * 16 + dd) * 8 + c] * kp[(part * 16 + dd) * 8 + s2];
      d += shx<1>(d, tid & 63); d += shx<2>(d, tid & 63); d += shx<4>(d, tid & 63);
      if (part == 0) A[pr] = (s2 <= c) ? d * __builtin_amdgcn_exp2f((float)(c - 7) * lg2) : 0.f; }
    { const int dq = tid >> 7, e = tid & 127; float vr[8], acc[8];
#pragma unroll
      for (int c = 0; c < 8; ++c) { vr[c] = v[c * 128 + e]; acc[c] = 0.f; }
      const float g8 = __builtin_amdgcn_exp2f(8.0f * lg2);
      const float* S0 = P->in[I_STATE] + (((size_t)L * DB + b) * 4 + h) * 16384; float* S1 = P->out + O_RSS + (((size_t)L * DB + b) * 4 + h) * 16384;
      float s0v[32];
#pragma unroll
      for (int dd = 0; dd < 32; ++dd) s0v[dd] = S0[(dq * 32 + dd) * 128 + e];
#pragma unroll
      for (int dd = 0; dd < 32; ++dd) { const int d = dq * 32 + dd; const float s0 = s0v[dd];
          const f32x4 qa = *(const LAS f32x4*)(q + d * 8), qb = *(const LAS f32x4*)(q + d * 8 + 4), ka = *(const LAS f32x4*)(kp + d * 8), kb = *(const LAS f32x4*)(kp + d * 8 + 4);
          float sn = s0 * g8;
#pragma unroll
          for (int c = 0; c < 4; ++c) { acc[c] += qa[c] * s0; acc[4 + c] += qb[c] * s0; sn += ka[c] * vr[c]; sn += kb[c] * vr[4 + c]; }
          S1[d * 128 + e] = sn; }
#pragma unroll
      for (int c = 0; c < 8; ++c) op[(dq * 8 + c) * 128 + e] = acc[c]; }
    __syncthreads();
    { const int c = tid >> 6, i = tid & 63; float o[2]; const float gq = __builtin_amdgcn_exp2f((float)(c + 1) * lg2);
#pragma unroll
      for (int u = 0; u < 2; ++u) { const int e = i + 64 * u; float s = (op[(0 * 8 + c) * 128 + e] + op[(1 * 8 + c) * 128 + e]) + (op[(2 * 8 + c) * 128 + e] + op[(3 * 8 + c) * 128 + e]); s *= gq;
          for (int sidx = 0; sidx <= c; ++sidx) s += A[c * 8 + sidx] * v[sidx * 128 + e];
          o[u] = s; }
      float sm = o[0] + o[1];
      sm = wave_sum(sm, i);
      const float mu = sm * (1.0f / 128.0f); float qv = (o[0] - mu) * (o[0] - mu) + (o[1] - mu) * (o[1] - mu);
      qv = wave_sum(qv, i);
      const float rstd = __builtin_amdgcn_rsqf(qv * (1.0f / 128.0f) + 1e-5f);
      bf16* og = (bf16*)(ws + WS_OGR) + (size_t)(r0 + c) * 512 + h * 128;
#pragma unroll
      for (int u = 0; u < 2; ++u) { const int e = i + 64 * u; og[e] = (bf16)(pk2((o[u] - mu) * rstd * siluf_(rz[c * 128 + e]), 0.f) & 0xffffu); } }
    __syncthreads();
}
template <bool SAMPLE>
__device__ __forceinline__ void score_item(PK P, const Ctx& C, int L, int b, int qblk, int kc) {
    constexpr int QG = SAMPLE ? 1 : 2;
    constexpr int TG = SAMPLE ? 4 : 5;
    unsigned char* ws = P->ws; const int lane = C.lane, r32 = lane & 31, hf = lane >> 5;
    const bf16* IQ = (const bf16*)(ws + WS_IQ); const float* IW = (const float*)(ws + WS_IW);
    const int q0 = SAMPLE ? 0 : qblk * 16;
    const size_t rowbase = SAMPLE ? (size_t)MP + b * 8 : (size_t)b * SEQ + q0;
    bf16x8 af[QG][4]; f32x4 wv[QG][4];
#pragma unroll
    for (int gq = 0; gq < QG; ++gq) {
#pragma unroll
        for (int s = 0; s < 4; ++s) af[gq][s] = *(const bf16x8*)(IQ + (rowbase + 8 * gq + (r32 >> 2)) * 256 + (r32 & 3) * 64 + 16 * s + 8 * hf);
#pragma unroll
        for (int i = 0; i < 4; ++i) wv[gq][i] = *(const f32x4*)(IW + (rowbase + 8 * gq + 2 * i + hf) * 4); }
    const int nkeys = SAMPLE ? PAST + DS : q0 + 16;
    const int kt_end = min(kc * 16 + 16, (nkeys + 31) >> 5);
    const int* pt = (const int*)P->in[I_PT] + b * NPAGES;
    const float* cik = P->in[I_CIK] + (size_t)L * NPOOL * 128 * 64; const float* nik = P->out + O_IKS + ((size_t)L * DB + b) * DS * 64;
    const bf16* ikb = (const bf16*)(ws + WS_IKB) + (size_t)b * SEQ * 64;
    u32x4 cur[TG][SAMPLE ? 8 : 4];
    auto load_group = [&](int kt0, u32x4 (&dst)[TG][SAMPLE ? 8 : 4]) {
#pragma unroll
        for (int j = 0; j < TG; ++j) { const int kt = min(kt0 + j, kt_end - 1); const int key = kt * 32 + r32;
            if (SAMPLE) { const int kcl = key < PAST + DS ? key : PAST + DS - 1;
                const float* kr = (kcl < PAST) ? cik + ((size_t)pt[(kt >> 2) & 15] * 128 + (kcl & 127)) * 64 : nik + (size_t)(kcl - PAST) * 64;
#pragma unroll
                for (int s = 0; s < 4; ++s) { dst[j][2 * s] = *(const u32x4*)(kr + 16 * s + 8 * hf); dst[j][2 * s + 1] = *(const u32x4*)(kr + 16 * s + 8 * hf + 4); }
            } else { const bf16* kr = ikb + (size_t)key * 64;
#pragma unroll
                for (int s = 0; s < 4; ++s) dst[j][s] = *(const u32x4*)(kr + 16 * s + 8 * hf); } }
    };
    for (int kt0 = kc * 16; kt0 < kt_end; kt0 += TG) {
        load_group(kt0, cur);
#pragma unroll
        for (int j = 0; j < TG; ++j) { const int kt = kt0 + j;
            if (kt < kt_end) {
                const int key = kt * 32 + r32;
                bf16x8 bfr[4];
#pragma unroll
                for (int s = 0; s < 4; ++s) {
                    if (SAMPLE) { const f32x4 a = __builtin_bit_cast(f32x4, cur[j][2 * s]), c = __builtin_bit_cast(f32x4, cur[j][2 * s + 1]);
                        u32x4 w; w.x = pk2(a[0], a[1]); w.y = pk2(a[2], a[3]); w.z = pk2(c[0], c[1]); w.w = pk2(c[2], c[3]); bfr[s] = as_bf16x8(w); }
                    else bfr[s] = as_bf16x8(cur[j][s]); }
#pragma unroll
                for (int gq = 0; gq < QG; ++gq) {
                    f32x16 acc;
#pragma unroll
                    for (int i = 0; i < 16; ++i) acc[i] = 0.f;
#pragma unroll
                    for (int s = 0; s < 4; ++s) acc = mfma32(af[gq][s], bfr[s], acc);
                    float sc[4];
#pragma unroll
                    for (int i = 0; i < 4; ++i) {
                        float v = fmaxf(acc[4 * i + 0], 0.f) * wv[gq][i][0]; v += fmaxf(acc[4 * i + 1], 0.f) * wv[gq][i][1]; v += fmaxf(acc[4 * i + 2], 0.f) * wv[gq][i][2]; v += fmaxf(acc[4 * i + 3], 0.f) * wv[gq][i][3];
                        sc[i] = v + 0.0f; }
                    const bool odd = (lane & 1) != 0;
#pragma unroll
                    for (int i = 0; i < 4; i += 2) {
                        const float snd = odd ? sc[i] : sc[i + 1], rcv = shx<1>(snd, lane);
                        const float lo = odd ? rcv : sc[i], hi = odd ? sc[i + 1] : rcv;
                        const unsigned w = (unsigned)__builtin_bit_cast(unsigned short, (_Float16)lo) | ((unsigned)__builtin_bit_cast(unsigned short, (_Float16)hi) << 16);
                        const int ql = 8 * gq + 2 * (odd ? i + 1 : i) + hf, k0 = key & ~1;
                        if (SAMPLE) { if (k0 < PAST + DS) *(unsigned*)((unsigned short*)(ws + WS_SS) + ((size_t)b * 8 + ql) * SS_LD + k0) = w; }
                        else *(unsigned*)((unsigned short*)(ws + WS_SP) + ((size_t)b * SEQ + q0 + ql) * SEQ + k0) = w;
                    }
                }
            }
        }
        asm volatile("" ::: "memory");
    }
}
__device__ __forceinline__ void score_item_dma(PK P, const Ctx& C, int L, int b, int qblk, int kc, LAS unsigned char* img) {
    constexpr int QG = 2, TG = 4;
    unsigned char* ws = P->ws; const int lane = C.lane, r32 = lane & 31, hf = lane >> 5;
    const bf16* IQ = (const bf16*)(ws + WS_IQ); const float* IW = (const float*)(ws + WS_IW);
    const int q0 = qblk * 16;
    const size_t rowbase = (size_t)b * SEQ + q0;
    bf16x8 af[QG][4]; f32x4 wv[QG][4];
#pragma unroll
    for (int gq = 0; gq < QG; ++gq) {
#pragma unroll
        for (int s = 0; s < 4; ++s) af[gq][s] = *(const bf16x8*)(IQ + (rowbase + 8 * gq + (r32 >> 2)) * 256 + (r32 & 3) * 64 + 16 * s + 8 * hf);
#pragma unroll
        for (int i = 0; i < 4; ++i) wv[gq][i] = *(const f32x4*)(IW + (rowbase + 8 * gq + 2 * i + hf) * 4); }
    const int kt_end = min(kc * 16 + 16, (q0 + 16 + 31) >> 5);
    const unsigned char* ikb = ws + WS_IKB + (size_t)b * SEQ * 128;
    int voff[4], roff[4];
#pragma unroll
    for (int i = 0; i < 4; ++i) { voff[i] = (8 * i + (lane >> 3)) * 128 + 16 * ((lane & 7) ^ ((4 * i + (lane >> 4)) & 7)); roff[i] = r32 * 128 + 16 * ((2 * i + hf) ^ ((r32 >> 1) & 7)); }
#define SC_ISSUE(kt0_) do { _Pragma("unroll") for (int j = 0; j < TG; ++j) { const int kt_ = min((kt0_) + j, kt_end - 1); _Pragma("unroll") for (int i = 0; i < 4; ++i) \
        __builtin_amdgcn_global_load_lds((const unsigned*)(ikb + (size_t)kt_ * 4096 + voff[i]), (LAS unsigned*)(img + j * 4096 + i * 1024), 16, 0, 0); } } while (0)
    SC_ISSUE(kc * 16);
    for (int kt0 = kc * 16; kt0 < kt_end; kt0 += TG) {
        asm volatile("s_waitcnt vmcnt(0)" ::: "memory");
        u32x4 cur[TG][4];
#pragma unroll
        for (int j = 0; j < TG; ++j) {
#pragma unroll
            for (int s = 0; s < 4; ++s) cur[j][s] = *(const LAS u32x4*)(img + j * 4096 + roff[s]); }
        asm volatile("s_waitcnt lgkmcnt(0)" ::: "memory");
        if (kt0 + TG < kt_end) SC_ISSUE(kt0 + TG);
        asm volatile("" ::: "memory");
#pragma unroll
        for (int j = 0; j < TG; ++j) { const int kt = kt0 + j;
            if (kt < kt_end) {
                const int key = kt * 32 + r32;
#pragma unroll
                for (int gq = 0; gq < QG; ++gq) {
                    f32x16 acc;
#pragma unroll
                    for (int i = 0; i < 16; ++i) acc[i] = 0.f;
#pragma unroll
                    for (int s = 0; s < 4; ++s) acc = mfma32(af[gq][s], as_bf16x8(cur[j][s]), acc);
                    float sc[4];
#pragma unroll
                    for (int i = 0; i < 4; ++i) {
                        float v = fmaxf(acc[4 * i + 0], 0.f) * wv[gq][i][0]; v += fmaxf(acc[4 * i + 1], 0.f) * wv[gq][i][1]; v += fmaxf(acc[4 * i + 2], 0.f) * wv[gq][i][2]; v += fmaxf(acc[4 * i + 3], 0.f) * wv[gq][i][3];
                        sc[i] = v + 0.0f; }
                    const bool odd = (lane & 1) != 0;
#pragma unroll
                    for (int i = 0; i < 4; i += 2) {
                        const float snd = odd ? sc[i] : sc[i + 1], rcv = shx<1>(snd, lane);
                        const float lo = odd ? rcv : sc[i], hi = odd ? sc[i + 1] : rcv;
                        const unsigned w = (unsigned)__builtin_bit_cast(unsigned short, (_Float16)lo) | ((unsigned)__builtin_bit_cast(unsigned short, (_Float16)hi) << 16);
                        const int ql = 8 * gq + 2 * (odd ? i + 1 : i) + hf, k0 = key & ~1;
                        *(unsigned*)((unsigned short*)(ws + WS_SP) + ((size_t)b * SEQ + q0 + ql) * SEQ + k0) = w;
                    }
                }
            }
        }
        asm volatile("" ::: "memory");
    }
#undef SC_ISSUE
}
__device__ __forceinline__ void score_item_sdma(PK P, const Ctx& C, int L, int b, int kc, LAS unsigned char* img) {
    constexpr int TG = 2;
    unsigned char* ws = P->ws; const int lane = C.lane, r32 = lane & 31, hf = lane >> 5;
    const bf16* IQ = (const bf16*)(ws + WS_IQ); const float* IW = (const float*)(ws + WS_IW);
    const size_t rowbase = (size_t)MP + b * 8;
    bf16x8 af[4]; f32x4 wv[4];
#pragma unroll
    for (int s = 0; s < 4; ++s) af[s] = *(const bf16x8*)(IQ + (rowbase + (r32 >> 2)) * 256 + (r32 & 3) * 64 + 16 * s + 8 * hf);
#pragma unroll
    for (int i = 0; i < 4; ++i) wv[i] = *(const f32x4*)(IW + (rowbase + 2 * i + hf) * 4);
    const int kt_end = min(kc * 16 + 16, (PAST + DS + 31) >> 5);
    const int* pt = (const int*)P->in[I_PT] + b * NPAGES;
    const float* cik = P->in[I_CIK] + (size_t)L * NPOOL * 128 * 64; const float* nik = P->out + O_IKS + ((size_t)L * DB + b) * DS * 64;
    const int dr = lane >> 4, dq = lane & 15;
#define SS_ISSUE(kt0_) do { _Pragma("unroll") for (int j = 0; j < TG; ++j) { const int kt_ = min((kt0_) + j, kt_end - 1); const float* pg_ = cik + ((size_t)pt[(kt_ >> 2) & 15] * 128 + (kt_ & 3) * 32) * 64; \
        _Pragma("unroll") for (int i = 0; i < 8; ++i) { const int row_ = 4 * i + dr, key_ = kt_ * 32 + row_, kcl_ = key_ < PAST + DS ? key_ : PAST + DS - 1; \
            const float* src_ = (kcl_ < PAST ? pg_ + row_ * 64 : nik + (kcl_ - PAST) * 64) + 4 * (dq ^ (row_ & 15)); \
            __builtin_amdgcn_global_load_lds((const unsigned*)src_, (LAS unsigned*)(img + j * 8192 + i * 1024), 16, 0, 0); } } } while (0)
    SS_ISSUE(kc * 16);
    for (int kt0 = kc * 16; kt0 < kt_end; kt0 += TG) {
        asm volatile("s_waitcnt vmcnt(0)" ::: "memory");
        u32x4 cur[TG][8];
#pragma unroll
        for (int j = 0; j < TG; ++j) {
#pragma unroll
            for (int s = 0; s < 8; ++s) cur[j][s] = *(const LAS u32x4*)(img + j * 8192 + r32 * 256 + 16 * ((4 * (s >> 1) + 2 * hf + (s & 1)) ^ (r32 & 15))); }
        asm volatile("s_waitcnt lgkmcnt(0)" ::: "memory");
        if (kt0 + TG < kt_end) SS_ISSUE(kt0 + TG);
        asm volatile("" ::: "memory");
#pragma unroll
        for (int j = 0; j < TG; ++j) { const int kt = kt0 + j;
            if (kt < kt_end) {
                const int key = kt * 32 + r32;
                f32x16 acc;
#pragma unroll
                for (int i = 0; i < 16; ++i) acc[i] = 0.f;
#pragma unroll
                for (int s = 0; s < 4; ++s) { const f32x4 a = __builtin_bit_cast(f32x4, cur[j][2 * s]), c = __builtin_bit_cast(f32x4, cur[j][2 * s + 1]);
                    u32x4 w; w.x = pk2(a[0], a[1]); w.y = pk2(a[2], a[3]); w.z = pk2(c[0], c[1]); w.w = pk2(c[2], c[3]);
                    acc = mfma32(af[s], as_bf16x8(w), acc); }
                float sc[4];
#pragma unroll
                for (int i = 0; i < 4; ++i) {
                    float v = fmaxf(acc[4 * i + 0], 0.f) * wv[i][0]; v += fmaxf(acc[4 * i + 1], 0.f) * wv[i][1]; v += fmaxf(acc[4 * i + 2], 0.f) * wv[i][2]; v += fmaxf(acc[4 * i + 3], 0.f) * wv[i][3];
                    sc[i] = v + 0.0f; }
                const bool odd = (lane & 1) != 0;
#pragma unroll
                for (int i = 0; i < 4; i += 2) {
                    const float snd = odd ? sc[i] : sc[i + 1], rcv = shx<1>(snd, lane);
                    const float lo = odd ? rcv : sc[i], hi = odd ? sc[i + 1] : rcv;
                    const unsigned w = (unsigned)__builtin_bit_cast(unsigned short, (_Float16)lo) | ((unsigned)__builtin_bit_cast(unsigned short, (_Float16)hi) << 16);
                    const int ql = 2 * (odd ? i + 1 : i) + hf, k0 = key & ~1;
                    if (k0 < PAST + DS) *(unsigned*)((unsigned short*)(ws + WS_SS) + ((size_t)b * 8 + ql) * SS_LD + k0) = w;
                }
            }
        }
        asm volatile("" ::: "memory");
    }
#undef SS_ISSUE
}
__device__ __forceinline__ void phase_c(PK P, const Ctx& C, int L, int sel = 15) {
    LAS unsigned char* imgw = C.lds + C.wave * 16384;
    if (C.nblk == 256) {
        const int q1 = C.blk & 127, n1 = q1 / 32 + 1;
        if (C.wave < 4) { if (sel & 1) for (int it = C.blk * 4 + C.wave; it < 1024; it += C.nblk * 4) ret_state_item(P, C, L, it); }
        else { const int k = C.wave & 3, f = (C.blk >> 7) * 4 + k; LAS unsigned char* imgf = C.lds + (k < 3 ? 71680 + k * 16384 : XPOSE_OFF);
            if ((sel & 8) && f < 5) score_item_sdma(P, C, L, q1, f, imgf);
            if ((sel & 4) && f >= 4) { const int j = f == 4 ? 35 : 27 + f; const int b = j / 9, c = j - 9 * b; if (c < n1) score_item_dma(P, C, L, b, q1, c, imgf); else score_item_dma(P, C, L, b, 255 - q1, c - n1, imgf); } }
        if (sel & 2) for (int u = C.blk; u < 512; u += C.nblk) ret_sample_unit(P, C, L, u);
        if (sel & 4) { const int wp = (C.blk >> 7) * NWAVES + C.wave;
            for (int j = wp; j < 32; j += 16) { const int b = j / 9, c = j - 9 * b; if (c < n1) score_item_dma(P, C, L, b, q1, c, imgw); else score_item_dma(P, C, L, b, 255 - q1, c - n1, imgw); } }
    } else {
        if ((sel & 1) && C.wave < 4) for (int it = C.blk * 4 + C.wave; it < 1024; it += C.nblk * 4) ret_state_item(P, C, L, it);
        if (sel & 2) for (int u = C.blk; u < 512; u += C.nblk) ret_sample_unit(P, C, L, u);
        if (sel & 4) for (int it = C.gw; it < NB * 256 * 8; it += C.ngw) { const int kc = it & 7, qb = (it >> 3) & 255, b = it >> 11; if (kc * 512 <= qb * 16 + 15) score_item_dma(P, C, L, b, qb, kc, imgw); }
        if ((sel & 8) && C.wave >= 4) for (int it = C.blk * 4 + (C.wave & 3); it < DB * 5; it += C.nblk * 4) score_item_sdma(P, C, L, it / 5, it % 5, imgw);
    }
}

__device__ __forceinline__ void ret_scan_item(PK P, const Ctx& C, int L, int item) {
    unsigned char* ws = P->ws; const float* KVT = (const float*)(ws + WS_KVT); bf16* ST = (bf16*)(ws + WS_ST);
    const int e0 = item * 1024 + C.tid * 2, bh = e0 >> 14, rem = e0 & 16383, h = bh & 3;
    const float dec = __builtin_amdgcn_exp2f(128.0f * ret_log2g(h));
    float s0 = 0.f, s1 = 0.f;
#pragma unroll 8
    for (int n = 0; n < 32; ++n) { const f32x2 kv = *(const f32x2*)(KVT + ((size_t)bh * 32 + n) * 16384 + rem);
        *(unsigned*)(ST + ((size_t)bh * 32 + n) * 16384 + rem) = pk2(s0, s1); s0 = s0 * dec + kv[0]; s1 = s1 * dec + kv[1]; }
    const int e = rem >> 7, d = rem & 127;
    float* o = P->out + O_RSP + ((size_t)L * 16 + bh) * 16384; o[d * 128 + e] = s0; o[(d + 1) * 128 + e] = s1;
}
template <int G>
__device__ __forceinline__ void cnt_ge4(const unsigned (&kp)[32], unsigned cm1, unsigned& c0, unsigned& c1) {
    unsigned t0, t1, t2, t3;
    asm("v_pk_sub_u16 %2, %6, %10 clamp\n\tv_pk_sub_u16 %3, %7, %10 clamp\n\tv_pk_sub_u16 %4, %8, %10 clamp\n\tv_pk_sub_u16 %5, %9, %10 clamp\n\t"
        "v_pk_min_u16 %2, %2, %11\n\tv_pk_min_u16 %3, %3, %11\n\tv_pk_min_u16 %4, %4, %11\n\tv_pk_min_u16 %5, %5, %11\n\t"
        "v_pk_add_u16 %0, %0, %2\n\tv_pk_add_u16 %1, %1, %3\n\tv_pk_add_u16 %0, %0, %4\n\tv_pk_add_u16 %1, %1, %5"
        : "+v"(c0), "+v"(c1), "=&v"(t0), "=&v"(t1), "=&v"(t2), "=&v"(t3)
        : "v"(kp[4 * G + 0]), "v"(kp[4 * G + 1]), "v"(kp[4 * G + 2]), "v"(kp[4 * G + 3]), "s"(cm1), "s"(0x00010001u));
}
__device__ __forceinline__ int wave_sum_dpp(int v) {
    v += __builtin_amdgcn_update_dpp(0, v, 0x111, 0xf, 0xf, true);
    v += __builtin_amdgcn_update_dpp(0, v, 0x112, 0xf, 0xf, true);
    v += __builtin_amdgcn_update_dpp(0, v, 0x114, 0xf, 0xf, true);
    v += __builtin_amdgcn_update_dpp(0, v, 0x118, 0xf, 0xf, true);
    v += __builtin_amdgcn_update_dpp(0, v, 0x142, 0xa, 0xf, true);
    v += __builtin_amdgcn_update_dpp(0, v, 0x143, 0xc, 0xf, true);
    return __builtin_amdgcn_readlane(v, 63);
}
__device__ __forceinline__ unsigned cnt_ge_lane(const unsigned (&kp)[32], unsigned cand, int ng) {
    const unsigned cm1 = (cand - 1u) * 0x00010001u; unsigned c0 = 0u, c1 = 0u;
    cnt_ge4<0>(kp, cm1, c0, c1);
    if (ng > 1) cnt_ge4<1>(kp, cm1, c0, c1);
    if (ng > 2) cnt_ge4<2>(kp, cm1, c0, c1);
    if (ng > 3) cnt_ge4<3>(kp, cm1, c0, c1);
    if (ng > 4) cnt_ge4<4>(kp, cm1, c0, c1);
    if (ng > 5) cnt_ge4<5>(kp, cm1, c0, c1);
    if (ng > 6) cnt_ge4<6>(kp, cm1, c0, c1);
    if (ng > 7) cnt_ge4<7>(kp, cm1, c0, c1);
    const unsigned c = c0 + c1;
    return (c & 0xffffu) + (c >> 16);
}
__device__ __forceinline__ int cnt_ge(const unsigned (&kp)[32], unsigned cand, int ng) { return wave_sum_dpp((int)cnt_ge_lane(kp, cand, ng)); }
__device__ __forceinline__ void bit_transpose16(unsigned (&x)[16]) {
#define BT_STAGE(J, M) _Pragma("unroll") for (int r = 0; r < 16; ++r) if ((r & (J)) == 0) { const unsigned a = x[r], b = x[r + (J)]; x[r] = (a & (M)) | ((b << (J)) & ~(M)); x[r + (J)] = ((a >> (J)) & (M)) | (b & ~(M)); }
    BT_STAGE(8, 0x00ff00ffu) BT_STAGE(4, 0x0f0f0f0fu) BT_STAGE(2, 0x33333333u) BT_STAGE(1, 0x55555555u)
#undef BT_STAGE
}
__device__ __forceinline__ void select_topk(const unsigned short* srow, int Lk, LAS unsigned* list, int lane, int mode = 3) {
    const int ng = (Lk + 511) >> 9;
    unsigned kp[32];
    const unsigned* sl = (const unsigned*)srow + lane;
    if (ng > 4) {
#pragma unroll
        for (int j = 0; j < 32; ++j) kp[j] = sl[j * 64];
    } else {
#pragma unroll
        for (int j = 0; j < 16; ++j) kp[j] = sl[j * 64];
#pragma unroll
        for (int j = 16; j < 32; ++j) kp[j] = 0u;
    }
    typedef short s16x2 __attribute__((ext_vector_type(2)));
#pragma unroll
    for (int j = 0; j < 32; ++j) { const unsigned w = kp[j];
        const unsigned sg = __builtin_bit_cast(unsigned, __builtin_bit_cast(s16x2, w) >> (s16x2){15, 15});
        unsigned kk = w ^ (sg | 0x80008000u);
        const int rem = Lk - 128 * j;
        if (rem < 128) kk &= ((2 * lane < rem) ? 0xffffu : 0u) | ((2 * lane + 1 < rem) ? 0xffff0000u : 0u);
        kp[j] = kk; }
    unsigned p0[16], p1[16];
#pragma unroll
    for (int j = 0; j < 16; ++j) { p0[j] = kp[j]; p1[j] = 0u; }
    bit_transpose16(p0);
    if (ng > 4) {
#pragma unroll
        for (int j = 0; j < 16; ++j) p1[j] = kp[16 + j];
        bit_transpose16(p1); }
    unsigned act0 = ~0u, act1 = ~0u, gt0 = 0u, gt1 = 0u; int G = 0;
#pragma unroll
    for (int bit = 15; bit >= 0; --bit) {
        const unsigned t0 = act0 & p0[bit], t1 = act1 & p1[bit];
        const int c = __builtin_popcount(t0) + __builtin_popcount(t1);
        const int tot = wave_sum_dpp(c);
        const bool take = G + tot >= TOPK;
        if (take) { act0 = t0; act1 = t1; } else { G += tot; gt0 |= t0; gt1 |= t1; act0 ^= t0; act1 ^= t1; }
    }
    const int neq = wave_sum_dpp(__builtin_popcount(act0) + __builtin_popcount(act1));
    unsigned sel0, sel1;
    if (G + neq == TOPK) { sel0 = gt0 | act0; sel1 = gt1 | act1; }
    else {
        const int need_eq = TOPK - G; int jc = 0, base = 0;
#define SEL_MASKR(m_) ((m_) <= 0 ? 0u : (m_) >= 16 ? 0xffffffffu : ((1u << (m_)) - 1u) * 0x00010001u)
#pragma unroll
        for (int s = 16; s >= 1; s >>= 1) { const int jm = jc + s; const unsigned m0 = SEL_MASKR(jm), m1 = SEL_MASKR(jm - 16);
            const int cb = wave_sum_dpp(__builtin_popcount(act0 & m0) + __builtin_popcount(act1 & m1));
            if (cb < need_eq) { jc = jm; base = cb; } }
        const int rc = jc & 15; const unsigned aw = jc >= 16 ? act1 : act0;
        const bool e0 = ((aw >> rc) & 1u) != 0u, e1 = ((aw >> (16 + rc)) & 1u) != 0u;
        const unsigned long long b0 = __ballot(e0), b1 = __ballot(e1);
        const int rk = base + mbcnt64(b0) + mbcnt64(b1);
        const bool s0 = e0 && rk < need_eq, s1 = e1 && (rk + (e0 ? 1 : 0)) < need_eq;
        const unsigned add = ((s0 ? 1u : 0u) << rc) | ((s1 ? 1u : 0u) << (16 + rc));
        const unsigned m0 = SEL_MASKR(jc), m1 = SEL_MASKR(jc - 16);
        sel0 = gt0 | (act0 & m0) | (jc < 16 ? add : 0u);
        sel1 = gt1 | (act1 & m1) | (jc >= 16 ? add : 0u);
#undef SEL_MASKR
    }
    { const int cl = __builtin_popcount(sel0) + __builtin_popcount(sel1);
      int inc = cl;
      inc += __builtin_amdgcn_update_dpp(0, inc, 0x111, 0xf, 0xf, true);
      inc += __builtin_amdgcn_update_dpp(0, inc, 0x112, 0xf, 0xf, true);
      inc += __builtin_amdgcn_update_dpp(0, inc, 0x114, 0xf, 0xf, true);
      inc += __builtin_amdgcn_update_dpp(0, inc, 0x118, 0xf, 0xf, true);
      inc += __builtin_amdgcn_update_dpp(0, inc, 0x142, 0xa, 0xf, true);
      inc += __builtin_amdgcn_update_dpp(0, inc, 0x143, 0xc, 0xf, true);
      int off = inc - cl; unsigned m0 = sel0, m1 = sel1;
      while (__ballot((m0 | m1) != 0u) != 0ull) {
          const bool has0 = m0 != 0u; const unsigned m = has0 ? m0 : m1; const bool valid = m != 0u;
          const int p = __builtin_ctz(m | 0x80000000u);
          const unsigned idx = (unsigned)((((p & 15) + (has0 ? 0 : 16)) << 7) + 2 * lane + (p >> 4));
          list[valid ? off : 2368 + lane] = idx;
          off += valid ? 1 : 0;
          const unsigned nm = m & (m - 1u);
          m0 = has0 ? nm : m0; m1 = has0 ? m1 : nm; }
    }
}
#ifndef SEL2
#define SEL2 0
#endif
#ifndef QK2
#define QK2 0
#endif
#ifndef PV2
#define PV2 0
#endif
#ifndef NOXCD
#define NOXCD 0
#endif
constexpr int ATT_WSTRIDE = 10496;
template <bool SAMPLE>
__device__ __forceinline__ void attend_query(PK P, const Ctx& C, int L, int row, int mode = 3) {
    int lane_ = C.lane; asm volatile("" : "+v"(lane_));
    unsigned char* ws = P->ws; const int lane = lane_;
    LAS unsigned* list = (LAS unsigned*)(C.lds + C.wave * ATT_WSTRIDE);
    int b, Lk; const unsigned short* srow;
    if (SAMPLE) { b = (row - MP) >> 3; const int j = (row - MP) & 7; Lk = PAST + j + 1; srow = (const unsigned short*)(ws + WS_SS) + (size_t)(row - MP) * SS_LD; }
    else { b = row >> 12; const int t = row & (SEQ - 1); Lk = t + 1; srow = (const unsigned short*)(ws + WS_SP) + (size_t)row * SEQ; }
    const int n16 = lane & 15, g = lane >> 4;
    u32x4 qraw[2]; qraw[0] = (u32x4){0u, 0u, 0u, 0u}; qraw[1] = qraw[0];
    if (n16 < 8) { qraw[0] = *(const u32x4*)((const bf16*)(ws + WS_AQ) + (size_t)row * 512 + n16 * 64 + 8 * g); qraw[1] = *(const u32x4*)((const bf16*)(ws + WS_AQ) + (size_t)row * 512 + n16 * 64 + 32 + 8 * g); }
    u32x2 azr[4];
#pragma unroll
    for (int dl = 0; dl < 4; ++dl) azr[dl] = *(const u32x2*)((const bf16*)(ws + WS_Z) + (size_t)row * NZ + ZC_AZ + (n16 & 7) * 64 + 16 * dl + 4 * g);
    int ptv = 0; if (SAMPLE) ptv = ((const int*)P->in[I_PT])[b * NPAGES + (lane & 15)];
    int count;
    if (Lk <= TOPK) { for (int i = lane; i < TOPK; i += 64) list[i] = i < Lk ? (unsigned)i : 0u; count = Lk; }
    else { select_topk(srow, Lk, list, lane, mode); if (SEL2) { LDS_WAIT(); asm volatile("" ::: "memory"); select_topk(srow, Lk, list, lane, mode); } count = TOPK; }
    LDS_WAIT(); asm volatile("" ::: "memory");
    if (mode == 1 || mode == 4 || mode == 5) return;
    {
#pragma unroll
      for (int i = 0; i < 4; ++i) { const unsigned k = list[lane + 64 * i]; unsigned phys;
          if (SAMPLE) { const unsigned pg = (unsigned)__builtin_amdgcn_ds_bpermute((int)(((k >> 7) & 15u) << 2), ptv); phys = (k < (unsigned)PAST) ? pg * 128u + (k & 127u) : (0x80000000u | (k - PAST)); }
          else phys = (unsigned)b * SEQ + k;
          list[lane + 64 * i] = phys; } }
    LDS_WAIT(); asm volatile("" ::: "memory");
    const float* ck = SAMPLE ? P->in[I_CK] + (size_t)L * NPOOL * 128 * 128 : nullptr; const float* cv = SAMPLE ? P->in[I_CV] + (size_t)L * NPOOL * 128 * 128 : nullptr;
    const float* nk = P->out + O_KS + ((size_t)L * DB + b) * DS * 128; const float* nv = P->out + O_VS + ((size_t)L * DB + b) * DS * 128;
    const bf16* KBp = (const bf16*)(ws + WS_KB); const bf16* VBp = (const bf16*)(ws + WS_VB);
    bf16x8 qf[2][2];
#pragma unroll
    for (int kvh = 0; kvh < 2; ++kvh)
#pragma unroll
        for (int s = 0; s < 2; ++s) { const u32x4 zz = {0u, 0u, 0u, 0u}; qf[kvh][s] = as_bf16x8(((n16 >> 2) == kvh) ? qraw[s] : zz); }
    f32x4 S[16];
    for (int rq_ = 0; rq_ < (QK2 ? 2 : 1); ++rq_) {
    { LAS unsigned char* kbuf = C.lds + C.wave * ATT_WSTRIDE + 1024; const int c16k = lane & 15, tqk = lane >> 4;
      constexpr int SB = SAMPLE ? 1 : 2, NBT = 8 / SB;
      u32x4 kraw[2][SB][SAMPLE ? 16 : 8];
#define ATT_KLOAD(buf_, k_) do { _Pragma("unroll") for (int q = 0; q < SB; ++q) _Pragma("unroll") for (int i = 0; i < 8; ++i) { const unsigned phys = list[32 * ((k_) * SB + q) + tqk + 4 * i]; \
                if (SAMPLE) { const float* kr = ((phys & 0x80000000u) ? nk + (size_t)(phys & 7u) * 128 : ck + (size_t)phys * 128) + 8 * c16k; kraw[buf_][q][2 * i] = *(const u32x4*)kr; kraw[buf_][q][2 * i + 1] = *(const u32x4*)(kr + 4); } \
                else kraw[buf_][q][i] = *(const u32x4*)(KBp + (size_t)phys * 128 + 8 * c16k); } } while (0)
      ATT_KLOAD(0, 0); ATT_KLOAD(1, 1);
      asm volatile("" ::: "memory");
#pragma unroll
      for (int k = 0; k < NBT; ++k) {
#pragma unroll
        for (int q = 0; q < SB; ++q) { const int st = k * SB + q;
#pragma unroll
            for (int i = 0; i < 8; ++i) { u32x4 w;
                if (SAMPLE) { const f32x4 a = __builtin_bit_cast(f32x4, kraw[k & 1][q][2 * i]), c = __builtin_bit_cast(f32x4, kraw[k & 1][q][2 * i + 1]); w.x = pk2(a[0], a[1]); w.y = pk2(a[2], a[3]); w.z = pk2(c[0], c[1]); w.w = pk2(c[2], c[3]); }
                else w = kraw[k & 1][q][i];
                *(LAS u32x4*)(kbuf + (tqk + 4 * i) * 288 + 16 * c16k) = w; }
            if (q == SB - 1 && k + 2 < NBT) ATT_KLOAD(k & 1, k + 2);
            LDS_WAIT(); asm volatile("" ::: "memory");
#pragma unroll
            for (int tt = 0; tt < 2; ++tt) { const LAS unsigned char* rp = kbuf + (16 * tt + n16) * 288 + 16 * g;
                const bf16x8 a00 = *(const LAS bf16x8*)rp, a01 = *(const LAS bf16x8*)(rp + 64), a10 = *(const LAS bf16x8*)(rp + 128), a11 = *(const LAS bf16x8*)(rp + 192);
                f32x4 acc = {0.f, 0.f, 0.f, 0.f};
                acc = mfma16(a00, qf[0][0], acc); acc = mfma16(a01, qf[0][1], acc); acc = mfma16(a10, qf[1][0], acc); acc = mfma16(a11, qf[1][1], acc); asm volatile("" : "+v"(acc)); S[2 * st + tt] = acc; }
            LDS_WAIT(); asm volatile("" ::: "memory"); }
      }
#undef ATT_KLOAD
    }
    asm volatile("" ::: "memory"); }
    LAS unsigned char* vbuf = C.lds + C.wave * ATT_WSTRIDE + 1024;
    const int c16 = lane & 15, tq = lane >> 4;
    constexpr int VD = SAMPLE ? 1 : 2;
    u32x4 vraw[VD][SAMPLE ? 16 : 8];
#define ATT_VLOAD(buf_, st_) do { _Pragma("unroll") for (int i = 0; i < 8; ++i) { const unsigned phys = list[32 * (st_) + tq + 4 * i]; \
            if (SAMPLE) { const float* vr = ((phys & 0x80000000u) ? nv + (size_t)(phys & 7u) * 128 : cv + (size_t)phys * 128) + 8 * c16; vraw[buf_][2 * i] = *(const u32x4*)vr; vraw[buf_][2 * i + 1] = *(const u32x4*)(vr + 4); } \
            else vraw[buf_][i] = *(const u32x4*)(VBp + (size_t)phys * 128 + 8 * c16); } } while (0)
    if (mode != 2) {
#pragma unroll
        for (int d = 0; d < VD; ++d) ATT_VLOAD(d, d); }
    asm volatile("" ::: "memory");
    float mx = -INFINITY;
#pragma unroll
    for (int i = 0; i < 16; ++i)
#pragma unroll
        for (int r = 0; r < 4; ++r) { const int slot = 16 * i + 4 * g + r; const float sv = slot < count ? S[i][r] * 0.125f : -INFINITY; S[i][r] = sv; mx = fmaxf(mx, sv); }
    mx = fmaxf(mx, shx<16>(mx, lane)); mx = fmaxf(mx, shx<32>(mx, lane));
    float sum = 0.f;
#pragma unroll
    for (int i = 0; i < 16; ++i)
#pragma unroll
        for (int r = 0; r < 4; ++r) { const float p = __builtin_amdgcn_exp2f((S[i][r] - mx) * 1.4426950408889634f); S[i][r] = p; sum += p; }
    sum += shx<16>(sum, lane); sum += shx<32>(sum, lane);
    if (mode == 2) return;
    f32x4 oacc[8];
    {
#pragma unroll
    for (int dt = 0; dt < 8; ++dt) oacc[dt] = (f32x4){0.f, 0.f, 0.f, 0.f};
    const unsigned tr_a = (unsigned)(4 * g + (c16 >> 2)) * 288u + (unsigned)(c16 & 3) * 8u;
#pragma unroll
    for (int st = 0; st < 8; ++st) {
#pragma unroll
        for (int i = 0; i < 8; ++i) { u32x4 w;
            if (SAMPLE) { const f32x4 a = __builtin_bit_cast(f32x4, vraw[st % VD][2 * i]), c = __builtin_bit_cast(f32x4, vraw[st % VD][2 * i + 1]); w.x = pk2(a[0], a[1]); w.y = pk2(a[2], a[3]); w.z = pk2(c[0], c[1]); w.w = pk2(c[2], c[3]); }
            else w = vraw[st % VD][i];
            *(LAS u32x4*)(vbuf + (tq + 4 * i) * 288 + 16 * c16) = w; }
        if (st + VD < 8) ATT_VLOAD(st % VD, st + VD);
        const f32x4 p0 = S[2 * st], p1 = S[2 * st + 1];
        u32x4 pw; pw.x = pk2(p0[0], p0[1]); pw.y = pk2(p0[2], p0[3]); pw.z = pk2(p1[0], p1[1]); pw.w = pk2(p1[2], p1[3]);
        const bf16x8 pf = as_bf16x8(pw);
        LDS_WAIT(); asm volatile("" ::: "memory");
#pragma unroll
        for (int dt = 0; dt < 8; ++dt) {
            typedef short v4i16_t __attribute__((ext_vector_type(4)));
            const v4i16_t lo = __builtin_amdgcn_ds_read_tr16_b64_v4i16((LAS v4i16_t*)(vbuf + tr_a + 32 * dt));
            const v4i16_t hi = __builtin_amdgcn_ds_read_tr16_b64_v4i16((LAS v4i16_t*)(vbuf + tr_a + 16 * 288 + 32 * dt));
            bf16x8 af; af[0] = lo[0]; af[1] = lo[1]; af[2] = lo[2]; af[3] = lo[3]; af[4] = hi[0]; af[5] = hi[1]; af[6] = hi[2]; af[7] = hi[3];
            oacc[dt] = mfma16(af, pf, oacc[dt]); }
        LDS_WAIT(); asm volatile("" ::: "memory");
    }
    asm volatile("" ::: "memory"); }
    { const float inv = 1.0f / sum;
#define ATT_EPI(base_) do { _Pragma("unroll") for (int dl = 0; dl < 4; ++dl) { const f32x4 v = oacc[(base_) + dl]; \
              const float y0 = v[0] * inv * siluf_(bflo(azr[dl].x)), y1 = v[1] * inv * siluf_(bfhi(azr[dl].x)), y2 = v[2] * inv * siluf_(bflo(azr[dl].y)), y3 = v[3] * inv * siluf_(bfhi(azr[dl].y)); \
              u32x2 ow; ow.x = pk2(y0, y1); ow.y = pk2(y2, y3); \
              *(u32x2*)((bf16*)(ws + WS_OGA) + (size_t)row * 512 + n16 * 64 + 16 * dl + 4 * g) = ow; } } while (0)
      if (n16 < 4) ATT_EPI(0); else if (n16 < 8) ATT_EPI(4);
#undef ATT_EPI
    }
    LDS_WAIT(); asm volatile("" ::: "memory");
#undef ATT_VLOAD
}
__device__ __forceinline__ void ret_out_unit(PK P, const Ctx& C, int unit, bool flip);
__device__ __forceinline__ void phase_d(PK P, const Ctx& C, int L, int mode = 3) {
    if (mode == 3) { bool flip = false; for (int u = C.blk; u < 512; u += C.nblk) { ret_out_unit(P, C, u, flip); flip = !flip; } __syncthreads(); }
#ifndef DSEL
#define DSEL 7
#endif
    if (!(DSEL & 2)) {} else
    if (C.nblk == 256 && !NOXCD) {
        const int x = C.blk & 7, b = x >> 1, wq = (((C.blk >> 3) * 2 + (x & 1)) * NWAVES + C.wave);
        for (int t = wq; t < SEQ; t += 512) attend_query<false>(P, C, L, b * SEQ + t, mode);
    } else for (int row = C.gw; row < MP; row += C.ngw) attend_query<false>(P, C, L, row, mode);
    if (DSEL & 4) for (int i = C.gw; i < 2 * MS; i += C.ngw) if ((i & 1) == 0) attend_query<true>(P, C, L, MP + (i >> 1), mode);
}

__device__ __forceinline__ void ret_out_unit(PK P, const Ctx& C, int unit, bool flip) {
    unsigned char* ws = P->ws; const bf16* RQ = (const bf16*)(ws + WS_RQ); const bf16* RK = (const bf16*)(ws + WS_RK); const bf16* RVT = (const bf16*)(ws + WS_RVT); const bf16* ST = (const bf16*)(ws + WS_ST);
    const int bh = unit >> 5, b = bh >> 2, h = bh & 3, n = unit & 31, r16 = C.lane & 15, g = C.lane >> 4, t0 = n * 128;
    const int w = flip ? 7 - C.wave : C.wave;
    const size_t rowbase = (size_t)b * SEQ + t0;
    const float lg2 = ret_log2g(h);
    constexpr int RS = 272; LAS unsigned char* Ks = C.lds; LAS unsigned char* Vs = C.lds + 128 * RS; LAS unsigned char* Ss = C.lds + 256 * RS;
    bf16x8 qf[4];
#pragma unroll
    for (int kk = 0; kk < 4; ++kk) qf[kk] = *(const bf16x8*)(RQ + (rowbase + 16 * w + r16) * 512 + h * 128 + 32 * kk + 8 * g);
    { const int pr = C.tid >> 4, pc = C.tid & 15;
      u32x4 rk[4], rv[4], rs_[4];
#pragma unroll
      for (int q = 0; q < 4; ++q) { const int r = pr + 32 * q;
          rk[q] = *(const u32x4*)(RK + (rowbase + r) * 512 + h * 128 + 8 * pc);
          rv[q] = *(const u32x4*)(RVT + ((size_t)bh * 128 + r) * SEQ + t0 + 8 * pc);
          rs_[q] = *(const u32x4*)(ST + (((size_t)bh * 32 + n) * 128 + r) * 128 + 8 * pc); }
      __syncthreads();
#pragma unroll
      for (int q = 0; q < 4; ++q) { const int r = pr + 32 * q; *(LAS u32x4*)(Ks + r * RS + 16 * pc) = rk[q]; *(LAS u32x4*)(Vs + r * RS + 16 * pc) = rv[q]; *(LAS u32x4*)(Ss + r * RS + 16 * pc) = rs_[q]; }
      __syncthreads(); }
    unsigned pt[8][2];
#pragma unroll
    for (int st = 0; st < 8; ++st) {
        pt[st][0] = 0u; pt[st][1] = 0u;
        if (st <= w) { f32x4 acc = {0.f, 0.f, 0.f, 0.f};
#pragma unroll
            for (int kk = 0; kk < 4; ++kk) { const bf16x8 kf = *(const LAS bf16x8*)(Ks + (16 * st + r16) * RS + 64 * kk + 16 * g); acc = mfma16(kf, qf[kk], acc); }
            float vals[4];
#pragma unroll
            for (int r = 0; r < 4; ++r) { const int dlt = (16 * w + r16) - (16 * st + 4 * g + r); vals[r] = dlt >= 0 ? acc[r] * __builtin_amdgcn_exp2f((float)dlt * lg2) : 0.f; }
            pt[st][0] = pk2(vals[0], vals[1]); pt[st][1] = pk2(vals[2], vals[3]); }
    }
    const float dq = __builtin_amdgcn_exp2f((float)(16 * w + r16 + 1) * lg2);
    f32x4 o[8];
#pragma unroll
    for (int et = 0; et < 8; ++et) {
        f32x4 a1 = {0.f, 0.f, 0.f, 0.f}, a2 = {0.f, 0.f, 0.f, 0.f};
        const LAS unsigned char* vrow = Vs + (16 * et + r16) * RS;
#pragma unroll
        for (int i = 0; i < 4; ++i) if (2 * i <= w) {
            const u32x2 lo = *(const LAS u32x2*)(vrow + 2 * (32 * i + 4 * g)), hi = *(const LAS u32x2*)(vrow + 2 * (32 * i + 16 + 4 * g));
            const u32x4 aw = {lo.x, lo.y, hi.x, hi.y}, bw = {pt[2 * i][0], pt[2 * i][1], pt[2 * i + 1][0], pt[2 * i + 1][1]};
            a1 = mfma16(as_bf16x8(aw), as_bf16x8(bw), a1); }
#pragma unroll
        for (int kk = 0; kk < 4; ++kk) { const bf16x8 sf = *(const LAS bf16x8*)(Ss + (16 * et + r16) * RS + 64 * kk + 16 * g); a2 = mfma16(sf, qf[kk], a2); }
        o[et] = a1 + a2 * dq;
    }
    float sm = 0.f;
#pragma unroll
    for (int et = 0; et < 8; ++et) sm += (o[et][0] + o[et][1]) + (o[et][2] + o[et][3]);
    sm += shx<16>(sm, C.lane); sm += shx<32>(sm, C.lane);
    const float mu = sm * (1.0f / 128.0f); float qv = 0.f;
#pragma unroll
    for (int et = 0; et < 8; ++et) { const f32x4 d = o[et] - mu; qv += (d[0] * d[0] + d[1] * d[1]) + (d[2] * d[2] + d[3] * d[3]); }
    qv += shx<16>(qv, C.lane); qv += shx<32>(qv, C.lane);
    const float rstd = __builtin_amdgcn_rsqf(qv * (1.0f / 128.0f) + 1e-5f);
    const size_t row = rowbase + 16 * w + r16;
    const bf16* zr = (const bf16*)(ws + WS_Z) + row * NZ + ZC_RZ + h * 128; bf16* og = (bf16*)(ws + WS_OGR) + row * 512 + h * 128;
#pragma unroll
    for (int et = 0; et < 8; ++et) { const u32x2 zw = *(const u32x2*)(zr + 16 * et + 4 * g);
        const float y0 = (o[et][0] - mu) * rstd * siluf_(bflo(zw.x)), y1 = (o[et][1] - mu) * rstd * siluf_(bfhi(zw.x)), y2 = (o[et][2] - mu) * rstd * siluf_(bflo(zw.y)), y3 = (o[et][3] - mu) * rstd * siluf_(bfhi(zw.y));
        u32x2 ow; ow.x = pk2(y0, y1); ow.y = pk2(y2, y3); *(u32x2*)(og + 16 * et + 4 * g) = ow; }
}

template <int K>
__device__ __forceinline__ void mini_mma(const bf16* A, const bf16* Bt, int row0, int col0, const Ctx& C, f32x4 (&acc)[2]) {
    constexpr int RS = 272, BUF = 2 * 64 * RS;
    constexpr int NC = K / 128, PF = NC < 4 ? NC : 4;
    const int tid = C.tid, lane = C.lane, rt = C.wave >> 1, ch = C.wave & 1, r16 = lane & 15, g = lane >> 4;
    LAS unsigned char* sm = C.lds;
    const int pr0 = tid >> 4, pc = tid & 15;
    const bf16* ga = A + (size_t)(row0 + pr0) * K + 8 * pc; const bf16* gb = Bt + (size_t)(col0 + pr0) * K + 8 * pc;
    acc[0] = (f32x4){0.f, 0.f, 0.f, 0.f}; acc[1] = (f32x4){0.f, 0.f, 0.f, 0.f};
    u32x4 rr[PF][4];
#pragma unroll
    for (int p = 0; p < PF; ++p) { rr[p][0] = *(const u32x4*)(ga + 128 * p); rr[p][1] = *(const u32x4*)(ga + (size_t)32 * K + 128 * p); rr[p][2] = *(const u32x4*)(gb + 128 * p); rr[p][3] = *(const u32x4*)(gb + (size_t)32 * K + 128 * p); }
    asm volatile("" ::: "memory");
    __syncthreads();
#pragma unroll
    for (int c = 0; c < NC; ++c) {
        { LAS unsigned char* w = sm + (c & 1) * BUF + pr0 * RS + 16 * pc; *(LAS u32x4*)w = rr[c % PF][0]; *(LAS u32x4*)(w + 32 * RS) = rr[c % PF][1]; *(LAS u32x4*)(w + 64 * RS) = rr[c % PF][2]; *(LAS u32x4*)(w + 96 * RS) = rr[c % PF][3]; }
        if (c + PF < NC) { const int n = c + PF; rr[c % PF][0] = *(const u32x4*)(ga + 128 * n); rr[c % PF][1] = *(const u32x4*)(ga + (size_t)32 * K + 128 * n); rr[c % PF][2] = *(const u32x4*)(gb + 128 * n); rr[c % PF][3] = *(const u32x4*)(gb + (size_t)32 * K + 128 * n); }
        asm volatile("" ::: "memory");
        __syncthreads();
        const LAS unsigned char* rd = sm + (c & 1) * BUF;
#pragma unroll
        for (int kk = 0; kk < 4; ++kk) {
            const bf16x8 a = *(const LAS bf16x8*)(rd + (16 * rt + r16) * RS + 64 * kk + 16 * g);
            const bf16x8 b0 = *(const LAS bf16x8*)(rd + (64 + 32 * ch + r16) * RS + 64 * kk + 16 * g), b1 = *(const LAS bf16x8*)(rd + (64 + 32 * ch + 16 + r16) * RS + 64 * kk + 16 * g);
            acc[0] = mfma16(a, b0, acc[0]); acc[1] = mfma16(a, b1, acc[1]); }
    }
    __syncthreads();
}
__device__ __forceinline__ void mini_oproj(PK P, const Ctx& C, int L) {
    unsigned char* ws = P->ws; const int lane = C.lane, rt = C.wave >> 1, ch = C.wave & 1, r16 = lane & 15, g = lane >> 4;
    for (int u = C.blk; u < 256; u += C.nblk) { const int row0 = MP + 64 * (u >> 4), col0 = 64 * (u & 15);
        f32x4 a1[2], a2[2];
        mini_mma<512>((const bf16*)(ws + WS_OGR), (const bf16*)(ws + WS_WOR) + (size_t)L * DM * 512, row0, col0, C, a1);
        mini_mma<512>((const bf16*)(ws + WS_OGA), (const bf16*)(ws + WS_WOA) + (size_t)L * DM * 512, row0, col0, C, a2);
        const bf16* Z = (const bf16*)(ws + WS_Z); bf16* MB = (bf16*)(ws + WS_MB);
#pragma unroll
        for (int j = 0; j < 2; ++j)
#pragma unroll
            for (int r = 0; r < 4; ++r) { const size_t row = (size_t)(row0 + 16 * rt + 4 * g + r); const int col = col0 + 32 * ch + 16 * j + r16;
                const float m = sigmoidf_(bf2f(Z[row * NZ + ZC_GR + col])) * a1[j][r] + sigmoidf_(bf2f(Z[row * NZ + ZC_GA + col])) * a2[j][r];
                MB[row * DM + col] = (bf16)(pk2(m, 0.f) & 0xffffu); } }
}
__device__ __forceinline__ void mini_wout(PK P, const Ctx& C, int L) {
    unsigned char* ws = P->ws; const int lane = C.lane, rt = C.wave >> 1, ch = C.wave & 1, r16 = lane & 15, g = lane >> 4;
    const float* xs = P->in[I_XS] - (size_t)MP * DM;
    const bf16* xh = (const bf16*)(ws + WS_XB0);
    for (int u = C.blk; u < 256; u += C.nblk) { const int row0 = MP + 64 * (u >> 4), col0 = 64 * (u & 15);
        f32x4 a1[2];
        mini_mma<1024>((const bf16*)(ws + WS_MB), (const bf16*)(ws + WS_WOUT) + (size_t)L * DM * DM, row0, col0, C, a1);
        bf16* XB1 = (bf16*)(ws + WS_XB1);
#pragma unroll
        for (int j = 0; j < 2; ++j)
#pragma unroll
            for (int r = 0; r < 4; ++r) { const size_t row = (size_t)(row0 + 16 * rt + 4 * g + r); const int col = col0 + 32 * ch + 16 * j + r16;
                const float x = (L == 0) ? xs[row * DM + col] : bf2f(xh[row * DM + col]);
                XB1[row * DM + col] = (bf16)(pk2(x + a1[j][r], 0.f) & 0xffffu); } }
}
__device__ __forceinline__ void mini_ple(PK P, const Ctx& C, int L, bool do_ss = true) {
    unsigned char* ws = P->ws; const int lane = C.lane, rt = C.wave >> 1, ch = C.wave & 1, r16 = lane & 15, g = lane >> 4;
    float* rowss = (L + 1 < DEPTH && do_ss) ? (float*)(ws + WS_CTL) + CW_ROWSS1 : nullptr;
    for (int u = C.blk; u < 256; u += C.nblk) { const int row0 = MP + 64 * (u >> 4), col0 = 64 * (u & 15);
        f32x4 a1[2], a2[2];
        mini_mma<1024>((const bf16*)(ws + WS_XB1), (const bf16*)(ws + WS_WPG) + (size_t)L * DM * DM, row0, col0, C, a1);
        mini_mma<256>((const bf16*)(ws + WS_PB) + (size_t)L * MT * 256, (const bf16*)(ws + WS_WPP) + (size_t)L * DM * 256, row0, col0, C, a2);
        const bf16* XB1 = (const bf16*)(ws + WS_XB1); float* Y = P->out; bf16* XB0 = (bf16*)(ws + WS_XB0);
#pragma unroll
        for (int r = 0; r < 4; ++r) { const size_t row = (size_t)(row0 + 16 * rt + 4 * g + r); float ssq = 0.f;
#pragma unroll
            for (int j = 0; j < 2; ++j) { const int col = col0 + 32 * ch + 16 * j + r16;
                const float v = bf2f(XB1[row * DM + col]) + sigmoidf_(a1[j][r]) * a2[j][r]; if (L + 1 == DEPTH) Y[row * DM + col] = v; XB0[row * DM + col] = (bf16)(pk2(v, 0.f) & 0xffffu); ssq += v * v; }
            if (rowss != nullptr) { ssq += shx<1>(ssq, lane); ssq += shx<2>(ssq, lane); ssq += shx<4>(ssq, lane); ssq += shx<8>(ssq, lane); if (r16 == 0) atomicAdd(rowss + row, ssq); } } }
}


__device__ __forceinline__ void mini_inproj_gates(PK P, const Ctx& C, int L) {
    unsigned char* ws = P->ws; const int lane = C.lane, rt = C.wave >> 1, ch = C.wave & 1, r16 = lane & 15, g = lane >> 4;
    const float* rowss = (L == 0) ? (const float*)(ws + WS_ROWSS0) : (const float*)(ws + WS_CTL) + CW_ROWSS1;
    bf16* Z = (bf16*)(ws + WS_Z);
    for (int u = C.blk; u < 16 * 30; u += C.nblk) { const int row0 = MP + 64 * (u / 30), col0 = 15 * 256 + 64 * (u % 30);
        f32x4 a1[2];
        mini_mma<1024>((const bf16*)(ws + WS_XB0), (const bf16*)(ws + WS_WIN) + (size_t)L * NZ * DM, row0, col0, C, a1);
#pragma unroll
        for (int r = 0; r < 4; ++r) { const size_t row = (size_t)(row0 + 16 * rt + 4 * g + r); const float rs = __builtin_amdgcn_rsqf(rowss[row] * (1.0f / 1024.0f) + 1e-6f);
#pragma unroll
            for (int j = 0; j < 2; ++j) Z[row * NZ + col0 + 32 * ch + 16 * j + r16] = (bf16)(pk2(a1[j][r] * rs, 0.f) & 0xffffu); } }
}
__global__ void __launch_bounds__(NTHREADS, 2) mk_fwd(Params Pval) {
    extern __shared__ __attribute__((aligned(16))) unsigned char lds_raw[];
    LAS unsigned char* lds = (LAS unsigned char*)lds_raw;
    volatile LAS unsigned* MISC = (volatile LAS unsigned*)(lds + MISC_OFF);
    const int wave_s = __builtin_amdgcn_readfirstlane((int)threadIdx.x >> 6);
    for (int u = wave_s * 64 + hw_lane(); u < (LDS_BYTES - RING_BYTES) / 4; u += NTHREADS) ((LAS unsigned*)(lds + RING_BYTES))[u] = 0u;
    __syncthreads();
    const int lo = Pval.ph_lo, hi = Pval.ph_hi;
    XcdBarrier bar; bar.bar = (unsigned*)(Pval.ws + WS_CTL) + CW_BAR + Pval.li * XCD_BAR_WORDS; bar.x = 0; bar.st = MISC + 8;
    if (hi - lo > 1) bar = xcd_barrier_post(bar.bar, MISC + 8, wave_s == 0 && hw_lane() == 0);
#ifndef STEPSEL
#define STEPSEL(j) true
#endif
#define IN(k) (lo <= (k) && (k) < hi)
#ifndef DUPMASK
#define DUPMASK 0
#endif
#ifndef XBAR2
#define XBAR2 0
#endif
#ifndef MINI2
#define MINI2 0
#endif
#ifndef DUPMODE
#define DUPMODE 3
#endif
#ifndef CSEL
#define CSEL 15
#endif
#define INL(j) (STEPSEL(j) && IN(pb + (j)))
#define NREP(j) (((DUPMASK) >> (j)) & 1 ? 2 : 1)
#define SEAM(k) do { if (IN((k) + 1)) { XcdBarrier b2_ = bar; asm volatile("" : "+s"(b2_.bar), "+s"(b2_.x)); int t0_ = wave_s * 64 + hw_lane(salt_); asm volatile("" : "+v"(t0_)); xcd_barrier(b2_, t0_ == 0); if (XBAR2) xcd_barrier(b2_, t0_ == 0); } } while (0)
#define PH_ENTER() PK P = phase_args(); const Ctx C = phase_ctx(lds, wave_s, salt_); unsigned char* ws = P->ws; (void)ws; (void)C
    #ifndef PRODUP
#define PRODUP 1
#endif
    const int salt_ = 0;
    if (STEPSEL(-1) && IN(0)) { for (int rep = 0; rep < PRODUP; ++rep) { PH_ENTER(); p0_prologue(P, C); __syncthreads(); } SEAM(0); }
#pragma unroll 1
    for (int L = 0; L < DEPTH; ++L) {
        const int pb = 1 + 8 * L; const int salt_ = pb;
        if (INL(0)) {
            if (blockIdx.x & 1) for (int rm = 0; rm < (MINI2 ? 2 : 1); ++rm) { PH_ENTER(); mini_inproj_gates(P, C, L); }
            for (int rep = 0; rep < NREP(0); ++rep) { PH_ENTER();
            pg8::Gemm g{(const bf16*)(ws + WS_XB0), (const bf16*)(ws + WS_WIN) + (size_t)L * NZ * DM, MT, NZ, DM}; InProjOrder S; S.init(C.nblk, C.blk);
            EpiZ E{ws, P->out, L == 0 ? (const float*)(ws + WS_ROWSS0) : (const float*)(ws + WS_CTL) + CW_ROWSS1, P->in[I_QG] + L * 64, P->in[I_KG] + L * 64, L, lds + XPOSE_OFF};
            pg8::gemm_phase<EpiZ, InProjOrder, true, true>(lds, g, S, E, C.tid); }
            if (!(blockIdx.x & 1)) for (int rm = 0; rm < (MINI2 ? 2 : 1); ++rm) { PH_ENTER(); mini_inproj_gates(P, C, L); }
            SEAM(pb + 0); }
        if (INL(1)) { for (int rep = 0; rep < NREP(1); ++rep) { PH_ENTER(); (void)P; (void)C; }   }
        if (INL(2)) { for (int rep = 0; rep < NREP(2); ++rep) { PH_ENTER(); phase_c(P, C, L, rep == 0 ? 15 : CSEL); __syncthreads(); } SEAM(pb + 2); }
        if (INL(3)) { for (int rep = 0; rep < NREP(3); ++rep) { PH_ENTER(); phase_d(P, C, L, rep == 0 ? 3 : DUPMODE); __syncthreads(); } SEAM(pb + 3); }
        if (INL(4)) {   }
        if (INL(5)) {
            for (int rep = 0; rep < NREP(5); ++rep) {
            { PH_ENTER(); mini_oproj(P, C, L); }
            { PH_ENTER(); pg8::StaticOrder S; S.init(MP, DM, C.nblk, C.blk);
              pg8::Gemm g{(const bf16*)(ws + WS_OGR), (const bf16*)(ws + WS_WOR) + (size_t)L * DM * 512, MP, DM, 512}; EpiGate<0> E{(const bf16*)(ws + WS_Z), ZC_GR, (bf16*)(ws + WS_TMP), (bf16*)(ws + WS_MB)};
              pg8::gemm_phase<EpiGate<0>, pg8::StaticOrder, true, true>(lds, g, S, E, C.tid); }
            { PH_ENTER(); pg8::StaticOrder S; S.init(MP, DM, C.nblk, C.blk);
              pg8::Gemm g{(const bf16*)(ws + WS_OGA), (const bf16*)(ws + WS_WOA) + (size_t)L * DM * 512, MP, DM, 512}; EpiGate<1> E{(const bf16*)(ws + WS_Z), ZC_GA, (bf16*)(ws + WS_TMP), (bf16*)(ws + WS_MB)};
              pg8::gemm_phase<EpiGate<1>, pg8::StaticOrder, true, true>(lds, g, S, E, C.tid); } }
            SEAM(pb + 5); }
        if (INL(6)) {
            for (int rep = 0; rep < NREP(6); ++rep) {
            { PH_ENTER(); mini_wout(P, C, L); }
            { PH_ENTER(); pg8::StaticOrder S; S.init(MP, DM, C.nblk, C.blk);
            pg8::Gemm g{(const bf16*)(ws + WS_MB), (const bf16*)(ws + WS_WOUT) + (size_t)L * DM * DM, MP, DM, DM};
            EpiRes E{P->in[I_XP], P->in[I_XS], L == 0 ? (const bf16*)nullptr : (const bf16*)(ws + WS_XB0), (bf16*)(ws + WS_XB1)};
            pg8::gemm_phase<EpiRes, pg8::StaticOrder, true, true>(lds, g, S, E, C.tid); } }
            SEAM(pb + 6); }
        if (INL(7)) {
            for (int rep = 0; rep < NREP(7); ++rep) {
            { PH_ENTER(); mini_ple(P, C, L, rep == NREP(7) - 1); }
            { PH_ENTER(); pg8::StaticOrder S; S.init(MP, DM, C.nblk, C.blk);
              pg8::Gemm g{(const bf16*)(ws + WS_XB1), (const bf16*)(ws + WS_WPG) + (size_t)L * DM * DM, MP, DM, DM}; EpiPle<0> E{(bf16*)(ws + WS_TMP), (const bf16*)(ws + WS_XB1), nullptr, (bf16*)(ws + WS_XB0), nullptr};
              pg8::gemm_phase<EpiPle<0>, pg8::StaticOrder, true, true>(lds, g, S, E, C.tid); }
            if (L + 1 < DEPTH) { PH_ENTER(); pg8::StaticOrder S; S.init(MP, DM, C.nblk, C.blk);
                pg8::Gemm g{(const bf16*)(ws + WS_PB) + (size_t)L * MT * 256, (const bf16*)(ws + WS_WPP) + (size_t)L * DM * 256, MP, DM, 256};
                EpiPle<1> E{(bf16*)(ws + WS_TMP), (const bf16*)(ws + WS_XB1), P->out, (bf16*)(ws + WS_XB0), (float*)(ws + WS_CTL) + CW_ROWSS1};
                pg8::gemm_phase<EpiPle<1>, pg8::StaticOrder, true, true>(lds, g, S, E, C.tid); }
            else { PH_ENTER(); pg8::StaticOrder S; S.init(MP, DM, C.nblk, C.blk);
                pg8::Gemm g{(const bf16*)(ws + WS_PB) + (size_t)L * MT * 256, (const bf16*)(ws + WS_WPP) + (size_t)L * DM * 256, MP, DM, 256};
                EpiPle<2> E{(bf16*)(ws + WS_TMP), (const bf16*)(ws + WS_XB1), P->out, (bf16*)(ws + WS_XB0), (float*)(ws + WS_CTL) + CW_ROWSS1};
                pg8::gemm_phase<EpiPle<2>, pg8::StaticOrder, true, true>(lds, g, S, E, C.tid); } }
            SEAM(pb + 7); }
    }
#undef IN
#undef INL
#undef SEAM
#undef PH_ENTER
}

#ifndef MK_N_LAUNCHES
#define MK_N_LAUNCHES 1
#endif
extern "C" void kernel_launch(void* const* d_in, const int* in_sizes, int n_in, void* d_out, int out_size, void* d_ws, size_t ws_size, hipStream_t stream) {
    static int grid = 0;
    if (grid == 0) {
        if (n_in != 18 || out_size != (int)O_END || ws_size < WS_END) { fprintf(stderr, "kernel_launch: unexpected problem: n_in %d out %d ws %zu; nothing launched\n", n_in, out_size, ws_size); grid = -1; return; }
        int dev = 0, cus = 0, per_cu = 0;
        if (hipGetDevice(&dev) != hipSuccess || hipDeviceGetAttribute(&cus, hipDeviceAttributeMultiprocessorCount, dev) != hipSuccess) { grid = -1; return; }
        if (hipFuncSetAttribute((const void*)mk_fwd, hipFuncAttributeMaxDynamicSharedMemorySize, LDS_BYTES) != hipSuccess) { fprintf(stderr, "kernel_launch: hipFuncSetAttribute failed\n"); grid = -1; return; }
        if (hipOccupancyMaxActiveBlocksPerMultiprocessor(&per_cu, (const void*)mk_fwd, NTHREADS, LDS_BYTES) != hipSuccess || per_cu < 1) { fprintf(stderr, "kernel_launch: occupancy query says %d blocks per CU\n", per_cu); grid = -1; (void)hipGetLastError(); return; }
        grid = cus;
    }
    if (grid < 0) return;
    (void)hipMemsetAsync((char*)d_ws + WS_CTL, 0, CTL_ZERO_BYTES, stream);
    Params a{};
    for (int i = 0; i < 18; ++i) a.in[i] = (const float*)d_in[i];
    a.out = (float*)d_out; a.ws = (unsigned char*)d_ws;
#if MK_N_LAUNCHES == 1
    a.ph_lo = 0; a.ph_hi = N_PHASES; a.li = 0;
    hipLaunchKernelGGL(mk_fwd, dim3(grid), dim3(NTHREADS), LDS_BYTES, stream, a);
#else
    for (int li = 0; li < N_PHASES; ++li) { a.ph_lo = li; a.ph_hi = li + 1; a.li = 0; hipLaunchKernelGGL(mk_fwd, dim3(grid), dim3(NTHREADS), LDS_BYTES, stream, a); }
#endif
    (void)in_sizes;
}
```

```cpp
#include <hip/hip_runtime.h>
#include <cstdio>
#include <cstdint>
namespace pg8 {
#define PG8_LAS __attribute__((address_space(3)))
typedef unsigned short bf16_t;
typedef short bf16x8 __attribute__((ext_vector_type(8)));
typedef float f32x4 __attribute__((ext_vector_type(4)));
typedef unsigned u32x4 __attribute__((ext_vector_type(4)));
constexpr int BM = 256, BK = 64, HALF = 128, HTB = HALF * BK * 2  , STAGE_BYTES = 8 * HTB, NXCD = 8, WGM = 8;

__host__ __device__ __forceinline__ int lds_byte(int r, int c) { const int st = (r >> 4) * 2 + (c >> 5), rr = r & 15, cc = c & 31, ob = rr * 64 + cc * 2; return st * 1024 + (ob ^ (((ob >> 9) & 1) << 5)); }
__host__ __device__ __forceinline__ void stage_rc(int b, int& R, int& C) { const int st = b / 1024, sb = b % 1024, swz = sb ^ (((sb >> 9) & 1) << 5); R = (st >> 1) * 16 + swz / 64; C = (st & 1) * 32 + (swz % 64) / 2; }
__host__ __device__ __forceinline__ int perm32(int rho) { const int n = rho >> 4, i = rho & 15; return 8 * (i >> 2) + 4 * n + (i & 3); }

struct Unit { int pm, pn; };
struct Gemm { const bf16_t* A; const bf16_t* Bt; int M, N, K; };

struct StaticOrder {
    int nM, nN, nwg, G, c;
    __host__ __device__ void init(int M, int N, int G_, int c_) { nM = M / BM; nN = N / BM; nwg = nM * nN; G = G_; c = c_; }
    __host__ __device__ bool next(int i, Unit& u) const {
        const int L = i * G + c; if (L >= nwg) return false;
        int wgid = L; { const int q = nwg / NXCD, r = nwg % NXCD, xcd = wgid % NXCD, off = wgid / NXCD; wgid = (xcd < r ? xcd * (q + 1) : r * (q + 1) + (xcd - r) * q) + off; }
        const int nig = WGM * nN, gid = wgid / nig, fm = gid * WGM, gsz = (nM - fm) < WGM ? (nM - fm) : WGM;
        u.pm = fm + ((wgid % nig) % gsz); u.pn = (wgid % nig) / gsz; return true;
    }
    __device__ __forceinline__ void a_ready(const Unit&) const {}
    __device__ __forceinline__ void done(const Unit&) const {}
};
__device__ __forceinline__ unsigned cvt_pk_bf16(float lo, float hi) { unsigned r; asm volatile("v_cvt_pk_bf16_f32 %0, %1, %2" : "=v"(r) : "v"(lo), "v"(hi)); return r; }

template <class Epi, class Sched, bool ALIGN_EPI = false, bool SP2 = false>
__device__ __forceinline__ void gemm_phase(PG8_LAS unsigned char* lds, const Gemm g, const Sched& S, const Epi& E, int tid_) {
    asm volatile("" : "+v"(tid_)); const int tid = tid_, wid = __builtin_amdgcn_readfirstlane(tid >> 6), lane = tid & 63, wr = wid >> 2, wc = wid & 3, fr = lane & 15, fq = lane >> 4;
    const int K = g.K, nt = K / BK;
    unsigned voffA[2], voffB[2];
#pragma unroll
    for (int i = 0; i < 2; ++i) { int R, C; stage_rc(tid * 16 + i * 8192, R, C); const int Rb = Epi::PERM ? ((R & ~31) + perm32(R & 31)) : R;
        voffA[i] = (unsigned)(R * K + C) * 2u; voffB[i] = (unsigned)(Rb * K + C) * 2u; }
    const size_t kstep = (size_t)(BK * 2);
    const size_t hstep = (size_t)HALF * K * 2;
    const size_t tstep = 2 * hstep;
    const unsigned ldsw = (unsigned)wid * 1024u;
    const int aoff = lds_byte(wr * 64 + fr, fq * 8), boff = lds_byte(wc * 32 + fr, fq * 8);
#define PG8_SA(b, h) (((b) * 2 + (h)) * HTB)
#define PG8_SB(b, h) ((4 + (b) * 2 + (h)) * HTB)
#define PG8_STAGE(bufoff, gbase, voff) do { _Pragma("unroll") for (int _i = 0; _i < 2; ++_i) \
        __builtin_amdgcn_global_load_lds((const unsigned*)((const char*)(gbase) + (voff)[_i]), (PG8_LAS unsigned*)(lds + (bufoff) + ldsw + _i * 8192), 16, 0, 0); } while (0)
#define PG8_LDA(dst, b, h) do { _Pragma("unroll") for (int m = 0; m < 4; ++m) _Pragma("unroll") for (int k = 0; k < 2; ++k) dst[m][k] = *(const PG8_LAS bf16x8*)(lds + PG8_SA(b, h) + aoff + m * 2048 + k * 1024); } while (0)
#define PG8_LDB(dst, b, h) do { _Pragma("unroll") for (int n = 0; n < 2; ++n) _Pragma("unroll") for (int k = 0; k < 2; ++k) dst[n][k] = *(const PG8_LAS bf16x8*)(lds + PG8_SB(b, h) + boff + n * 2048 + k * 1024); } while (0)
#define PG8_MMA(ai, bj, At, Bt) do { __builtin_amdgcn_s_setprio(1); _Pragma("unroll") for (int m = 0; m < 4; ++m) _Pragma("unroll") for (int n = 0; n < 2; ++n) _Pragma("unroll") for (int k = 0; k < 2; ++k) \
        acc[ai][bj][m][n] = __builtin_amdgcn_mfma_f32_16x16x32_bf16(Bt[n][k], At[m][k], acc[ai][bj][m][n], 0, 0, 0); __builtin_amdgcn_s_setprio(0); } while (0)
#define PG8_WAIT_V(n) asm volatile("s_waitcnt vmcnt(" #n ")" ::: "memory")
#define PG8_WAIT_L(n) asm volatile("s_waitcnt lgkmcnt(" #n ")" ::: "memory")
#define PG8_BAR __builtin_amdgcn_s_barrier()
#define PG8_SCHED __builtin_amdgcn_sched_barrier(0)
    Unit cur, nxt; int ui = 0;
    if (!S.next(0, cur)) return;
    f32x4 acc[2][2][4][2];
#pragma unroll
    for (int a = 0; a < 2; ++a)
#pragma unroll
        for (int b = 0; b < 2; ++b)
#pragma unroll
            for (int m = 0; m < 4; ++m)
#pragma unroll
                for (int n = 0; n < 2; ++n) acc[a][b][m][n] = (f32x4){0.f, 0.f, 0.f, 0.f};
    bf16x8 At[4][2], B0[2][2], B1[2][2];
    const char* cA = (const char*)g.A + (size_t)cur.pm * tstep; const char* cB = (const char*)g.Bt + (size_t)cur.pn * tstep;
    S.a_ready(cur);
    if constexpr (SP2) {
        PG8_STAGE(PG8_SB(0, 0), cB, voffB); PG8_STAGE(PG8_SB(0, 1), cB + hstep, voffB); PG8_STAGE(PG8_SA(0, 0), cA, voffA); PG8_STAGE(PG8_SA(0, 1), cA + hstep, voffA);
        if (wr == 1) PG8_BAR;
        PG8_WAIT_V(2); PG8_BAR;
        PG8_STAGE(PG8_SB(1, 0), cB + kstep, voffB); PG8_STAGE(PG8_SA(1, 0), cA + kstep, voffA); PG8_STAGE(PG8_SB(1, 1), cB + hstep + kstep, voffB);
        PG8_WAIT_V(6); PG8_BAR;
    } else {
        PG8_STAGE(PG8_SB(0, 0), cB, voffB); PG8_STAGE(PG8_SA(0, 0), cA, voffA); PG8_STAGE(PG8_SB(0, 1), cB + hstep, voffB); PG8_STAGE(PG8_SA(0, 1), cA + hstep, voffA);
        if (wr == 1) PG8_BAR;
        PG8_WAIT_V(4); PG8_BAR;
        PG8_STAGE(PG8_SB(1, 0), cB + kstep, voffB); PG8_STAGE(PG8_SA(1, 0), cA + kstep, voffA); PG8_STAGE(PG8_SB(1, 1), cB + hstep + kstep, voffB);
        PG8_WAIT_V(6); PG8_BAR;
    }
    for (;;) {
        const bool has_next = S.next(ui + 1, nxt);
        const char* nA = has_next ? (const char*)g.A + (size_t)nxt.pm * tstep : cA; const char* nB = has_next ? (const char*)g.Bt + (size_t)nxt.pn * tstep : cB;
        for (int t = 0; t < nt; t += 2) {
            const bool last = (t == nt - 2);
            const char* a1 = cA + (size_t)(t + 1) * kstep;
            const char* a2 = last ? nA : cA + (size_t)(t + 2) * kstep; const char* b2 = last ? nB : cB + (size_t)(t + 2) * kstep;
            const char* a3 = a2 + kstep; const char* b3 = b2 + kstep;
            if (last && has_next) S.a_ready(nxt);
            if constexpr (SP2) {
            PG8_LDB(B0, 0, 0); PG8_LDB(B1, 0, 1); PG8_SCHED; PG8_LDA(At, 0, 0); PG8_STAGE(PG8_SA(1, 1), a1 + hstep, voffA);
            PG8_WAIT_V(8); PG8_WAIT_L(0); PG8_BAR; PG8_MMA(0, 0, At, B0); PG8_MMA(0, 1, At, B1); PG8_BAR; PG8_SCHED;
            PG8_LDA(At, 0, 1); PG8_STAGE(PG8_SB(0, 0), b2, voffB); PG8_STAGE(PG8_SB(0, 1), b2 + hstep, voffB); PG8_STAGE(PG8_SA(0, 0), a2, voffA);
            PG8_WAIT_V(8); PG8_WAIT_L(0); PG8_BAR; PG8_MMA(1, 0, At, B0); PG8_MMA(1, 1, At, B1); PG8_BAR; PG8_SCHED;
            PG8_LDB(B0, 1, 0); PG8_LDB(B1, 1, 1); PG8_SCHED; PG8_LDA(At, 1, 0); PG8_STAGE(PG8_SA(0, 1), a2 + hstep, voffA);
            PG8_WAIT_V(8); PG8_WAIT_L(0); PG8_BAR; PG8_MMA(0, 0, At, B0); PG8_MMA(0, 1, At, B1); PG8_BAR; PG8_SCHED;
            PG8_LDA(At, 1, 1); PG8_STAGE(PG8_SB(1, 0), b3, voffB); PG8_STAGE(PG8_SB(1, 1), b3 + hstep, voffB); PG8_STAGE(PG8_SA(1, 0), a3, voffA);
            PG8_WAIT_V(8); PG8_WAIT_L(0); PG8_BAR; PG8_MMA(1, 0, At, B0); PG8_MMA(1, 1, At, B1); PG8_BAR; PG8_SCHED;
            } else {
            PG8_LDB(B0, 0, 0); PG8_SCHED; PG8_LDA(At, 0, 0); PG8_STAGE(PG8_SA(1, 1), a1 + hstep, voffA);
            PG8_WAIT_L(8); PG8_BAR; PG8_WAIT_L(0); PG8_MMA(0, 0, At, B0); PG8_BAR; PG8_SCHED;
            PG8_LDB(B1, 0, 1); PG8_STAGE(PG8_SB(0, 0), b2, voffB);
            PG8_BAR; PG8_WAIT_L(0); PG8_MMA(0, 1, At, B1); PG8_BAR;
            PG8_LDA(At, 0, 1); PG8_STAGE(PG8_SA(0, 0), a2, voffA);
            PG8_BAR; PG8_WAIT_L(0); PG8_MMA(1, 0, At, B0); PG8_BAR; PG8_SCHED;
            PG8_STAGE(PG8_SB(0, 1), b2 + hstep, voffB);
            PG8_WAIT_V(6); PG8_BAR; PG8_MMA(1, 1, At, B1); PG8_BAR;
            PG8_LDB(B0, 1, 0); PG8_SCHED; PG8_LDA(At, 1, 0); PG8_STAGE(PG8_SA(0, 1), a2 + hstep, voffA);
            PG8_WAIT_L(8); PG8_BAR; PG8_WAIT_L(0); PG8_MMA(0, 0, At, B0); PG8_BAR; PG8_SCHED;
            PG8_LDB(B1, 1, 1); PG8_STAGE(PG8_SB(1, 0), b3, voffB);
            PG8_BAR; PG8_WAIT_L(0); PG8_MMA(0, 1, At, B1); PG8_BAR;
            PG8_LDA(At, 1, 1); PG8_STAGE(PG8_SA(1, 0), a3, voffA);
            PG8_BAR; PG8_WAIT_L(0); PG8_MMA(1, 0, At, B0); PG8_BAR; PG8_SCHED;
            PG8_STAGE(PG8_SB(1, 1), b3 + hstep, voffB);
            PG8_WAIT_V(6); PG8_BAR; PG8_MMA(1, 1, At, B1); PG8_BAR;
            }
        }
        if constexpr (ALIGN_EPI) { if (wr == 0) PG8_BAR; }
        if constexpr (!Epi::AFTER_DRAIN) { E(acc, cur, wr, wc, fr, fq); S.done(cur); }
        if (!has_next) break;
#pragma unroll
        for (int a = 0; a < 2; ++a)
#pragma unroll
            for (int b = 0; b < 2; ++b)
#pragma unroll
                for (int m = 0; m < 4; ++m)
#pragma unroll
                    for (int n = 0; n < 2; ++n) acc[a][b][m][n] = (f32x4){0.f, 0.f, 0.f, 0.f};
        cur = nxt; cA = nA; cB = nB; ++ui;
        if constexpr (ALIGN_EPI) { if (wr == 1) PG8_BAR; }
    }
    PG8_WAIT_V(0);
    if constexpr (!ALIGN_EPI) { if (wr == 0) PG8_BAR; }
    PG8_BAR;
    if constexpr (Epi::AFTER_DRAIN) { E.fused(acc, cur, wr, wc, fr, fq, lds, wid, lane); S.done(cur); }
#undef PG8_SA
#undef PG8_SB
#undef PG8_STAGE
#undef PG8_LDA
#undef PG8_LDB
#undef PG8_MMA
#undef PG8_WAIT_V
#undef PG8_WAIT_L
#undef PG8_BAR
#undef PG8_SCHED
}
}

#define GAS __attribute__((address_space(1)))
#define LAS __attribute__((address_space(3)))
typedef unsigned short bf16;
typedef float f32x4 __attribute__((ext_vector_type(4)));
typedef float f32x2 __attribute__((ext_vector_type(2)));
typedef float f32x16 __attribute__((ext_vector_type(16)));
typedef short bf16x8 __attribute__((ext_vector_type(8)));
typedef unsigned u32x4 __attribute__((ext_vector_type(4)));
typedef unsigned u32x2 __attribute__((ext_vector_type(2)));

constexpr int NWAVES = 8, NTHREADS = 512;
constexpr int DM = 1024, NB = 4, SEQ = 4096, DEPTH = 2, DB = 128, DS = 8, PAST = 2048, NPAGES = 16, NPOOL = 2560;
constexpr int MP = NB * SEQ, MS = DB * DS, MT = MP + MS;
constexpr int NZ = 5888;
constexpr int WIN_N = 5700;
constexpr int ZC_RQ = 0, ZC_RK = 512, ZC_RV = 1024, ZC_RZ = 1536, ZC_AQ = 2048, ZC_AK = 2560, ZC_AV = 2688, ZC_AZ = 2816, ZC_IQ = 3328, ZC_IK = 3584, ZC_IW = 3648, ZC_GR = 3712, ZC_GA = 4736;
constexpr int SS_LD = 2064;
constexpr int TOPK = 256;
constexpr size_t O_Y = 0, O_KP = 17825792, O_VP = 22020096, O_IKP = 26214400, O_RSP = 28311552, O_KS = 28835840, O_VS = 29097984, O_IKS = 29360128, O_RSS = 29491200, O_END = 46268416;
constexpr size_t MiB = 1u << 20;
constexpr size_t WS_CTL = 0, CTL_ZERO_BYTES = 1 * MiB;
constexpr size_t WS_WIN = 1 * MiB, WS_WOR = 24 * MiB, WS_WOA = 26 * MiB, WS_WOUT = 28 * MiB, WS_WPG = 32 * MiB, WS_WPP = 36 * MiB;
constexpr size_t WS_ROPER = 37 * MiB, WS_ROPEA = 39 * MiB, WS_ROWSS0 = 39 * MiB + 256 * 1024, WS_IW = 39 * MiB + 512 * 1024;
constexpr size_t WS_XB0 = 40 * MiB, WS_XB1 = 74 * MiB, WS_X1 = 108 * MiB, WS_TMP = 176 * MiB, WS_MB = 244 * MiB, WS_Z = 278 * MiB;
constexpr size_t WS_RQ = 474 * MiB, WS_RK = 490 * MiB, WS_RKT = 506 * MiB, WS_RVT = 522 * MiB, WS_AQ = 538 * MiB, WS_KB = 555 * MiB, WS_VB = 559 * MiB;
constexpr size_t WS_IQ = 563 * MiB, WS_IKB = 572 * MiB, WS_PB = 930 * MiB, WS_KVT = 583 * MiB, WS_ST = 615 * MiB, WS_OGR = 631 * MiB, WS_OGA = 648 * MiB;
constexpr size_t WS_SS = 665 * MiB, WS_SP = 674 * MiB, WS_END = 948 * MiB;
static_assert(WS_Z + (size_t)MT * NZ * 2 <= WS_RQ && WS_SS + (size_t)MS * SS_LD * 4 <= WS_SP && WS_IW + (size_t)MT * 16 <= WS_XB0, "ws map");
constexpr int CW_TMO = 0, CW_BAR = 4096, CW_ROWSS1 = 131072;
constexpr int N_PHASES = 1 + 8 * DEPTH;
constexpr int RING_BYTES = 131072, MISC_OFF = RING_BYTES + 320, XPOSE_OFF = RING_BYTES + 1024, LDS_BYTES = XPOSE_OFF + 8 * 2048;

#define LDS_WAIT() asm volatile("s_waitcnt lgkmcnt(0)" ::: "memory")
#define VM_WAIT() asm volatile("s_waitcnt vmcnt(0)" ::: "memory")
__device__ __forceinline__ unsigned pk2(float lo, float hi) { unsigned r; asm("v_cvt_pk_bf16_f32 %0, %1, %2" : "=v"(r) : "v"(lo), "v"(hi)); return r; }
__device__ __forceinline__ float bflo(unsigned w) { return __uint_as_float(w << 16); }
__device__ __forceinline__ float bfhi(unsigned w) { return __uint_as_float(w & 0xffff0000u); }
__device__ __forceinline__ float bf2f(bf16 b) { return __uint_as_float(((unsigned)b) << 16); }
__device__ __forceinline__ float sigmoidf_(float x) { return __builtin_amdgcn_rcpf(1.0f + __builtin_amdgcn_exp2f(x * -1.4426950408889634f)); }
__device__ __forceinline__ float siluf_(float x) { return x * sigmoidf_(x); }
__device__ __forceinline__ void unpack8(const u32x4 w, float (&f)[8]) { f[0] = bflo(w.x); f[1] = bfhi(w.x); f[2] = bflo(w.y); f[3] = bfhi(w.y); f[4] = bflo(w.z); f[5] = bfhi(w.z); f[6] = bflo(w.w); f[7] = bfhi(w.w); }
__device__ __forceinline__ u32x4 pack8(const float (&f)[8]) { u32x4 w; w.x = pk2(f[0], f[1]); w.y = pk2(f[2], f[3]); w.z = pk2(f[4], f[5]); w.w = pk2(f[6], f[7]); return w; }
__device__ __forceinline__ bf16x8 as_bf16x8(const u32x4 w) { return __builtin_bit_cast(bf16x8, w); }
__device__ __forceinline__ f32x4 mfma16(bf16x8 a, bf16x8 b, f32x4 c) { return __builtin_amdgcn_mfma_f32_16x16x32_bf16(a, b, c, 0, 0, 0); }
__device__ __forceinline__ f32x16 mfma32(bf16x8 a, bf16x8 b, f32x16 c) { return __builtin_amdgcn_mfma_f32_32x32x16_bf16(a, b, c, 0, 0, 0); }
__device__ __forceinline__ float ret_log2g(int h) { return h == 0 ? -0.04580369f : h == 1 ? -0.022720076f : h == 2 ? -0.011315313f : -0.0056465627f; }
__device__ __forceinline__ int mbcnt64(unsigned long long m) { return (int)__builtin_amdgcn_mbcnt_hi((unsigned)(m >> 32), __builtin_amdgcn_mbcnt_lo((unsigned)m, 0u)); }

template <int M> __device__ __forceinline__ float shx(float v, int lane) {
    if constexpr (M < 32) return __int_as_float(__builtin_amdgcn_ds_swizzle(__float_as_int(v), 0x1F | (M << 10)));
    else return __int_as_float(__builtin_amdgcn_ds_bpermute((lane ^ 32) << 2, __float_as_int(v)));
}
__device__ __forceinline__ float wave_sum(float v, int lane) { v += shx<1>(v, lane); v += shx<2>(v, lane); v += shx<4>(v, lane); v += shx<8>(v, lane); v += shx<16>(v, lane); v += shx<32>(v, lane); return v; }

#define XB_TMO      128
#define XB_XCNT(j)  (256  + 64 * (j))
#define XB_XSUB(j)  (1280 + 64 * (j))
#define XB_XGEN(j)  (2304 + 64 * (j))
#define XB_TOP      3328
#define XB_TOPGEN   3392
#define XCD_BAR_WORDS 3456
#define XB_SPIN_CAP (1u << 18)
__device__ __forceinline__ unsigned xb_ld(unsigned* p)              { return __hip_atomic_load(p, __ATOMIC_RELAXED, __HIP_MEMORY_SCOPE_AGENT); }
__device__ __forceinline__ unsigned xb_add(unsigned* p, unsigned v) { return __hip_atomic_fetch_add(p, v, __ATOMIC_RELAXED, __HIP_MEMORY_SCOPE_AGENT); }
__device__ __forceinline__ unsigned xb_xcc_id() { return (unsigned)__builtin_amdgcn_s_getreg((3 << 11) | 20) & 0xFu; }
#define XB_SPIN(cond, bar) do { unsigned _sp = 0; while (cond) { __builtin_amdgcn_s_sleep(1); \
    if ((++_sp & 255u) == 0u) { if (xb_ld(&(bar)[XB_TMO])) break; if (_sp > XB_SPIN_CAP) { atomicAdd(&(bar)[XB_TMO], 1u); break; } } } } while (0)
struct XcdBarrier { unsigned* bar; unsigned x; volatile LAS unsigned* st; };
__device__ __forceinline__ XcdBarrier xcd_barrier_post(unsigned* bar, volatile LAS unsigned* st, bool leader) {
    XcdBarrier b; b.bar = bar; b.x = xb_xcc_id(); b.st = st;
    if (leader) (void)xb_add(&bar[XB_XCNT(b.x)], 1u);
    return b;
}
__device__ __forceinline__ void xcd_barrier_complete(unsigned* bar, unsigned x, unsigned& nloc, unsigned& nx) {
    const unsigned G = gridDim.x * gridDim.y * gridDim.z;
    unsigned sum, cnt, mine, sp = 0u;
    for (;;) {
        sum = 0u; cnt = 0u; mine = 0u;
#pragma unroll
        for (unsigned j = 0; j < 16; ++j) { const unsigned c = xb_ld(&bar[XB_XCNT(j)]); sum += c; cnt += (c > 0u) ? 1u : 0u; mine = (j == x) ? c : mine; }
        if (sum == G) break;
        __builtin_amdgcn_s_sleep(1);
        if ((++sp & 255u) == 0u) { if (xb_ld(&bar[XB_TMO])) break; if (sp > XB_SPIN_CAP) { atomicAdd(&bar[XB_TMO], 1u); break; } }
    }
    nloc = mine > 0u ? mine : 1u; nx = cnt > 0u ? cnt : 1u;
}
__device__ __forceinline__ void xcd_barrier(const XcdBarrier& b, bool leader) {
    asm volatile("s_waitcnt vmcnt(0)" ::: "memory");
    __syncthreads();
    if (leader) {
        unsigned* bar = b.bar;
        __builtin_amdgcn_s_waitcnt(0);
        unsigned nloc = b.st[0], nx = b.st[1];
        if (nloc == 0u) { xcd_barrier_complete(bar, b.x, nloc, nx); b.st[0] = nloc; b.st[1] = nx; }
        const unsigned old = xb_add(&bar[XB_XSUB(b.x)], 1u);
        const unsigned gen = old / nloc;
        if (old + 1u == (gen + 1u) * nloc) {
            __builtin_amdgcn_fence(__ATOMIC_RELEASE, "agent");
            asm volatile("s_waitcnt vmcnt(0)" ::: "memory");
            const unsigned og = xb_add(&bar[XB_TOP], 1u);
            const unsigned tg = og / nx;
            if (og + 1u == (tg + 1u) * nx) xb_add(&bar[XB_TOPGEN], 1u);
            else XB_SPIN(xb_ld(&bar[XB_TOPGEN]) == tg, bar);
            __builtin_amdgcn_fence(__ATOMIC_ACQUIRE, "agent");
            xb_add(&bar[XB_XGEN(b.x)], 1u);
            asm volatile("s_waitcnt vmcnt(0)" ::: "memory");
        } else {
            XB_SPIN(xb_ld(&bar[XB_XGEN(b.x)]) == gen, bar);
            __builtin_amdgcn_fence(__ATOMIC_ACQUIRE, "agent");
            asm volatile("s_waitcnt vmcnt(0)" ::: "memory");
        }
    }
    __syncthreads();
}

struct Params { const float* in[18]; float* out; unsigned char* ws; int ph_lo, ph_hi, li, pad; };
enum { I_XP = 0, I_XS, I_CK, I_CV, I_CIK, I_STATE, I_PT, I_PP, I_PS, I_GAIN, I_WIN, I_QG, I_KG, I_WOR, I_WOA, I_WOUT, I_WPG, I_WPP };
struct Ctx { int tid, lane, wave, gw, ngw, nblk, blk; LAS unsigned char* lds; };
typedef const __attribute__((address_space(4))) Params* PK;
__device__ __forceinline__ PK phase_args() { PK p = (PK)__builtin_amdgcn_kernarg_segment_ptr(); asm volatile("" : "+s"(p)); return p; }
__device__ __forceinline__ int hw_lane(int salt = 0) { int l; asm volatile("v_mbcnt_lo_u32_b32 %0, -1, 0 ; %1\n\tv_mbcnt_hi_u32_b32 %0, -1, %0" : "=v"(l) : "s"(salt)); return l; }
__device__ __forceinline__ Ctx phase_ctx(LAS unsigned char* lds, int wave_s, int salt) { Ctx C; int tid = wave_s * 64 + hw_lane(salt); asm volatile("" : "+v"(tid)); C.lds = lds; C.tid = tid; C.lane = tid & 63; C.wave = __builtin_amdgcn_readfirstlane(tid >> 6);
    int bx = blockIdx.x; asm volatile("" : "+s"(bx)); C.nblk = gridDim.x; C.blk = bx; C.gw = C.blk * NWAVES + C.wave; C.ngw = C.nblk * NWAVES; return C; }

__device__ __forceinline__ int win_orig_col(int np) {
    const int pn = np >> 8, c = np & 255, bj = c >> 7, cc = c & 127, wc = cc >> 5, l8 = cc & 31;
    if (pn < 4) { const int head = 2 * (pn & 1) + bj, dim = (cc >> 1) + 64 * (cc & 1); return (pn < 2 ? 0 : 512) + head * 128 + dim; }
    if (pn < 8) return np;
    if (pn == 11 || pn == 12) return np;
    if (pn <= 10 || pn == 13) { const int dimp = 32 * bj + l8; const bool rope = !(pn == 10 && wc >= 2);
        const int dim = (rope && dimp < 16) ? (dimp >> 1) + 8 * (dimp & 1) : dimp;
        if (pn < 10) return 2048 + (4 * (pn - 8) + wc) * 64 + dim;
        if (pn == 10) return 2560 + wc * 64 + dim;
        return 3328 + wc * 64 + dim; }
    if (np < 3584 + 64) { const int dimp = np - 3584; return 3584 + (dimp < 16 ? (dimp >> 1) + 8 * (dimp & 1) : dimp); }
    if (np < 3652) return np;
    if (np < ZC_GR) return -1;
    if (np < ZC_GR + 2048) return np - (ZC_GR - 3652);
    return -1;
}
struct EpiZ {
    static constexpr bool PERM = true, AFTER_DRAIN = false;
    unsigned char* ws; float* out; const float* rowss; const float* qgain; const float* kgain; int L; LAS unsigned char* xl;
    __device__ __forceinline__ void rope16(float (&x)[8], const f32x2* ropeA, int fq, int hl) const {
        float lo[4], hi[4];
#pragma unroll
        for (int k = 0; k < 4; ++k) { const f32x2 cs = ropeA[(fq & 1) * 4 + k]; lo[k] = x[2 * k] * cs[0] - x[2 * k + 1] * cs[1]; hi[k] = x[2 * k + 1] * cs[0] + x[2 * k] * cs[1]; }
        float rc[4];
#pragma unroll
        for (int k = 0; k < 4; ++k) rc[k] = shx<16>(fq == 0 ? hi[k] : lo[k], hl);
        if (fq == 0) {
#pragma unroll
            for (int k = 0; k < 4; ++k) { x[k] = lo[k]; x[4 + k] = rc[k]; } }
        else if (fq == 1) {
#pragma unroll
            for (int k = 0; k < 4; ++k) { x[k] = rc[k]; x[4 + k] = hi[k]; } }
    }
    __device__ __forceinline__ void operator()(const f32x4 (&acc)[2][2][4][2], const pg8::Unit& u, int wr, int wc, int, int) const {
        const int hl = hw_lane(), fr = hl & 15, fq = hl >> 4;
        const int pn = u.pn; const bool prompt = u.pm < MP / 256;
        const int row0 = u.pm * 256 + wr * 64 + fr;
        bf16* Z = (bf16*)(ws + WS_Z);
        float rsv[2][4];
#pragma unroll
        for (int ai = 0; ai < 2; ++ai)
#pragma unroll
            for (int m = 0; m < 4; ++m) rsv[ai][m] = rowss[row0 + ai * 128 + m * 16];
        asm volatile("" ::: "memory");
#pragma unroll
        for (int ai = 0; ai < 2; ++ai)
#pragma unroll
            for (int m = 0; m < 4; ++m) rsv[ai][m] = __builtin_amdgcn_rsqf(rsv[ai][m] * (1.0f / 1024.0f) + 1e-6f);
        if (prompt && pn >= 2 && pn < 6) {
            const bool isk = pn < 4; LAS unsigned char* xt = xl + (wr * 4 + wc) * 2048;
            const int b = (u.pm * 256) >> 12, tpan = (u.pm * 256) & (SEQ - 1);
#pragma unroll
            for (int ai = 0; ai < 2; ++ai)
#pragma unroll
                for (int bj = 0; bj < 2; ++bj) { const int head = 2 * (pn & 1) + bj;
#pragma unroll
                    for (int mp = 0; mp < 2; ++mp) {
#pragma unroll
                        for (int mm = 0; mm < 2; ++mm) { const int m = 2 * mp + mm; const int row = row0 + ai * 128 + m * 16, t = row & (SEQ - 1);
                            const float rs = rsv[ai][m];
                            float x[8];
#pragma unroll
                            for (int j = 0; j < 4; ++j) { x[j] = acc[ai][bj][m][0][j] * rs; x[4 + j] = acc[ai][bj][m][1][j] * rs; }
                            const int t32 = 16 * mm + fr;
                            if (isk) { const int p0 = 16 * wc + 4 * fq; const f32x2* rr = (const f32x2*)(ws + WS_ROPER) + (size_t)t * 64 + p0; float lo[4], hi[4];
#pragma unroll
                                for (int k = 0; k < 4; ++k) { const f32x2 cs = rr[k]; lo[k] = (x[2 * k] * cs[0] - x[2 * k + 1] * cs[1]) * 0.08838834764831845f; hi[k] = (x[2 * k + 1] * cs[0] + x[2 * k] * cs[1]) * 0.08838834764831845f; }
                                bf16* q = (bf16*)(ws + WS_RK) + (size_t)row * 512 + head * 128 + p0;
                                u32x2 a, c; a.x = pk2(lo[0], lo[1]); a.y = pk2(lo[2], lo[3]); c.x = pk2(hi[0], hi[1]); c.y = pk2(hi[2], hi[3]); *(u32x2*)q = a; *(u32x2*)(q + 64) = c;
                                const float dk = __builtin_amdgcn_exp2f((float)(127 - (t & 127)) * ret_log2g(head));
#pragma unroll
                                for (int k = 0; k < 4; ++k) { *(LAS bf16*)(xt + (4 * fq + k) * 64 + 2 * t32) = (bf16)(pk2(lo[k] * dk, 0.f) & 0xffffu); *(LAS bf16*)(xt + (16 + 4 * fq + k) * 64 + 2 * t32) = (bf16)(pk2(hi[k] * dk, 0.f) & 0xffffu); }
                            } else {
#pragma unroll
                                for (int j = 0; j < 8; ++j) *(LAS bf16*)(xt + (8 * fq + j) * 64 + 2 * t32) = (bf16)(pk2(x[j], 0.f) & 0xffffu); } }
                        asm volatile("s_waitcnt lgkmcnt(0)" ::: "memory");
#pragma unroll
                        for (int i = 0; i < 2; ++i) { const int c = hl + 64 * i, dl = c >> 2, q4 = c & 3; const u32x4 v = *(const LAS u32x4*)(xt + dl * 64 + 16 * q4);
                            const int d = isk ? 16 * wc + (dl & 15) + 64 * (dl >> 4) : 32 * wc + dl;
                            bf16* dst = (bf16*)(ws + (isk ? WS_RKT : WS_RVT)) + ((size_t)(b * 4 + head) * 128 + d) * SEQ + tpan + 128 * ai + 64 * wr + 32 * mp + 8 * q4;
                            *(u32x4*)dst = v; }
                        asm volatile("s_waitcnt lgkmcnt(0)" ::: "memory"); } }
            return;
        }
#define EZ_X(bj_, xv_) float xv_[8]; _Pragma("unroll") for (int j_ = 0; j_ < 4; ++j_) { xv_[j_] = acc[ai][bj_][m][0][j_] * rs; xv_[4 + j_] = acc[ai][bj_][m][1][j_] * rs; }
#pragma unroll
        for (int ai = 0; ai < 2; ++ai)
#pragma unroll
            for (int m = 0; m < 4; ++m) {
                const int row = row0 + ai * 128 + m * 16; const float rs = rsv[ai][m];
                const int pos = prompt ? (row & (SEQ - 1)) : PAST + ((row - MP) & 7);
                const unsigned zrow = (unsigned)row * NZ;
                if (pn < 4) {
                    const int p0 = 16 * wc + 4 * fq; const bool isk = pn >= 2;
                    if (!prompt) {
#pragma unroll
                        for (int bj = 0; bj < 2; ++bj) { EZ_X(bj, x) const int hc = (isk ? ZC_RK : ZC_RQ) + (2 * (pn & 1) + bj) * 128;
                            u32x2 a, b; a.x = pk2(x[0], x[2]); a.y = pk2(x[4], x[6]); b.x = pk2(x[1], x[3]); b.y = pk2(x[5], x[7]);
                            *(u32x2*)(Z + zrow + hc + p0) = a; *(u32x2*)(Z + zrow + hc + 64 + p0) = b; }
                    } else {
                        const f32x2* rr = (const f32x2*)(ws + WS_ROPER) + (size_t)pos * 64 + p0; const int b = row >> 12, t = row & (SEQ - 1);
                        f32x2 cs[4];
#pragma unroll
                        for (int k = 0; k < 4; ++k) cs[k] = rr[k];
#pragma unroll
                        for (int bj = 0; bj < 2; ++bj) { EZ_X(bj, x) const int head = 2 * (pn & 1) + bj; float lo[4], hi[4];
#pragma unroll
                            for (int k = 0; k < 4; ++k) { lo[k] = x[2 * k] * cs[k][0] - x[2 * k + 1] * cs[k][1]; hi[k] = x[2 * k + 1] * cs[k][0] + x[2 * k] * cs[k][1]; }
                            if (!isk) { bf16* q = (bf16*)(ws + WS_RQ) + (size_t)row * 512 + head * 128 + p0;
                                u32x2 a, c; a.x = pk2(lo[0], lo[1]); a.y = pk2(lo[2], lo[3]); c.x = pk2(hi[0], hi[1]); c.y = pk2(hi[2], hi[3]); *(u32x2*)q = a; *(u32x2*)(q + 64) = c; }
                            else { const float sc = 0.08838834764831845f;
#pragma unroll
                                for (int k = 0; k < 4; ++k) { lo[k] *= sc; hi[k] *= sc; }
                                bf16* q = (bf16*)(ws + WS_RK) + (size_t)row * 512 + head * 128 + p0;
                                u32x2 a, c; a.x = pk2(lo[0], lo[1]); a.y = pk2(lo[2], lo[3]); c.x = pk2(hi[0], hi[1]); c.y = pk2(hi[2], hi[3]); *(u32x2*)q = a; *(u32x2*)(q + 64) = c;
                                const float dk = __builtin_amdgcn_exp2f((float)(127 - (t & 127)) * ret_log2g(head));
                                bf16* kt = (bf16*)(ws + WS_RKT) + ((size_t)(b * 4 + head) * 128 + p0) * SEQ + t;
#pragma unroll
                                for (int k = 0; k < 4; ++k) { kt[(size_t)k * SEQ] = (bf16)(pk2(lo[k] * dk, 0.f) & 0xffffu); kt[(size_t)(64 + k) * SEQ] = (bf16)(pk2(hi[k] * dk, 0.f) & 0xffffu); } } }
                    }
                } else if (pn < 6 && prompt) {
                    const int b = row >> 12, t = row & (SEQ - 1);
#pragma unroll
                    for (int bj = 0; bj < 2; ++bj) { EZ_X(bj, x) bf16* vt = (bf16*)(ws + WS_RVT) + ((size_t)(b * 4 + 2 * (pn & 1) + bj) * 128 + 32 * wc + 8 * fq) * SEQ + t;
#pragma unroll
                        for (int j = 0; j < 8; ++j) vt[(size_t)j * SEQ] = (bf16)(pk2(x[j], 0.f) & 0xffffu); }
                } else if (pn == 8 || pn == 9 || pn == 10 || pn == 13) {
                    const bool norm = (pn < 10) || (pn == 10 && wc < 2), rope = norm || pn == 13;
                    EZ_X(0, x0) EZ_X(1, x1)
                    if (norm) { float ss = 0.f;
#pragma unroll
                        for (int j = 0; j < 8; ++j) ss += x0[j] * x0[j] + x1[j] * x1[j];
                        ss += shx<16>(ss, hl); ss += shx<32>(ss, hl);
                        const float rr = __builtin_amdgcn_rsqf(ss * (1.0f / 64.0f) + 1e-6f); const float* gn = (pn < 10) ? qgain : kgain;
#pragma unroll
                        for (int j = 0; j < 8; ++j) { const int d0 = (fq < 2) ? 4 * fq + (j >> 1) + 8 * (j & 1) : 8 * fq + j; x0[j] *= rr * gn[d0]; x1[j] *= rr * gn[32 + 8 * fq + j]; } }
                    if (rope) rope16(x0, (const f32x2*)(ws + WS_ROPEA) + (size_t)pos * 8, fq, hl);
                    if (pn < 10) { bf16* q = (bf16*)(ws + WS_AQ) + (size_t)row * 512 + (4 * (pn - 8) + wc) * 64 + 8 * fq; *(u32x4*)q = pack8(x0); *(u32x4*)(q + 32) = pack8(x1); }
                    else if (pn == 13) { bf16* q = (bf16*)(ws + WS_IQ) + (size_t)row * 256 + wc * 64 + 8 * fq; *(u32x4*)q = pack8(x0); *(u32x4*)(q + 32) = pack8(x1); }
                    else { const bool isk = wc < 2; const int hk = wc & 1;
                        float* dst = (isk ? (prompt ? out + O_KP + ((size_t)L * MP + row) * 128 : out + O_KS + ((size_t)L * MS + (row - MP)) * 128)
                                          : (prompt ? out + O_VP + ((size_t)L * MP + row) * 128 : out + O_VS + ((size_t)L * MS + (row - MP)) * 128)) + hk * 64 + 8 * fq;
                        *(f32x4*)dst = (f32x4){x0[0], x0[1], x0[2], x0[3]}; *(f32x4*)(dst + 4) = (f32x4){x0[4], x0[5], x0[6], x0[7]};
                        *(f32x4*)(dst + 32) = (f32x4){x1[0], x1[1], x1[2], x1[3]}; *(f32x4*)(dst + 36) = (f32x4){x1[4], x1[5], x1[6], x1[7]};
                        if (prompt) { bf16* d2 = (bf16*)(ws + (isk ? WS_KB : WS_VB)) + (size_t)row * 128 + hk * 64 + 8 * fq; *(u32x4*)d2 = pack8(x0); *(u32x4*)(d2 + 32) = pack8(x1); } }
                } else if (pn == 14) {
                    { EZ_X(0, x0)
                      if (wc == 0) rope16(x0, (const f32x2*)(ws + WS_ROPEA) + (size_t)pos * 8, fq, hl);
                      if (wc < 2) { float* dst = (prompt ? out + O_IKP + ((size_t)L * MP + row) * 64 : out + O_IKS + ((size_t)L * MS + (row - MP)) * 64) + 32 * wc + 8 * fq;
                          *(f32x4*)dst = (f32x4){x0[0], x0[1], x0[2], x0[3]}; *(f32x4*)(dst + 4) = (f32x4){x0[4], x0[5], x0[6], x0[7]};
                          if (prompt) *(u32x4*)((bf16*)(ws + WS_IKB) + (size_t)row * 64 + 32 * wc + 8 * fq) = pack8(x0); }
                      else if (wc == 2 && fq == 0) *(f32x4*)((float*)(ws + WS_IW) + (size_t)row * 4) = (f32x4){x0[0] * 0.0625f, x0[1] * 0.0625f, x0[2] * 0.0625f, x0[3] * 0.0625f}; }
                    { EZ_X(1, x1) *(u32x4*)(Z + zrow + pn * 256 + 128 + 32 * wc + 8 * fq) = pack8(x1); }
                } else {
#pragma unroll
                    for (int bj = 0; bj < 2; ++bj) { EZ_X(bj, x) *(u32x4*)(Z + zrow + pn * 256 + 128 * bj + 32 * wc + 8 * fq) = pack8(x); }
                }
                asm volatile("" ::: "memory"); }
#undef EZ_X
    }
};

struct InProjOrder {
    pg8::StaticOrder base; int G, c;
    __device__ void init(int G_, int c_) { base.init(MP, NZ, G_, c_); G = G_; c = c_; }
    __device__ bool next(int i, pg8::Unit& u) const {
        const int np = (MP / 256) * (NZ / 256), total = np + 4 * 15;
        const int cnt = (total - c + G - 1) / G;
        if (i >= cnt) return false;
        const int ii = (c & 1) ? cnt - 1 - i : i;
        const int L = ii * G + c;
        if (L < np) return base.next(ii, u);
        const int l2 = L - np;
        u.pm = MP / 256 + l2 / 15; u.pn = l2 % 15; return true;
    }
    __device__ __forceinline__ void a_ready(const pg8::Unit&) const {}
    __device__ __forceinline__ void done(const pg8::Unit&) const {}
};
template <int MODE> struct EpiGate {
    static constexpr bool PERM = true, AFTER_DRAIN = false;
    const bf16* Z; int gcol; bf16* TMP; bf16* MB;
    __device__ __forceinline__ void operator()(const f32x4 (&acc)[2][2][4][2], const pg8::Unit& u, int wr, int wc, int, int) const {
        const int hl_ = hw_lane(), fr = hl_ & 15, fq = hl_ >> 4;
        const int row0 = u.pm * 256 + wr * 64 + fr, col0 = u.pn * 256 + wc * 32 + 8 * fq;
        constexpr int AB = (MODE == 0) ? 2 : 1;
#pragma unroll
        for (int a0 = 0; a0 < 2; a0 += AB) {
            u32x4 gw[AB][4][2], tw[AB][4][2];
#pragma unroll
            for (int aa = 0; aa < AB; ++aa)
#pragma unroll
                for (int m = 0; m < 4; ++m)
#pragma unroll
                    for (int bj = 0; bj < 2; ++bj) { const int row = row0 + (a0 + aa) * 128 + m * 16, col = col0 + bj * 128;
                        gw[aa][m][bj] = *(const u32x4*)(Z + ((unsigned)row * NZ + (unsigned)(gcol + col)));
                        if (MODE == 1) tw[aa][m][bj] = *(const u32x4*)(TMP + ((unsigned)row * DM + (unsigned)col)); }
            asm volatile("" ::: "memory");
#pragma unroll
            for (int aa = 0; aa < AB; ++aa)
#pragma unroll
                for (int m = 0; m < 4; ++m)
#pragma unroll
                    for (int bj = 0; bj < 2; ++bj) { const int ai = a0 + aa; const int row = row0 + ai * 128 + m * 16, col = col0 + bj * 128; const unsigned off = (unsigned)row * DM + (unsigned)col;
                        float g[8]; unpack8(gw[aa][m][bj], g);
                        const f32x4 a0v = acc[ai][bj][m][0], a1v = acc[ai][bj][m][1];
                        float r[8];
#pragma unroll
                        for (int j = 0; j < 4; ++j) { r[j] = sigmoidf_(g[j]) * a0v[j]; r[4 + j] = sigmoidf_(g[4 + j]) * a1v[j]; }
                        if (MODE == 0) *(u32x4*)(TMP + off) = pack8(r);
                        else { float t[8]; unpack8(tw[aa][m][bj], t);
#pragma unroll
                            for (int j = 0; j < 8; ++j) r[j] += t[j];
                            *(u32x4*)(MB + off) = pack8(r); } }
            asm volatile("" ::: "memory"); }
    }
};
struct EpiRes {
    static constexpr bool PERM = true, AFTER_DRAIN = false;
    const float* xa; const float* xb; const bf16* xh; bf16* XB1;
    __device__ __forceinline__ void operator()(const f32x4 (&acc)[2][2][4][2], const pg8::Unit& u, int wr, int wc, int, int) const {
        const int hl_ = hw_lane(), fr = hl_ & 15, fq = hl_ >> 4;
        const int row0 = u.pm * 256 + wr * 64 + fr, col0 = u.pn * 256 + wc * 32 + 8 * fq;
        const float* xr = (u.pm < MP / 256) ? xa : xb - (size_t)MP * DM;
#pragma unroll
        for (int ai = 0; ai < 2; ++ai) {
            u32x4 xw[4][2][2];
#pragma unroll
            for (int m = 0; m < 4; ++m)
#pragma unroll
                for (int bj = 0; bj < 2; ++bj) { const unsigned off = (unsigned)(row0 + ai * 128 + m * 16) * DM + (unsigned)(col0 + bj * 128);
                    if (xh != nullptr) xw[m][bj][0] = *(const u32x4*)(xh + off);
                    else { xw[m][bj][0] = *(const u32x4*)(xr + off); xw[m][bj][1] = *(const u32x4*)(xr + off + 4); } }
            asm volatile("" ::: "memory");
#pragma unroll
            for (int m = 0; m < 4; ++m)
#pragma unroll
                for (int bj = 0; bj < 2; ++bj) { const unsigned off = (unsigned)(row0 + ai * 128 + m * 16) * DM + (unsigned)(col0 + bj * 128);
                    float x[8];
                    if (xh != nullptr) unpack8(xw[m][bj][0], x);
                    else { const f32x4 x0 = __builtin_bit_cast(f32x4, xw[m][bj][0]), x1 = __builtin_bit_cast(f32x4, xw[m][bj][1]); x[0] = x0[0]; x[1] = x0[1]; x[2] = x0[2]; x[3] = x0[3]; x[4] = x1[0]; x[5] = x1[1]; x[6] = x1[2]; x[7] = x1[3]; }
                    const f32x4 a0 = acc[ai][bj][m][0], a1 = acc[ai][bj][m][1];
#pragma unroll
                    for (int j = 0; j < 4; ++j) { x[j] += a0[j]; x[4 + j] += a1[j]; }
                    *(u32x4*)(XB1 + off) = pack8(x); }
            asm volatile("" ::: "memory"); }
    }
};
template <int MODE> struct EpiPle {
    static constexpr bool PERM = true, AFTER_DRAIN = false;
    bf16* TMP; const bf16* XB1; float* Y; bf16* XB0; float* rowss;
    __device__ __forceinline__ void operator()(const f32x4 (&acc)[2][2][4][2], const pg8::Unit& u, int wr, int wc, int, int) const {
        const int hl_ = hw_lane(), fr = hl_ & 15, fq = hl_ >> 4;
        const int row0 = u.pm * 256 + wr * 64 + fr, col0 = u.pn * 256 + wc * 32 + 8 * fq;
#pragma unroll
        for (int ai = 0; ai < 2; ++ai) {
            u32x4 tw[4][2], xw[4][2];
            if (MODE != 0) {
#pragma unroll
                for (int m = 0; m < 4; ++m)
#pragma unroll
                    for (int bj = 0; bj < 2; ++bj) { const unsigned off = (unsigned)(row0 + ai * 128 + m * 16) * DM + (unsigned)(col0 + bj * 128);
                        tw[m][bj] = *(const u32x4*)(TMP + off); xw[m][bj] = *(const u32x4*)(XB1 + off); }
                asm volatile("" ::: "memory"); }
#pragma unroll
            for (int m = 0; m < 4; ++m) { const int row = row0 + ai * 128 + m * 16; float ssq = 0.f;
#pragma unroll
                for (int bj = 0; bj < 2; ++bj) { const unsigned off = (unsigned)row * DM + (unsigned)(col0 + bj * 128);
                    const f32x4 a0 = acc[ai][bj][m][0], a1 = acc[ai][bj][m][1];
                    if (MODE == 0) { float r[8];
#pragma unroll
                        for (int j = 0; j < 4; ++j) { r[j] = sigmoidf_(a0[j]); r[4 + j] = sigmoidf_(a1[j]); }
                        *(u32x4*)(TMP + off) = pack8(r); }
                    else { float t[8], x[8]; unpack8(tw[m][bj], t); unpack8(xw[m][bj], x);
#pragma unroll
                        for (int j = 0; j < 4; ++j) { x[j] += t[j] * a0[j]; x[4 + j] += t[4 + j] * a1[j]; }
                        if (MODE == 2) { *(f32x4*)(Y + off) = (f32x4){x[0], x[1], x[2], x[3]}; *(f32x4*)(Y + off + 4) = (f32x4){x[4], x[5], x[6], x[7]}; }
                        *(u32x4*)(XB0 + off) = pack8(x);
                        if (MODE == 1) {
#pragma unroll
                            for (int j = 0; j < 8; ++j) ssq += x[j] * x[j]; } } }
                if (MODE == 1) { const int ln_ = fr + 16 * fq; ssq += shx<16>(ssq, ln_); ssq += shx<32>(ssq, ln_); if (fq == 0) atomicAdd(rowss + row, ssq); } }
            asm volatile("" ::: "memory"); }
    }
};
__device__ __forceinline__ void p0_transpose_item(const float* W, int ldw, int K, const float* gain, bf16* WT, int nblk, int item, bool win_map, LAS float* scr, int lane) {
    const int kb = item / nblk, nb = item % nblk, k0 = 64 * kb, n0 = 32 * nb;
    const int np = n0 + (lane & 31); int n = np; bool valid = true;
    if (win_map) { n = win_orig_col(np); valid = n >= 0; if (!valid) n = 0; }
#pragma unroll
    for (int h = 0; h < 2; ++h) {
        float wv[16], gv[16];
#pragma unroll
        for (int i = 0; i < 16; ++i) { const int kk = 2 * (16 * h + i) + (lane >> 5); wv[i] = valid ? W[(size_t)(k0 + kk) * ldw + n] : 0.f; gv[i] = gain ? gain[k0 + kk] : 1.0f; }
        asm volatile("" ::: "memory");
#pragma unroll
        for (int i = 0; i < 16; ++i) { const int kk = 2 * (16 * h + i) + (lane >> 5); scr[kk * 33 + (lane & 31)] = wv[i] * gv[i]; } }
    LDS_WAIT(); asm volatile("" ::: "memory");
    const int c = lane & 7;
#pragma unroll
    for (int j = 0; j < 4; ++j) { const int nn = (lane >> 3) + 8 * j; const LAS float* s = scr + (8 * c) * 33 + nn;
        u32x4 o; o.x = pk2(s[0 * 33], s[1 * 33]); o.y = pk2(s[2 * 33], s[3 * 33]); o.z = pk2(s[4 * 33], s[5 * 33]); o.w = pk2(s[6 * 33], s[7 * 33]);
        *(u32x4*)(WT + (size_t)(n0 + nn) * K + k0 + 8 * c) = o; }
    LDS_WAIT(); asm volatile("" ::: "memory");
}
__device__ __forceinline__ void p0_prologue(PK P, const Ctx& C, int part, LAS float* scr, int s = 0, int ns = 1) {
    unsigned char* ws = P->ws;
    constexpr int I_IN = 16 * (NZ / 32), I_OR = 8 * 32, I_OUT = 16 * 32, I_PPJ = 4 * 32, I_LAYER = I_IN + 2 * I_OR + 2 * I_OUT + I_PPJ;
    for (int it = (part == 0 ? 0 : I_IN) + C.gw + s * C.ngw; it < (part == 0 ? I_IN : DEPTH * I_LAYER); it += ns * C.ngw) {
        const int L = it / I_LAYER; int r = it % I_LAYER;
        if (r < I_IN) { p0_transpose_item(P->in[I_WIN] + (size_t)L * DM * WIN_N, WIN_N, DM, P->in[I_GAIN] + L * DM, (bf16*)(ws + WS_WIN) + (size_t)L * NZ * DM, NZ / 32, r, true, scr, C.lane); continue; } r -= I_IN;
        if (r < I_OR) { p0_transpose_item(P->in[I_WOR] + (size_t)L * 512 * DM, DM, 512, nullptr, (bf16*)(ws + WS_WOR) + (size_t)L * DM * 512, 32, r, false, scr, C.lane); continue; } r -= I_OR;
        if (r < I_OR) { p0_transpose_item(P->in[I_WOA] + (size_t)L * 512 * DM, DM, 512, nullptr, (bf16*)(ws + WS_WOA) + (size_t)L * DM * 512, 32, r, false, scr, C.lane); continue; } r -= I_OR;
        if (r < I_OUT) { p0_transpose_item(P->in[I_WOUT] + (size_t)L * DM * DM, DM, DM, nullptr, (bf16*)(ws + WS_WOUT) + (size_t)L * DM * DM, 32, r, false, scr, C.lane); continue; } r -= I_OUT;
        if (r < I_OUT) { p0_transpose_item(P->in[I_WPG] + (size_t)L * DM * DM, DM, DM, nullptr, (bf16*)(ws + WS_WPG) + (size_t)L * DM * DM, 32, r, false, scr, C.lane); continue; } r -= I_OUT;
        p0_transpose_item(P->in[I_WPP] + (size_t)L * 256 * DM, DM, 256, nullptr, (bf16*)(ws + WS_WPP) + (size_t)L * DM * 256, 32, r, false, scr, C.lane);
    }
    bf16* XB0 = (bf16*)(ws + WS_XB0); float* rowss0 = (float*)(ws + WS_ROWSS0);
    if (part == 0) for (int row0 = C.gw; row0 < MT; row0 += 4 * C.ngw) {
        f32x4 v[4][4];
#pragma unroll
        for (int q = 0; q < 4; ++q) { const int row = min(row0 + q * C.ngw, MT - 1);
            const float* xr = (row < MP) ? P->in[I_XP] + (size_t)row * DM : P->in[I_XS] + (size_t)(row - MP) * DM;
#pragma unroll
            for (int j = 0; j < 4; ++j) v[q][j] = *(const f32x4*)(xr + 256 * j + 4 * C.lane); }
        asm volatile("" ::: "memory");
#pragma unroll
        for (int q = 0; q < 4; ++q) { const int row = row0 + q * C.ngw;
            if (row < MT) { float ss = 0.f;
#pragma unroll
                for (int j = 0; j < 4; ++j) { const f32x4 w4 = v[q][j]; ss += (w4[0] * w4[0] + w4[1] * w4[1]) + (w4[2] * w4[2] + w4[3] * w4[3]);
                    u32x2 w; w.x = pk2(w4[0], w4[1]); w.y = pk2(w4[2], w4[3]); *(u32x2*)(XB0 + (size_t)row * DM + 256 * j + 4 * C.lane) = w; }
                ss = wave_sum(ss, C.lane);
                if (C.lane == 0) rowss0[row] = ss; } }
    }
    if (part == 1) for (int r0 = C.gw + s * C.ngw; r0 < DEPTH * MT; r0 += 4 * ns * C.ngw) {
        f32x4 v[4];
#pragma unroll
        for (int q = 0; q < 4; ++q) { const int r = min(r0 + q * ns * C.ngw, DEPTH * MT - 1); const int L = r / MT, row = r - L * MT;
            const float* pr = (row < MP) ? P->in[I_PP] + ((size_t)L * MP + row) * 256 : P->in[I_PS] + ((size_t)L * MS + (row - MP)) * 256; v[q] = *(const f32x4*)(pr + 4 * C.lane); }
        asm volatile("" ::: "memory");
#pragma unroll
        for (int q = 0; q < 4; ++q) { const int r = r0 + q * ns * C.ngw; if (r < DEPTH * MT) { const int L = r / MT, row = r - L * MT;
            u32x2 w; w.x = pk2(v[q][0], v[q][1]); w.y = pk2(v[q][2], v[q][3]); *(u32x2*)((bf16*)(ws + WS_PB) + ((size_t)L * MT + row) * 256 + 4 * C.lane) = w; } } }
    if (part != 0) return;
    f32x2* rr = (f32x2*)(ws + WS_ROPER); f32x2* ra = (f32x2*)(ws + WS_ROPEA);
    for (int i = C.blk * NTHREADS + C.tid; i < 4096 * 64; i += C.nblk * NTHREADS) { const int pos = i >> 6, k = i & 63;
        const float fr = expf((-9.210340371976184f * (float)k) / 64.0f), ang = (float)pos * fr; rr[i] = (f32x2){cosf(ang), sinf(ang)}; }
    for (int i = C.blk * NTHREADS + C.tid; i < 4096 * 8; i += C.nblk * NTHREADS) { const int pos = i >> 3, k = i & 7;
        const float fr = expf((-13.122363377404328f * (float)k) / 8.0f), ang = (float)pos * fr; ra[i] = (f32x2){cosf(ang), sinf(ang)}; }
}

constexpr int LDT = 272;
__device__ __forceinline__ void post_ret_tile(PK P, const Ctx& C, int unit) {
    unsigned char* ws = P->ws; const bf16* Z = (const bf16*)(ws + WS_Z);
    const int b = unit >> 7, h = (unit >> 5) & 3, n = unit & 31, t0 = n * 128; const int bh = b * 4 + h;
    LAS unsigned char* TK = C.lds; LAS unsigned char* TV = C.lds + 128 * LDT;
    const f32x2* ropeR = (const f32x2*)(ws + WS_ROPER);
    bf16* RQ = (bf16*)(ws + WS_RQ); bf16* RK = (bf16*)(ws + WS_RK);
    const float lg2 = ret_log2g(h);
#pragma unroll
    for (int u = 0; u < 2; ++u) {
        const int idx = C.tid + 512 * u, r = idx >> 3, j = idx & 7, t = t0 + r; const size_t grow = (size_t)b * SEQ + t;
        float cs[8], sn[8];
#pragma unroll
        for (int e = 0; e < 8; e += 2) { const f32x4 v = *(const f32x4*)(ropeR + (size_t)t * 64 + 8 * j + e); cs[e] = v[0]; sn[e] = v[1]; cs[e + 1] = v[2]; sn[e + 1] = v[3]; }
        { float x1[8], x2[8], o1[8], o2[8]; unpack8(*(const u32x4*)(Z + grow * NZ + ZC_RQ + h * 128 + 8 * j), x1); unpack8(*(const u32x4*)(Z + grow * NZ + ZC_RQ + h * 128 + 64 + 8 * j), x2);
#pragma unroll
          for (int e = 0; e < 8; ++e) { o1[e] = x1[e] * cs[e] - x2[e] * sn[e]; o2[e] = x2[e] * cs[e] + x1[e] * sn[e]; }
          *(u32x4*)(RQ + grow * 512 + h * 128 + 8 * j) = pack8(o1); *(u32x4*)(RQ + grow * 512 + h * 128 + 64 + 8 * j) = pack8(o2); }
        { float x1[8], x2[8], o1[8], o2[8]; unpack8(*(const u32x4*)(Z + grow * NZ + ZC_RK + h * 128 + 8 * j), x1); unpack8(*(const u32x4*)(Z + grow * NZ + ZC_RK + h * 128 + 64 + 8 * j), x2);
          const float sc = 0.08838834764831845f, dk = __builtin_amdgcn_exp2f((float)(127 - r) * lg2);
#pragma unroll
          for (int e = 0; e < 8; ++e) { o1[e] = (x1[e] * cs[e] - x2[e] * sn[e]) * sc; o2[e] = (x2[e] * cs[e] + x1[e] * sn[e]) * sc; }
          *(u32x4*)(RK + grow * 512 + h * 128 + 8 * j) = pack8(o1); *(u32x4*)(RK + grow * 512 + h * 128 + 64 + 8 * j) = pack8(o2);
#pragma unroll
          for (int e = 0; e < 8; ++e) { *(LAS bf16*)(TK + (8 * j + e) * LDT + 2 * r) = (bf16)(pk2(o1[e] * dk, 0.f) & 0xffffu); *(LAS bf16*)(TK + (64 + 8 * j + e) * LDT + 2 * r) = (bf16)(pk2(o2[e] * dk, 0.f) & 0xffffu); } }
    }
#pragma unroll
    for (int u = 0; u < 4; ++u) {
        const int idx = C.tid + 512 * u, r = idx >> 4, c = idx & 15; const size_t grow = (size_t)b * SEQ + t0 + r;
        const u32x4 w = *(const u32x4*)(Z + grow * NZ + ZC_RV + h * 128 + 8 * c);
        const unsigned ww[4] = {w.x, w.y, w.z, w.w};
#pragma unroll
        for (int e = 0; e < 4; ++e) { *(LAS bf16*)(TV + (8 * c + 2 * e) * LDT + 2 * r) = (bf16)(ww[e] & 0xffffu); *(LAS bf16*)(TV + (8 * c + 2 * e + 1) * LDT + 2 * r) = (bf16)(ww[e] >> 16); }
    }
    __syncthreads();
    bf16* RKT = (bf16*)(ws + WS_RKT); bf16* RVT = (bf16*)(ws + WS_RVT);
#pragma unroll
    for (int u = 0; u < 4; ++u) {
        const int idx = C.tid + 512 * u, d = idx >> 4, c = idx & 15;
        const u32x4 a = *(const LAS u32x4*)(TK + d * LDT + 16 * c), v = *(const LAS u32x4*)(TV + d * LDT + 16 * c);
        *(u32x4*)(RKT + ((size_t)bh * 128 + d) * SEQ + t0 + 8 * c) = a; *(u32x4*)(RVT + ((size_t)bh * 128 + d) * SEQ + t0 + 8 * c) = v;
    }
    __syncthreads();
}
__device__ __forceinline__ void post_token(PK P, const Ctx& C, int L, int row) {
    unsigned char* ws = P->ws; const bf16* Zr = (const bf16*)(ws + WS_Z) + (size_t)row * NZ; const int lane = C.lane;
    const bool prompt = row < MP; const int sb = (row - MP) >> 3, sc = (row - MP) & 7;
    const int pos = prompt ? (row & (SEQ - 1)) : PAST + sc;
    const f32x2* ropeA = (const f32x2*)(ws + WS_ROPEA) + (size_t)pos * 8;
    const int c8 = lane & 7;
    float cs[8], sn[8];
#pragma unroll
    for (int e = 0; e < 8; e += 2) { const f32x4 v = *(const f32x4*)(ropeA + e); cs[e] = v[0]; sn[e] = v[1]; cs[e + 1] = v[2]; sn[e + 1] = v[3]; }
    { float x[8]; unpack8(*(const u32x4*)(Zr + ZC_AQ + 8 * lane), x);
      float ss = 0.f;
#pragma unroll
      for (int e = 0; e < 8; ++e) ss += x[e] * x[e];
      ss += shx<1>(ss, lane); ss += shx<2>(ss, lane); ss += shx<4>(ss, lane);
      const float rs = __builtin_amdgcn_rsqf(ss * (1.0f / 64.0f) + 1e-6f);
      const float* qg = P->in[I_QG] + L * 64 + 8 * c8; float o[8];
#pragma unroll
      for (int e = 0; e < 8; ++e) { const float y = x[e] * rs * qg[e]; const float pr = shx<1>(y, lane); o[e] = (c8 == 0) ? y * cs[e] - pr * sn[e] : (c8 == 1) ? y * cs[e] + pr * sn[e] : y; }
      *(u32x4*)((bf16*)(ws + WS_AQ) + (size_t)row * 512 + 8 * lane) = pack8(o); }
    { float x[8]; unpack8(*(const u32x4*)(Zr + ZC_AK + 8 * (lane & 31)), x);
      float ss = 0.f;
#pragma unroll
      for (int e = 0; e < 8; ++e) ss += x[e] * x[e];
      ss += shx<1>(ss, lane); ss += shx<2>(ss, lane); ss += shx<4>(ss, lane);
      const float rs = __builtin_amdgcn_rsqf(ss * (1.0f / 64.0f) + 1e-6f);
      const float* kg = P->in[I_KG] + L * 64 + 8 * c8; float o[8]; const bool isk = (lane & 31) < 16;
#pragma unroll
      for (int e = 0; e < 8; ++e) { const float y = isk ? x[e] * rs * kg[e] : x[e]; const float pr = shx<1>(y, lane); o[e] = (isk && c8 == 0) ? y * cs[e] - pr * sn[e] : (isk && c8 == 1) ? y * cs[e] + pr * sn[e] : y; }
      if (lane < 32) {
          const int l16 = lane & 15;
          float* dst = isk ? (prompt ? P->out + O_KP + ((size_t)L * MP + row) * 128 : P->out + O_KS + ((size_t)L * MS + (row - MP)) * 128)
                           : (prompt ? P->out + O_VP + ((size_t)L * MP + row) * 128 : P->out + O_VS + ((size_t)L * MS + (row - MP)) * 128);
          *(f32x4*)(dst + 8 * l16) = (f32x4){o[0], o[1], o[2], o[3]}; *(f32x4*)(dst + 8 * l16 + 4) = (f32x4){o[4], o[5], o[6], o[7]};
          if (prompt) { bf16* d2 = (bf16*)(ws + (isk ? WS_KB : WS_VB)) + (size_t)row * 128 + 8 * l16; *(u32x4*)d2 = pack8(o); } } }
    { const int l40 = lane < 40 ? lane : 39; float x[8]; unpack8(*(const u32x4*)(Zr + ZC_IQ + 8 * l40), x); float o[8];
#pragma unroll
      for (int e = 0; e < 8; ++e) { const float y = x[e]; const float pr = shx<1>(y, lane); o[e] = (c8 == 0) ? y * cs[e] - pr * sn[e] : (c8 == 1) ? y * cs[e] + pr * sn[e] : y; }
      if (lane < 32) *(u32x4*)((bf16*)(ws + WS_IQ) + (size_t)row * 256 + 8 * lane) = pack8(o);
      else if (lane < 40) { const int l8 = lane - 32;
          float* dst = prompt ? P->out + O_IKP + ((size_t)L * MP + row) * 64 : P->out + O_IKS + ((size_t)L * MS + (row - MP)) * 64;
          *(f32x4*)(dst + 8 * l8) = (f32x4){o[0], o[1], o[2], o[3]}; *(f32x4*)(dst + 8 * l8 + 4) = (f32x4){o[4], o[5], o[6], o[7]};
          if (prompt) *(u32x4*)((bf16*)(ws + WS_IKB) + (size_t)row * 64 + 8 * l8) = pack8(o); } }
    if (lane < 4) ((float*)(ws + WS_IW))[(size_t)row * 4 + lane] = bf2f(Zr[ZC_IW + lane]) * 0.0625f;
    { const float* pr = prompt ? P->in[I_PP] + ((size_t)L * MP + row) * 256 : P->in[I_PS] + ((size_t)L * MS + (row - MP)) * 256;
      const f32x4 v = *(const f32x4*)(pr + 4 * lane); u32x2 w; w.x = pk2(v[0], v[1]); w.y = pk2(v[2], v[3]); *(u32x2*)((bf16*)(ws + WS_PB) + (size_t)row * 256 + 4 * lane) = w; }
    (void)sb;
}
__device__ __forceinline__ void phase_post(PK P, const Ctx& C, int L) {
    for (int u = C.blk; u < 512; u += C.nblk) post_ret_tile(P, C, u);
    for (int row = C.gw; row < MT; row += 2 * C.ngw) { post_token(P, C, L, row); if (row + C.ngw < MT) post_token(P, C, L, row + C.ngw); }
}

__device__ __forceinline__ void ret_state_item(PK P, const Ctx& C, int L, int item) {
    unsigned char* ws = P->ws; const bf16* RKT = (const bf16*)(ws + WS_RKT); const bf16* RVT = (const bf16*)(ws + WS_RVT); bf16* ST = (bf16*)(ws + WS_ST);
    const int bh = item >> 6, et = (item >> 3) & 7, dt = item & 7, lane = C.lane, r16 = lane & 15, g = lane >> 4;
    const float dec = __builtin_amdgcn_exp2f(128.0f * ret_log2g(bh & 3));
    LAS unsigned char* img = C.lds + 36864 + (C.wave & 3) * 8704;
    const int tq = lane >> 4, c16 = lane & 15;
    const bf16* vp = RVT + ((size_t)bh * 128 + 16 * et + tq) * SEQ + 8 * c16;
    const bf16* kp = RKT + ((size_t)bh * 128 + 16 * dt + tq) * SEQ + 8 * c16;
    f32x4 S = {0.f, 0.f, 0.f, 0.f};
    u32x4 rv[2][2][4], rk[2][2][4];
#define RS_LOAD(buf_, n0_) do { _Pragma("unroll") for (int i = 0; i < 2; ++i) _Pragma("unroll") for (int q = 0; q < 4; ++q) { \
        rv[buf_][i][q] = *(const u32x4*)(vp + (size_t)(4 * q) * SEQ + ((n0_) + i) * 128); rk[buf_][i][q] = *(const u32x4*)(kp + (size_t)(4 * q) * SEQ + ((n0_) + i) * 128); } } while (0)
#define RS_CHUNK(buf_, i_, n_, refill_) do { \
        _Pragma("unroll") for (int q = 0; q < 4; ++q) { *(LAS u32x4*)(img + (tq + 4 * q) * 272 + 16 * c16) = rv[buf_][i_][q]; *(LAS u32x4*)(img + (16 + tq + 4 * q) * 272 + 16 * c16) = rk[buf_][i_][q]; } \
        refill_; \
        LDS_WAIT(); asm volatile("" ::: "memory"); \
        f32x4 acc = {0.f, 0.f, 0.f, 0.f}; \
        _Pragma("unroll") for (int kk = 0; kk < 4; ++kk) { const bf16x8 a = *(const LAS bf16x8*)(img + r16 * 272 + 64 * kk + 16 * g), b = *(const LAS bf16x8*)(img + (16 + r16) * 272 + 64 * kk + 16 * g); acc = mfma16(a, b, acc); } \
        LDS_WAIT(); asm volatile("" ::: "memory"); \
        bf16* st = ST + (((size_t)bh * 32 + (n_)) * 128 + 16 * et + 4 * g) * 128 + 16 * dt + r16; \
        _Pragma("unroll") for (int r = 0; r < 4; ++r) st[r * 128] = (bf16)(pk2(S[r], 0.f) & 0xffffu); \
        S = S * dec + acc; } while (0)
    RS_LOAD(0, 0); RS_LOAD(1, 2);
    asm volatile("" ::: "memory");
#pragma unroll 1
    for (int n0 = 0; n0 < 32; n0 += 4) {
        RS_CHUNK(0, 0, n0, (void)0);
        RS_CHUNK(0, 1, n0 + 1, if (n0 + 4 < 32) RS_LOAD(0, n0 + 4));
        RS_CHUNK(1, 0, n0 + 2, (void)0);
        RS_CHUNK(1, 1, n0 + 3, if (n0 + 6 < 32) RS_LOAD(1, n0 + 6));
        asm volatile("" : "+v"(S));
    }
#undef RS_LOAD
#undef RS_CHUNK
    float* o = P->out + O_RSP + ((size_t)L * 16 + bh) * 16384 + (size_t)(16 * dt + r16) * 128 + 16 * et + 4 * g;
    *(f32x4*)o = S;
}
__device__ __forceinline__ void ret_sample_unit(PK P, const Ctx& C, int L, int unit) {
    unsigned char* ws = P->ws; const bf16* Z = (const bf16*)(ws + WS_Z);
    const int b = unit >> 2, h = unit & 3, tid = C.tid; const int r0 = MP + b * 8;
    LAS float* q = (LAS float*)C.lds;
    LAS float* kp = q + 1024;
    LAS float* v = kp + 1024;
    LAS float* rz = v + 1024;
    LAS float* A = rz + 1024;
    LAS float* op = A + 64;
    const float lg2 = ret_log2g(h);
    const float* S0 = P->in[I_STATE] + (((size_t)L * DB + b) * 4 + h) * 16384;
    float s0v[32];
    { const int dq = tid >> 7, e = tid & 127;
#pragma unroll
      for (int dd = 0; dd < 32; ++dd) s0v[dd] = S0[(dq * 32 + dd) * 128 + e]; }
    asm volatile("" ::: "memory");
    { const int c = tid >> 6, i = tid & 63; const size_t row = (size_t)(r0 + c);
      const f32x2 cs = ((const f32x2*)(ws + WS_ROPER))[(size_t)(PAST + c) * 64 + i];
      const float q1 = bf2f(Z[row * NZ + ZC_RQ + h * 128 + i]), q2 = bf2f(Z[row * NZ + ZC_RQ + h * 128 + 64 + i]);
      q[i * 8 + c] = q1 * cs[0] - q2 * cs[1]; q[(64 + i) * 8 + c] = q2 * cs[0] + q1 * cs[1];
      const float k1 = bf2f(Z[row * NZ + ZC_RK + h * 128 + i]), k2 = bf2f(Z[row * NZ + ZC_RK + h * 128 + 64 + i]);
      const float ks = 0.08838834764831845f * __builtin_amdgcn_exp2f((float)(7 - c) * lg2);
      kp[i * 8 + c] = (k1 * cs[0] - k2 * cs[1]) * ks; kp[(64 + i) * 8 + c] = (k2 * cs[0] + k1 * cs[1]) * ks;
      v[c * 128 + i] = bf2f(Z[row * NZ + ZC_RV + h * 128 + i]); v[c * 128 + 64 + i] = bf2f(Z[row * NZ + ZC_RV + h * 128 + 64 + i]);
      rz[c * 128 + i] = bf2f(Z[row * NZ + ZC_RZ + h * 128 + i]); rz[c * 128 + 64 + i] = bf2f(Z[row * NZ + ZC_RZ + h * 128 + 64 + i]); }
    __syncthreads();
    { const int pr = tid >> 3, part = tid & 7, c = pr >> 3, s2 = pr & 7; float d = 0.f;
#pragma unroll
      for (int dd = 0; dd < 16; ++dd) d += q[(part * 16 + dd) * 8 + c] * kp[(part * 16 + dd) * 8 + s2];
      d += shx<1>(d, tid & 63); d += shx<2>(d, tid & 63); d += shx<4>(d, tid & 63);
      if (part == 0) A[pr] = (s2 <= c) ? d * __builtin_amdgcn_exp2f((float)(c - 7) * lg2) : 0.f; }
    { const int dq = tid >> 7, e = tid & 127; float vr[8], acc[8];
#pragma unroll
      for (int c = 0; c < 8; ++c) { vr[c] = v[c * 128 + e]; acc[c] = 0.f; }
      const float g8 = __builtin_amdgcn_exp2f(8.0f * lg2);
      float* S1 = P->out + O_RSS + (((size_t)L * DB + b) * 4 + h) * 16384;
#pragma unroll
      for (int dd = 0; dd < 32; ++dd) { const int d = dq * 32 + dd; const float s0 = s0v[dd];
          const f32x4 qa = *(const LAS f32x4*)(q + d * 8), qb = *(const LAS f32x4*)(q + d * 8 + 4), ka = *(const LAS f32x4*)(kp + d * 8), kb = *(const LAS f32x4*)(kp + d * 8 + 4);
          float sn = s0 * g8;
#pragma unroll
          for (int c = 0; c < 4; ++c) { acc[c] += qa[c] * s0; acc[4 + c] += qb[c] * s0; sn += ka[c] * vr[c]; sn += kb[c] * vr[4 + c]; }
          S1[d * 128 + e] = sn; }
#pragma unroll
      for (int c = 0; c < 8; ++c) op[(dq * 8 + c) * 128 + e] = acc[c]; }
    __syncthreads();
    { const int c = tid >> 6, i = tid & 63; float o[2]; const float gq = __builtin_amdgcn_exp2f((float)(c + 1) * lg2);
#pragma unroll
      for (int u = 0; u < 2; ++u) { const int e = i + 64 * u; float s = (op[(0 * 8 + c) * 128 + e] + op[(1 * 8 + c) * 128 + e]) + (op[(2 * 8 + c) * 128 + e] + op[(3 * 8 + c) * 128 + e]); s *= gq;
          for (int sidx = 0; sidx <= c; ++sidx) s += A[c * 8 + sidx] * v[sidx * 128 + e];
          o[u] = s; }
      float sm = o[0] + o[1];
      sm = wave_sum(sm, i);
      const float mu = sm * (1.0f / 128.0f); float qv = (o[0] - mu) * (o[0] - mu) + (o[1] - mu) * (o[1] - mu);
      qv = wave_sum(qv, i);
      const float rstd = __builtin_amdgcn_rsqf(qv * (1.0f / 128.0f) + 1e-5f);
      bf16* og = (bf16*)(ws + WS_OGR) + (size_t)(r0 + c) * 512 + h * 128;
#pragma unroll
      for (int u = 0; u < 2; ++u) { const int e = i + 64 * u; og[e] = (bf16)(pk2((o[u] - mu) * rstd * siluf_(rz[c * 128 + e]), 0.f) & 0xffffu); } }
    __syncthreads();
}
template <bool SAMPLE>
__device__ __forceinline__ void score_item(PK P, const Ctx& C, int L, int b, int qblk, int kc) {
    constexpr int QG = SAMPLE ? 1 : 2;
    constexpr int TG = SAMPLE ? 4 : 5;
    unsigned char* ws = P->ws; const int lane = C.lane, r32 = lane & 31, hf = lane >> 5;
    const bf16* IQ = (const bf16*)(ws + WS_IQ); const float* IW = (const float*)(ws + WS_IW);
    const int q0 = SAMPLE ? 0 : qblk * 16;
    const size_t rowbase = SAMPLE ? (size_t)MP + b * 8 : (size_t)b * SEQ + q0;
    bf16x8 af[QG][4]; f32x4 wv[QG][4];
#pragma unroll
    for (int gq = 0; gq < QG; ++gq) {
#pragma unroll
        for (int s = 0; s < 4; ++s) af[gq][s] = *(const bf16x8*)(IQ + (rowbase + 8 * gq + (r32 >> 2)) * 256 + (r32 & 3) * 64 + 16 * s + 8 * hf);
#pragma unroll
        for (int i = 0; i < 4; ++i) wv[gq][i] = *(const f32x4*)(IW + (rowbase + 8 * gq + 2 * i + hf) * 4); }
    const int nkeys = SAMPLE ? PAST + DS : q0 + 16;
    const int kt_end = min(kc * 16 + 16, (nkeys + 31) >> 5);
    const int* pt = (const int*)P->in[I_PT] + b * NPAGES;
    const float* cik = P->in[I_CIK] + (size_t)L * NPOOL * 128 * 64; const float* nik = P->out + O_IKS + ((size_t)L * DB + b) * DS * 64;
    const bf16* ikb = (const bf16*)(ws + WS_IKB) + (size_t)b * SEQ * 64;
    u32x4 cur[TG][SAMPLE ? 8 : 4];
    auto load_group = [&](int kt0, u32x4 (&dst)[TG][SAMPLE ? 8 : 4]) {
#pragma unroll
        for (int j = 0; j < TG; ++j) { const int kt = min(kt0 + j, kt_end - 1); const int key = kt * 32 + r32;
            if (SAMPLE) { const int kcl = key < PAST + DS ? key : PAST + DS - 1;
                const float* kr = (kcl < PAST) ? cik + ((size_t)pt[(kt >> 2) & 15] * 128 + (kcl & 127)) * 64 : nik + (size_t)(kcl - PAST) * 64;
#pragma unroll
                for (int s = 0; s < 4; ++s) { dst[j][2 * s] = *(const u32x4*)(kr + 16 * s + 8 * hf); dst[j][2 * s + 1] = *(const u32x4*)(kr + 16 * s + 8 * hf + 4); }
            } else { const bf16* kr = ikb + (size_t)key * 64;
#pragma unroll
                for (int s = 0; s < 4; ++s) dst[j][s] = *(const u32x4*)(kr + 16 * s + 8 * hf); } }
    };
    for (int kt0 = kc * 16; kt0 < kt_end; kt0 += TG) {
        load_group(kt0, cur);
#pragma unroll
        for (int j = 0; j < TG; ++j) { const int kt = kt0 + j;
            if (kt < kt_end) {
                const int key = kt * 32 + r32;
                bf16x8 bfr[4];
#pragma unroll
                for (int s = 0; s < 4; ++s) {
                    if (SAMPLE) { const f32x4 a = __builtin_bit_cast(f32x4, cur[j][2 * s]), c = __builtin_bit_cast(f32x4, cur[j][2 * s + 1]);
                        u32x4 w; w.x = pk2(a[0], a[1]); w.y = pk2(a[2], a[3]); w.z = pk2(c[0], c[1]); w.w = pk2(c[2], c[3]); bfr[s] = as_bf16x8(w); }
                    else bfr[s] = as_bf16x8(cur[j][s]); }
#pragma unroll
                for (int gq = 0; gq < QG; ++gq) {
                    f32x16 acc;
#pragma unroll
                    for (int i = 0; i < 16; ++i) acc[i] = 0.f;
#pragma unroll
                    for (int s = 0; s < 4; ++s) acc = mfma32(af[gq][s], bfr[s], acc);
                    float sc[4];
#pragma unroll
                    for (int i = 0; i < 4; ++i) {
                        float v = fmaxf(acc[4 * i + 0], 0.f) * wv[gq][i][0]; v += fmaxf(acc[4 * i + 1], 0.f) * wv[gq][i][1]; v += fmaxf(acc[4 * i + 2], 0.f) * wv[gq][i][2]; v += fmaxf(acc[4 * i + 3], 0.f) * wv[gq][i][3];
                        sc[i] = v + 0.0f; }
                    const bool odd = (lane & 1) != 0;
#pragma unroll
                    for (int i = 0; i < 4; i += 2) {
                        const float snd = odd ? sc[i] : sc[i + 1], rcv = shx<1>(snd, lane);
                        const float lo = odd ? rcv : sc[i], hi = odd ? sc[i + 1] : rcv;
                        const unsigned w = (unsigned)__builtin_bit_cast(unsigned short, (_Float16)lo) | ((unsigned)__builtin_bit_cast(unsigned short, (_Float16)hi) << 16);
                        const int ql = 8 * gq + 2 * (odd ? i + 1 : i) + hf, k0 = key & ~1;
                        if (SAMPLE) { if (k0 < PAST + DS) *(unsigned*)((unsigned short*)(ws + WS_SS) + ((size_t)b * 8 + ql) * SS_LD + k0) = w; }
                        else *(unsigned*)((unsigned short*)(ws + WS_SP) + ((size_t)b * SEQ + q0 + ql) * SEQ + k0) = w;
                    }
                }
            }
        }
        asm volatile("" ::: "memory");
    }
}
__device__ __forceinline__ void score_item_dma(PK P, const Ctx& C, int L, int b, int qblk, int kc, LAS unsigned char* img) {
    constexpr int QG = 2, TG = 4;
    unsigned char* ws = P->ws; const int lane = C.lane, r32 = lane & 31, hf = lane >> 5;
    const bf16* IQ = (const bf16*)(ws + WS_IQ); const float* IW = (const float*)(ws + WS_IW);
    const int q0 = qblk * 16;
    const size_t rowbase = (size_t)b * SEQ + q0;
    bf16x8 af[QG][4]; f32x4 wv[QG][4];
#pragma unroll
    for (int gq = 0; gq < QG; ++gq) {
#pragma unroll
        for (int s = 0; s < 4; ++s) af[gq][s] = *(const bf16x8*)(IQ + (rowbase + 8 * gq + (r32 >> 2)) * 256 + (r32 & 3) * 64 + 16 * s + 8 * hf);
#pragma unroll
        for (int i = 0; i < 4; ++i) wv[gq][i] = *(const f32x4*)(IW + (rowbase + 8 * gq + 2 * i + hf) * 4); }
    const int kt_end = min(kc * 16 + 16, (q0 + 16 + 31) >> 5);
    const unsigned char* ikb = ws + WS_IKB + (size_t)b * SEQ * 128;
    int voff[4], roff[4];
#pragma unroll
    for (int i = 0; i < 4; ++i) { voff[i] = (8 * i + (lane >> 3)) * 128 + 16 * ((lane & 7) ^ ((4 * i + (lane >> 4)) & 7)); roff[i] = r32 * 128 + 16 * ((2 * i + hf) ^ ((r32 >> 1) & 7)); }
#define SC_ISSUE(kt0_) do { _Pragma("unroll") for (int j = 0; j < TG; ++j) { const int kt_ = min((kt0_) + j, kt_end - 1); _Pragma("unroll") for (int i = 0; i < 4; ++i) \
        __builtin_amdgcn_global_load_lds((const unsigned*)(ikb + (size_t)kt_ * 4096 + voff[i]), (LAS unsigned*)(img + j * 4096 + i * 1024), 16, 0, 0); } } while (0)
    SC_ISSUE(kc * 16);
    for (int kt0 = kc * 16; kt0 < kt_end; kt0 += TG) {
        asm volatile("s_waitcnt vmcnt(0)" ::: "memory");
        u32x4 cur[TG][4];
#pragma unroll
        for (int j = 0; j < TG; ++j) {
#pragma unroll
            for (int s = 0; s < 4; ++s) cur[j][s] = *(const LAS u32x4*)(img + j * 4096 + roff[s]); }
        asm volatile("s_waitcnt lgkmcnt(0)" ::: "memory");
        if (kt0 + TG < kt_end) SC_ISSUE(kt0 + TG);
        asm volatile("" ::: "memory");
#pragma unroll
        for (int j = 0; j < TG; ++j) { const int kt = kt0 + j;
            if (kt < kt_end) {
                const int key = kt * 32 + r32;
#pragma unroll
                for (int gq = 0; gq < QG; ++gq) {
                    f32x16 acc;
#pragma unroll
                    for (int i = 0; i < 16; ++i) acc[i] = 0.f;
#pragma unroll
                    for (int s = 0; s < 4; ++s) acc = mfma32(af[gq][s], as_bf16x8(cur[j][s]), acc);
                    float sc[4];
#pragma unroll
                    for (int i = 0; i < 4; ++i) {
                        float v = fmaxf(acc[4 * i + 0], 0.f) * wv[gq][i][0]; v += fmaxf(acc[4 * i + 1], 0.f) * wv[gq][i][1]; v += fmaxf(acc[4 * i + 2], 0.f) * wv[gq][i][2]; v += fmaxf(acc[4 * i + 3], 0.f) * wv[gq][i][3];
                        sc[i] = v + 0.0f; }
                    const bool odd = (lane & 1) != 0;
#pragma unroll
                    for (int i = 0; i < 4; i += 2) {
                        const float snd = odd ? sc[i] : sc[i + 1], rcv = shx<1>(snd, lane);
                        const float lo = odd ? rcv : sc[i], hi = odd ? sc[i + 1] : rcv;
                        const unsigned w = (unsigned)__builtin_bit_cast(unsigned short, (_Float16)lo) | ((unsigned)__builtin_bit_cast(unsigned short, (_Float16)hi) << 16);
                        const int ql = 8 * gq + 2 * (odd ? i + 1 : i) + hf, k0 = key & ~1;
                        *(unsigned*)((unsigned short*)(ws + WS_SP) + ((size_t)b * SEQ + q0 + ql) * SEQ + k0) = w;
                    }
                }
            }
        }
        asm volatile("" ::: "memory");
    }
#undef SC_ISSUE
}
__device__ __forceinline__ void score_item_sdma(PK P, const Ctx& C, int L, int b, int kc, LAS unsigned char* img) {
    constexpr int TG = 2;
    unsigned char* ws = P->ws; const int lane = C.lane, r32 = lane & 31, hf = lane >> 5;
    const bf16* IQ = (const bf16*)(ws + WS_IQ); const float* IW = (const float*)(ws + WS_IW);
    const size_t rowbase = (size_t)MP + b * 8;
    bf16x8 af[4]; f32x4 wv[4];
#pragma unroll
    for (int s = 0; s < 4; ++s) af[s] = *(const bf16x8*)(IQ + (rowbase + (r32 >> 2)) * 256 + (r32 & 3) * 64 + 16 * s + 8 * hf);
#pragma unroll
    for (int i = 0; i < 4; ++i) wv[i] = *(const f32x4*)(IW + (rowbase + 2 * i + hf) * 4);
    const int kt_end = min(kc * 16 + 16, (PAST + DS + 31) >> 5);
    const int* pt = (const int*)P->in[I_PT] + b * NPAGES;
    const float* cik = P->in[I_CIK] + (size_t)L * NPOOL * 128 * 64; const float* nik = P->out + O_IKS + ((size_t)L * DB + b) * DS * 64;
    const int dr = lane >> 4, dq = lane & 15;
#define SS_ISSUE(kt0_) do { _Pragma("unroll") for (int j = 0; j < TG; ++j) { const int kt_ = min((kt0_) + j, kt_end - 1); const float* pg_ = cik + ((size_t)pt[(kt_ >> 2) & 15] * 128 + (kt_ & 3) * 32) * 64; \
        _Pragma("unroll") for (int i = 0; i < 8; ++i) { const int row_ = 4 * i + dr, key_ = kt_ * 32 + row_, kcl_ = key_ < PAST + DS ? key_ : PAST + DS - 1; \
            const float* src_ = (kcl_ < PAST ? pg_ + row_ * 64 : nik + (kcl_ - PAST) * 64) + 4 * (dq ^ (row_ & 15)); \
            __builtin_amdgcn_global_load_lds((const unsigned*)src_, (LAS unsigned*)(img + j * 8192 + i * 1024), 16, 0, 0); } } } while (0)
    SS_ISSUE(kc * 16);
    for (int kt0 = kc * 16; kt0 < kt_end; kt0 += TG) {
        asm volatile("s_waitcnt vmcnt(0)" ::: "memory");
        u32x4 cur[TG][8];
#pragma unroll
        for (int j = 0; j < TG; ++j) {
#pragma unroll
            for (int s = 0; s < 8; ++s) cur[j][s] = *(const LAS u32x4*)(img + j * 8192 + r32 * 256 + 16 * ((4 * (s >> 1) + 2 * hf + (s & 1)) ^ (r32 & 15))); }
        asm volatile("s_waitcnt lgkmcnt(0)" ::: "memory");
        if (kt0 + TG < kt_end) SS_ISSUE(kt0 + TG);
        asm volatile("" ::: "memory");
#pragma unroll
        for (int j = 0; j < TG; ++j) { const int kt = kt0 + j;
            if (kt < kt_end) {
                const int key = kt * 32 + r32;
                f32x16 acc;
#pragma unroll
                for (int i = 0; i < 16; ++i) acc[i] = 0.f;
#pragma unroll
                for (int s = 0; s < 4; ++s) { const f32x4 a = __builtin_bit_cast(f32x4, cur[j][2 * s]), c = __builtin_bit_cast(f32x4, cur[j][2 * s + 1]);
                    u32x4 w; w.x = pk2(a[0], a[1]); w.y = pk2(a[2], a[3]); w.z = pk2(c[0], c[1]); w.w = pk2(c[2], c[3]);
                    acc = mfma32(af[s], as_bf16x8(w), acc); }
                float sc[4];
#pragma unroll
                for (int i = 0; i < 4; ++i) {
                    float v = fmaxf(acc[4 * i + 0], 0.f) * wv[i][0]; v += fmaxf(acc[4 * i + 1], 0.f) * wv[i][1]; v += fmaxf(acc[4 * i + 2], 0.f) * wv[i][2]; v += fmaxf(acc[4 * i + 3], 0.f) * wv[i][3];
                    sc[i] = v + 0.0f; }
                const bool odd = (lane & 1) != 0;
#pragma unroll
                for (int i = 0; i < 4; i += 2) {
                    const float snd = odd ? sc[i] : sc[i + 1], rcv = shx<1>(snd, lane);
                    const float lo = odd ? rcv : sc[i], hi = odd ? sc[i + 1] : rcv;
                    const unsigned w = (unsigned)__builtin_bit_cast(unsigned short, (_Float16)lo) | ((unsigned)__builtin_bit_cast(unsigned short, (_Float16)hi) << 16);
                    const int ql = 2 * (odd ? i + 1 : i) + hf, k0 = key & ~1;
                    if (k0 < PAST + DS) *(unsigned*)((unsigned short*)(ws + WS_SS) + ((size_t)b * 8 + ql) * SS_LD + k0) = w;
                }
            }
        }
        asm volatile("" ::: "memory");
    }
#undef SS_ISSUE
}
__device__ __forceinline__ void phase_c(PK P, const Ctx& C, int L, int sel = 15) {
    LAS unsigned char* imgw = C.lds + C.wave * 16384;
    if (C.nblk == 256) {
        const int q1 = C.blk & 127, n1 = q1 / 32 + 1;
        if (C.wave < 4) { if (sel & 1) for (int it = C.blk * 4 + C.wave; it < 1024; it += C.nblk * 4) ret_state_item(P, C, L, it); }
        else { const int k = C.wave & 3, f = (C.blk >> 7) * 4 + k; LAS unsigned char* imgf = C.lds + (k < 3 ? 71680 + k * 16384 : XPOSE_OFF);
            if ((sel & 8) && f < 5) score_item_sdma(P, C, L, q1, f, imgf);
            if ((sel & 4) && f >= 4) { const int j = f == 4 ? 35 : 27 + f; const int b = j / 9, c = j - 9 * b; if (c < n1) score_item_dma(P, C, L, b, q1, c, imgf); else score_item_dma(P, C, L, b, 255 - q1, c - n1, imgf); } }
        if (sel & 2) for (int u = C.blk; u < 512; u += C.nblk) ret_sample_unit(P, C, L, u);
        if (sel & 4) { const int wp = (C.blk >> 7) * NWAVES + C.wave;
            for (int j = wp; j < 32; j += 16) { const int b = j / 9, c = j - 9 * b; if (c < n1) score_item_dma(P, C, L, b, q1, c, imgw); else score_item_dma(P, C, L, b, 255 - q1, c - n1, imgw); } }
    } else {
        if ((sel & 1) && C.wave < 4) for (int it = C.blk * 4 + C.wave; it < 1024; it += C.nblk * 4) ret_state_item(P, C, L, it);
        if (sel & 2) for (int u = C.blk; u < 512; u += C.nblk) ret_sample_unit(P, C, L, u);
        if (sel & 4) for (int it = C.gw; it < NB * 256 * 8; it += C.ngw) { const int kc = it & 7, qb = (it >> 3) & 255, b = it >> 11; if (kc * 512 <= qb * 16 + 15) score_item_dma(P, C, L, b, qb, kc, imgw); }
        if ((sel & 8) && C.wave >= 4) for (int it = C.blk * 4 + (C.wave & 3); it < DB * 5; it += C.nblk * 4) score_item_sdma(P, C, L, it / 5, it % 5, imgw);
    }
}

__device__ __forceinline__ void ret_scan_item(PK P, const Ctx& C, int L, int item) {
    unsigned char* ws = P->ws; const float* KVT = (const float*)(ws + WS_KVT); bf16* ST = (bf16*)(ws + WS_ST);
    const int e0 = item * 1024 + C.tid * 2, bh = e0 >> 14, rem = e0 & 16383, h = bh & 3;
    const float dec = __builtin_amdgcn_exp2f(128.0f * ret_log2g(h));
    float s0 = 0.f, s1 = 0.f;
#pragma unroll 8
    for (int n = 0; n < 32; ++n) { const f32x2 kv = *(const f32x2*)(KVT + ((size_t)bh * 32 + n) * 16384 + rem);
        *(unsigned*)(ST + ((size_t)bh * 32 + n) * 16384 + rem) = pk2(s0, s1); s0 = s0 * dec + kv[0]; s1 = s1 * dec + kv[1]; }
    const int e = rem >> 7, d = rem & 127;
    float* o = P->out + O_RSP + ((size_t)L * 16 + bh) * 16384; o[d * 128 + e] = s0; o[(d + 1) * 128 + e] = s1;
}
template <int G>
__device__ __forceinline__ void cnt_ge4(const unsigned (&kp)[32], unsigned cm1, unsigned& c0, unsigned& c1) {
    unsigned t0, t1, t2, t3;
    asm("v_pk_sub_u16 %2, %6, %10 clamp\n\tv_pk_sub_u16 %3, %7, %10 clamp\n\tv_pk_sub_u16 %4, %8, %10 clamp\n\tv_pk_sub_u16 %5, %9, %10 clamp\n\t"
        "v_pk_min_u16 %2, %2, %11\n\tv_pk_min_u16 %3, %3, %11\n\tv_pk_min_u16 %4, %4, %11\n\tv_pk_min_u16 %5, %5, %11\n\t"
        "v_pk_add_u16 %0, %0, %2\n\tv_pk_add_u16 %1, %1, %3\n\tv_pk_add_u16 %0, %0, %4\n\tv_pk_add_u16 %1, %1, %5"
        : "+v"(c0), "+v"(c1), "=&v"(t0), "=&v"(t1), "=&v"(t2), "=&v"(t3)
        : "v"(kp[4 * G + 0]), "v"(kp[4 * G + 1]), "v"(kp[4 * G + 2]), "v"(kp[4 * G + 3]), "s"(cm1), "s"(0x00010001u));
}
__device__ __forceinline__ int wave_sum_dpp(int v) {
    v += __builtin_amdgcn_update_dpp(0, v, 0x111, 0xf, 0xf, true);
    v += __builtin_amdgcn_update_dpp(0, v, 0x112, 0xf, 0xf, true);
    v += __builtin_amdgcn_update_dpp(0, v, 0x114, 0xf, 0xf, true);
    v += __builtin_amdgcn_update_dpp(0, v, 0x118, 0xf, 0xf, true);
    v += __builtin_amdgcn_update_dpp(0, v, 0x142, 0xa, 0xf, true);
    v += __builtin_amdgcn_update_dpp(0, v, 0x143, 0xc, 0xf, true);
    return __builtin_amdgcn_readlane(v, 63);
}
__device__ __forceinline__ unsigned cnt_ge_lane(const unsigned (&kp)[32], unsigned cand, int ng) {
    const unsigned cm1 = (cand - 1u) * 0x00010001u; unsigned c0 = 0u, c1 = 0u;
    cnt_ge4<0>(kp, cm1, c0, c1);
    if (ng > 1) cnt_ge4<1>(kp, cm1, c0, c1);
    if (ng > 2) cnt_ge4<2>(kp, cm1, c0, c1);
    if (ng > 3) cnt_ge4<3>(kp, cm1, c0, c1);
    if (ng > 4) cnt_ge4<4>(kp, cm1, c0, c1);
    if (ng > 5) cnt_ge4<5>(kp, cm1, c0, c1);
    if (ng > 6) cnt_ge4<6>(kp, cm1, c0, c1);
    if (ng > 7) cnt_ge4<7>(kp, cm1, c0, c1);
    const unsigned c = c0 + c1;
    return (c & 0xffffu) + (c >> 16);
}
__device__ __forceinline__ int cnt_ge(const unsigned (&kp)[32], unsigned cand, int ng) { return wave_sum_dpp((int)cnt_ge_lane(kp, cand, ng)); }
__device__ __forceinline__ void bit_transpose16(unsigned (&x)[16]) {
#define BT_STAGE(J, M) _Pragma("unroll") for (int r = 0; r < 16; ++r) if ((r & (J)) == 0) { const unsigned a = x[r], b = x[r + (J)]; x[r] = (a & (M)) | ((b << (J)) & ~(M)); x[r + (J)] = ((a >> (J)) & (M)) | (b & ~(M)); }
    BT_STAGE(8, 0x00ff00ffu) BT_STAGE(4, 0x0f0f0f0fu) BT_STAGE(2, 0x33333333u) BT_STAGE(1, 0x55555555u)
#undef BT_STAGE
}
__device__ __forceinline__ void select_topk(const unsigned short* srow, int Lk, LAS unsigned* list, int lane, int mode = 3) {
    const int ng = (Lk + 511) >> 9;
    unsigned kp[32];
    const unsigned* sl = (const unsigned*)srow + lane;
    if (ng > 4) {
#pragma unroll
        for (int j = 0; j < 32; ++j) kp[j] = sl[j * 64];
    } else {
#pragma unroll
        for (int j = 0; j < 16; ++j) kp[j] = sl[j * 64];
#pragma unroll
        for (int j = 16; j < 32; ++j) kp[j] = 0u;
    }
    typedef short s16x2 __attribute__((ext_vector_type(2)));
#pragma unroll
    for (int j = 0; j < 32; ++j) { const unsigned w = kp[j];
        const unsigned sg = __builtin_bit_cast(unsigned, __builtin_bit_cast(s16x2, w) >> (s16x2){15, 15});
        unsigned kk = w ^ (sg | 0x80008000u);
        const int rem = Lk - 128 * j;
        if (rem < 128) kk &= ((2 * lane < rem) ? 0xffffu : 0u) | ((2 * lane + 1 < rem) ? 0xffff0000u : 0u);
        kp[j] = kk; }
    unsigned p0[16], p1[16];
#pragma unroll
    for (int j = 0; j < 16; ++j) { p0[j] = kp[j]; p1[j] = 0u; }
    bit_transpose16(p0);
    if (ng > 4) {
#pragma unroll
        for (int j = 0; j < 16; ++j) p1[j] = kp[16 + j];
        bit_transpose16(p1); }
    unsigned act0 = ~0u, act1 = ~0u, gt0 = 0u, gt1 = 0u; int G = 0;
#pragma unroll
    for (int bit = 15; bit >= 0; --bit) {
        const unsigned t0 = act0 & p0[bit], t1 = act1 & p1[bit];
        const int c = __builtin_popcount(t0) + __builtin_popcount(t1);
        const int tot = wave_sum_dpp(c);
        const bool take = G + tot >= TOPK;
        if (take) { act0 = t0; act1 = t1; } else { G += tot; gt0 |= t0; gt1 |= t1; act0 ^= t0; act1 ^= t1; }
    }
    const int neq = wave_sum_dpp(__builtin_popcount(act0) + __builtin_popcount(act1));
    unsigned sel0, sel1;
    if (G + neq == TOPK) { sel0 = gt0 | act0; sel1 = gt1 | act1; }
    else {
        const int need_eq = TOPK - G; int jc = 0, base = 0;
#define SEL_MASKR(m_) ((m_) <= 0 ? 0u : (m_) >= 16 ? 0xffffffffu : ((1u << (m_)) - 1u) * 0x00010001u)
#pragma unroll
        for (int s = 16; s >= 1; s >>= 1) { const int jm = jc + s; const unsigned m0 = SEL_MASKR(jm), m1 = SEL_MASKR(jm - 16);
            const int cb = wave_sum_dpp(__builtin_popcount(act0 & m0) + __builtin_popcount(act1 & m1));
            if (cb < need_eq) { jc = jm; base = cb; } }
        const int rc = jc & 15; const unsigned aw = jc >= 16 ? act1 : act0;
        const bool e0 = ((aw >> rc) & 1u) != 0u, e1 = ((aw >> (16 + rc)) & 1u) != 0u;
        const unsigned long long b0 = __ballot(e0), b1 = __ballot(e1);
        const int rk = base + mbcnt64(b0) + mbcnt64(b1);
        const bool s0 = e0 && rk < need_eq, s1 = e1 && (rk + (e0 ? 1 : 0)) < need_eq;
        const unsigned add = ((s0 ? 1u : 0u) << rc) | ((s1 ? 1u : 0u) << (16 + rc));
        const unsigned m0 = SEL_MASKR(jc), m1 = SEL_MASKR(jc - 16);
        sel0 = gt0 | (act0 & m0) | (jc < 16 ? add : 0u);
        sel1 = gt1 | (act1 & m1) | (jc >= 16 ? add : 0u);
#undef SEL_MASKR
    }
    { const int cl = __builtin_popcount(sel0) + __builtin_popcount(sel1);
      int inc = cl;
      inc += __builtin_amdgcn_update_dpp(0, inc, 0x111, 0xf, 0xf, true);
      inc += __builtin_amdgcn_update_dpp(0, inc, 0x112, 0xf, 0xf, true);
      inc += __builtin_amdgcn_update_dpp(0, inc, 0x114, 0xf, 0xf, true);
      inc += __builtin_amdgcn_update_dpp(0, inc, 0x118, 0xf, 0xf, true);
      inc += __builtin_amdgcn_update_dpp(0, inc, 0x142, 0xa, 0xf, true);
      inc += __builtin_amdgcn_update_dpp(0, inc, 0x143, 0xc, 0xf, true);
      int off = inc - cl; unsigned m0 = sel0, m1 = sel1;
      while (__ballot((m0 | m1) != 0u) != 0ull) {
          const bool has0 = m0 != 0u; const unsigned m = has0 ? m0 : m1; const bool valid = m != 0u;
          const int p = __builtin_ctz(m | 0x80000000u);
          const unsigned idx = (unsigned)((((p & 15) + (has0 ? 0 : 16)) << 7) + 2 * lane + (p >> 4));
          list[valid ? off : 2368 + lane] = idx;
          off += valid ? 1 : 0;
          const unsigned nm = m & (m - 1u);
          m0 = has0 ? nm : m0; m1 = has0 ? m1 : nm; }
    }
}
#ifndef SEL2
#define SEL2 0
#endif
#ifndef QK2
#define QK2 0
#endif
#ifndef PV2
#define PV2 0
#endif
#ifndef NOXCD
#define NOXCD 0
#endif
constexpr int ATT_WSTRIDE = 10496;
template <bool SAMPLE>
__device__ __forceinline__ void attend_query(PK P, const Ctx& C, int L, int row, int mode = 3) {
    int lane_ = C.lane; asm volatile("" : "+v"(lane_));
    unsigned char* ws = P->ws; const int lane = lane_;
    LAS unsigned* list = (LAS unsigned*)(C.lds + C.wave * ATT_WSTRIDE);
    int b, Lk; const unsigned short* srow;
    if (SAMPLE) { b = (row - MP) >> 3; const int j = (row - MP) & 7; Lk = PAST + j + 1; srow = (const unsigned short*)(ws + WS_SS) + (size_t)(row - MP) * SS_LD; }
    else { b = row >> 12; const int t = row & (SEQ - 1); Lk = t + 1; srow = (const unsigned short*)(ws + WS_SP) + (size_t)row * SEQ; }
    const int n16 = lane & 15, g = lane >> 4;
    u32x4 qraw[2]; qraw[0] = (u32x4){0u, 0u, 0u, 0u}; qraw[1] = qraw[0];
    if (n16 < 8) { qraw[0] = *(const u32x4*)((const bf16*)(ws + WS_AQ) + (size_t)row * 512 + n16 * 64 + 8 * g); qraw[1] = *(const u32x4*)((const bf16*)(ws + WS_AQ) + (size_t)row * 512 + n16 * 64 + 32 + 8 * g); }
    u32x2 azr[4];
#pragma unroll
    for (int dl = 0; dl < 4; ++dl) azr[dl] = *(const u32x2*)((const bf16*)(ws + WS_Z) + (size_t)row * NZ + ZC_AZ + (n16 & 7) * 64 + 16 * dl + 4 * g);
    int ptv = 0; if (SAMPLE) ptv = ((const int*)P->in[I_PT])[b * NPAGES + (lane & 15)];
    int count;
    if (Lk <= TOPK) { for (int i = lane; i < TOPK; i += 64) list[i] = i < Lk ? (unsigned)i : 0u; count = Lk; }
    else { select_topk(srow, Lk, list, lane, mode); if (SEL2) { LDS_WAIT(); asm volatile("" ::: "memory"); select_topk(srow, Lk, list, lane, mode); } count = TOPK; }
    LDS_WAIT(); asm volatile("" ::: "memory");
    if (mode == 1 || mode == 4 || mode == 5) return;
    {
#pragma unroll
      for (int i = 0; i < 4; ++i) { const unsigned k = list[lane + 64 * i]; unsigned phys;
          if (SAMPLE) { const unsigned pg = (unsigned)__builtin_amdgcn_ds_bpermute((int)(((k >> 7) & 15u) << 2), ptv); phys = (k < (unsigned)PAST) ? pg * 128u + (k & 127u) : (0x80000000u | (k - PAST)); }
          else phys = (unsigned)b * SEQ + k;
          list[lane + 64 * i] = phys; } }
    LDS_WAIT(); asm volatile("" ::: "memory");
    const float* ck = SAMPLE ? P->in[I_CK] + (size_t)L * NPOOL * 128 * 128 : nullptr; const float* cv = SAMPLE ? P->in[I_CV] + (size_t)L * NPOOL * 128 * 128 : nullptr;
    const float* nk = P->out + O_KS + ((size_t)L * DB + b) * DS * 128; const float* nv = P->out + O_VS + ((size_t)L * DB + b) * DS * 128;
    const bf16* KBp = (const bf16*)(ws + WS_KB); const bf16* VBp = (const bf16*)(ws + WS_VB);
    bf16x8 qf[2][2];
#pragma unroll
    for (int kvh = 0; kvh < 2; ++kvh)
#pragma unroll
        for (int s = 0; s < 2; ++s) { const u32x4 zz = {0u, 0u, 0u, 0u}; qf[kvh][s] = as_bf16x8(((n16 >> 2) == kvh) ? qraw[s] : zz); }
    f32x4 S[16];
    for (int rq_ = 0; rq_ < (QK2 ? 2 : 1); ++rq_) {
    { LAS unsigned char* kbuf = C.lds + C.wave * ATT_WSTRIDE + 1024; const int c16k = lane & 15, tqk = lane >> 4;
      constexpr int SB = SAMPLE ? 1 : 2, NBT = 8 / SB;
      u32x4 kraw[2][SB][SAMPLE ? 16 : 8];
#define ATT_KLOAD(buf_, k_) do { _Pragma("unroll") for (int q = 0; q < SB; ++q) _Pragma("unroll") for (int i = 0; i < 8; ++i) { const unsigned phys = list[32 * ((k_) * SB + q) + tqk + 4 * i]; \
                if (SAMPLE) { const float* kr = ((phys & 0x80000000u) ? nk + (size_t)(phys & 7u) * 128 : ck + (size_t)phys * 128) + 8 * c16k; kraw[buf_][q][2 * i] = *(const u32x4*)kr; kraw[buf_][q][2 * i + 1] = *(const u32x4*)(kr + 4); } \
                else kraw[buf_][q][i] = *(const u32x4*)(KBp + (size_t)phys * 128 + 8 * c16k); } } while (0)
      ATT_KLOAD(0, 0); ATT_KLOAD(1, 1);
      asm volatile("" ::: "memory");
#pragma unroll
      for (int k = 0; k < NBT; ++k) {
#pragma unroll
        for (int q = 0; q < SB; ++q) { const int st = k * SB + q;
#pragma unroll
            for (int i = 0; i < 8; ++i) { u32x4 w;
                if (SAMPLE) { const f32x4 a = __builtin_bit_cast(f32x4, kraw[k & 1][q][2 * i]), c = __builtin_bit_cast(f32x4, kraw[k & 1][q][2 * i + 1]); w.x = pk2(a[0], a[1]); w.y = pk2(a[2], a[3]); w.z = pk2(c[0], c[1]); w.w = pk2(c[2], c[3]); }
                else w = kraw[k & 1][q][i];
                *(LAS u32x4*)(kbuf + (tqk + 4 * i) * 288 + 16 * c16k) = w; }
            if (q == SB - 1 && k + 2 < NBT) ATT_KLOAD(k & 1, k + 2);
            LDS_WAIT(); asm volatile("" ::: "memory");
#pragma unroll
            for (int tt = 0; tt < 2; ++tt) { const LAS unsigned char* rp = kbuf + (16 * tt + n16) * 288 + 16 * g;
                const bf16x8 a00 = *(const LAS bf16x8*)rp, a01 = *(const LAS bf16x8*)(rp + 64), a10 = *(const LAS bf16x8*)(rp + 128), a11 = *(const LAS bf16x8*)(rp + 192);
                f32x4 acc = {0.f, 0.f, 0.f, 0.f};
                acc = mfma16(a00, qf[0][0], acc); acc = mfma16(a01, qf[0][1], acc); acc = mfma16(a10, qf[1][0], acc); acc = mfma16(a11, qf[1][1], acc); asm volatile("" : "+v"(acc)); S[2 * st + tt] = acc; }
            LDS_WAIT(); asm volatile("" ::: "memory"); }
      }
#undef ATT_KLOAD
    }
    asm volatile("" ::: "memory"); }
    LAS unsigned char* vbuf = C.lds + C.wave * ATT_WSTRIDE + 1024;
    const int c16 = lane & 15, tq = lane >> 4;
    constexpr int VD = SAMPLE ? 1 : 2;
    u32x4 vraw[VD][SAMPLE ? 16 : 8];
#define ATT_VLOAD(buf_, st_) do { _Pragma("unroll") for (int i = 0; i < 8; ++i) { const unsigned phys = list[32 * (st_) + tq + 4 * i]; \
            if (SAMPLE) { const float* vr = ((phys & 0x80000000u) ? nv + (size_t)(phys & 7u) * 128 : cv + (size_t)phys * 128) + 8 * c16; vraw[buf_][2 * i] = *(const u32x4*)vr; vraw[buf_][2 * i + 1] = *(const u32x4*)(vr + 4); } \
            else vraw[buf_][i] = *(const u32x4*)(VBp + (size_t)phys * 128 + 8 * c16); } } while (0)
    if (mode != 2) {
#pragma unroll
        for (int d = 0; d < VD; ++d) ATT_VLOAD(d, d); }
    asm volatile("" ::: "memory");
    float mx = -INFINITY;
#pragma unroll
    for (int i = 0; i < 16; ++i)
#pragma unroll
        for (int r = 0; r < 4; ++r) { const int slot = 16 * i + 4 * g + r; const float sv = slot < count ? S[i][r] * 0.125f : -INFINITY; S[i][r] = sv; mx = fmaxf(mx, sv); }
    mx = fmaxf(mx, shx<16>(mx, lane)); mx = fmaxf(mx, shx<32>(mx, lane));
    float sum = 0.f;
#pragma unroll
    for (int i = 0; i < 16; ++i)
#pragma unroll
        for (int r = 0; r < 4; ++r) { const float p = __builtin_amdgcn_exp2f((S[i][r] - mx) * 1.4426950408889634f); S[i][r] = p; sum += p; }
    sum += shx<16>(sum, lane); sum += shx<32>(sum, lane);
    if (mode == 2) return;
    f32x4 oacc[8];
    {
#pragma unroll
    for (int dt = 0; dt < 8; ++dt) oacc[dt] = (f32x4){0.f, 0.f, 0.f, 0.f};
    const unsigned tr_a = (unsigned)(4 * g + (c16 >> 2)) * 288u + (unsigned)(c16 & 3) * 8u;
#pragma unroll
    for (int st = 0; st < 8; ++st) {
#pragma unroll
        for (int i = 0; i < 8; ++i) { u32x4 w;
            if (SAMPLE) { const f32x4 a = __builtin_bit_cast(f32x4, vraw[st % VD][2 * i]), c = __builtin_bit_cast(f32x4, vraw[st % VD][2 * i + 1]); w.x = pk2(a[0], a[1]); w.y = pk2(a[2], a[3]); w.z = pk2(c[0], c[1]); w.w = pk2(c[2], c[3]); }
            else w = vraw[st % VD][i];
            *(LAS u32x4*)(vbuf + (tq + 4 * i) * 288 + 16 * c16) = w; }
        if (st + VD < 8) ATT_VLOAD(st % VD, st + VD);
        const f32x4 p0 = S[2 * st], p1 = S[2 * st + 1];
        u32x4 pw; pw.x = pk2(p0[0], p0[1]); pw.y = pk2(p0[2], p0[3]); pw.z = pk2(p1[0], p1[1]); pw.w = pk2(p1[2], p1[3]);
        const bf16x8 pf = as_bf16x8(pw);
        LDS_WAIT(); asm volatile("" ::: "memory");
#pragma unroll
        for (int dt = 0; dt < 8; ++dt) {
            typedef short v4i16_t __attribute__((ext_vector_type(4)));
            const v4i16_t lo = __builtin_amdgcn_ds_read_tr16_b64_v4i16((LAS v4i16_t*)(vbuf + tr_a + 32 * dt));
            const v4i16_t hi = __builtin_amdgcn_ds_read_tr16_b64_v4i16((LAS v4i16_t*)(vbuf + tr_a + 16 * 288 + 32 * dt));
            bf16x8 af; af[0] = lo[0]; af[1] = lo[1]; af[2] = lo[2]; af[3] = lo[3]; af[4] = hi[0]; af[5] = hi[1]; af[6] = hi[2]; af[7] = hi[3];
            oacc[dt] = mfma16(af, pf, oacc[dt]); }
        LDS_WAIT(); asm volatile("" ::: "memory");
    }
    asm volatile("" ::: "memory"); }
    { const float inv = 1.0f / sum;
#define ATT_EPI(base_) do { _Pragma("unroll") for (int dl = 0; dl < 4; ++dl) { const f32x4 v = oacc[(base_) + dl]; \
              const float y0 = v[0] * inv * siluf_(bflo(azr[dl].x)), y1 = v[1] * inv * siluf_(bfhi(azr[dl].x)), y2 = v[2] * inv * siluf_(bflo(azr[dl].y)), y3 = v[3] * inv * siluf_(bfhi(azr[dl].y)); \
              u32x2 ow; ow.x = pk2(y0, y1); ow.y = pk2(y2, y3); \
              *(u32x2*)((bf16*)(ws + WS_OGA) + (size_t)row * 512 + n16 * 64 + 16 * dl + 4 * g) = ow; } } while (0)
      if (n16 < 4) ATT_EPI(0); else if (n16 < 8) ATT_EPI(4);
#undef ATT_EPI
    }
    LDS_WAIT(); asm volatile("" ::: "memory");
#undef ATT_VLOAD
}
__device__ __forceinline__ void ret_out_unit(PK P, const Ctx& C, int unit, bool flip);
__device__ __forceinline__ void phase_d(PK P, const Ctx& C, int L, int mode = 3) {
    if (mode == 3) { bool flip = false; for (int u = C.blk; u < 512; u += C.nblk) { ret_out_unit(P, C, u, flip); flip = !flip; } __syncthreads(); }
    const bool sliced = C.nblk == 256 && !NOXCD;
    if (mode == 3 && L == 0 && !sliced) { p0_prologue(P, C, 1, (LAS float*)(C.lds + C.wave * ATT_WSTRIDE)); LDS_WAIT(); asm volatile("" ::: "memory"); }
#ifndef DSEL
#define DSEL 7
#endif
    if (!(DSEL & 2)) {} else
    if (C.nblk == 256 && !NOXCD) {
        const int x = C.blk & 7, b = x >> 1, wq = (((C.blk >> 3) * 2 + (x & 1)) * NWAVES + C.wave);
        for (int t = wq; t < SEQ; t += 512) { attend_query<false>(P, C, L, b * SEQ + t, mode);
            if (mode == 3 && L == 0) { p0_prologue(P, C, 1, (LAS float*)(C.lds + C.wave * ATT_WSTRIDE), t >> 9, 8); LDS_WAIT(); asm volatile("" ::: "memory"); } }
    } else for (int row = C.gw; row < MP; row += C.ngw) attend_query<false>(P, C, L, row, mode);
    if (DSEL & 4) for (int i = C.gw; i < 2 * MS; i += C.ngw) if ((i & 1) == 0) attend_query<true>(P, C, L, MP + (i >> 1), mode);
}

__device__ __forceinline__ void ret_out_unit(PK P, const Ctx& C, int unit, bool flip) {
    unsigned char* ws = P->ws; const bf16* RQ = (const bf16*)(ws + WS_RQ); const bf16* RK = (const bf16*)(ws + WS_RK); const bf16* RVT = (const bf16*)(ws + WS_RVT); const bf16* ST = (const bf16*)(ws + WS_ST);
    const int bh = unit >> 5, b = bh >> 2, h = bh & 3, n = unit & 31, r16 = C.lane & 15, g = C.lane >> 4, t0 = n * 128;
    const int w = flip ? 7 - C.wave : C.wave;
    const size_t rowbase = (size_t)b * SEQ + t0;
    const float lg2 = ret_log2g(h);
    constexpr int RS = 272; LAS unsigned char* Ks = C.lds; LAS unsigned char* Vs = C.lds + 128 * RS; LAS unsigned char* Ss = C.lds + 256 * RS;
    bf16x8 qf[4];
#pragma unroll
    for (int kk = 0; kk < 4; ++kk) qf[kk] = *(const bf16x8*)(RQ + (rowbase + 16 * w + r16) * 512 + h * 128 + 32 * kk + 8 * g);
    { const int pr = C.tid >> 4, pc = C.tid & 15;
      u32x4 rk[4], rv[4], rs_[4];
#pragma unroll
      for (int q = 0; q < 4; ++q) { const int r = pr + 32 * q;
          rk[q] = *(const u32x4*)(RK + (rowbase + r) * 512 + h * 128 + 8 * pc);
          rv[q] = *(const u32x4*)(RVT + ((size_t)bh * 128 + r) * SEQ + t0 + 8 * pc);
          rs_[q] = *(const u32x4*)(ST + (((size_t)bh * 32 + n) * 128 + r) * 128 + 8 * pc); }
      __syncthreads();
#pragma unroll
      for (int q = 0; q < 4; ++q) { const int r = pr + 32 * q; *(LAS u32x4*)(Ks + r * RS + 16 * pc) = rk[q]; *(LAS u32x4*)(Vs + r * RS + 16 * pc) = rv[q]; *(LAS u32x4*)(Ss + r * RS + 16 * pc) = rs_[q]; }
      __syncthreads(); }
    unsigned pt[8][2];
#pragma unroll
    for (int st = 0; st < 8; ++st) {
        pt[st][0] = 0u; pt[st][1] = 0u;
        if (st <= w) { f32x4 acc = {0.f, 0.f, 0.f, 0.f};
#pragma unroll
            for (int kk = 0; kk < 4; ++kk) { const bf16x8 kf = *(const LAS bf16x8*)(Ks + (16 * st + r16) * RS + 64 * kk + 16 * g); acc = mfma16(kf, qf[kk], acc); }
            float vals[4];
#pragma unroll
            for (int r = 0; r < 4; ++r) { const int dlt = (16 * w + r16) - (16 * st + 4 * g + r); vals[r] = dlt >= 0 ? acc[r] * __builtin_amdgcn_exp2f((float)dlt * lg2) : 0.f; }
            pt[st][0] = pk2(vals[0], vals[1]); pt[st][1] = pk2(vals[2], vals[3]); }
    }
    const float dq = __builtin_amdgcn_exp2f((float)(16 * w + r16 + 1) * lg2);
    f32x4 o[8];
#pragma unroll
    for (int et = 0; et < 8; ++et) {
        f32x4 a1 = {0.f, 0.f, 0.f, 0.f}, a2 = {0.f, 0.f, 0.f, 0.f};
        const LAS unsigned char* vrow = Vs + (16 * et + r16) * RS;
#pragma unroll
        for (int i = 0; i < 4; ++i) if (2 * i <= w) {
            const u32x2 lo = *(const LAS u32x2*)(vrow + 2 * (32 * i + 4 * g)), hi = *(const LAS u32x2*)(vrow + 2 * (32 * i + 16 + 4 * g));
            const u32x4 aw = {lo.x, lo.y, hi.x, hi.y}, bw = {pt[2 * i][0], pt[2 * i][1], pt[2 * i + 1][0], pt[2 * i + 1][1]};
            a1 = mfma16(as_bf16x8(aw), as_bf16x8(bw), a1); }
#pragma unroll
        for (int kk = 0; kk < 4; ++kk) { const bf16x8 sf = *(const LAS bf16x8*)(Ss + (16 * et + r16) * RS + 64 * kk + 16 * g); a2 = mfma16(sf, qf[kk], a2); }
        o[et] = a1 + a2 * dq;
    }
    float sm = 0.f;
#pragma unroll
    for (int et = 0; et < 8; ++et) sm += (o[et][0] + o[et][1]) + (o[et][2] + o[et][3]);
    sm += shx<16>(sm, C.lane); sm += shx<32>(sm, C.lane);
    const float mu = sm * (1.0f / 128.0f); float qv = 0.f;
#pragma unroll
    for (int et = 0; et < 8; ++et) { const f32x4 d = o[et] - mu; qv += (d[0] * d[0] + d[1] * d[1]) + (d[2] * d[2] + d[3] * d[3]); }
    qv += shx<16>(qv, C.lane); qv += shx<32>(qv, C.lane);
    const float rstd = __builtin_amdgcn_rsqf(qv * (1.0f / 128.0f) + 1e-5f);
    const size_t row = rowbase + 16 * w + r16;
    const bf16* zr = (const bf16*)(ws + WS_Z) + row * NZ + ZC_RZ + h * 128; bf16* og = (bf16*)(ws + WS_OGR) + row * 512 + h * 128;
#pragma unroll
    for (int et = 0; et < 8; ++et) { const u32x2 zw = *(const u32x2*)(zr + 16 * et + 4 * g);
        const float y0 = (o[et][0] - mu) * rstd * siluf_(bflo(zw.x)), y1 = (o[et][1] - mu) * rstd * siluf_(bfhi(zw.x)), y2 = (o[et][2] - mu) * rstd * siluf_(bflo(zw.y)), y3 = (o[et][3] - mu) * rstd * siluf_(bfhi(zw.y));
        u32x2 ow; ow.x = pk2(y0, y1); ow.y = pk2(y2, y3); *(u32x2*)(og + 16 * et + 4 * g) = ow; }
}

template <int K>
__device__ __forceinline__ void mini_mma(const bf16* A, const bf16* Bt, int row0, int col0, const Ctx& C, f32x4 (&acc)[2]) {
    constexpr int RS = 272, BUF = 2 * 64 * RS;
    constexpr int NC = K / 128, PF = NC < 4 ? NC : 4;
    const int tid = C.tid, lane = C.lane, rt = C.wave >> 1, ch = C.wave & 1, r16 = lane & 15, g = lane >> 4;
    LAS unsigned char* sm = C.lds;
    const int pr0 = tid >> 4, pc = tid & 15;
    const bf16* ga = A + (size_t)(row0 + pr0) * K + 8 * pc; const bf16* gb = Bt + (size_t)(col0 + pr0) * K + 8 * pc;
    acc[0] = (f32x4){0.f, 0.f, 0.f, 0.f}; acc[1] = (f32x4){0.f, 0.f, 0.f, 0.f};
    u32x4 rr[PF][4];
#pragma unroll
    for (int p = 0; p < PF; ++p) { rr[p][0] = *(const u32x4*)(ga + 128 * p); rr[p][1] = *(const u32x4*)(ga + (size_t)32 * K + 128 * p); rr[p][2] = *(const u32x4*)(gb + 128 * p); rr[p][3] = *(const u32x4*)(gb + (size_t)32 * K + 128 * p); }
    asm volatile("" ::: "memory");
    __syncthreads();
#pragma unroll
    for (int c = 0; c < NC; ++c) {
        { LAS unsigned char* w = sm + (c & 1) * BUF + pr0 * RS + 16 * pc; *(LAS u32x4*)w = rr[c % PF][0]; *(LAS u32x4*)(w + 32 * RS) = rr[c % PF][1]; *(LAS u32x4*)(w + 64 * RS) = rr[c % PF][2]; *(LAS u32x4*)(w + 96 * RS) = rr[c % PF][3]; }
        if (c + PF < NC) { const int n = c + PF; rr[c % PF][0] = *(const u32x4*)(ga + 128 * n); rr[c % PF][1] = *(const u32x4*)(ga + (size_t)32 * K + 128 * n); rr[c % PF][2] = *(const u32x4*)(gb + 128 * n); rr[c % PF][3] = *(const u32x4*)(gb + (size_t)32 * K + 128 * n); }
        asm volatile("" ::: "memory");
        __syncthreads();
        const LAS unsigned char* rd = sm + (c & 1) * BUF;
#pragma unroll
        for (int kk = 0; kk < 4; ++kk) {
            const bf16x8 a = *(const LAS bf16x8*)(rd + (16 * rt + r16) * RS + 64 * kk + 16 * g);
            const bf16x8 b0 = *(const LAS bf16x8*)(rd + (64 + 32 * ch + r16) * RS + 64 * kk + 16 * g), b1 = *(const LAS bf16x8*)(rd + (64 + 32 * ch + 16 + r16) * RS + 64 * kk + 16 * g);
            acc[0] = mfma16(a, b0, acc[0]); acc[1] = mfma16(a, b1, acc[1]); }
    }
    __syncthreads();
}
__device__ __forceinline__ void mini_oproj(PK P, const Ctx& C, int L) {
    unsigned char* ws = P->ws; const int lane = C.lane, rt = C.wave >> 1, ch = C.wave & 1, r16 = lane & 15, g = lane >> 4;
    for (int u = C.blk; u < 256; u += C.nblk) { const int row0 = MP + 64 * (u >> 4), col0 = 64 * (u & 15);
        f32x4 a1[2], a2[2];
        mini_mma<512>((const bf16*)(ws + WS_OGR), (const bf16*)(ws + WS_WOR) + (size_t)L * DM * 512, row0, col0, C, a1);
        mini_mma<512>((const bf16*)(ws + WS_OGA), (const bf16*)(ws + WS_WOA) + (size_t)L * DM * 512, row0, col0, C, a2);
        const bf16* Z = (const bf16*)(ws + WS_Z); bf16* MB = (bf16*)(ws + WS_MB);
#pragma unroll
        for (int j = 0; j < 2; ++j)
#pragma unroll
            for (int r = 0; r < 4; ++r) { const size_t row = (size_t)(row0 + 16 * rt + 4 * g + r); const int col = col0 + 32 * ch + 16 * j + r16;
                const float m = sigmoidf_(bf2f(Z[row * NZ + ZC_GR + col])) * a1[j][r] + sigmoidf_(bf2f(Z[row * NZ + ZC_GA + col])) * a2[j][r];
                MB[row * DM + col] = (bf16)(pk2(m, 0.f) & 0xffffu); } }
}
__device__ __forceinline__ void mini_wout(PK P, const Ctx& C, int L) {
    unsigned char* ws = P->ws; const int lane = C.lane, rt = C.wave >> 1, ch = C.wave & 1, r16 = lane & 15, g = lane >> 4;
    const float* xs = P->in[I_XS] - (size_t)MP * DM;
    const bf16* xh = (const bf16*)(ws + WS_XB0);
    for (int u = C.blk; u < 256; u += C.nblk) { const int row0 = MP + 64 * (u >> 4), col0 = 64 * (u & 15);
        f32x4 a1[2];
        mini_mma<1024>((const bf16*)(ws + WS_MB), (const bf16*)(ws + WS_WOUT) + (size_t)L * DM * DM, row0, col0, C, a1);
        bf16* XB1 = (bf16*)(ws + WS_XB1);
#pragma unroll
        for (int j = 0; j < 2; ++j)
#pragma unroll
            for (int r = 0; r < 4; ++r) { const size_t row = (size_t)(row0 + 16 * rt + 4 * g + r); const int col = col0 + 32 * ch + 16 * j + r16;
                const float x = (L == 0) ? xs[row * DM + col] : bf2f(xh[row * DM + col]);
                XB1[row * DM + col] = (bf16)(pk2(x + a1[j][r], 0.f) & 0xffffu); } }
}
__device__ __forceinline__ void mini_ple(PK P, const Ctx& C, int L, bool do_ss = true) {
    unsigned char* ws = P->ws; const int lane = C.lane, rt = C.wave >> 1, ch = C.wave & 1, r16 = lane & 15, g = lane >> 4;
    float* rowss = (L + 1 < DEPTH && do_ss) ? (float*)(ws + WS_CTL) + CW_ROWSS1 : nullptr;
    for (int u = C.blk; u < 256; u += C.nblk) { const int row0 = MP + 64 * (u >> 4), col0 = 64 * (u & 15);
        f32x4 a1[2], a2[2];
        mini_mma<1024>((const bf16*)(ws + WS_XB1), (const bf16*)(ws + WS_WPG) + (size_t)L * DM * DM, row0, col0, C, a1);
        mini_mma<256>((const bf16*)(ws + WS_PB) + (size_t)L * MT * 256, (const bf16*)(ws + WS_WPP) + (size_t)L * DM * 256, row0, col0, C, a2);
        const bf16* XB1 = (const bf16*)(ws + WS_XB1); float* Y = P->out; bf16* XB0 = (bf16*)(ws + WS_XB0);
#pragma unroll
        for (int r = 0; r < 4; ++r) { const size_t row = (size_t)(row0 + 16 * rt + 4 * g + r); float ssq = 0.f;
#pragma unroll
            for (int j = 0; j < 2; ++j) { const int col = col0 + 32 * ch + 16 * j + r16;
                const float v = bf2f(XB1[row * DM + col]) + sigmoidf_(a1[j][r]) * a2[j][r]; if (L + 1 == DEPTH) Y[row * DM + col] = v; XB0[row * DM + col] = (bf16)(pk2(v, 0.f) & 0xffffu); ssq += v * v; }
            if (rowss != nullptr) { ssq += shx<1>(ssq, lane); ssq += shx<2>(ssq, lane); ssq += shx<4>(ssq, lane); ssq += shx<8>(ssq, lane); if (r16 == 0) atomicAdd(rowss + row, ssq); } } }
}


__device__ __forceinline__ void mini_inproj_gates(PK P, const Ctx& C, int L) {
    unsigned char* ws = P->ws; const int lane = C.lane, rt = C.wave >> 1, ch = C.wave & 1, r16 = lane & 15, g = lane >> 4;
    const float* rowss = (L == 0) ? (const float*)(ws + WS_ROWSS0) : (const float*)(ws + WS_CTL) + CW_ROWSS1;
    bf16* Z = (bf16*)(ws + WS_Z);
    for (int u = C.blk; u < 16 * 30; u += C.nblk) { const int row0 = MP + 64 * (u / 30), col0 = 15 * 256 + 64 * (u % 30);
        f32x4 a1[2];
        mini_mma<1024>((const bf16*)(ws + WS_XB0), (const bf16*)(ws + WS_WIN) + (size_t)L * NZ * DM, row0, col0, C, a1);
#pragma unroll
        for (int r = 0; r < 4; ++r) { const size_t row = (size_t)(row0 + 16 * rt + 4 * g + r); const float rs = __builtin_amdgcn_rsqf(rowss[row] * (1.0f / 1024.0f) + 1e-6f);
#pragma unroll
            for (int j = 0; j < 2; ++j) Z[row * NZ + col0 + 32 * ch + 16 * j + r16] = (bf16)(pk2(a1[j][r] * rs, 0.f) & 0xffffu); } }
}
__global__ void __launch_bounds__(NTHREADS, 2) mk_fwd(Params Pval) {
    extern __shared__ __attribute__((aligned(16))) unsigned char lds_raw[];
    LAS unsigned char* lds = (LAS unsigned char*)lds_raw;
    volatile LAS unsigned* MISC = (volatile LAS unsigned*)(lds + MISC_OFF);
    const int wave_s = __builtin_amdgcn_readfirstlane((int)threadIdx.x >> 6);
    for (int u = wave_s * 64 + hw_lane(); u < (LDS_BYTES - RING_BYTES) / 4; u += NTHREADS) ((LAS unsigned*)(lds + RING_BYTES))[u] = 0u;
    __syncthreads();
    const int lo = Pval.ph_lo, hi = Pval.ph_hi;
    XcdBarrier bar; bar.bar = (unsigned*)(Pval.ws + WS_CTL) + CW_BAR + Pval.li * XCD_BAR_WORDS; bar.x = 0; bar.st = MISC + 8;
    if (hi - lo > 1) bar = xcd_barrier_post(bar.bar, MISC + 8, wave_s == 0 && hw_lane() == 0);
#ifndef STEPSEL
#define STEPSEL(j) true
#endif
#define IN(k) (lo <= (k) && (k) < hi)
#ifndef DUPMASK
#define DUPMASK 0
#endif
#ifndef XBAR2
#define XBAR2 0
#endif
#ifndef MINI2
#define MINI2 0
#endif
#ifndef DUPMODE
#define DUPMODE 3
#endif
#ifndef CSEL
#define CSEL 15
#endif
#define INL(j) (STEPSEL(j) && IN(pb + (j)))
#define NREP(j) (((DUPMASK) >> (j)) & 1 ? 2 : 1)
#define SEAM(k) do { if (IN((k) + 1)) { XcdBarrier b2_ = bar; asm volatile("" : "+s"(b2_.bar), "+s"(b2_.x)); int t0_ = wave_s * 64 + hw_lane(salt_); asm volatile("" : "+v"(t0_)); xcd_barrier(b2_, t0_ == 0); if (XBAR2) xcd_barrier(b2_, t0_ == 0); } } while (0)
#define PH_ENTER() PK P = phase_args(); const Ctx C = phase_ctx(lds, wave_s, salt_); unsigned char* ws = P->ws; (void)ws; (void)C
    #ifndef PRODUP
#define PRODUP 1
#endif
    const int salt_ = 0;
    if (STEPSEL(-1) && IN(0)) { for (int rep = 0; rep < PRODUP; ++rep) { PH_ENTER(); p0_prologue(P, C, 0, (LAS float*)(C.lds + C.wave * 16384)); __syncthreads(); } SEAM(0); }
#pragma unroll 1
    for (int L = 0; L < DEPTH; ++L) {
        const int pb = 1 + 8 * L; const int salt_ = pb;
        if (INL(0)) {
            if (blockIdx.x & 2) for (int rm = 0; rm < (MINI2 ? 2 : 1); ++rm) { PH_ENTER(); mini_inproj_gates(P, C, L); }
            for (int rep = 0; rep < NREP(0); ++rep) { PH_ENTER();
            pg8::Gemm g{(const bf16*)(ws + WS_XB0), (const bf16*)(ws + WS_WIN) + (size_t)L * NZ * DM, MT, NZ, DM}; InProjOrder S; S.init(C.nblk, C.blk);
            EpiZ E{ws, P->out, L == 0 ? (const float*)(ws + WS_ROWSS0) : (const float*)(ws + WS_CTL) + CW_ROWSS1, P->in[I_QG] + L * 64, P->in[I_KG] + L * 64, L, lds + XPOSE_OFF};
            pg8::gemm_phase<EpiZ, InProjOrder, true, true>(lds, g, S, E, C.tid); }
            if (!(blockIdx.x & 2)) for (int rm = 0; rm < (MINI2 ? 2 : 1); ++rm) { PH_ENTER(); mini_inproj_gates(P, C, L); }
            SEAM(pb + 0); }
        if (INL(1)) { for (int rep = 0; rep < NREP(1); ++rep) { PH_ENTER(); (void)P; (void)C; }   }
        if (INL(2)) { for (int rep = 0; rep < NREP(2); ++rep) { PH_ENTER(); phase_c(P, C, L, rep == 0 ? 15 : CSEL); __syncthreads(); } SEAM(pb + 2); }
        if (INL(3)) { for (int rep = 0; rep < NREP(3); ++rep) { PH_ENTER(); phase_d(P, C, L, rep == 0 ? 3 : DUPMODE); __syncthreads(); } SEAM(pb + 3); }
        if (INL(4)) {   }
        if (INL(5)) {
            for (int rep = 0; rep < NREP(5); ++rep) {
            { PH_ENTER(); mini_oproj(P, C, L); }
            { PH_ENTER(); pg8::StaticOrder S; S.init(MP, DM, C.nblk, C.blk);
              pg8::Gemm g{(const bf16*)(ws + WS_OGR), (const bf16*)(ws + WS_WOR) + (size_t)L * DM * 512, MP, DM, 512}; EpiGate<0> E{(const bf16*)(ws + WS_Z), ZC_GR, (bf16*)(ws + WS_TMP), (bf16*)(ws + WS_MB)};
              pg8::gemm_phase<EpiGate<0>, pg8::StaticOrder, true, true>(lds, g, S, E, C.tid); }
            { PH_ENTER(); pg8::StaticOrder S; S.init(MP, DM, C.nblk, C.blk);
              pg8::Gemm g{(const bf16*)(ws + WS_OGA), (const bf16*)(ws + WS_WOA) + (size_t)L * DM * 512, MP, DM, 512}; EpiGate<1> E{(const bf16*)(ws + WS_Z), ZC_GA, (bf16*)(ws + WS_TMP), (bf16*)(ws + WS_MB)};
              pg8::gemm_phase<EpiGate<1>, pg8::StaticOrder, true, true>(lds, g, S, E, C.tid); } }
            SEAM(pb + 5); }
        if (INL(6)) {
            for (int rep = 0; rep < NREP(6); ++rep) {
            { PH_ENTER(); mini_wout(P, C, L); }
            { PH_ENTER(); pg8::StaticOrder S; S.init(MP, DM, C.nblk, C.blk);
            pg8::Gemm g{(const bf16*)(ws + WS_MB), (const bf16*)(ws + WS_WOUT) + (size_t)L * DM * DM, MP, DM, DM};
            EpiRes E{P->in[I_XP], P->in[I_XS], L == 0 ? (const bf16*)nullptr : (const bf16*)(ws + WS_XB0), (bf16*)(ws + WS_XB1)};
            pg8::gemm_phase<EpiRes, pg8::StaticOrder, true, true>(lds, g, S, E, C.tid); } }
            SEAM(pb + 6); }
        if (INL(7)) {
            for (int rep = 0; rep < NREP(7); ++rep) {
            { PH_ENTER(); mini_ple(P, C, L, rep == NREP(7) - 1); }
            { PH_ENTER(); pg8::StaticOrder S; S.init(MP, DM, C.nblk, C.blk);
              pg8::Gemm g{(const bf16*)(ws + WS_XB1), (const bf16*)(ws + WS_WPG) + (size_t)L * DM * DM, MP, DM, DM}; EpiPle<0> E{(bf16*)(ws + WS_TMP), (const bf16*)(ws + WS_XB1), nullptr, (bf16*)(ws + WS_XB0), nullptr};
              pg8::gemm_phase<EpiPle<0>, pg8::StaticOrder, true, true>(lds, g, S, E, C.tid); }
            if (L + 1 < DEPTH) { PH_ENTER(); pg8::StaticOrder S; S.init(MP, DM, C.nblk, C.blk);
                pg8::Gemm g{(const bf16*)(ws + WS_PB) + (size_t)L * MT * 256, (const bf16*)(ws + WS_WPP) + (size_t)L * DM * 256, MP, DM, 256};
                EpiPle<1> E{(bf16*)(ws + WS_TMP), (const bf16*)(ws + WS_XB1), P->out, (bf16*)(ws + WS_XB0), (float*)(ws + WS_CTL) + CW_ROWSS1};
                pg8::gemm_phase<EpiPle<1>, pg8::StaticOrder, true, true>(lds, g, S, E, C.tid); }
            else { PH_ENTER(); pg8::StaticOrder S; S.init(MP, DM, C.nblk, C.blk);
                pg8::Gemm g{(const bf16*)(ws + WS_PB) + (size_t)L * MT * 256, (const bf16*)(ws + WS_WPP) + (size_t)L * DM * 256, MP, DM, 256};
                EpiPle<2> E{(bf16*)(ws + WS_TMP), (const bf16*)(ws + WS_XB1), P->out, (bf16*)(ws + WS_XB0), (float*)(ws + WS_CTL) + CW_ROWSS1};
                pg8::gemm_phase<EpiPle<2>, pg8::StaticOrder, true, true>(lds, g, S, E, C.tid); } }
            SEAM(pb + 7); }
    }
#undef IN
#undef INL
#undef SEAM
#undef PH_ENTER
}

#ifndef MK_N_LAUNCHES
#define MK_N_LAUNCHES 1
#endif
extern "C" void kernel_launch(void* const* d_in, const int* in_sizes, int n_in, void* d_out, int out_size, void* d_ws, size_t ws_size, hipStream_t stream) {
    static int grid = 0;
    if (grid == 0) {
        if (n_in != 18 || out_size != (int)O_END || ws_size < WS_END) { fprintf(stderr, "kernel_launch: unexpected problem: n_in %d out %d ws %zu; nothing launched\n", n_in, out_size, ws_size); grid = -1; return; }
        int dev = 0, cus = 0, per_cu = 0;
        if (hipGetDevice(&dev) != hipSuccess || hipDeviceGetAttribute(&cus, hipDeviceAttributeMultiprocessorCount, dev) != hipSuccess) { grid = -1; return; }
        if (hipFuncSetAttribute((const void*)mk_fwd, hipFuncAttributeMaxDynamicSharedMemorySize, LDS_BYTES) != hipSuccess) { fprintf(stderr, "kernel_launch: hipFuncSetAttribute failed\n"); grid = -1; return; }
        if (hipOccupancyMaxActiveBlocksPerMultiprocessor(&per_cu, (const void*)mk_fwd, NTHREADS, LDS_BYTES) != hipSuccess || per_cu < 1) { fprintf(stderr, "kernel_launch: occupancy query says %d blocks per CU\n", per_cu); grid = -1; (void)hipGetLastError(); return; }
        grid = cus;
    }
    if (grid < 0) return;
    (void)hipMemsetAsync((char*)d_ws + WS_CTL, 0, CTL_ZERO_BYTES, stream);
    Params a{};
    for (int i = 0; i < 18; ++i) a.in[i] = (const float*)d_in[i];
    a.out = (float*)d_out; a.ws = (unsigned char*)d_ws;
#if MK_N_LAUNCHES == 1
    a.ph_lo = 0; a.ph_hi = N_PHASES; a.li = 0;
    hipLaunchKernelGGL(mk_fwd, dim3(grid), dim3(NTHREADS), LDS_BYTES, stream, a);
#else
    for (int li = 0; li < N_PHASES; ++li) { a.ph_lo = li; a.ph_hi = li + 1; a.li = 0; hipLaunchKernelGGL(mk_fwd, dim3(grid), dim3(NTHREADS), LDS_BYTES, stream, a); }
#endif
    (void)in_sizes;
}
```
